# Optimizing an MI355X kernel written in HIP

```python
import jax
import jax.numpy as jnp
from jax import lax
import numpy as np

D_MODEL = 1024
BATCH = 8
SEQ = 4096
DEPTH = 1

D_MIX = D_MODEL
D_ATT = D_MIX // 2
ATT_HEAD_DIM = 64
ATT_HEADS = D_ATT // ATT_HEAD_DIM
D_MLSTM = D_MIX - D_ATT
MLSTM_HEADS = 4
MLSTM_HEAD_DIM = D_MLSTM // MLSTM_HEADS
IN_WIDTH = 3 * D_ATT + 4 * D_MLSTM + 2 * MLSTM_HEADS

MOBA_BLOCK = 256
MOBA_TOPK = 3
MOBA_Q_CHUNK = 32
ROPE_THETA = 10000.0

MLSTM_CHUNK = 128
CONV_WIDTH = 4

N_GROUPS = 4
EXPERTS_PER_GROUP = 8
N_EXPERTS = N_GROUPS * EXPERTS_PER_GROUP
TOP_K_EXPERTS = 2
D_EXPERT = 512
MOE_BLOCK_ROWS = 256

NORM_EPS = 1e-6
NEG_INF = -1e30

kernel_name = "hymba_moba_mlstm_hmoe_layer"


def rms_norm(x, g):
    xf = x.astype(jnp.float32)
    y = xf * lax.rsqrt(jnp.mean(xf * xf, axis=-1, keepdims=True) + NORM_EPS)
    return (y * g.astype(jnp.float32)).astype(x.dtype)


def head_rms_norm(h, g, n_heads):
    b, s, w = h.shape
    hf = h.astype(jnp.float32).reshape(b, s, n_heads, w // n_heads)
    hf = hf * lax.rsqrt(jnp.mean(hf * hf, axis=-1, keepdims=True) + NORM_EPS)
    return (hf.reshape(b, s, w) * g.astype(jnp.float32)).astype(h.dtype)


def modulate(x, g, shift, scale):
    return rms_norm(x, g) * (1.0 + scale[:, None, :]) + shift[:, None, :]


def split_heads(t, n_heads):
    b, s, w = t.shape
    return t.reshape(b, s, n_heads, w // n_heads).transpose(0, 2, 1, 3)


def merge_heads(t):
    b, h, s, d = t.shape
    return t.transpose(0, 2, 1, 3).reshape(b, s, h * d)


def rope(t, positions):
    half = t.shape[-1] // 2
    inv_freq = ROPE_THETA ** (-jnp.arange(half, dtype=jnp.float32) / half)
    ang = positions.astype(jnp.float32)[:, None, :, None] * inv_freq
    cos, sin = jnp.cos(ang), jnp.sin(ang)
    tf = t.astype(jnp.float32)
    t1, t2 = tf[..., :half], tf[..., half:]
    return jnp.concatenate([t1 * cos - t2 * sin, t2 * cos + t1 * sin], axis=-1).astype(t.dtype)


def moba_attention(q, k, v):
    b, h, s, dh = q.shape
    nb = -(-s // MOBA_BLOCK)
    s_pad = nb * MOBA_BLOCK
    pad = ((0, 0), (0, 0), (0, s_pad - s), (0, 0))
    kb = jnp.pad(k, pad).reshape(b, h, nb, MOBA_BLOCK, dh)
    vb = jnp.pad(v, pad).reshape(b, h, nb, MOBA_BLOCK, dh)
    scale = dh ** -0.5

    k_mean = jnp.mean(kb.astype(jnp.float32), axis=3)
    gate = jnp.einsum('bhsd,bhnd->bhsn', q.astype(jnp.float32), k_mean)
    q_blk = jnp.arange(s) // MOBA_BLOCK
    past = jnp.arange(nb)[None, :] < q_blk[:, None]
    gate = jnp.where(past, gate, NEG_INF)
    topk = min(MOBA_TOPK, nb)
    _, sel = lax.top_k(gate, topk)
    sel_valid = sel < q_blk[:, None]

    nqc = s // MOBA_Q_CHUNK

    def to_chunks(t):
        t = t.reshape((b, h, nqc, MOBA_Q_CHUNK) + t.shape[3:])
        return jnp.moveaxis(t, 2, 0)

    bi = jnp.arange(b)[:, None, None]
    hi = jnp.arange(h)[None, :, None]

    def chunk(args):
        q_c, sel_c, valid_c, ci = args
        start = ci * MOBA_Q_CHUNK
        j = start // MOBA_BLOCK
        k_own = lax.dynamic_index_in_dim(kb, j, axis=2, keepdims=False)
        v_own = lax.dynamic_index_in_dim(vb, j, axis=2, keepdims=False)
        q_pos = start + jnp.arange(MOBA_Q_CHUNK)
        k_pos = j * MOBA_BLOCK + jnp.arange(MOBA_BLOCK)
        causal = k_pos[None, :] <= q_pos[:, None]
        qf = q_c.astype(jnp.float32) * scale
        s_own = jnp.where(causal, jnp.einsum('bhqd,bhkd->bhqk', qf, k_own.astype(jnp.float32)), NEG_INF)
        scores = [s_own]
        for r in range(topk):
            k_r = kb[bi, hi, sel_c[..., r]]
            s_r = jnp.einsum('bhqd,bhqkd->bhqk', qf, k_r.astype(jnp.float32))
            scores.append(jnp.where(valid_c[..., r, None], s_r, NEG_INF))
        s_all = jnp.stack(scores, axis=3)
        p = jax.nn.softmax(s_all.reshape(b, h, MOBA_Q_CHUNK, -1), axis=-1).reshape(s_all.shape)
        out = jnp.einsum('bhqk,bhkd->bhqd', p[..., 0, :], v_own.astype(jnp.float32))
        for r in range(topk):
            v_r = vb[bi, hi, sel_c[..., r]]
            out = out + jnp.einsum('bhqk,bhqkd->bhqd', p[..., r + 1, :], v_r.astype(jnp.float32))
        return out.astype(v.dtype)

    out = lax.map(chunk, (to_chunks(q), to_chunks(sel), to_chunks(sel_valid),
                          jnp.arange(nqc, dtype=jnp.int32)))
    return jnp.moveaxis(out, 0, 2).reshape(b, h, s, dh)


def mlstm_chunkwise(q, k, v, i_pre, f_pre):
    b, nh, s, dh = q.shape
    L = MLSTM_CHUNK
    nc = s // L
    q = q.reshape(b, nh, nc, L, dh)
    k = k.reshape(b, nh, nc, L, dh)
    v = v.reshape(b, nh, nc, L, dh)
    logf = jax.nn.log_sigmoid(f_pre).reshape(b, nh, nc, L)
    ig = i_pre.reshape(b, nh, nc, L)
    cum = jnp.cumsum(logf, axis=-1)
    a = cum[..., -1]

    g = a[..., None] - cum + ig
    m_loc = jnp.max(g, axis=-1)
    w = jnp.exp(g - m_loc[..., None])
    c_loc = jnp.einsum('bhcs,bhcse,bhcsd->bhced', w, v, k)
    n_loc = jnp.einsum('bhcs,bhcsd->bhcd', w, k)

    def step(carry, inp):
        c_st, n_st, m_st = carry
        a_c, m_loc_c, c_loc_c, n_loc_c = inp
        m_new = jnp.maximum(a_c + m_st, m_loc_c)
        s_prev = jnp.exp(a_c + m_st - m_new)
        s_loc = jnp.exp(m_loc_c - m_new)
        c_new = s_prev[..., None, None] * c_st + s_loc[..., None, None] * c_loc_c
        n_new = s_prev[..., None] * n_st + s_loc[..., None] * n_loc_c
        return (c_new, n_new, m_new), (c_st, n_st, m_st)

    init = (jnp.zeros((b, nh, dh, dh), jnp.float32),
            jnp.zeros((b, nh, dh), jnp.float32),
            jnp.zeros((b, nh), jnp.float32))
    xs = (jnp.moveaxis(a, 2, 0), jnp.moveaxis(m_loc, 2, 0),
          jnp.moveaxis(c_loc, 2, 0), jnp.moveaxis(n_loc, 2, 0))
    _, (c_prev, n_prev, m_prev) = lax.scan(step, init, xs)
    c_prev = jnp.moveaxis(c_prev, 0, 2)
    n_prev = jnp.moveaxis(n_prev, 0, 2)
    m_prev = jnp.moveaxis(m_prev, 0, 2)

    causal = jnp.tril(jnp.ones((L, L), dtype=bool))
    dmat = jnp.where(causal, cum[..., :, None] - cum[..., None, :] + ig[..., None, :], NEG_INF)
    inter = cum + m_prev[..., None]
    m_t = jnp.maximum(inter, jnp.max(dmat, axis=-1))
    s_qk = jnp.einsum('bhctd,bhcsd->bhcts', q, k) * jnp.exp(dmat - m_t[..., None])
    w_inter = jnp.exp(inter - m_t)
    num = (jnp.einsum('bhcts,bhcse->bhcte', s_qk, v)
           + w_inter[..., None] * jnp.einsum('bhced,bhctd->bhcte', c_prev, q))
    den = jnp.sum(s_qk, axis=-1) + w_inter * jnp.einsum('bhcd,bhctd->bhct', n_prev, q)
    h = num / jnp.maximum(jnp.abs(den), jnp.exp(-m_t))[..., None]
    return h.reshape(b, nh, s, dh)


def causal_conv(u, w, bias):
    ch = u.shape[-1]
    out = lax.conv_general_dilated(u, w[:, None, :], window_strides=(1,),
                                   padding=[(CONV_WIDTH - 1, 0)],
                                   dimension_numbers=('NWC', 'WIO', 'NWC'),
                                   feature_group_count=ch)
    return out + bias


def hier_moe(h, w_rg, b_rg, w_re, b_re, w1, w3, w2):
    t, d = h.shape
    gp = jax.nn.softmax((h @ w_rg + b_rg).astype(jnp.float32), axis=-1)
    g_w, g_idx = lax.top_k(gp, 1)
    el = (h @ w_re + b_re).astype(jnp.float32).reshape(t, N_GROUPS, EXPERTS_PER_GROUP)
    el_sel = jnp.take_along_axis(el, g_idx[:, :, None], axis=1)[:, 0]
    ep = jax.nn.softmax(el_sel, axis=-1)
    e_w, e_loc = lax.top_k(ep, TOP_K_EXPERTS)
    weights = g_w * e_w / jnp.sum(e_w, axis=-1, keepdims=True)
    expert_id = g_idx * EXPERTS_PER_GROUP + e_loc

    n_assign = t * TOP_K_EXPERTS
    flat_e = expert_id.reshape(-1)
    flat_w = weights.reshape(-1)
    flat_tok = jnp.repeat(jnp.arange(t, dtype=jnp.int32), TOP_K_EXPERTS)
    order = jnp.argsort(flat_e)
    sorted_e = flat_e[order]
    counts = jnp.bincount(flat_e, length=N_EXPERTS)
    padded = ((counts + MOE_BLOCK_ROWS - 1) // MOE_BLOCK_ROWS) * MOE_BLOCK_ROWS
    pad_end = jnp.cumsum(padded)
    pad_start = pad_end - padded
    cnt_start = jnp.cumsum(counts) - counts
    dest = pad_start[sorted_e] + (jnp.arange(n_assign) - cnt_start[sorted_e])
    n_rows = n_assign + N_EXPERTS * MOE_BLOCK_ROWS
    n_blocks = n_rows // MOE_BLOCK_ROWS
    row_tok = jnp.zeros((n_rows,), jnp.int32).at[dest].set(flat_tok[order])
    row_w = jnp.zeros((n_rows,), jnp.float32).at[dest].set(flat_w[order])
    block_e = jnp.minimum(jnp.searchsorted(pad_end, jnp.arange(n_blocks) * MOE_BLOCK_ROWS, side='right'),
                          N_EXPERTS - 1)
    xs = h[row_tok].reshape(n_blocks, MOE_BLOCK_ROWS, d)

    def expert_block(args):
        xb, e = args
        return (jax.nn.silu(xb @ w1[e]) * (xb @ w3[e])) @ w2[e]

    ys = lax.map(expert_block, (xs, block_e)).reshape(n_rows, d)
    ys = ys * row_w[:, None].astype(h.dtype)
    return jnp.zeros((t, d), h.dtype).at[row_tok].add(ys)


def setup_inputs(seed: int = 0) -> dict:
    key = jax.random.key(seed)
    ks = jax.random.split(key, 24)

    def nrm(k, shape, scale):
        return jax.random.normal(k, shape, jnp.float32) * scale

    x = nrm(ks[0], (BATCH, SEQ, D_MODEL), 1.0)
    c = nrm(ks[1], (BATCH, D_MODEL), 1.0)
    positions = (jnp.arange(SEQ, dtype=jnp.int32)[None, :]
                 + jax.random.randint(ks[2], (BATCH, 1), 0, 1024, dtype=jnp.int32))
    w_ada = nrm(ks[3], (DEPTH, D_MODEL, 6 * D_MODEL), 0.5 * D_MODEL ** -0.5)
    b_ada = nrm(ks[4], (DEPTH, 6 * D_MODEL), 0.02)
    norm1_g = 1.0 + nrm(ks[5], (DEPTH, D_MODEL), 0.02)
    w_in = nrm(ks[6], (DEPTH, D_MODEL, IN_WIDTH), D_MODEL ** -0.5)
    b_gate = jnp.concatenate([
        nrm(ks[7], (DEPTH, MLSTM_HEADS), 0.1),
        jnp.linspace(3.0, 6.0, MLSTM_HEADS, dtype=jnp.float32)[None, :]
        + nrm(ks[8], (DEPTH, MLSTM_HEADS), 0.1)], axis=-1)
    conv_w = nrm(ks[9], (DEPTH, CONV_WIDTH, 2 * D_MLSTM), CONV_WIDTH ** -0.5)
    conv_b = nrm(ks[10], (DEPTH, 2 * D_MLSTM), 0.02)
    attn_out_g = 1.0 + nrm(ks[11], (DEPTH, D_ATT), 0.02)
    mlstm_out_g = 1.0 + nrm(ks[12], (DEPTH, D_MLSTM), 0.02)
    w_out = nrm(ks[13], (DEPTH, D_MIX, D_MODEL), D_MIX ** -0.5)
    norm2_g = 1.0 + nrm(ks[14], (DEPTH, D_MODEL), 0.02)
    w_rg = nrm(ks[15], (DEPTH, D_MODEL, N_GROUPS), D_MODEL ** -0.5)
    b_rg = nrm(ks[16], (DEPTH, N_GROUPS), 0.01)
    w_re = nrm(ks[17], (DEPTH, D_MODEL, N_EXPERTS), D_MODEL ** -0.5)
    b_re = nrm(ks[18], (DEPTH, N_EXPERTS), 0.01)
    w1 = nrm(ks[19], (DEPTH, N_EXPERTS, D_MODEL, D_EXPERT), D_MODEL ** -0.5)
    w3 = nrm(ks[20], (DEPTH, N_EXPERTS, D_MODEL, D_EXPERT), D_MODEL ** -0.5)
    w2 = nrm(ks[21], (DEPTH, N_EXPERTS, D_EXPERT, D_MODEL), D_EXPERT ** -0.5)
    norm_f_g = 1.0 + nrm(ks[22], (D_MODEL,), 0.02)
    return {"x": x, "c": c, "positions": positions, "w_ada": w_ada, "b_ada": b_ada,
            "norm1_g": norm1_g, "w_in": w_in, "b_gate": b_gate, "conv_w": conv_w,
            "conv_b": conv_b, "attn_out_g": attn_out_g, "mlstm_out_g": mlstm_out_g,
            "w_out": w_out, "norm2_g": norm2_g, "w_rg": w_rg, "b_rg": b_rg,
            "w_re": w_re, "b_re": b_re, "w1": w1, "w3": w3, "w2": w2, "norm_f_g": norm_f_g}


def reference(x, c, positions, w_ada, b_ada, norm1_g, w_in, b_gate, conv_w, conv_b,
              attn_out_g, mlstm_out_g, w_out, norm2_g, w_rg, b_rg, w_re, b_re,
              w1, w3, w2, norm_f_g):
    b, s, d = x.shape
    offs = [D_ATT, 2 * D_ATT, 3 * D_ATT, 3 * D_ATT + 2 * D_MLSTM,
            3 * D_ATT + 3 * D_MLSTM, 3 * D_ATT + 4 * D_MLSTM]
    for l in range(DEPTH):
        mod = jax.nn.silu(c) @ w_ada[l] + b_ada[l]
        sh1, sc1, g1, sh2, sc2, g2 = jnp.split(mod, 6, axis=-1)

        h = modulate(x, norm1_g[l], sh1, sc1)
        proj = h @ w_in[l]
        q_a, k_a, v_a, qk_m, v_m, o_m, gates = jnp.split(proj, offs, axis=-1)

        qa = rope(split_heads(q_a, ATT_HEADS), positions)
        ka = rope(split_heads(k_a, ATT_HEADS), positions)
        attn = merge_heads(moba_attention(qa, ka, split_heads(v_a, ATT_HEADS)))
        attn = head_rms_norm(attn, attn_out_g[l], ATT_HEADS)

        qk_m = jax.nn.silu(causal_conv(qk_m, conv_w[l], conv_b[l]))
        q_m, k_m = jnp.split(qk_m, 2, axis=-1)
        gates = gates.astype(jnp.float32) + b_gate[l].astype(jnp.float32)
        i_pre = jnp.transpose(gates[..., :MLSTM_HEADS], (0, 2, 1))
        f_pre = jnp.transpose(gates[..., MLSTM_HEADS:], (0, 2, 1))
        hm = mlstm_chunkwise(split_heads(q_m, MLSTM_HEADS).astype(jnp.float32),
                             split_heads(k_m, MLSTM_HEADS).astype(jnp.float32) * MLSTM_HEAD_DIM ** -0.5,
                             split_heads(v_m, MLSTM_HEADS).astype(jnp.float32),
                             i_pre, f_pre)
        hm = head_rms_norm(merge_heads(hm), mlstm_out_g[l], MLSTM_HEADS)
        hm = (hm * jax.nn.sigmoid(o_m.astype(jnp.float32))).astype(x.dtype)

        y = jnp.concatenate([attn.astype(x.dtype), hm], axis=-1) @ w_out[l]
        x = x + g1[:, None, :] * y

        h2 = modulate(x, norm2_g[l], sh2, sc2)
        moe = hier_moe(h2.reshape(b * s, d), w_rg[l], b_rg[l], w_re[l], b_re[l],
                       w1[l], w3[l], w2[l]).reshape(b, s, d)
        x = x + g2[:, None, :] * moe
    return rms_norm(x, norm_f_g)
```

```cpp
#include <hip/hip_runtime.h>
#include <cstdio>
#include <cstdint>
#include <cmath>

#define LAS __attribute__((address_space(3)))
#define GAS __attribute__((address_space(1)))
typedef _Float16 f16;
typedef _Float16 f16x8 __attribute__((ext_vector_type(8)));
typedef _Float16 f16x4 __attribute__((ext_vector_type(4)));
typedef _Float16 f16x2 __attribute__((ext_vector_type(2)));
typedef float f32x4 __attribute__((ext_vector_type(4)));
typedef float f32x2 __attribute__((ext_vector_type(2)));
typedef unsigned u32x4 __attribute__((ext_vector_type(4)));
typedef unsigned u32x2 __attribute__((ext_vector_type(2)));

constexpr int NB = 8, SEQ = 4096, DM = 1024, T = NB * SEQ;
constexpr int NPROJ = 3584, NPROJ_SRC = 3592;
constexpr int C_QA = 0, C_KA = 512, C_VA = 1024, C_QM = 1536, C_KM = 2048, C_VM = 2560, C_OM = 3072;
constexpr int NEXP = 32, DEXP = 512, LISTCAP = 32768;
constexpr float EPS = 1e-6f;
constexpr float C2 = 0.125f * 1.4426950408889634f;
constexpr int NWAVES = 8, NTHR = 512;

constexpr size_t MiB = 1u << 20;
constexpr size_t WS_CTL = 0, CTL_ZERO_BYTES = 1 * MiB;
constexpr int CW_BAR = 4096;
constexpr int CW_CNT = 8192;
constexpr size_t CTL_KMEAN = 256 * 1024;
constexpr size_t WS_MOD = 1 * MiB, WS_GATES = 2 * MiB, WS_POS = 3 * MiB, WS_COS = 4 * MiB, WS_SIN = 8 * MiB, WS_LIST = 12 * MiB;
constexpr size_t WS_WIN = 20 * MiB, WS_WOUT = 27 * MiB, WS_W1 = 29 * MiB, WS_W3 = 61 * MiB, WS_W2 = 93 * MiB;
constexpr size_t WS_A = 126 * MiB;
constexpr size_t WS_PROJ = 190 * MiB;
constexpr size_t WS_H2 = 190 * MiB;
constexpr size_t WS_HID = 254 * MiB;
constexpr size_t WS_Y = 320 * MiB;
constexpr size_t WS_END = 450 * MiB;

constexpr int RING_BYTES = 131072;
constexpr int LDSCTL_OFF = RING_BYTES, MISC_OFF = LDSCTL_OFF + 320, TAB_OFF = LDSCTL_OFF + 1024;
constexpr int LDS_BYTES = 147456;

#define RLX_AGENT __ATOMIC_RELAXED, __HIP_MEMORY_SCOPE_AGENT
#define LDS_WAIT() asm volatile("s_waitcnt lgkmcnt(0)" ::: "memory")
__device__ __forceinline__ unsigned pk2h(float a, float b) { f16x2 v = {(f16)a, (f16)b}; return __builtin_bit_cast(unsigned, v); }
__device__ __forceinline__ float wave_sum(float v) {
#pragma unroll
    for (int o = 1; o < 64; o <<= 1) v += __shfl_xor(v, o);
    return v;
}
__device__ __forceinline__ float sigmoidf_(float x) { return 1.f / (1.f + __expf(-x)); }

#define XB_TMO      128
#define XB_XCNT(j)  (256  + 64 * (j))
#define XB_XSUB(j)  (1280 + 64 * (j))
#define XB_XGEN(j)  (2304 + 64 * (j))
#define XB_TOP      3328
#define XB_TOPGEN   3392
#define XCD_BAR_WORDS 3456
#define XB_SPIN_CAP (1u << 22)
__device__ __forceinline__ unsigned xb_ld(unsigned* p)              { return __hip_atomic_load(p, __ATOMIC_RELAXED, __HIP_MEMORY_SCOPE_AGENT); }
__device__ __forceinline__ unsigned xb_add(unsigned* p, unsigned v) { return __hip_atomic_fetch_add(p, v, __ATOMIC_RELAXED, __HIP_MEMORY_SCOPE_AGENT); }
__device__ __forceinline__ unsigned xb_xcc_id() { return (unsigned)__builtin_amdgcn_s_getreg((3 << 11) | 20) & 0xFu; }
#define XB_SPIN(cond, bar) do { unsigned _sp = 0; while (cond) { __builtin_amdgcn_s_sleep(1); \
    if ((++_sp & 255u) == 0u) { if (xb_ld(&(bar)[XB_TMO])) break; if (_sp > XB_SPIN_CAP) { atomicAdd(&(bar)[XB_TMO], 1u); break; } } } } while (0)
struct XcdBarrier { unsigned* bar; unsigned x; volatile LAS unsigned* st; };
__device__ __forceinline__ XcdBarrier xcd_barrier_post(unsigned* bar, volatile LAS unsigned* st) {
    XcdBarrier b; b.bar = bar; b.x = xb_xcc_id(); b.st = st;
    if (threadIdx.x == 0) (void)xb_add(&bar[XB_XCNT(b.x)], 1u);
    return b;
}
__device__ __forceinline__ void xcd_barrier_complete(unsigned* bar, unsigned x, unsigned& nloc, unsigned& nx) {
    const unsigned G = gridDim.x * gridDim.y * gridDim.z;
    unsigned sum, cnt, mine, sp = 0u;
    for (;;) {
        sum = 0u; cnt = 0u; mine = 0u;
#pragma unroll
        for (unsigned j = 0; j < 16; ++j) { const unsigned c = xb_ld(&bar[XB_XCNT(j)]); sum += c; cnt += (c > 0u) ? 1u : 0u; mine = (j == x) ? c : mine; }
        if (sum == G) break;
        __builtin_amdgcn_s_sleep(1);
        if ((++sp & 255u) == 0u) { if (xb_ld(&bar[XB_TMO])) break; if (sp > XB_SPIN_CAP) { atomicAdd(&bar[XB_TMO], 1u); break; } }
    }
    nloc = mine > 0u ? mine : 1u; nx = cnt > 0u ? cnt : 1u;
}
__device__ __forceinline__ void xcd_barrier(const XcdBarrier& b) {
    asm volatile("s_waitcnt vmcnt(0)" ::: "memory");
    __syncthreads();
    if (threadIdx.x == 0) {
        unsigned* bar = b.bar;
        __builtin_amdgcn_s_waitcnt(0);
        unsigned nloc = b.st[0], nx = b.st[1];
        if (nloc == 0u) { xcd_barrier_complete(bar, b.x, nloc, nx); b.st[0] = nloc; b.st[1] = nx; }
        const unsigned old = xb_add(&bar[XB_XSUB(b.x)], 1u);
        const unsigned gen = old / nloc;
        if (old + 1u == (gen + 1u) * nloc) {
            __builtin_amdgcn_fence(__ATOMIC_RELEASE, "agent");
            asm volatile("s_waitcnt vmcnt(0)" ::: "memory");
            const unsigned og = xb_add(&bar[XB_TOP], 1u);
            const unsigned tg = og / nx;
            if (og + 1u == (tg + 1u) * nx) xb_add(&bar[XB_TOPGEN], 1u);
            else XB_SPIN(xb_ld(&bar[XB_TOPGEN]) == tg, bar);
            __builtin_amdgcn_fence(__ATOMIC_ACQUIRE, "agent");
            xb_add(&bar[XB_XGEN(b.x)], 1u);
            asm volatile("s_waitcnt vmcnt(0)" ::: "memory");
        } else {
            XB_SPIN(xb_ld(&bar[XB_XGEN(b.x)]) == gen, bar);
            __builtin_amdgcn_fence(__ATOMIC_ACQUIRE, "agent");
            asm volatile("s_waitcnt vmcnt(0)" ::: "memory");
        }
    }
    __syncthreads();
}

namespace pg8 {
constexpr int BM = 256, BK = 64, HALF = 128, HTB = HALF * BK * 2, STAGE_BYTES = 8 * HTB;
__host__ __device__ __forceinline__ int lds_byte(int r, int c) { const int st = (r >> 4) * 2 + (c >> 5), rr = r & 15, cc = c & 31, ob = rr * 64 + cc * 2; return st * 1024 + (ob ^ (((ob >> 9) & 1) << 5)); }
__host__ __device__ __forceinline__ void stage_rc(int b, int& R, int& C) { const int st = b / 1024, sb = b % 1024, swz = sb ^ (((sb >> 9) & 1) << 5); R = (st >> 1) * 16 + swz / 64; C = (st & 1) * 32 + (swz % 64) / 2; }
__host__ __device__ __forceinline__ int perm32(int rho) { const int n = rho >> 4, i = rho & 15; return 8 * (i >> 2) + 4 * n + (i & 3); }

struct Unit { size_t b0, b1; int pm, pn, e, row0, rows; };

template <bool ROPE, class Epi, class Sched>
__device__ __forceinline__ void gemm_phase(LAS unsigned char* lds, const char* Abase, const char* Bbase, const int K, const Sched& S, const Epi& E) {
    int tid = threadIdx.x; asm volatile("" : "+v"(tid));
    const int wid = __builtin_amdgcn_readfirstlane(tid >> 6), lane = tid & 63, wr = wid >> 2, wc = wid & 3, fr = lane & 15, fq = lane >> 4;
    const int nt = K / BK;
    int R[2], C[2]; unsigned voffB[2];
#pragma unroll
    for (int i = 0; i < 2; ++i) { stage_rc(tid * 16 + i * 8192, R[i], C[i]);
        const int Rb = ROPE ? (64 * (R[i] >> 5) + perm32(R[i] & 31)) : ((R[i] & ~31) + perm32(R[i] & 31));
        voffB[i] = (unsigned)(Rb * K + C[i]) * 2u; }
    const size_t kstep = (size_t)(BK * 2);
    const unsigned ldsw = (unsigned)wid * 1024u;
    const int aoff = lds_byte(wr * 64 + fr, fq * 8), boff = lds_byte(wc * 32 + fr, fq * 8);
#define PG8_SA(b, h) (((b) * 2 + (h)) * HTB)
#define PG8_SB(b, h) ((4 + (b) * 2 + (h)) * HTB)
#define PG8_STG(bufoff, gbase, voff) do { _Pragma("unroll") for (int _i = 0; _i < 2; ++_i) \
        __builtin_amdgcn_global_load_lds((const unsigned*)((const char*)(gbase) + (voff)[_i]), (LAS unsigned*)(lds + (bufoff) + ldsw + _i * 8192), 16, 0, 0); } while (0)
#define PG8_LDA(dst, b, h) do { _Pragma("unroll") for (int m = 0; m < 4; ++m) _Pragma("unroll") for (int k = 0; k < 2; ++k) dst[m][k] = *(const LAS f16x8*)(lds + PG8_SA(b, h) + aoff + m * 2048 + k * 1024); } while (0)
#define PG8_LDB(dst, b, h) do { _Pragma("unroll") for (int n = 0; n < 2; ++n) _Pragma("unroll") for (int k = 0; k < 2; ++k) dst[n][k] = *(const LAS f16x8*)(lds + PG8_SB(b, h) + boff + n * 2048 + k * 1024); } while (0)
#define PG8_MMA(ai, bj, At, Bt) do { __builtin_amdgcn_s_setprio(1); _Pragma("unroll") for (int m = 0; m < 4; ++m) _Pragma("unroll") for (int n = 0; n < 2; ++n) _Pragma("unroll") for (int k = 0; k < 2; ++k) \
        acc[ai][bj][m][n] = __builtin_amdgcn_mfma_f32_16x16x32_f16(Bt[n][k], At[m][k], acc[ai][bj][m][n], 0, 0, 0); __builtin_amdgcn_s_setprio(0); } while (0)
#define PG8_WAIT_V(n) asm volatile("s_waitcnt vmcnt(" #n ")" ::: "memory")
#define PG8_WAIT_L(n) asm volatile("s_waitcnt lgkmcnt(" #n ")" ::: "memory")
#define PG8_BAR __builtin_amdgcn_s_barrier()
#define PG8_SCHED __builtin_amdgcn_sched_barrier(0)
    Unit cur, nxt; int ui = 0;
    if (!S.next(0, cur)) return;
    f32x4 acc[2][2][4][2];
#pragma unroll
    for (int a = 0; a < 2; ++a)
#pragma unroll
        for (int b = 0; b < 2; ++b)
#pragma unroll
            for (int m = 0; m < 4; ++m)
#pragma unroll
                for (int n = 0; n < 2; ++n) acc[a][b][m][n] = (f32x4){0.f, 0.f, 0.f, 0.f};
    f16x8 At[4][2], B0[2][2], B1[2][2];
    unsigned cvA[2][2], nvA[2][2];
    S.avoff(cur, cvA, R, C);
    const char* cB0 = Bbase + cur.b0; const char* cB1 = Bbase + cur.b1;
    PG8_STG(PG8_SB(0, 0), cB0, voffB); PG8_STG(PG8_SB(0, 1), cB1, voffB); PG8_STG(PG8_SA(0, 0), Abase, cvA[0]); PG8_STG(PG8_SA(0, 1), Abase, cvA[1]);
    if (wr == 1) PG8_BAR;
    PG8_WAIT_V(2); PG8_BAR;
    PG8_STG(PG8_SB(1, 0), cB0 + kstep, voffB); PG8_STG(PG8_SA(1, 0), Abase + kstep, cvA[0]); PG8_STG(PG8_SB(1, 1), cB1 + kstep, voffB);
    PG8_WAIT_V(6); PG8_BAR;
    for (;;) {
        const bool has_next = S.next(ui + 1, nxt);
        if (has_next) S.avoff(nxt, nvA, R, C);
        else {
#pragma unroll
            for (int h = 0; h < 2; ++h)
#pragma unroll
                for (int i = 0; i < 2; ++i) nvA[h][i] = cvA[h][i];
        }
        const char* nB0 = has_next ? Bbase + nxt.b0 : cB0; const char* nB1 = has_next ? Bbase + nxt.b1 : cB1;
        for (int t = 0; t < nt; t += 2) {
            const bool last = (t == nt - 2);
            const char* a1 = Abase + (size_t)(t + 1) * kstep;
            const size_t k2 = last ? (size_t)0 : (size_t)(t + 2) * kstep;
            const char* a2 = Abase + k2; const char* a3 = a2 + kstep;
            const char* b20 = (last ? nB0 : cB0) + k2; const char* b21 = (last ? nB1 : cB1) + k2;
            const char* b30 = b20 + kstep; const char* b31 = b21 + kstep;
            unsigned vA2[2][2];
#pragma unroll
            for (int h = 0; h < 2; ++h)
#pragma unroll
                for (int i = 0; i < 2; ++i) vA2[h][i] = last ? nvA[h][i] : cvA[h][i];
            PG8_LDB(B0, 0, 0); PG8_LDB(B1, 0, 1); PG8_SCHED; PG8_LDA(At, 0, 0); PG8_STG(PG8_SA(1, 1), a1, cvA[1]);
            PG8_WAIT_V(8); PG8_WAIT_L(0); PG8_BAR; PG8_MMA(0, 0, At, B0); PG8_MMA(0, 1, At, B1); PG8_BAR; PG8_SCHED;
            PG8_LDA(At, 0, 1); PG8_STG(PG8_SB(0, 0), b20, voffB); PG8_STG(PG8_SB(0, 1), b21, voffB); PG8_STG(PG8_SA(0, 0), a2, vA2[0]);
            PG8_WAIT_V(8); PG8_WAIT_L(0); PG8_BAR; PG8_MMA(1, 0, At, B0); PG8_MMA(1, 1, At, B1); PG8_BAR; PG8_SCHED;
            PG8_LDB(B0, 1, 0); PG8_LDB(B1, 1, 1); PG8_SCHED; PG8_LDA(At, 1, 0); PG8_STG(PG8_SA(0, 1), a2, vA2[1]);
            PG8_WAIT_V(8); PG8_WAIT_L(0); PG8_BAR; PG8_MMA(0, 0, At, B0); PG8_MMA(0, 1, At, B1); PG8_BAR; PG8_SCHED;
            PG8_LDA(At, 1, 1); PG8_STG(PG8_SB(1, 0), b30, voffB); PG8_STG(PG8_SB(1, 1), b31, voffB); PG8_STG(PG8_SA(1, 0), a3, vA2[0]);
            PG8_WAIT_V(8); PG8_WAIT_L(0); PG8_BAR; PG8_MMA(1, 0, At, B0); PG8_MMA(1, 1, At, B1); PG8_BAR; PG8_SCHED;
        }
        if (wr == 0) PG8_BAR;
        E(acc, cur, wr, wc, fr, fq);
        if (!has_next) break;
#pragma unroll
        for (int a = 0; a < 2; ++a)
#pragma unroll
            for (int b = 0; b < 2; ++b)
#pragma unroll
                for (int m = 0; m < 4; ++m)
#pragma unroll
                    for (int n = 0; n < 2; ++n) acc[a][b][m][n] = (f32x4){0.f, 0.f, 0.f, 0.f};
        cur = nxt; cB0 = nB0; cB1 = nB1; ++ui;
#pragma unroll
        for (int h = 0; h < 2; ++h)
#pragma unroll
            for (int i = 0; i < 2; ++i) cvA[h][i] = nvA[h][i];
        if (wr == 1) PG8_BAR;
    }
    PG8_WAIT_V(0);
    PG8_BAR;
#undef PG8_SA
#undef PG8_SB
#undef PG8_STG
#undef PG8_LDA
#undef PG8_LDB
#undef PG8_MMA
#undef PG8_WAIT_V
#undef PG8_WAIT_L
#undef PG8_BAR
#undef PG8_SCHED
}

struct DenseSched {
    int nM, nN, nwg, G, c, K; bool rope;
    __device__ __forceinline__ void init(int M, int N, int K_, int G_, int c_, bool rope_) { nM = M / BM; nN = N / BM; nwg = nM * nN; G = G_; c = c_; K = K_; rope = rope_; }
    __device__ __forceinline__ bool next(int i, Unit& u) const {
        const long L = (long)i * G + c; if (L >= nwg) return false;
        int wgid = (int)L; { const int q = nwg / 8, r = nwg % 8, xcd = wgid % 8, off = wgid / 8; wgid = (xcd < r ? xcd * (q + 1) : r * (q + 1) + (xcd - r) * q) + off; }
        const int WGM = 8, nig = WGM * nN, gid = wgid / nig, fm = gid * WGM, gsz = (nM - fm) < WGM ? (nM - fm) : WGM;
        u.pm = fm + ((wgid % nig) % gsz); u.pn = (wgid % nig) / gsz; u.e = 0; u.row0 = u.pm * BM; u.rows = BM;
        u.b0 = (size_t)(u.pn * BM) * K * 2; u.b1 = u.b0 + (size_t)(rope ? 32 : 128) * K * 2;
        return true;
    }
    __device__ __forceinline__ void avoff(const Unit& u, unsigned (&vo)[2][2], const int (&R)[2], const int (&C)[2]) const {
#pragma unroll
        for (int h = 0; h < 2; ++h)
#pragma unroll
            for (int i = 0; i < 2; ++i) vo[h][i] = (unsigned)((u.row0 + 128 * h + R[i]) * K + C[i]) * 2u;
    }
};
struct MoeSched {
    const LAS int* tab; int G, cv, K; bool gather; const int* list; size_t bstep, bhalf;
    __device__ __forceinline__ bool next(int i, Unit& u) const {
        const int L = i * G + cv; if (L >= tab[32]) return false;
        int e = 0;
#pragma unroll 1
        for (int k = 1; k < 32; ++k) if (tab[k] <= L) e = k;
        const int local = L - tab[e]; u.e = e; u.pm = local >> 2; u.pn = local & 3;
        const int cnt = tab[80 + e]; u.rows = min(256, cnt - u.pm * 256); u.row0 = tab[40 + e] + u.pm * 256;
        if (gather) { u.b0 = ((size_t)e * 512 + 128 * u.pn) * 1024 * 2; u.b1 = u.b0 + (WS_W3 - WS_W1); }
        else        { u.b0 = ((size_t)e * 1024 + 256 * u.pn) * 512 * 2; u.b1 = u.b0 + (size_t)128 * 512 * 2; }
        return true;
    }
    __device__ __forceinline__ void avoff(const Unit& u, unsigned (&vo)[2][2], const int (&R)[2], const int (&C)[2]) const {
#pragma unroll
        for (int h = 0; h < 2; ++h)
#pragma unroll
            for (int i = 0; i < 2; ++i) {
                if (gather) { int r = 128 * h + R[i]; r = r < u.rows ? r : u.rows - 1; const int tok = list[2 * ((size_t)u.e * LISTCAP + u.pm * 256 + r)];
                    vo[h][i] = (unsigned)(tok * 1024 + C[i]) * 2u; }
                else vo[h][i] = (unsigned)((u.row0 + 128 * h + R[i]) * 512 + C[i]) * 2u;
            }
    }
};

struct EpiProj {
    f16* proj; const float* cosT; const float* sinT; float* ksum;
    __device__ __forceinline__ void operator()(const f32x4 (&acc)[2][2][4][2], const Unit& u, int wr, int wc, int fr, int fq) const {
        const int tile = u.pn, row0 = u.row0 + wr * 64 + fr, col0 = tile * 256 + 64 * wc + 8 * fq;
        if (tile < 4) {
            const float sc = tile < 2 ? C2 : 1.f;
            float ks[2][8];
#pragma unroll
            for (int bj = 0; bj < 2; ++bj)
#pragma unroll
                for (int j = 0; j < 8; ++j) ks[bj][j] = 0.f;
#pragma unroll
            for (int ai = 0; ai < 2; ++ai)
#pragma unroll
                for (int m = 0; m < 4; ++m) {
                    const int row = row0 + ai * HALF + m * 16;
                    const f32x4 c0 = *(const f32x4*)(cosT + (size_t)row * 32 + 8 * fq), c1 = *(const f32x4*)(cosT + (size_t)row * 32 + 8 * fq + 4);
                    const f32x4 s0 = *(const f32x4*)(sinT + (size_t)row * 32 + 8 * fq), s1 = *(const f32x4*)(sinT + (size_t)row * 32 + 8 * fq + 4);
                    const f32x4 a0 = acc[ai][0][m][0], a1 = acc[ai][0][m][1], b0 = acc[ai][1][m][0], b1 = acc[ai][1][m][1];
                    const f32x4 o10 = (a0 * c0 - b0 * s0) * sc, o11 = (a1 * c1 - b1 * s1) * sc;
                    const f32x4 o20 = (b0 * c0 + a0 * s0) * sc, o21 = (b1 * c1 + a1 * s1) * sc;
                    u32x4 w1, w2;
                    w1.x = pk2h(o10[0], o10[1]); w1.y = pk2h(o10[2], o10[3]); w1.z = pk2h(o11[0], o11[1]); w1.w = pk2h(o11[2], o11[3]);
                    w2.x = pk2h(o20[0], o20[1]); w2.y = pk2h(o20[2], o20[3]); w2.z = pk2h(o21[0], o21[1]); w2.w = pk2h(o21[2], o21[3]);
                    f16* rp = proj + (size_t)row * NPROJ + col0;
                    *(u32x4*)rp = w1; *(u32x4*)(rp + 32) = w2;
                    if (tile >= 2) {
#pragma unroll
                        for (int j = 0; j < 4; ++j) { ks[0][j] += o10[j]; ks[0][4 + j] += o11[j]; ks[1][j] += o20[j]; ks[1][4 + j] += o21[j]; }
                    }
                }
            if (tile >= 2) {
                const int b = u.pm >> 4, blk = u.pm & 15, head = (tile - 2) * 4 + wc;
                float* kp = ksum + ((size_t)((b * 8 + head) * 16 + blk)) * 64 + 8 * fq;
#pragma unroll
                for (int bj = 0; bj < 2; ++bj)
#pragma unroll
                    for (int j = 0; j < 8; ++j) { float v = ks[bj][j]; v += __shfl_xor(v, 1); v += __shfl_xor(v, 2); v += __shfl_xor(v, 4); v += __shfl_xor(v, 8);
                        if (fr == 0) atomicAdd(kp + 32 * bj + j, v); }
            }
        } else {
#pragma unroll
            for (int ai = 0; ai < 2; ++ai)
#pragma unroll
                for (int m = 0; m < 4; ++m) {
                    f16* rp = proj + (size_t)(row0 + ai * HALF + m * 16) * NPROJ + col0;
#pragma unroll
                    for (int bj = 0; bj < 2; ++bj) { const f32x4 v0 = acc[ai][bj][m][0], v1 = acc[ai][bj][m][1]; u32x4 w;
                        w.x = pk2h(v0[0], v0[1]); w.y = pk2h(v0[2], v0[3]); w.z = pk2h(v1[0], v1[1]); w.w = pk2h(v1[2], v1[3]);
                        *(u32x4*)(rp + 32 * bj) = w; }
                }
        }
    }
};
struct EpiOut {
    const float* x; const float* mod; float* x1;
    __device__ __forceinline__ void operator()(const f32x4 (&acc)[2][2][4][2], const Unit& u, int wr, int wc, int fr, int fq) const {
        const int row0 = u.row0 + wr * 64 + fr, col0 = u.pn * BM + wc * 32 + 8 * fq, b = u.row0 / SEQ;
        const float* g1 = mod + (size_t)b * 6144 + 2048;
#pragma unroll
        for (int bj = 0; bj < 2; ++bj) {
            const f32x4 g0 = *(const f32x4*)(g1 + col0 + bj * HALF), gg1 = *(const f32x4*)(g1 + col0 + bj * HALF + 4);
#pragma unroll
            for (int ai = 0; ai < 2; ++ai)
#pragma unroll
                for (int m = 0; m < 4; ++m) { const size_t off = (size_t)(row0 + ai * HALF + m * 16) * DM + col0 + bj * HALF;
                    const f32x4 x0 = *(const f32x4*)(x + off), xx1 = *(const f32x4*)(x + off + 4);
                    *(f32x4*)(x1 + off) = x0 + g0 * acc[ai][bj][m][0]; *(f32x4*)(x1 + off + 4) = xx1 + gg1 * acc[ai][bj][m][1]; }
        }
    }
};
struct EpiMoe1 {
    f16* H;
    __device__ __forceinline__ void operator()(const f32x4 (&acc)[2][2][4][2], const Unit& u, int wr, int wc, int fr, int fq) const {
        const int r0 = wr * 64 + fr, col0 = u.pn * 128 + wc * 32 + 8 * fq;
#pragma unroll
        for (int ai = 0; ai < 2; ++ai)
#pragma unroll
            for (int m = 0; m < 4; ++m) { const int r = r0 + ai * HALF + m * 16;
                float o[8];
#pragma unroll
                for (int n = 0; n < 2; ++n)
#pragma unroll
                    for (int j = 0; j < 4; ++j) { const float a = acc[ai][0][m][n][j], bb = acc[ai][1][m][n][j]; o[4 * n + j] = a / (1.f + __expf(-a)) * bb; }
                u32x4 w; w.x = pk2h(o[0], o[1]); w.y = pk2h(o[2], o[3]); w.z = pk2h(o[4], o[5]); w.w = pk2h(o[6], o[7]);
                if (r < u.rows) *(u32x4*)(H + (size_t)(u.row0 + r) * DEXP + col0) = w; }
    }
};
struct EpiMoe2 {
    f16* Y; const int* list;
    __device__ __forceinline__ void operator()(const f32x4 (&acc)[2][2][4][2], const Unit& u, int wr, int wc, int fr, int fq) const {
        const int r0 = wr * 64 + fr, col0 = u.pn * BM + wc * 32 + 8 * fq;
#pragma unroll
        for (int ai = 0; ai < 2; ++ai)
#pragma unroll
            for (int m = 0; m < 4; ++m) { const int r = r0 + ai * HALF + m * 16;
                if (r < u.rows) {
                    const float w = __int_as_float(list[2 * ((size_t)u.e * LISTCAP + u.pm * 256 + r) + 1]);
#pragma unroll
                    for (int bj = 0; bj < 2; ++bj) { const f32x4 v0 = acc[ai][bj][m][0] * w, v1 = acc[ai][bj][m][1] * w; u32x4 o;
                        o.x = pk2h(v0[0], v0[1]); o.y = pk2h(v0[2], v0[3]); o.z = pk2h(v1[0], v1[1]); o.w = pk2h(v1[2], v1[3]);
                        *(u32x4*)(Y + (size_t)(u.row0 + r) * DM + col0 + bj * HALF) = o; }
                } }
    }
};
}

struct Args { const void* in[22]; float* out; unsigned char* ws; };
struct Frame {
    LAS unsigned char* lds; int tid, lane, wave, vcu, G;
    __device__ __forceinline__ void fresh() { int t = threadIdx.x; asm volatile("" : "+v"(t)); tid = t; lane = t & 63; wave = __builtin_amdgcn_readfirstlane(t >> 6); }
    const float *x, *c, *w_ada, *b_ada, *norm1_g, *w_in, *b_gate, *conv_w, *conv_b, *attn_g, *mlstm_g, *w_out, *norm2_g, *w_rg, *b_rg, *w_re, *b_re, *w1, *w3, *w2, *normf_g;
    const int* positions; float* out; unsigned char* ws;
};

__device__ __forceinline__ void p0_transpose_item(const float* W, int K, int ldw, int nblk, f16* WT, LAS float* scr, int item, int lane) {
    const int kb = item / nblk, nb = item % nblk, k0 = 64 * kb, n0 = 32 * nb;
#pragma unroll 8
    for (int i = 0; i < 32; ++i) { const int kk = 2 * i + (lane >> 5); scr[kk * 33 + (lane & 31)] = W[(size_t)(k0 + kk) * ldw + n0 + (lane & 31)]; }
    LDS_WAIT(); asm volatile("" ::: "memory");
    const int c = lane & 7;
#pragma unroll
    for (int j = 0; j < 4; ++j) { const int n = (lane >> 3) + 8 * j; const LAS float* s = scr + (8 * c) * 33 + n;
        u32x4 o; o.x = pk2h(s[0 * 33], s[1 * 33]); o.y = pk2h(s[2 * 33], s[3 * 33]); o.z = pk2h(s[4 * 33], s[5 * 33]); o.w = pk2h(s[6 * 33], s[7 * 33]);
        *(GAS u32x4*)(WT + (size_t)(n0 + n) * K + k0 + 8 * c) = o; }
    LDS_WAIT(); asm volatile("" ::: "memory");
}

__device__ __forceinline__ void p0_prologue(Frame F) {
    F.fresh();
    LAS float* sc = (LAS float*)F.lds; LAS float* part = (LAS float*)(F.lds + 32768);
    float* mod = (float*)(F.ws + WS_MOD);
    if ((int)blockIdx.x < 192) {
        for (int i = F.tid; i < 8 * 1024; i += NTHR) { const float v = F.c[i]; sc[i] = v / (1.f + __expf(-v)); }
        __syncthreads();
        for (int jb = blockIdx.x; jb < 192; jb += F.G) {
            const int jj = F.tid & 31, kc = F.tid >> 5, j0 = jb * 32;
            float a[8];
#pragma unroll
            for (int b = 0; b < 8; ++b) a[b] = 0.f;
            for (int kk = 0; kk < 64; ++kk) { const int k = kc * 64 + kk; const float w = F.w_ada[(size_t)k * 6144 + j0 + jj];
#pragma unroll
                for (int b = 0; b < 8; ++b) a[b] += sc[b * 1024 + k] * w; }
#pragma unroll
            for (int b = 0; b < 8; ++b) part[(kc * 8 + b) * 32 + jj] = a[b];
            __syncthreads();
            if (F.tid < 256) { const int b = F.tid >> 5; float s = F.b_ada[j0 + jj];
                for (int k2 = 0; k2 < 16; ++k2) s += part[(k2 * 8 + b) * 32 + jj];
                mod[(size_t)b * 6144 + j0 + jj] = s; }
            __syncthreads();
        }
    }
    __syncthreads();
    LAS float* scr = (LAS float*)(F.lds + F.wave * 16384);
    const int gw = F.vcu * NWAVES + F.wave, NGW = F.G * NWAVES;
    constexpr int I_IN = 16 * 112, I_OUT = 16 * 32, I_E13 = 16 * 16, I_E2 = 8 * 32;
    constexpr int NITEMS = I_IN + I_OUT + NEXP * (2 * I_E13 + I_E2);
    for (int it = gw; it < NITEMS; it += NGW) {
        int r = it;
        if (r < I_IN) { p0_transpose_item(F.w_in, 1024, NPROJ_SRC, 112, (f16*)(F.ws + WS_WIN), scr, r, F.lane); continue; } r -= I_IN;
        if (r < I_OUT) { p0_transpose_item(F.w_out, 1024, 1024, 32, (f16*)(F.ws + WS_WOUT), scr, r, F.lane); continue; } r -= I_OUT;
        const int per = 2 * I_E13 + I_E2, e = r / per; r -= e * per;
        if (r < I_E13) { p0_transpose_item(F.w1 + (size_t)e * 1024 * 512, 1024, 512, 16, (f16*)(F.ws + WS_W1) + (size_t)e * 512 * 1024, scr, r, F.lane); continue; } r -= I_E13;
        if (r < I_E13) { p0_transpose_item(F.w3 + (size_t)e * 1024 * 512, 1024, 512, 16, (f16*)(F.ws + WS_W3) + (size_t)e * 512 * 1024, scr, r, F.lane); continue; } r -= I_E13;
        p0_transpose_item(F.w2 + (size_t)e * 512 * 1024, 512, 1024, 32, (f16*)(F.ws + WS_W2) + (size_t)e * 1024 * 512, scr, r, F.lane);
    }
}

__device__ __forceinline__ void p1_rows(Frame F) {
    F.fresh();
    const int gw = F.vcu * NWAVES + F.wave, NGW = F.G * NWAVES;
    const float* mod = (const float*)(F.ws + WS_MOD);
    f16* hbuf = (f16*)(F.ws + WS_A); float* gates = (float*)(F.ws + WS_GATES);
    float* cosT = (float*)(F.ws + WS_COS); float* sinT = (float*)(F.ws + WS_SIN);
    for (int row = gw; row < T; row += NGW) {
        const int b = row / SEQ;
        const GAS f32x4* xr = (const GAS f32x4*)(F.x + (size_t)row * DM) + F.lane;
        f32x4 v[4]; float ss = 0.f;
#pragma unroll
        for (int j = 0; j < 4; ++j) { v[j] = xr[64 * j]; ss += (v[j].x * v[j].x + v[j].y * v[j].y) + (v[j].z * v[j].z + v[j].w * v[j].w); }
        const float rstd = 1.f / sqrtf(wave_sum(ss) * (1.f / DM) + EPS);
        float ga[8];
#pragma unroll
        for (int q = 0; q < 8; ++q) ga[q] = 0.f;
        GAS u32x2* o8 = (GAS u32x2*)(hbuf + (size_t)row * DM) + F.lane;
#pragma unroll
        for (int j = 0; j < 4; ++j) {
            const int k0 = 4 * F.lane + 256 * j;
            const f32x4 g = *(const f32x4*)(F.norm1_g + k0), sh = *(const f32x4*)(mod + (size_t)b * 6144 + k0), scl = *(const f32x4*)(mod + (size_t)b * 6144 + 1024 + k0);
            const f32x4 h = v[j] * rstd * g * (scl + 1.f) + sh;
            u32x2 w; w.x = pk2h(h[0], h[1]); w.y = pk2h(h[2], h[3]); o8[64 * j] = w;
#pragma unroll
            for (int i = 0; i < 4; ++i) { const float* wp = F.w_in + (size_t)(k0 + i) * NPROJ_SRC + NPROJ; const f32x4 w0 = *(const f32x4*)wp, w1 = *(const f32x4*)(wp + 4);
                ga[0] += h[i] * w0[0]; ga[1] += h[i] * w0[1]; ga[2] += h[i] * w0[2]; ga[3] += h[i] * w0[3];
                ga[4] += h[i] * w1[0]; ga[5] += h[i] * w1[1]; ga[6] += h[i] * w1[2]; ga[7] += h[i] * w1[3]; }
        }
#pragma unroll
        for (int q = 0; q < 8; ++q) ga[q] = wave_sum(ga[q]);
        if (F.lane == 0) {
#pragma unroll
            for (int q = 0; q < 8; ++q) gates[(size_t)row * 8 + q] = ga[q] + F.b_gate[q];
        }
        if (F.lane < 32) { const float invf = exp2f(-(float)F.lane * (13.287712379549449f / 32.f)); const float ang = (float)F.positions[row] * invf;
            cosT[(size_t)row * 32 + F.lane] = cosf(ang); sinT[(size_t)row * 32 + F.lane] = sinf(ang); }
    }
}

__device__ __forceinline__ void p3_attn_simple(Frame F) {
    F.fresh();
    const f16* proj = (const f16*)(F.ws + WS_PROJ); const float* ksum = (const float*)(F.ws + WS_CTL + CTL_KMEAN); f16* mix = (f16*)(F.ws + WS_A);
    for (int u = blockIdx.x; u < 64 * 8; u += F.G) {
        const int bh = u >> 3, chunk = u & 7, b = bh >> 3, h = bh & 7;
        const int q = chunk * 512 + F.tid, jb = q >> 8, row = b * SEQ + q;
        float qv[64];
        { const f16x8* qp = (const f16x8*)(proj + (size_t)row * NPROJ + C_QA + h * 64);
#pragma unroll
          for (int i = 0; i < 8; ++i) { const f16x8 t = qp[i];
#pragma unroll
              for (int k = 0; k < 8; ++k) qv[8 * i + k] = (float)t[k]; } }
        unsigned sel = 0u;
        { float g[16];
#pragma unroll
          for (int n = 0; n < 16; ++n) { float s = 0.f;
              if (n < jb) { const float* kp = ksum + ((size_t)bh * 16 + n) * 64;
#pragma unroll
                  for (int d = 0; d < 64; ++d) s += qv[d] * kp[d]; }
              g[n] = (n < jb) ? s : -INFINITY; }
#pragma unroll
          for (int r = 0; r < 3; ++r) { float best = -INFINITY; int bi = -1;
#pragma unroll
              for (int n = 0; n < 16; ++n) { const bool ok = !((sel >> n) & 1u) && g[n] > best; best = ok ? g[n] : best; bi = ok ? n : bi; }
              if (bi >= 0) sel |= 1u << bi; } }
        float m = -INFINITY, l = 0.f, acc[64];
#pragma unroll
        for (int d = 0; d < 64; ++d) acc[d] = 0.f;
        for (int n = 0; n <= jb; ++n) {
            const bool own = (n == jb), act = own || ((sel >> n) & 1u);
            for (int kk = 0; kk < 256; ++kk) {
                const bool on = act && (!own || kk <= (q & 255));
                if (!__any(on)) break;
                const size_t krow = (size_t)(b * SEQ + n * 256 + kk) * NPROJ;
                const f16x8* kp = (const f16x8*)(proj + krow + C_KA + h * 64);
                float s = 0.f;
#pragma unroll
                for (int i = 0; i < 8; ++i) { const f16x8 t = kp[i];
#pragma unroll
                    for (int k = 0; k < 8; ++k) s += qv[8 * i + k] * (float)t[k]; }
                if (on) {
                    const float mn = fmaxf(m, s), f = exp2f(m - mn), p = exp2f(s - mn);
                    const f16x8* vp = (const f16x8*)(proj + krow + C_VA + h * 64);
                    l = l * f + p; m = mn;
#pragma unroll
                    for (int i = 0; i < 8; ++i) { const f16x8 t = vp[i];
#pragma unroll
                        for (int k = 0; k < 8; ++k) acc[8 * i + k] = acc[8 * i + k] * f + p * (float)t[k]; }
                }
            }
        }
        const float il = 1.f / l; float ss = 0.f;
#pragma unroll
        for (int d = 0; d < 64; ++d) { acc[d] *= il; ss += acc[d] * acc[d]; }
        const float rs = 1.f / sqrtf(ss * (1.f / 64.f) + EPS);
        u32x4* op = (u32x4*)(mix + (size_t)row * DM + h * 64);
#pragma unroll
        for (int i = 0; i < 8; ++i) { float o[8];
#pragma unroll
            for (int k = 0; k < 8; ++k) o[k] = acc[8 * i + k] * rs * F.attn_g[h * 64 + 8 * i + k];
            u32x4 w; w.x = pk2h(o[0], o[1]); w.y = pk2h(o[2], o[3]); w.z = pk2h(o[4], o[5]); w.w = pk2h(o[6], o[7]); op[i] = w; }
    }
}

__device__ __forceinline__ void p3_mlstm_simple(Frame F) {
    F.fresh();
    const f16* proj = (const f16*)(F.ws + WS_PROJ); const float* gates = (const float*)(F.ws + WS_GATES); f16* mix = (f16*)(F.ws + WS_A);
    LAS float* qs = (LAS float*)F.lds; LAS float* ks = qs + 128; LAS float* vs = qs + 256; LAS float* red = qs + 384;
    for (int bh = blockIdx.x; bh < 32; bh += F.G) {
        const int b = bh >> 2, hm = bh & 3, e = F.tid >> 2, dq = F.tid & 3;
        float Cs[32], nn[32], m = 0.f;
#pragma unroll
        for (int j = 0; j < 32; ++j) { Cs[j] = 0.f; nn[j] = 0.f; }
        const float og = F.mlstm_g[hm * 128 + e];
        for (int t = 0; t < SEQ; ++t) {
            const int row = b * SEQ + t;
            if (F.tid < 256) {
                const bool isk = F.tid >= 128; const int d = F.tid & 127, col = (isk ? C_KM : C_QM) + hm * 128 + d, cc = (isk ? 512 : 0) + hm * 128 + d;
                float val = F.conv_b[cc];
#pragma unroll
                for (int j = 0; j < 4; ++j) { const int tt = t - 3 + j; if (tt >= 0) val += (float)proj[(size_t)(b * SEQ + tt) * NPROJ + col] * F.conv_w[j * 1024 + cc]; }
                val = val / (1.f + __expf(-val));
                if (isk) ks[d] = val * 0.08838834764831845f; else qs[d] = val;
            } else if (F.tid < 384) { const int d = F.tid - 256; vs[d] = (float)proj[(size_t)row * NPROJ + C_VM + hm * 128 + d]; }
            const float ig = gates[(size_t)row * 8 + hm], fg = gates[(size_t)row * 8 + 4 + hm];
            __syncthreads();
            const float logf = fminf(fg, 0.f) - log1pf(__expf(-fabsf(fg)));
            const float mn = fmaxf(logf + m, ig), a = __expf(logf + m - mn), bb = __expf(ig - mn); m = mn;
            const float ve = vs[e] * bb; float pn = 0.f, pd = 0.f;
#pragma unroll
            for (int j = 0; j < 32; ++j) { const int d = 32 * dq + j; const float kd = ks[d], qd = qs[d];
                Cs[j] = a * Cs[j] + ve * kd; nn[j] = a * nn[j] + bb * kd; pn += Cs[j] * qd; pd += nn[j] * qd; }
            pn += __shfl_xor(pn, 1); pn += __shfl_xor(pn, 2); pd += __shfl_xor(pd, 1); pd += __shfl_xor(pd, 2);
            const float hv = pn / fmaxf(fabsf(pd), __expf(-m));
            const float sq = wave_sum(dq == 0 ? hv * hv : 0.f);
            if (F.lane == 0) red[F.wave] = sq;
            __syncthreads();
            float tot = 0.f;
#pragma unroll
            for (int w = 0; w < 8; ++w) tot += red[w];
            if (dq == 0) { const float om = (float)proj[(size_t)row * NPROJ + C_OM + hm * 128 + e];
                const float o = hv / sqrtf(tot * (1.f / 128.f) + EPS) * og * sigmoidf_(om);
                mix[(size_t)row * DM + 512 + hm * 128 + e] = (f16)o; }
            __syncthreads();
        }
    }
}

__device__ __forceinline__ void p5_route(Frame F) {
    F.fresh();
    const int gw = F.vcu * NWAVES + F.wave, NGW = F.G * NWAVES;
    const float* mod = (const float*)(F.ws + WS_MOD);
    f16* h2 = (f16*)(F.ws + WS_H2); int* list = (int*)(F.ws + WS_LIST); int* pos2 = (int*)(F.ws + WS_POS);
    unsigned* cnt = (unsigned*)(F.ws + WS_CTL) + CW_CNT;
    for (int row = gw; row < T; row += NGW) {
        const int b = row / SEQ;
        const GAS f32x4* xr = (const GAS f32x4*)(F.out + (size_t)row * DM) + F.lane;
        f32x4 v[4]; float ss = 0.f;
#pragma unroll
        for (int j = 0; j < 4; ++j) { v[j] = xr[64 * j]; ss += (v[j].x * v[j].x + v[j].y * v[j].y) + (v[j].z * v[j].z + v[j].w * v[j].w); }
        const float rstd = 1.f / sqrtf(wave_sum(ss) * (1.f / DM) + EPS);
        float lg[36];
#pragma unroll
        for (int q = 0; q < 36; ++q) lg[q] = 0.f;
        GAS u32x2* o8 = (GAS u32x2*)(h2 + (size_t)row * DM) + F.lane;
        const float* wgp = F.w_rg + (size_t)F.lane * 16; const float* wep = F.w_re + (size_t)F.lane * 128;
        const float* gp = F.norm2_g + 4 * F.lane; const float* mp = mod + (size_t)b * 6144 + 3072 + 4 * F.lane;
#pragma unroll 1
        for (int j = 0; j < 4; ++j) {
            const f32x4 g = *(const f32x4*)gp, sh = *(const f32x4*)mp, scl = *(const f32x4*)(mp + 1024);
            const f32x4 h = v[0] * rstd * g * (scl + 1.f) + sh;
            v[0] = v[1]; v[1] = v[2]; v[2] = v[3];
            u32x2 w; w.x = pk2h(h[0], h[1]); w.y = pk2h(h[2], h[3]); *o8 = w;
#pragma unroll
            for (int i = 0; i < 4; ++i) {
                const f32x4 wg = *(const f32x4*)(wgp + 4 * i);
#pragma unroll
                for (int q = 0; q < 4; ++q) lg[q] += h[i] * wg[q];
#pragma unroll
                for (int q4 = 0; q4 < 8; ++q4) { const f32x4 we = *(const f32x4*)(wep + 32 * i + 4 * q4);
#pragma unroll
                    for (int q = 0; q < 4; ++q) lg[4 + 4 * q4 + q] += h[i] * we[q]; }
            }
            wgp += 256 * 4; wep += 256 * 32; gp += 256; mp += 256; o8 += 64;
            asm volatile("" ::: "memory");
        }
#pragma unroll
        for (int q = 0; q < 36; ++q) lg[q] = wave_sum(lg[q]);
        float gl[4];
#pragma unroll
        for (int q = 0; q < 4; ++q) gl[q] = lg[q] + F.b_rg[q];
        int gi = 0; float gm = gl[0];
#pragma unroll
        for (int q = 1; q < 4; ++q) if (gl[q] > gm) { gm = gl[q]; gi = q; }
        float gsum = 0.f;
#pragma unroll
        for (int q = 0; q < 4; ++q) gsum += __expf(gl[q] - gm);
        const float pg = 1.f / gsum;
        float el[8];
#pragma unroll
        for (int q = 0; q < 8; ++q) { const float e0 = lg[4 + q], e1 = lg[12 + q], e2 = lg[20 + q], e3 = lg[28 + q]; el[q] = (gi == 0 ? e0 : gi == 1 ? e1 : gi == 2 ? e2 : e3) + F.b_re[gi * 8 + q]; }
        int i1 = 0; float m1 = el[0];
#pragma unroll
        for (int q = 1; q < 8; ++q) if (el[q] > m1) { m1 = el[q]; i1 = q; }
        int i2 = -1; float m2 = -INFINITY;
#pragma unroll
        for (int q = 0; q < 8; ++q) if (q != i1 && el[q] > m2) { m2 = el[q]; i2 = q; }
        const float r = __expf(m2 - m1), w1 = pg / (1.f + r), w2 = pg * r / (1.f + r);
        if (F.lane < 2) { const int e = gi * 8 + (F.lane == 0 ? i1 : i2); const float w = F.lane == 0 ? w1 : w2;
            const unsigned slot = atomicAdd(cnt + e, 1u);
            list[2 * ((size_t)e * LISTCAP + slot)] = row; list[2 * ((size_t)e * LISTCAP + slot) + 1] = __float_as_int(w);
            pos2[2 * row + F.lane] = e * LISTCAP + (int)slot; }
    }
}

__device__ __forceinline__ void moe_tables(Frame F) {
    F.fresh();
    LAS int* tab = (LAS int*)(F.lds + TAB_OFF);
    const unsigned* cnt = (const unsigned*)(F.ws + WS_CTL) + CW_CNT;
    __syncthreads();
    if (F.tid == 0) { int up = 0, rp = 0;
        for (int e = 0; e < 32; ++e) { const int c = (int)__hip_atomic_load(cnt + e, RLX_AGENT); tab[e] = up; tab[40 + e] = rp; tab[80 + e] = c; up += ((c + 255) >> 8) * 4; rp += c; }
        tab[32] = up; tab[72] = rp; }
    __syncthreads();
}

__device__ __forceinline__ void p8_final(Frame F) {
    F.fresh();
    const int gw = F.vcu * NWAVES + F.wave, NGW = F.G * NWAVES;
    const float* mod = (const float*)(F.ws + WS_MOD); const f16* Y = (const f16*)(F.ws + WS_Y); const int* pos2 = (const int*)(F.ws + WS_POS);
    const LAS int* tab = (const LAS int*)(F.lds + TAB_OFF);
    for (int row = gw; row < T; row += NGW) {
        const int b = row / SEQ; const int p0 = pos2[2 * row], p1 = pos2[2 * row + 1];
        const size_t y0 = (size_t)(tab[40 + (p0 >> 15)] + (p0 & 32767)) * DM, y1 = (size_t)(tab[40 + (p1 >> 15)] + (p1 & 32767)) * DM;
        GAS f32x4* xr = (GAS f32x4*)(F.out + (size_t)row * DM) + F.lane;
        f32x4 v[4]; float ss = 0.f;
#pragma unroll
        for (int j = 0; j < 4; ++j) { const int k0 = 4 * F.lane + 256 * j;
            const f16x4 a = *(const f16x4*)(Y + y0 + k0), c = *(const f16x4*)(Y + y1 + k0); const f32x4 g2 = *(const f32x4*)(mod + (size_t)b * 6144 + 5120 + k0);
            f32x4 s; s.x = (float)a[0] + (float)c[0]; s.y = (float)a[1] + (float)c[1]; s.z = (float)a[2] + (float)c[2]; s.w = (float)a[3] + (float)c[3];
            v[j] = xr[64 * j] + g2 * s; ss += (v[j].x * v[j].x + v[j].y * v[j].y) + (v[j].z * v[j].z + v[j].w * v[j].w); }
        const float rstd = 1.f / sqrtf(wave_sum(ss) * (1.f / DM) + EPS);
#pragma unroll
        for (int j = 0; j < 4; ++j) { const int k0 = 4 * F.lane + 256 * j; xr[64 * j] = v[j] * rstd * *(const f32x4*)(F.normf_g + k0); }
    }
}

__global__ void __launch_bounds__(NTHR, 2) fwd_kernel(Args args) {
    extern __shared__ __attribute__((aligned(16))) unsigned char lds_raw[];
    Frame F;
    F.lds = (LAS unsigned char*)lds_raw;
    F.tid = threadIdx.x; F.lane = F.tid & 63; F.wave = __builtin_amdgcn_readfirstlane(F.tid >> 6);
    F.G = gridDim.x; { const int bx = blockIdx.x; F.vcu = (F.G % 8 == 0) ? (bx % 8) * (F.G / 8) + bx / 8 : bx; }
    F.x = (const float*)args.in[0]; F.c = (const float*)args.in[1]; F.positions = (const int*)args.in[2]; F.w_ada = (const float*)args.in[3]; F.b_ada = (const float*)args.in[4];
    F.norm1_g = (const float*)args.in[5]; F.w_in = (const float*)args.in[6]; F.b_gate = (const float*)args.in[7]; F.conv_w = (const float*)args.in[8]; F.conv_b = (const float*)args.in[9];
    F.attn_g = (const float*)args.in[10]; F.mlstm_g = (const float*)args.in[11]; F.w_out = (const float*)args.in[12]; F.norm2_g = (const float*)args.in[13];
    F.w_rg = (const float*)args.in[14]; F.b_rg = (const float*)args.in[15]; F.w_re = (const float*)args.in[16]; F.b_re = (const float*)args.in[17];
    F.w1 = (const float*)args.in[18]; F.w3 = (const float*)args.in[19]; F.w2 = (const float*)args.in[20]; F.normf_g = (const float*)args.in[21];
    F.out = args.out; F.ws = args.ws;
    for (int u = F.tid; u < (LDS_BYTES - LDSCTL_OFF) / 4; u += NTHR) ((LAS unsigned*)(F.lds + LDSCTL_OFF))[u] = 0u;
    __syncthreads();
    unsigned* ctl = (unsigned*)(F.ws + WS_CTL);
    XcdBarrier bar = xcd_barrier_post(ctl + CW_BAR, (volatile LAS unsigned*)(F.lds + MISC_OFF) + 8);

    p0_prologue(F);
    xcd_barrier(bar);
    p1_rows(F);
    xcd_barrier(bar);
    { pg8::DenseSched S; S.init(T, NPROJ, 1024, F.G, (int)blockIdx.x, true);
      pg8::EpiProj E{(f16*)(F.ws + WS_PROJ), (const float*)(F.ws + WS_COS), (const float*)(F.ws + WS_SIN), (float*)(F.ws + WS_CTL + CTL_KMEAN)};
      pg8::gemm_phase<true>(F.lds, (const char*)(F.ws + WS_A), (const char*)(F.ws + WS_WIN), 1024, S, E); }
    xcd_barrier(bar);
    p3_mlstm_simple(F);
    p3_attn_simple(F);
    xcd_barrier(bar);
    { pg8::DenseSched S; S.init(T, DM, 1024, F.G, (int)blockIdx.x, false);
      pg8::EpiOut E{F.x, (const float*)(F.ws + WS_MOD), F.out};
      pg8::gemm_phase<false>(F.lds, (const char*)(F.ws + WS_A), (const char*)(F.ws + WS_WOUT), 1024, S, E); }
    xcd_barrier(bar);
    p5_route(F);
    xcd_barrier(bar);
    moe_tables(F);
    { pg8::MoeSched S{(const LAS int*)(F.lds + TAB_OFF), F.G, F.vcu, 1024, true, (const int*)(F.ws + WS_LIST), 0, 0};
      pg8::EpiMoe1 E{(f16*)(F.ws + WS_HID)};
      pg8::gemm_phase<false>(F.lds, (const char*)(F.ws + WS_H2), (const char*)(F.ws + WS_W1), 1024, S, E); }
    xcd_barrier(bar);
    { pg8::MoeSched S{(const LAS int*)(F.lds + TAB_OFF), F.G, F.vcu, 512, false, (const int*)(F.ws + WS_LIST), 0, 0};
      pg8::EpiMoe2 E{(f16*)(F.ws + WS_Y), (const int*)(F.ws + WS_LIST)};
      pg8::gemm_phase<false>(F.lds, (const char*)(F.ws + WS_HID), (const char*)(F.ws + WS_W2), 512, S, E); }
    xcd_barrier(bar);
    p8_final(F);
}

extern "C" void kernel_launch(void* const* d_in, const int* in_sizes, int n_in, void* d_out, int out_size, void* d_ws, size_t ws_size, hipStream_t stream) {
    static int grid = 0;
    if (grid == 0) {
        if (n_in != 22 || out_size != T * DM || ws_size < WS_END) { fprintf(stderr, "kernel_launch: unexpected problem (n_in %d, out %d, ws %zu)\n", n_in, out_size, ws_size); grid = -1; return; }
        int dev = 0, cus = 0, per_cu = 0;
        if (hipGetDevice(&dev) != hipSuccess || hipDeviceGetAttribute(&cus, hipDeviceAttributeMultiprocessorCount, dev) != hipSuccess) { grid = -1; return; }
        if (hipFuncSetAttribute((const void*)fwd_kernel, hipFuncAttributeMaxDynamicSharedMemorySize, LDS_BYTES) != hipSuccess) { fprintf(stderr, "kernel_launch: hipFuncSetAttribute failed\n"); grid = -1; return; }
        if (hipOccupancyMaxActiveBlocksPerMultiprocessor(&per_cu, (const void*)fwd_kernel, NTHR, LDS_BYTES) != hipSuccess || per_cu < 1) fprintf(stderr, "kernel_launch: occupancy query says %d\n", per_cu);
        (void)hipGetLastError();
        grid = cus;
    }
    if (grid < 0) return;
    (void)hipMemsetAsync((char*)d_ws + WS_CTL, 0, CTL_ZERO_BYTES, stream);
    Args a{};
    for (int i = 0; i < 22; ++i) a.in[i] = d_in[i];
    a.out = (float*)d_out; a.ws = (unsigned char*)d_ws;
    hipLaunchKernelGGL(fwd_kernel, dim3(grid), dim3(NTHR), LDS_BYTES, stream, a);
}
```

```cpp
#include <hip/hip_runtime.h>
#include <cstdio>
#include <cstdint>
#include <cmath>

#define LAS __attribute__((address_space(3)))
#define GAS __attribute__((address_space(1)))
typedef _Float16 f16;
typedef _Float16 f16x8 __attribute__((ext_vector_type(8)));
typedef _Float16 f16x4 __attribute__((ext_vector_type(4)));
typedef _Float16 f16x2 __attribute__((ext_vector_type(2)));
typedef float f32x4 __attribute__((ext_vector_type(4)));
typedef float f32x2 __attribute__((ext_vector_type(2)));
typedef unsigned u32x4 __attribute__((ext_vector_type(4)));
typedef unsigned u32x2 __attribute__((ext_vector_type(2)));

constexpr int NB = 8, SEQ = 4096, DM = 1024, T = NB * SEQ;
constexpr int NPROJ = 3584, NPROJ_SRC = 3592;
constexpr int C_QA = 0, C_KA = 512, C_VA = 1024, C_QM = 1536, C_KM = 2048, C_VM = 2560, C_OM = 3072;
constexpr int NEXP = 32, DEXP = 512, LISTCAP = 32768;
constexpr float EPS = 1e-6f;
constexpr float C2 = 0.125f * 1.4426950408889634f;
constexpr int NWAVES = 8, NTHR = 512;

constexpr size_t MiB = 1u << 20;
constexpr size_t WS_CTL = 0, CTL_ZERO_BYTES = 1 * MiB;
constexpr int CW_BAR = 4096;
constexpr int CW_CNT = 8192;
constexpr size_t CTL_KMEAN = 256 * 1024;
constexpr size_t WS_MOD = 1 * MiB, WS_GATES = 2 * MiB, WS_POS = 3 * MiB, WS_COS = 4 * MiB, WS_SIN = 8 * MiB, WS_LIST = 12 * MiB;
constexpr size_t WS_WIN = 20 * MiB, WS_WOUT = 27 * MiB, WS_W1 = 29 * MiB, WS_W3 = 61 * MiB, WS_W2 = 93 * MiB;
constexpr size_t WS_A = 126 * MiB;
constexpr size_t WS_PROJ = 190 * MiB;
constexpr size_t WS_H2 = 190 * MiB;
constexpr size_t WS_HID = 254 * MiB;
constexpr size_t WS_Y = 320 * MiB;
constexpr size_t WS_END = 450 * MiB;

constexpr int RING_BYTES = 131072;
constexpr int LDSCTL_OFF = RING_BYTES, MISC_OFF = LDSCTL_OFF + 320, TAB_OFF = LDSCTL_OFF + 1024;
constexpr int LDS_BYTES = 147456;

#define RLX_AGENT __ATOMIC_RELAXED, __HIP_MEMORY_SCOPE_AGENT
#define LDS_WAIT() asm volatile("s_waitcnt lgkmcnt(0)" ::: "memory")
__device__ __forceinline__ unsigned pk2h(float a, float b) { f16x2 v = {(f16)a, (f16)b}; return __builtin_bit_cast(unsigned, v); }
__device__ __forceinline__ float wave_sum(float v) {
#pragma unroll
    for (int o = 1; o < 64; o <<= 1) v += __shfl_xor(v, o);
    return v;
}
__device__ __forceinline__ float sigmoidf_(float x) { return 1.f / (1.f + __expf(-x)); }

#define XB_TMO      128
#define XB_XCNT(j)  (256  + 64 * (j))
#define XB_XSUB(j)  (1280 + 64 * (j))
#define XB_XGEN(j)  (2304 + 64 * (j))
#define XB_TOP      3328
#define XB_TOPGEN   3392
#define XCD_BAR_WORDS 3456
#define XB_SPIN_CAP (1u << 22)
__device__ __forceinline__ unsigned xb_ld(unsigned* p)              { return __hip_atomic_load(p, __ATOMIC_RELAXED, __HIP_MEMORY_SCOPE_AGENT); }
__device__ __forceinline__ unsigned xb_add(unsigned* p, unsigned v) { return __hip_atomic_fetch_add(p, v, __ATOMIC_RELAXED, __HIP_MEMORY_SCOPE_AGENT); }
__device__ __forceinline__ unsigned xb_xcc_id() { return (unsigned)__builtin_amdgcn_s_getreg((3 << 11) | 20) & 0xFu; }
#define XB_SPIN(cond, bar) do { unsigned _sp = 0; while (cond) { __builtin_amdgcn_s_sleep(1); \
    if ((++_sp & 255u) == 0u) { if (xb_ld(&(bar)[XB_TMO])) break; if (_sp > XB_SPIN_CAP) { atomicAdd(&(bar)[XB_TMO], 1u); break; } } } } while (0)
struct XcdBarrier { unsigned* bar; unsigned x; volatile LAS unsigned* st; };
__device__ __forceinline__ XcdBarrier xcd_barrier_post(unsigned* bar, volatile LAS unsigned* st) {
    XcdBarrier b; b.bar = bar; b.x = xb_xcc_id(); b.st = st;
    if (threadIdx.x == 0) (void)xb_add(&bar[XB_XCNT(b.x)], 1u);
    return b;
}
__device__ __forceinline__ void xcd_barrier_complete(unsigned* bar, unsigned x, unsigned& nloc, unsigned& nx) {
    const unsigned G = gridDim.x * gridDim.y * gridDim.z;
    unsigned sum, cnt, mine, sp = 0u;
    for (;;) {
        sum = 0u; cnt = 0u; mine = 0u;
#pragma unroll
        for (unsigned j = 0; j < 16; ++j) { const unsigned c = xb_ld(&bar[XB_XCNT(j)]); sum += c; cnt += (c > 0u) ? 1u : 0u; mine = (j == x) ? c : mine; }
        if (sum == G) break;
        __builtin_amdgcn_s_sleep(1);
        if ((++sp & 255u) == 0u) { if (xb_ld(&bar[XB_TMO])) break; if (sp > XB_SPIN_CAP) { atomicAdd(&bar[XB_TMO], 1u); break; } }
    }
    nloc = mine > 0u ? mine : 1u; nx = cnt > 0u ? cnt : 1u;
}
__device__ __forceinline__ void xcd_barrier(const XcdBarrier& b) {
    asm volatile("s_waitcnt vmcnt(0)" ::: "memory");
    __syncthreads();
    if (threadIdx.x == 0) {
        unsigned* bar = b.bar;
        __builtin_amdgcn_s_waitcnt(0);
        unsigned nloc = b.st[0], nx = b.st[1];
        if (nloc == 0u) { xcd_barrier_complete(bar, b.x, nloc, nx); b.st[0] = nloc; b.st[1] = nx; }
        const unsigned old = xb_add(&bar[XB_XSUB(b.x)], 1u);
        const unsigned gen = old / nloc;
        if (old + 1u == (gen + 1u) * nloc) {
            __builtin_amdgcn_fence(__ATOMIC_RELEASE, "agent");
            asm volatile("s_waitcnt vmcnt(0)" ::: "memory");
            const unsigned og = xb_add(&bar[XB_TOP], 1u);
            const unsigned tg = og / nx;
            if (og + 1u == (tg + 1u) * nx) xb_add(&bar[XB_TOPGEN], 1u);
            else XB_SPIN(xb_ld(&bar[XB_TOPGEN]) == tg, bar);
            __builtin_amdgcn_fence(__ATOMIC_ACQUIRE, "agent");
            xb_add(&bar[XB_XGEN(b.x)], 1u);
            asm volatile("s_waitcnt vmcnt(0)" ::: "memory");
        } else {
            XB_SPIN(xb_ld(&bar[XB_XGEN(b.x)]) == gen, bar);
            __builtin_amdgcn_fence(__ATOMIC_ACQUIRE, "agent");
            asm volatile("s_waitcnt vmcnt(0)" ::: "memory");
        }
    }
    __syncthreads();
}

namespace pg8 {
constexpr int BM = 256, BK = 64, HALF = 128, HTB = HALF * BK * 2, STAGE_BYTES = 8 * HTB;
__host__ __device__ __forceinline__ int lds_byte(int r, int c) { const int st = (r >> 4) * 2 + (c >> 5), rr = r & 15, cc = c & 31, ob = rr * 64 + cc * 2; return st * 1024 + (ob ^ (((ob >> 9) & 1) << 5)); }
__host__ __device__ __forceinline__ void stage_rc(int b, int& R, int& C) { const int st = b / 1024, sb = b % 1024, swz = sb ^ (((sb >> 9) & 1) << 5); R = (st >> 1) * 16 + swz / 64; C = (st & 1) * 32 + (swz % 64) / 2; }
__host__ __device__ __forceinline__ int perm32(int rho) { const int n = rho >> 4, i = rho & 15; return 8 * (i >> 2) + 4 * n + (i & 3); }

struct Unit { size_t b0, b1; int pm, pn, e, row0, rows; };

template <bool ROPE, class Epi, class Sched>
__device__ __forceinline__ void gemm_phase(LAS unsigned char* lds, const char* Abase, const char* Bbase, const int K, const Sched& S, const Epi& E) {
    int tid = threadIdx.x; asm volatile("" : "+v"(tid));
    const int wid = __builtin_amdgcn_readfirstlane(tid >> 6), lane = tid & 63, wr = wid >> 2, wc = wid & 3, fr = lane & 15, fq = lane >> 4;
    const int nt = K / BK;
    int R[2], C[2]; unsigned voffB[2];
#pragma unroll
    for (int i = 0; i < 2; ++i) { stage_rc(tid * 16 + i * 8192, R[i], C[i]);
        const int Rb = ROPE ? (64 * (R[i] >> 5) + perm32(R[i] & 31)) : ((R[i] & ~31) + perm32(R[i] & 31));
        voffB[i] = (unsigned)(Rb * K + C[i]) * 2u; }
    const size_t kstep = (size_t)(BK * 2);
    const unsigned ldsw = (unsigned)wid * 1024u;
    const int aoff = lds_byte(wr * 64 + fr, fq * 8), boff = lds_byte(wc * 32 + fr, fq * 8);
#define PG8_SA(b, h) (((b) * 2 + (h)) * HTB)
#define PG8_SB(b, h) ((4 + (b) * 2 + (h)) * HTB)
#define PG8_STG(bufoff, gbase, voff) do { _Pragma("unroll") for (int _i = 0; _i < 2; ++_i) \
        __builtin_amdgcn_global_load_lds((const unsigned*)((const char*)(gbase) + (voff)[_i]), (LAS unsigned*)(lds + (bufoff) + ldsw + _i * 8192), 16, 0, 0); } while (0)
#define PG8_LDA(dst, b, h) do { _Pragma("unroll") for (int m = 0; m < 4; ++m) _Pragma("unroll") for (int k = 0; k < 2; ++k) dst[m][k] = *(const LAS f16x8*)(lds + PG8_SA(b, h) + aoff + m * 2048 + k * 1024); } while (0)
#define PG8_LDB(dst, b, h) do { _Pragma("unroll") for (int n = 0; n < 2; ++n) _Pragma("unroll") for (int k = 0; k < 2; ++k) dst[n][k] = *(const LAS f16x8*)(lds + PG8_SB(b, h) + boff + n * 2048 + k * 1024); } while (0)
#define PG8_MMA(ai, bj, At, Bt) do { __builtin_amdgcn_s_setprio(1); _Pragma("unroll") for (int m = 0; m < 4; ++m) _Pragma("unroll") for (int n = 0; n < 2; ++n) _Pragma("unroll") for (int k = 0; k < 2; ++k) \
        acc[ai][bj][m][n] = __builtin_amdgcn_mfma_f32_16x16x32_f16(Bt[n][k], At[m][k], acc[ai][bj][m][n], 0, 0, 0); __builtin_amdgcn_s_setprio(0); } while (0)
#define PG8_WAIT_V(n) asm volatile("s_waitcnt vmcnt(" #n ")" ::: "memory")
#define PG8_WAIT_L(n) asm volatile("s_waitcnt lgkmcnt(" #n ")" ::: "memory")
#define PG8_BAR __builtin_amdgcn_s_barrier()
#define PG8_SCHED __builtin_amdgcn_sched_barrier(0)
    Unit cur, nxt; int ui = 0;
    if (!S.next(0, cur)) return;
    f32x4 acc[2][2][4][2];
#pragma unroll
    for (int a = 0; a < 2; ++a)
#pragma unroll
        for (int b = 0; b < 2; ++b)
#pragma unroll
            for (int m = 0; m < 4; ++m)
#pragma unroll
                for (int n = 0; n < 2; ++n) acc[a][b][m][n] = (f32x4){0.f, 0.f, 0.f, 0.f};
    f16x8 At[4][2], B0[2][2], B1[2][2];
    unsigned cvA[2][2], nvA[2][2];
    S.avoff(cur, cvA, R, C);
    const char* cB0 = Bbase + cur.b0; const char* cB1 = Bbase + cur.b1;
    PG8_STG(PG8_SB(0, 0), cB0, voffB); PG8_STG(PG8_SB(0, 1), cB1, voffB); PG8_STG(PG8_SA(0, 0), Abase, cvA[0]); PG8_STG(PG8_SA(0, 1), Abase, cvA[1]);
    if (wr == 1) PG8_BAR;
    PG8_WAIT_V(2); PG8_BAR;
    PG8_STG(PG8_SB(1, 0), cB0 + kstep, voffB); PG8_STG(PG8_SA(1, 0), Abase + kstep, cvA[0]); PG8_STG(PG8_SB(1, 1), cB1 + kstep, voffB);
    PG8_WAIT_V(6); PG8_BAR;
    for (;;) {
        const bool has_next = S.next(ui + 1, nxt);
        if (has_next) S.avoff(nxt, nvA, R, C);
        else {
#pragma unroll
            for (int h = 0; h < 2; ++h)
#pragma unroll
                for (int i = 0; i < 2; ++i) nvA[h][i] = cvA[h][i];
        }
        const char* nB0 = has_next ? Bbase + nxt.b0 : cB0; const char* nB1 = has_next ? Bbase + nxt.b1 : cB1;
        for (int t = 0; t < nt; t += 2) {
            const bool last = (t == nt - 2);
            const char* a1 = Abase + (size_t)(t + 1) * kstep;
            const size_t k2 = last ? (size_t)0 : (size_t)(t + 2) * kstep;
            const char* a2 = Abase + k2; const char* a3 = a2 + kstep;
            const char* b20 = (last ? nB0 : cB0) + k2; const char* b21 = (last ? nB1 : cB1) + k2;
            const char* b30 = b20 + kstep; const char* b31 = b21 + kstep;
            unsigned vA2[2][2];
#pragma unroll
            for (int h = 0; h < 2; ++h)
#pragma unroll
                for (int i = 0; i < 2; ++i) vA2[h][i] = last ? nvA[h][i] : cvA[h][i];
            PG8_LDB(B0, 0, 0); PG8_LDB(B1, 0, 1); PG8_SCHED; PG8_LDA(At, 0, 0); PG8_STG(PG8_SA(1, 1), a1, cvA[1]);
            PG8_WAIT_V(8); PG8_WAIT_L(0); PG8_BAR; PG8_MMA(0, 0, At, B0); PG8_MMA(0, 1, At, B1); PG8_BAR; PG8_SCHED;
            PG8_LDA(At, 0, 1); PG8_STG(PG8_SB(0, 0), b20, voffB); PG8_STG(PG8_SB(0, 1), b21, voffB); PG8_STG(PG8_SA(0, 0), a2, vA2[0]);
            PG8_WAIT_V(8); PG8_WAIT_L(0); PG8_BAR; PG8_MMA(1, 0, At, B0); PG8_MMA(1, 1, At, B1); PG8_BAR; PG8_SCHED;
            PG8_LDB(B0, 1, 0); PG8_LDB(B1, 1, 1); PG8_SCHED; PG8_LDA(At, 1, 0); PG8_STG(PG8_SA(0, 1), a2, vA2[1]);
            PG8_WAIT_V(8); PG8_WAIT_L(0); PG8_BAR; PG8_MMA(0, 0, At, B0); PG8_MMA(0, 1, At, B1); PG8_BAR; PG8_SCHED;
            PG8_LDA(At, 1, 1); PG8_STG(PG8_SB(1, 0), b30, voffB); PG8_STG(PG8_SB(1, 1), b31, voffB); PG8_STG(PG8_SA(1, 0), a3, vA2[0]);
            PG8_WAIT_V(8); PG8_WAIT_L(0); PG8_BAR; PG8_MMA(1, 0, At, B0); PG8_MMA(1, 1, At, B1); PG8_BAR; PG8_SCHED;
        }
        if (wr == 0) PG8_BAR;
        E(acc, cur, wr, wc, fr, fq);
        if (!has_next) break;
#pragma unroll
        for (int a = 0; a < 2; ++a)
#pragma unroll
            for (int b = 0; b < 2; ++b)
#pragma unroll
                for (int m = 0; m < 4; ++m)
#pragma unroll
                    for (int n = 0; n < 2; ++n) acc[a][b][m][n] = (f32x4){0.f, 0.f, 0.f, 0.f};
        cur = nxt; cB0 = nB0; cB1 = nB1; ++ui;
#pragma unroll
        for (int h = 0; h < 2; ++h)
#pragma unroll
            for (int i = 0; i < 2; ++i) cvA[h][i] = nvA[h][i];
        if (wr == 1) PG8_BAR;
    }
    PG8_WAIT_V(0);
    PG8_BAR;
#undef PG8_SA
#undef PG8_SB
#undef PG8_STG
#undef PG8_LDA
#undef PG8_LDB
#undef PG8_MMA
#undef PG8_WAIT_V
#undef PG8_WAIT_L
#undef PG8_BAR
#undef PG8_SCHED
}

struct DenseSched {
    int nM, nN, nwg, G, c, K; bool rope;
    __device__ __forceinline__ void init(int M, int N, int K_, int G_, int c_, bool rope_) { nM = M / BM; nN = N / BM; nwg = nM * nN; G = G_; c = c_; K = K_; rope = rope_; }
    __device__ __forceinline__ bool next(int i, Unit& u) const {
        const long L = (long)i * G + c; if (L >= nwg) return false;
        int wgid = (int)L; { const int q = nwg / 8, r = nwg % 8, xcd = wgid % 8, off = wgid / 8; wgid = (xcd < r ? xcd * (q + 1) : r * (q + 1) + (xcd - r) * q) + off; }
        const int WGM = 8, nig = WGM * nN, gid = wgid / nig, fm = gid * WGM, gsz = (nM - fm) < WGM ? (nM - fm) : WGM;
        u.pm = fm + ((wgid % nig) % gsz); u.pn = (wgid % nig) / gsz; u.e = 0; u.row0 = u.pm * BM; u.rows = BM;
        u.b0 = (size_t)(u.pn * BM) * K * 2; u.b1 = u.b0 + (size_t)(rope ? 32 : 128) * K * 2;
        return true;
    }
    __device__ __forceinline__ void avoff(const Unit& u, unsigned (&vo)[2][2], const int (&R)[2], const int (&C)[2]) const {
#pragma unroll
        for (int h = 0; h < 2; ++h)
#pragma unroll
            for (int i = 0; i < 2; ++i) vo[h][i] = (unsigned)((u.row0 + 128 * h + R[i]) * K + C[i]) * 2u;
    }
};
struct MoeSched {
    const LAS int* tab; int G, cv, K; bool gather; const int* list; size_t bstep, bhalf;
    __device__ __forceinline__ bool next(int i, Unit& u) const {
        const int L = i * G + cv; if (L >= tab[32]) return false;
        int e = 0;
#pragma unroll 1
        for (int k = 1; k < 32; ++k) if (tab[k] <= L) e = k;
        const int local = L - tab[e]; u.e = e; u.pm = local >> 2; u.pn = local & 3;
        const int cnt = tab[80 + e]; u.rows = min(256, cnt - u.pm * 256); u.row0 = tab[40 + e] + u.pm * 256;
        if (gather) { u.b0 = ((size_t)e * 512 + 128 * u.pn) * 1024 * 2; u.b1 = u.b0 + (WS_W3 - WS_W1); }
        else        { u.b0 = ((size_t)e * 1024 + 256 * u.pn) * 512 * 2; u.b1 = u.b0 + (size_t)128 * 512 * 2; }
        return true;
    }
    __device__ __forceinline__ void avoff(const Unit& u, unsigned (&vo)[2][2], const int (&R)[2], const int (&C)[2]) const {
#pragma unroll
        for (int h = 0; h < 2; ++h)
#pragma unroll
            for (int i = 0; i < 2; ++i) {
                if (gather) { int r = 128 * h + R[i]; r = r < u.rows ? r : u.rows - 1; const int tok = list[2 * ((size_t)u.e * LISTCAP + u.pm * 256 + r)];
                    vo[h][i] = (unsigned)(tok * 1024 + C[i]) * 2u; }
                else vo[h][i] = (unsigned)((u.row0 + 128 * h + R[i]) * 512 + C[i]) * 2u;
            }
    }
};

struct EpiProj {
    f16* proj; const float* cosT; const float* sinT; float* ksum;
    __device__ __forceinline__ void operator()(const f32x4 (&acc)[2][2][4][2], const Unit& u, int wr, int wc, int fr, int fq) const {
        const int tile = u.pn, row0 = u.row0 + wr * 64 + fr, col0 = tile * 256 + 64 * wc + 8 * fq;
        if (tile < 4) {
            const float sc = tile < 2 ? C2 : 1.f;
            float ks[2][8];
#pragma unroll
            for (int bj = 0; bj < 2; ++bj)
#pragma unroll
                for (int j = 0; j < 8; ++j) ks[bj][j] = 0.f;
#pragma unroll
            for (int ai = 0; ai < 2; ++ai)
#pragma unroll
                for (int m = 0; m < 4; ++m) {
                    const int row = row0 + ai * HALF + m * 16;
                    const f32x4 c0 = *(const f32x4*)(cosT + (size_t)row * 32 + 8 * fq), c1 = *(const f32x4*)(cosT + (size_t)row * 32 + 8 * fq + 4);
                    const f32x4 s0 = *(const f32x4*)(sinT + (size_t)row * 32 + 8 * fq), s1 = *(const f32x4*)(sinT + (size_t)row * 32 + 8 * fq + 4);
                    const f32x4 a0 = acc[ai][0][m][0], a1 = acc[ai][0][m][1], b0 = acc[ai][1][m][0], b1 = acc[ai][1][m][1];
                    const f32x4 o10 = (a0 * c0 - b0 * s0) * sc, o11 = (a1 * c1 - b1 * s1) * sc;
                    const f32x4 o20 = (b0 * c0 + a0 * s0) * sc, o21 = (b1 * c1 + a1 * s1) * sc;
                    u32x4 w1, w2;
                    w1.x = pk2h(o10[0], o10[1]); w1.y = pk2h(o10[2], o10[3]); w1.z = pk2h(o11[0], o11[1]); w1.w = pk2h(o11[2], o11[3]);
                    w2.x = pk2h(o20[0], o20[1]); w2.y = pk2h(o20[2], o20[3]); w2.z = pk2h(o21[0], o21[1]); w2.w = pk2h(o21[2], o21[3]);
                    f16* rp = proj + (size_t)row * NPROJ + col0;
                    *(u32x4*)rp = w1; *(u32x4*)(rp + 32) = w2;
                    if (tile >= 2) {
#pragma unroll
                        for (int j = 0; j < 4; ++j) { ks[0][j] += o10[j]; ks[0][4 + j] += o11[j]; ks[1][j] += o20[j]; ks[1][4 + j] += o21[j]; }
                    }
                }
            if (tile >= 2) {
                const int b = u.pm >> 4, blk = u.pm & 15, head = (tile - 2) * 4 + wc;
                float* kp = ksum + ((size_t)((b * 8 + head) * 16 + blk)) * 64 + 8 * fq;
#pragma unroll
                for (int bj = 0; bj < 2; ++bj)
#pragma unroll
                    for (int j = 0; j < 8; ++j) { float v = ks[bj][j]; v += __shfl_xor(v, 1); v += __shfl_xor(v, 2); v += __shfl_xor(v, 4); v += __shfl_xor(v, 8);
                        if (fr == 0) atomicAdd(kp + 32 * bj + j, v); }
            }
        } else {
#pragma unroll
            for (int ai = 0; ai < 2; ++ai)
#pragma unroll
                for (int m = 0; m < 4; ++m) {
                    f16* rp = proj + (size_t)(row0 + ai * HALF + m * 16) * NPROJ + col0;
#pragma unroll
                    for (int bj = 0; bj < 2; ++bj) { const f32x4 v0 = acc[ai][bj][m][0], v1 = acc[ai][bj][m][1]; u32x4 w;
                        w.x = pk2h(v0[0], v0[1]); w.y = pk2h(v0[2], v0[3]); w.z = pk2h(v1[0], v1[1]); w.w = pk2h(v1[2], v1[3]);
                        *(u32x4*)(rp + 32 * bj) = w; }
                }
        }
    }
};
struct EpiOut {
    const float* x; const float* mod; float* x1;
    __device__ __forceinline__ void operator()(const f32x4 (&acc)[2][2][4][2], const Unit& u, int wr, int wc, int fr, int fq) const {
        const int row0 = u.row0 + wr * 64 + fr, col0 = u.pn * BM + wc * 32 + 8 * fq, b = u.row0 / SEQ;
        const float* g1 = mod + (size_t)b * 6144 + 2048;
#pragma unroll
        for (int bj = 0; bj < 2; ++bj) {
            const f32x4 g0 = *(const f32x4*)(g1 + col0 + bj * HALF), gg1 = *(const f32x4*)(g1 + col0 + bj * HALF + 4);
#pragma unroll
            for (int ai = 0; ai < 2; ++ai)
#pragma unroll
                for (int m = 0; m < 4; ++m) { const size_t off = (size_t)(row0 + ai * HALF + m * 16) * DM + col0 + bj * HALF;
                    const f32x4 x0 = *(const f32x4*)(x + off), xx1 = *(const f32x4*)(x + off + 4);
                    *(f32x4*)(x1 + off) = x0 + g0 * acc[ai][bj][m][0]; *(f32x4*)(x1 + off + 4) = xx1 + gg1 * acc[ai][bj][m][1]; }
        }
    }
};
struct EpiMoe1 {
    f16* H;
    __device__ __forceinline__ void operator()(const f32x4 (&acc)[2][2][4][2], const Unit& u, int wr, int wc, int fr, int fq) const {
        const int r0 = wr * 64 + fr, col0 = u.pn * 128 + wc * 32 + 8 * fq;
#pragma unroll
        for (int ai = 0; ai < 2; ++ai)
#pragma unroll
            for (int m = 0; m < 4; ++m) { const int r = r0 + ai * HALF + m * 16;
                float o[8];
#pragma unroll
                for (int n = 0; n < 2; ++n)
#pragma unroll
                    for (int j = 0; j < 4; ++j) { const float a = acc[ai][0][m][n][j], bb = acc[ai][1][m][n][j]; o[4 * n + j] = a / (1.f + __expf(-a)) * bb; }
                u32x4 w; w.x = pk2h(o[0], o[1]); w.y = pk2h(o[2], o[3]); w.z = pk2h(o[4], o[5]); w.w = pk2h(o[6], o[7]);
                if (r < u.rows) *(u32x4*)(H + (size_t)(u.row0 + r) * DEXP + col0) = w; }
    }
};
struct EpiMoe2 {
    f16* Y; const int* list;
    __device__ __forceinline__ void operator()(const f32x4 (&acc)[2][2][4][2], const Unit& u, int wr, int wc, int fr, int fq) const {
        const int r0 = wr * 64 + fr, col0 = u.pn * BM + wc * 32 + 8 * fq;
#pragma unroll
        for (int ai = 0; ai < 2; ++ai)
#pragma unroll
            for (int m = 0; m < 4; ++m) { const int r = r0 + ai * HALF + m * 16;
                if (r < u.rows) {
                    const float w = __int_as_float(list[2 * ((size_t)u.e * LISTCAP + u.pm * 256 + r) + 1]);
#pragma unroll
                    for (int bj = 0; bj < 2; ++bj) { const f32x4 v0 = acc[ai][bj][m][0] * w, v1 = acc[ai][bj][m][1] * w; u32x4 o;
                        o.x = pk2h(v0[0], v0[1]); o.y = pk2h(v0[2], v0[3]); o.z = pk2h(v1[0], v1[1]); o.w = pk2h(v1[2], v1[3]);
                        *(u32x4*)(Y + (size_t)(u.row0 + r) * DM + col0 + bj * HALF) = o; }
                } }
    }
};
}


namespace moba {
using s16x8=__attribute__((ext_vector_type(8)))short;
using s16x4=__attribute__((ext_vector_type(4)))short;
using f32x16=__attribute__((ext_vector_type(16)))float;
constexpr int D=64, PITCH=NPROJ, OPITCH=DM;
constexpr int NW=8,QBLK=32,QB=QBLK*NW,KVBLK=64;
__device__ __forceinline__ int crow(int r,int hi){return (r&3)+8*(r>>2)+4*hi;}
#define SBAR() __builtin_amdgcn_sched_barrier(0)
#define MF32(a,b,c) __builtin_amdgcn_mfma_f32_32x32x16_f16(__builtin_bit_cast(f16x8,(a)),__builtin_bit_cast(f16x8,(b)),(c),0,0,0)
__device__ __forceinline__ void cmask(f32x16&p0,f32x16&p1,int jb,int qrel,int hi){
  const float NEG=-INFINITY; int kb=64*jb+4*hi;
  #pragma unroll
  for(int r=0;r<16;++r){int kv=kb+(r&3)+8*(r>>2); if(kv>qrel)p0[r]=NEG; if(kv+32>qrel)p1[r]=NEG;}
}
constexpr int NSLOT=3, SLOTB=8192;
constexpr int LDS_K=0, LDS_V=NSLOT*SLOTB, LDS_WS=2*NSLOT*SLOTB, LDS_OST=LDS_WS+NW*64*4, LDS_SEL=LDS_OST+NW*4096, LDS_BYTES_A=LDS_SEL+1024;
__device__ __forceinline__ void glds16(const void*gsrc,unsigned lds_dst){unsigned keep;
  asm volatile("s_mov_b32 %0, m0\n\ts_mov_b32 m0, %2\n\ts_nop 0\n\tglobal_load_lds_dwordx4 %1, off\n\ts_mov_b32 m0, %0":"=&s"(keep):"v"(gsrc),"s"(lds_dst):"memory");}
__device__ __forceinline__ float max3f(float a,float b,float c){float r;asm("v_max3_f32 %0, %1, %2, %3":"=v"(r):"v"(a),"v"(b),"v"(c));return r;}
__device__ __forceinline__ float max2f(float a,float b){float r;asm("v_max_f32_e32 %0, %1, %2":"=v"(r):"v"(a),"v"(b));return r;}
__device__ __forceinline__ float fadd_s(float a,float b){float r;asm("v_add_f32_e32 %0, %1, %2":"=v"(r):"v"(a),"v"(b));return r;}
__device__ __forceinline__ float fsub_s(float a,float b){float r;asm("v_sub_f32_e32 %0, %1, %2":"=v"(r):"v"(a),"v"(b));return r;}
__device__ __forceinline__ unsigned cvtpk_s(float lo,float hi){return __builtin_bit_cast(unsigned,__builtin_amdgcn_cvt_pkrtz(lo,hi));}
#define WAIT_BAR(N) asm volatile("s_waitcnt vmcnt(" #N ") lgkmcnt(0)\n\ts_barrier":::"memory")
__device__ __forceinline__ void qkt(f32x16&p0,f32x16&p1,const char*Kslot,const s16x8*qr,const f32x16&negm,int r32,int hi){
  const char*kb=Kslot+hi*1024+r32*16;
  #pragma unroll
  for(int d0=0;d0<4;++d0){
    const s16x8 b0=*reinterpret_cast<const s16x8*>(kb+d0*2048);
    const s16x8 b1=*reinterpret_cast<const s16x8*>(kb+d0*2048+512);
    if(d0==0){p0=MF32(b0,qr[0],negm);p1=MF32(b1,qr[0],negm);}
    else{p0=MF32(b0,qr[d0],p0);p1=MF32(b1,qr[d0],p1);}}
}
typedef __attribute__((address_space(3))) const char* lds_cptr;
typedef short v4i16_t __attribute__((ext_vector_type(4)));
__device__ __forceinline__ void kload8(s16x8*kf,lds_cptr kp){
  kf[0]=*(const __attribute__((address_space(3))) s16x8*)(kp);      kf[1]=*(const __attribute__((address_space(3))) s16x8*)(kp+512);
  kf[2]=*(const __attribute__((address_space(3))) s16x8*)(kp+2048); kf[3]=*(const __attribute__((address_space(3))) s16x8*)(kp+2560);
  kf[4]=*(const __attribute__((address_space(3))) s16x8*)(kp+4096); kf[5]=*(const __attribute__((address_space(3))) s16x8*)(kp+4608);
  kf[6]=*(const __attribute__((address_space(3))) s16x8*)(kp+6144); kf[7]=*(const __attribute__((address_space(3))) s16x8*)(kp+6656);
}
__device__ __forceinline__ void kload2(s16x8*kf,lds_cptr kp,int j){ kf[2*j]=*(const __attribute__((address_space(3))) s16x8*)(kp+j*2048); kf[2*j+1]=*(const __attribute__((address_space(3))) s16x8*)(kp+j*2048+512); }
__device__ __forceinline__ s16x4 vtr(lds_cptr p){ return __builtin_bit_cast(s16x4,__builtin_amdgcn_ds_read_tr16_b64_v4i16((__attribute__((address_space(3))) v4i16_t*)p)); }
__device__ __forceinline__ float rowmax(const f32x16&p0,const f32x16&p1){
  float a=max3f(p0[0],p0[1],p1[0]),b=max3f(p0[2],p0[3],p1[1]);a=max3f(a,p1[2],p1[3]);
  #pragma unroll
  for(int r=4;r<16;r+=4){a=max3f(a,p0[r],p0[r+1]);b=max3f(b,p0[r+2],p0[r+3]);a=max3f(a,p1[r],p1[r+1]);b=max3f(b,p1[r+2],p1[r+3]);}
  const float m=max2f(a,b);
  auto rr=__builtin_amdgcn_permlane32_swap(__float_as_uint(m),__float_as_uint(m),false,false);
  return max2f(__uint_as_float(rr[0]),__uint_as_float(rr[1]));
}
__device__ __forceinline__ void pv(f32x16*o,int vb,s16x8 pa0,s16x8 pa1,s16x8 pa2,s16x8 pa3){
  #pragma unroll
  for(int d0=0;d0<2;++d0){s16x4 lo[4],hi[4];
    #pragma unroll
    for(int ks=0;ks<4;++ks){
      asm volatile("ds_read_b64_tr_b16 %0,%1 offset:%c2":"=&v"(lo[ks]):"v"(vb),"i"(d0*4096+ks*1024):"memory");
      asm volatile("ds_read_b64_tr_b16 %0,%1 offset:%c2":"=&v"(hi[ks]):"v"(vb),"i"(d0*4096+ks*1024+512):"memory");}
    asm volatile("s_waitcnt lgkmcnt(0)":::"memory");SBAR();
    #define PK(k) (s16x8){lo[k][0],lo[k][1],lo[k][2],lo[k][3],hi[k][0],hi[k][1],hi[k][2],hi[k][3]}
    o[d0]=MF32(pa0,PK(0),o[d0]);
    o[d0]=MF32(pa1,PK(1),o[d0]);
    o[d0]=MF32(pa2,PK(2),o[d0]);
    o[d0]=MF32(pa3,PK(3),o[d0]);
    #undef PK
  }
}
__device__ __forceinline__ void sel_unit(int b,int h,int qb,const f16*Q,const float*ksum,char*shm){
  int tid=threadIdx.x; asm volatile("":"+v"(tid));
  const int row=tid>>1, half=tid&1;
  unsigned sel=0u;
  if(qb>0){
    float qf[32];
    { const f16x8*qp=(const f16x8*)(Q+((long)b*SEQ+qb*QB+row)*PITCH+h*D+32*half);
      #pragma unroll
      for(int i=0;i<4;++i){ const f16x8 t=qp[i];
        #pragma unroll
        for(int j=0;j<8;++j)qf[8*i+j]=(float)t[j]; } }
    float g[15];
    const float*kp=ksum+(size_t)((b*8+h)*16)*64+32*half;
    #pragma unroll
    for(int n=0;n<15;++n){ float s=0.f;
      if(n<qb){
        #pragma unroll
        for(int i=0;i<8;++i){ const f32x4 k4=*(const f32x4*)(kp+n*64+4*i); s+=qf[4*i]*k4[0]+qf[4*i+1]*k4[1]+qf[4*i+2]*k4[2]+qf[4*i+3]*k4[3]; }
        s+=__shfl_xor(s,1); }
      g[n]=(n<qb)?s:-INFINITY; }
    #pragma unroll
    for(int r=0;r<3;++r){ float best=-INFINITY; int bi=-1;
      #pragma unroll
      for(int n=0;n<15;++n){ const bool ok=!((sel>>n)&1u)&&g[n]>best; best=ok?g[n]:best; bi=ok?n:bi; }
      if(bi>=0)sel|=1u<<bi; } }
  if(half==0)((unsigned*)(shm+LDS_SEL))[row]=sel;
  asm volatile("s_waitcnt lgkmcnt(0)\n\ts_barrier":::"memory");
}
constexpr float NEGBIG=-1.0e30f;
template<int THRL> __device__ __forceinline__ void attn_unit(int b,int h,int qb,const f16*Q,const f16*__restrict__ K,const f16*__restrict__ V,f16*O,const float*ksum,const float*gain,char*shm){
  int tid_=threadIdx.x; asm volatile("":"+v"(tid_));
  const int tid=tid_,lane=tid&63,r32=lane&31,hi=lane>>5; const int wid=__builtin_amdgcn_readfirstlane(tid>>6);
  const long rowbase=(long)b*SEQ; const int q0=qb*QB;
  const f16*Qw=Q+(rowbase+q0+wid*QBLK)*PITCH+h*D;
  const f16*Kh=K+rowbase*PITCH+h*D,*Vh=V+rowbase*PITCH+h*D;
  const unsigned lds0=(unsigned)(uintptr_t)shm;
  float*wsf=(float*)(shm+LDS_WS)+wid*64;
  const f16*kptr=Kh+(long)lane*PITCH+wid*8+(long)(4*qb)*KVBLK*PITCH;
  const f16*vptr=Vh+(long)(16*(wid&3)+(lane>>2))*PITCH+(wid>>2)*32+(lane&3)*8+(long)(4*qb)*KVBLK*PITCH;
  const unsigned kdst=lds0+LDS_K+wid*1024, vdst=lds0+LDS_V+wid*1024;
  const long tstep_=(long)KVBLK*PITCH, twrap_=-(long)(4*qb+3)*KVBLK*PITCH;
  #define DMA_K(t,slot) do{ glds16(kptr,(unsigned)__builtin_amdgcn_readfirstlane(kdst+(slot))); kptr+=(((t)==3)?twrap_:tstep_); }while(0)
  #define DMA_V(t,slot) do{ glds16(vptr,(unsigned)__builtin_amdgcn_readfirstlane(vdst+(slot))); vptr+=(((t)==3)?twrap_:tstep_); }while(0)
  const int vb0=(int)(lds0+LDS_V)+((lane>>4)&1)*32+(lane&3)*8+(4*hi+((lane&15)>>2))*64;
  const char*Kbase=shm+LDS_K; s16x8 kf[8];
  const lds_cptr shm3=(lds_cptr)shm; const lds_cptr kp0=shm3+LDS_K+hi*1024+r32*16; const lds_cptr vp0=shm3+LDS_V+((lane>>4)&1)*32+(lane&3)*8+(4*hi+((lane&15)>>2))*64;
  const int NT=4*qb+4;
  DMA_K(0,0);DMA_V(0,0);DMA_K(1,SLOTB);
  s16x8 qr[4];
  #pragma unroll
  for(int d0=0;d0<4;++d0)qr[d0]=*reinterpret_cast<const s16x8*>(&Qw[(long)r32*PITCH+d0*16+hi*8]);
  const unsigned sel=((const unsigned*)(shm+LDS_SEL))[wid*QBLK+r32];
  bool msk=false;
  float mhat=0.f,l_reg=0.f;f32x16 o[2];o[0]=f32x16{};o[1]=f32x16{};f32x16 negm=f32x16{};asm volatile("":"+v"(negm));
  const int qrel=wid*QBLK+r32;
  #define CMASK(P0,P1,t) do{ if((t)<4)cmask(P0,P1,(t),qrel,hi); }while(0)
  #define SELM(t) do{ if((t)>=4&&(((t)&3)==0)){ msk=!((sel>>(((t)-4)>>2))&1u); const float nv_=msk?NEGBIG:-mhat; _Pragma("unroll") for(int r=0;r<16;++r)negm[r]=nv_; asm volatile("":"+v"(negm)); } }while(0)
  bool resc=false;
  #define START(P0,P1) do{ const float rm=rowmax(P0,P1); resc=false; \
    { const float dl=rm; mhat=fadd_s(mhat,dl); \
      _Pragma("unroll") for(int r=0;r<16;++r){P0[r]=fsub_s(P0[r],dl);P1[r]=fsub_s(P1[r],dl);} \
      _Pragma("unroll") for(int r=0;r<16;++r)negm[r]=-mhat; asm volatile("":"+v"(negm)); } \
    _Pragma("unroll") for(int r=0;r<16;++r)P0[r]=__builtin_amdgcn_exp2f(P0[r]); }while(0)
  #define RESC() do{ if(resc){ asm volatile("s_waitcnt lgkmcnt(0)":::"memory"); \
      _Pragma("unroll") for(int d_=0;d_<2;++d_) _Pragma("unroll") for(int r=0;r<16;++r)o[d_][r]*=wsf[crow(r,hi)]; } }while(0)
  f32x16 pA0,pA1,pB0,pB1;
  int sl_prev=0,sl_cur=0,sl_next=SLOTB;
  #define ROT() do{sl_prev=sl_cur;sl_cur=sl_next;sl_next=(sl_next==(NSLOT-1)*SLOTB)?0:sl_next+SLOTB;}while(0)
  DMA_K(2,2*SLOTB);
  WAIT_BAR(3);
  qkt(pA0,pA1,Kbase,qr,negm,r32,hi);asm volatile("s_nop 15\n\ts_nop 7":"+v"(pA0),"+v"(pA1));CMASK(pA0,pA1,0);
  START(pA0,pA1);
  _Pragma("unroll") for(int r=0;r<16;++r)pA1[r]=__builtin_amdgcn_exp2f(pA1[r]);
  WAIT_BAR(0);
  DMA_K(3,0);DMA_V(1,SLOTB);
  ROT();
  kload8(kf,kp0+sl_cur);
  WAIT_BAR(2);
  s16x4 vlo[8],vhi[8]; u32x4 pw0,pw1,pw2,pw3;
  #define PKW(P,B) cvtpk_s(P[B],P[B+1])
  #define PAF(k) __builtin_bit_cast(s16x8,pw##k)
  #define VFR(i) (s16x8){vlo[i][0],vlo[i][1],vlo[i][2],vlo[i][3],vhi[i][0],vhi[i][1],vhi[i][2],vhi[i][3]}
  #define PIN(x) asm volatile("":"+v"(x))
  #define MX3(a,b,c) __builtin_fmaxf(__builtin_fmaxf((a),(b)),(c))
  #define GAPA(MF,A0,A1,A2,A3,W0,W1,PW) do{ MF; sacc+=A0; sacc+=A1; sacc+=A2; sacc+=A3; PIN(sacc); W0; W1; PIN(PW); SBAR(); }while(0)
  #define EX(v) __builtin_amdgcn_exp2f(v)
  #define GAPB(MF,X,B) do{ MF; X[B]=EX(X[B]); X[B+1]=EX(X[B+1]); X[B+2]=EX(X[B+2]); X[B+3]=EX(X[B+3]); PIN(X); SBAR(); }while(0)
  #define VRD(i) do{ vlo[i]=vtr(vp_+(((i)>>2)*4096+((i)&3)*1024)); vhi[i]=vtr(vp_+(((i)>>2)*4096+((i)&3)*1024+512)); }while(0)
  #define KRD(G,j) do{ if(G){ kload2(kf,kp0+sl_next,j); SBAR(); } }while(0)
  #define STEP(C0,C1,P0,P1,t,GK,GV,GL) do{ SELM(t); SBAR(); \
    const lds_cptr vp_=vp0+sl_prev; \
    VRD(0); SBAR(); float sacc=(P0[0]+P0[1]); \
    GAPA(C0=MF32(kf[0],qr[0],negm), P0[2],P0[3],P0[4],P0[5],     pw0[0]=PKW(P0,0), pw0[1]=PKW(P0,2), pw0); \
    VRD(4); SBAR(); GAPA(C1=MF32(kf[1],qr[0],negm), P0[6],P0[7],P0[8],P0[9],     pw0[2]=PKW(P0,4), pw0[3]=PKW(P0,6), pw0); \
    VRD(1); SBAR(); GAPA(C0=MF32(kf[2],qr[1],C0),   P0[10],P0[11],P0[12],P0[13], pw1[0]=PKW(P0,8), pw1[1]=PKW(P0,10), pw1); \
    VRD(5); SBAR(); GAPA(C1=MF32(kf[3],qr[1],C1),   P0[14],P0[15],P1[0],P1[1],   pw1[2]=PKW(P0,12),pw1[3]=PKW(P0,14), pw1); \
    VRD(2); SBAR(); GAPA(C0=MF32(kf[4],qr[2],C0),   P1[2],P1[3],P1[4],P1[5],     pw2[0]=PKW(P1,0), pw2[1]=PKW(P1,2), pw2); \
    VRD(6); SBAR(); GAPA(C1=MF32(kf[5],qr[2],C1),   P1[6],P1[7],P1[8],P1[9],     pw2[2]=PKW(P1,4), pw2[3]=PKW(P1,6), pw2); \
    VRD(3); SBAR(); GAPA(C0=MF32(kf[6],qr[3],C0),   P1[10],P1[11],P1[12],P1[13], pw3[0]=PKW(P1,8), pw3[1]=PKW(P1,10), pw3); \
    VRD(7); SBAR(); GAPA(C1=MF32(kf[7],qr[3],C1),   P1[14],P1[15],0.f,0.f,       pw3[2]=PKW(P1,12),pw3[3]=PKW(P1,14), pw3); \
    l_reg+=sacc; \
    if(GK){DMA_K((t)+3,sl_cur);} if(GV){DMA_V((t)+1,sl_next);} \
    CMASK(C0,C1,t); \
    { float a=MX3(C0[0],C0[1],C1[0]),b=MX3(C0[2],C0[3],C1[1]); a=MX3(a,C1[2],C1[3]); \
      _Pragma("unroll") for(int r=4;r<16;r+=4){a=MX3(a,C0[r],C0[r+1]);b=MX3(b,C0[r+2],C0[r+3]);a=MX3(a,C1[r],C1[r+1]);b=MX3(b,C1[r+2],C1[r+3]);} \
      float rm=__builtin_fmaxf(a,b); { auto rr=__builtin_amdgcn_permlane32_swap(__float_as_uint(rm),__float_as_uint(rm),false,false); rm=__builtin_fmaxf(__uint_as_float(rr[0]),__uint_as_float(rr[1])); } \
      resc=false; \
      if(__builtin_expect(__any(rm>(float)THRL),0)){ const float dl=__builtin_fmaxf(rm,0.f); mhat+=dl; \
        _Pragma("unroll") for(int r=0;r<16;++r){C0[r]-=dl;C1[r]-=dl;} \
        { const float nv_=msk?NEGBIG:-mhat; _Pragma("unroll") for(int r=0;r<16;++r)negm[r]=nv_; } asm volatile("":"+v"(negm)); \
        const float f=__builtin_amdgcn_exp2f(-dl); l_reg*=f; if(hi==0)wsf[r32]=f; resc=true; } } \
    SBAR(); \
    GAPB(o[0]=MF32(PAF(0),VFR(0),o[0]), C0,0); \
    GAPB(o[1]=MF32(PAF(0),VFR(4),o[1]), C0,4); \
    KRD(GL,0); GAPB(o[0]=MF32(PAF(1),VFR(1),o[0]), C0,8); \
    KRD(GL,1); GAPB(o[1]=MF32(PAF(1),VFR(5),o[1]), C0,12); \
    KRD(GL,2); GAPB(o[0]=MF32(PAF(2),VFR(2),o[0]), C1,0); \
    KRD(GL,3); GAPB(o[1]=MF32(PAF(2),VFR(6),o[1]), C1,4); \
    GAPB(o[0]=MF32(PAF(3),VFR(3),o[0]), C1,8); \
    GAPB(o[1]=MF32(PAF(3),VFR(7),o[1]), C1,12); \
    }while(0)
  int t=1;
  for(;t+5<NT;t+=2){
    STEP(pB0,pB1,pA0,pA1,t,true,true,true);     WAIT_BAR(2); RESC(); ROT();
    STEP(pA0,pA1,pB0,pB1,t+1,true,true,true);   WAIT_BAR(2); RESC(); ROT();
  }
  #define ENDW(tt) do{ if((tt)+3<NT){WAIT_BAR(2);} else if((tt)+2<NT){WAIT_BAR(1);} else {WAIT_BAR(0);} }while(0)
  for(;t+1<NT;t+=2){
    STEP(pB0,pB1,pA0,pA1,t,(t+3<NT),(t+1<NT),(t+1<NT));       ENDW(t);   RESC(); ROT();
    STEP(pA0,pA1,pB0,pB1,t+1,(t+4<NT),(t+2<NT),(t+2<NT));     ENDW(t+1); RESC(); ROT();
  }
  STEP(pB0,pB1,pA0,pA1,NT-1,false,false,false); RESC();
  { float sacc=pB0[0]+pB0[1]; _Pragma("unroll") for(int r=2;r<16;++r)sacc+=pB0[r]; _Pragma("unroll") for(int r=0;r<16;++r)sacc+=pB1[r]; l_reg+=sacc;
    pw0=(u32x4){PKW(pB0,0),PKW(pB0,2),PKW(pB0,4),PKW(pB0,6)};pw1=(u32x4){PKW(pB0,8),PKW(pB0,10),PKW(pB0,12),PKW(pB0,14)};pw2=(u32x4){PKW(pB1,0),PKW(pB1,2),PKW(pB1,4),PKW(pB1,6)};pw3=(u32x4){PKW(pB1,8),PKW(pB1,10),PKW(pB1,12),PKW(pB1,14)};
    SBAR(); pv(o,vb0+sl_cur,PAF(0),PAF(1),PAF(2),PAF(3)); }
  #undef PKW
  #undef PAF
  #undef VFR
  #undef PIN
  #undef MX3
  #undef GAPA
  #undef GAPB
  #undef EX
  #undef VRD
  #undef KRD
  #undef STEP
  #undef ENDW
  {auto rr=__builtin_amdgcn_permlane32_swap(__float_as_uint(l_reg),__float_as_uint(l_reg),false,false);l_reg=__uint_as_float(rr[0])+__uint_as_float(rr[1]);}
  if(hi==0)wsf[32+r32]=l_reg;asm volatile("s_waitcnt lgkmcnt(0)":::"memory");
  float rli[16];
  #pragma unroll
  for(int r=0;r<16;++r)rli[r]=__builtin_amdgcn_rcpf(wsf[32+crow(r,hi)]);
  f16*Ow=O+(rowbase+q0+wid*QBLK)*OPITCH+h*D;
  { float*stg=(float*)(shm+LDS_OST)+wid*1024;
    #pragma unroll
    for(int half=0;half<2;++half){
      #pragma unroll
      for(int r=0;r<16;++r){ const int orow=crow(r,hi);
        if((orow>>4)==half){
          #pragma unroll
          for(int d0=0;d0<2;++d0)stg[(orow&15)*64+d0*32+r32]=o[d0][r]*rli[r]; } }
      asm volatile("s_waitcnt lgkmcnt(0)":::"memory");
      #pragma unroll
      for(int i=0;i<2;++i){ const int row=i*8+(lane>>3),ch=lane&7; const f32x4 v0=*(const f32x4*)(stg+row*64+ch*8),v1=*(const f32x4*)(stg+row*64+ch*8+4);
        float ss=(v0[0]*v0[0]+v0[1]*v0[1])+(v0[2]*v0[2]+v0[3]*v0[3])+(v1[0]*v1[0]+v1[1]*v1[1])+(v1[2]*v1[2]+v1[3]*v1[3]);
        ss+=__shfl_xor(ss,1); ss+=__shfl_xor(ss,2); ss+=__shfl_xor(ss,4);
        const float rs=1.f/sqrtf(ss*(1.f/64.f)+EPS);
        const f32x4 g0=*(const f32x4*)(gain+h*D+ch*8),g1=*(const f32x4*)(gain+h*D+ch*8+4);
        u32x4 w; w.x=pk2h(v0[0]*rs*g0[0],v0[1]*rs*g0[1]); w.y=pk2h(v0[2]*rs*g0[2],v0[3]*rs*g0[3]); w.z=pk2h(v1[0]*rs*g1[0],v1[1]*rs*g1[1]); w.w=pk2h(v1[2]*rs*g1[2],v1[3]*rs*g1[3]);
        *(u32x4*)(Ow+(long)(half*16+row)*OPITCH+ch*8)=w; }
      asm volatile("s_waitcnt lgkmcnt(0)":::"memory"); } }
  asm volatile("s_waitcnt lgkmcnt(0)\n\ts_barrier":::"memory");
  #undef DMA_K
  #undef DMA_V
  #undef CMASK
  #undef SELM
  #undef START
  #undef RESC
  #undef ROT
}
#undef SBAR
#undef WAIT_BAR
#undef MF32
}

struct Args { const void* in[22]; float* out; unsigned char* ws; };
struct Frame {
    LAS unsigned char* lds; int tid, lane, wave, vcu, G;
    __device__ __forceinline__ void fresh() { int t = threadIdx.x; asm volatile("" : "+v"(t)); tid = t; lane = t & 63; wave = __builtin_amdgcn_readfirstlane(t >> 6); }
    const float *x, *c, *w_ada, *b_ada, *norm1_g, *w_in, *b_gate, *conv_w, *conv_b, *attn_g, *mlstm_g, *w_out, *norm2_g, *w_rg, *b_rg, *w_re, *b_re, *w1, *w3, *w2, *normf_g;
    const int* positions; float* out; unsigned char* ws;
};

__device__ __forceinline__ void p0_transpose_item(const float* W, int K, int ldw, int nblk, f16* WT, LAS float* scr, int item, int lane) {
    const int kb = item / nblk, nb = item % nblk, k0 = 64 * kb, n0 = 32 * nb;
#pragma unroll 8
    for (int i = 0; i < 32; ++i) { const int kk = 2 * i + (lane >> 5); scr[kk * 33 + (lane & 31)] = W[(size_t)(k0 + kk) * ldw + n0 + (lane & 31)]; }
    LDS_WAIT(); asm volatile("" ::: "memory");
    const int c = lane & 7;
#pragma unroll
    for (int j = 0; j < 4; ++j) { const int n = (lane >> 3) + 8 * j; const LAS float* s = scr + (8 * c) * 33 + n;
        u32x4 o; o.x = pk2h(s[0 * 33], s[1 * 33]); o.y = pk2h(s[2 * 33], s[3 * 33]); o.z = pk2h(s[4 * 33], s[5 * 33]); o.w = pk2h(s[6 * 33], s[7 * 33]);
        *(GAS u32x4*)(WT + (size_t)(n0 + n) * K + k0 + 8 * c) = o; }
    LDS_WAIT(); asm volatile("" ::: "memory");
}

__device__ __forceinline__ void p0_prologue(Frame F) {
    F.fresh();
    LAS float* sc = (LAS float*)F.lds; LAS float* part = (LAS float*)(F.lds + 32768);
    float* mod = (float*)(F.ws + WS_MOD);
    if ((int)blockIdx.x < 192) {
        for (int i = F.tid; i < 8 * 1024; i += NTHR) { const float v = F.c[i]; sc[i] = v / (1.f + __expf(-v)); }
        __syncthreads();
        for (int jb = blockIdx.x; jb < 192; jb += F.G) {
            const int jj = F.tid & 31, kc = F.tid >> 5, j0 = jb * 32;
            float a[8];
#pragma unroll
            for (int b = 0; b < 8; ++b) a[b] = 0.f;
            for (int kk = 0; kk < 64; ++kk) { const int k = kc * 64 + kk; const float w = F.w_ada[(size_t)k * 6144 + j0 + jj];
#pragma unroll
                for (int b = 0; b < 8; ++b) a[b] += sc[b * 1024 + k] * w; }
#pragma unroll
            for (int b = 0; b < 8; ++b) part[(kc * 8 + b) * 32 + jj] = a[b];
            __syncthreads();
            if (F.tid < 256) { const int b = F.tid >> 5; float s = F.b_ada[j0 + jj];
                for (int k2 = 0; k2 < 16; ++k2) s += part[(k2 * 8 + b) * 32 + jj];
                mod[(size_t)b * 6144 + j0 + jj] = s; }
            __syncthreads();
        }
    }
    __syncthreads();
    LAS float* scr = (LAS float*)(F.lds + F.wave * 16384);
    const int gw = F.vcu * NWAVES + F.wave, NGW = F.G * NWAVES;
    constexpr int I_IN = 16 * 112, I_OUT = 16 * 32, I_E13 = 16 * 16, I_E2 = 8 * 32;
    constexpr int NITEMS = I_IN + I_OUT + NEXP * (2 * I_E13 + I_E2);
    for (int it = gw; it < NITEMS; it += NGW) {
        int r = it;
        if (r < I_IN) { p0_transpose_item(F.w_in, 1024, NPROJ_SRC, 112, (f16*)(F.ws + WS_WIN), scr, r, F.lane); continue; } r -= I_IN;
        if (r < I_OUT) { p0_transpose_item(F.w_out, 1024, 1024, 32, (f16*)(F.ws + WS_WOUT), scr, r, F.lane); continue; } r -= I_OUT;
        const int per = 2 * I_E13 + I_E2, e = r / per; r -= e * per;
        if (r < I_E13) { p0_transpose_item(F.w1 + (size_t)e * 1024 * 512, 1024, 512, 16, (f16*)(F.ws + WS_W1) + (size_t)e * 512 * 1024, scr, r, F.lane); continue; } r -= I_E13;
        if (r < I_E13) { p0_transpose_item(F.w3 + (size_t)e * 1024 * 512, 1024, 512, 16, (f16*)(F.ws + WS_W3) + (size_t)e * 512 * 1024, scr, r, F.lane); continue; } r -= I_E13;
        p0_transpose_item(F.w2 + (size_t)e * 512 * 1024, 512, 1024, 32, (f16*)(F.ws + WS_W2) + (size_t)e * 1024 * 512, scr, r, F.lane);
    }
}

__device__ __forceinline__ void p1_rows(Frame F) {
    F.fresh();
    const int gw = F.vcu * NWAVES + F.wave, NGW = F.G * NWAVES;
    const float* mod = (const float*)(F.ws + WS_MOD);
    f16* hbuf = (f16*)(F.ws + WS_A); float* gates = (float*)(F.ws + WS_GATES);
    float* cosT = (float*)(F.ws + WS_COS); float* sinT = (float*)(F.ws + WS_SIN);
    for (int row = gw; row < T; row += NGW) {
        const int b = row / SEQ;
        const GAS f32x4* xr = (const GAS f32x4*)(F.x + (size_t)row * DM) + F.lane;
        f32x4 v[4]; float ss = 0.f;
#pragma unroll
        for (int j = 0; j < 4; ++j) { v[j] = xr[64 * j]; ss += (v[j].x * v[j].x + v[j].y * v[j].y) + (v[j].z * v[j].z + v[j].w * v[j].w); }
        const float rstd = 1.f / sqrtf(wave_sum(ss) * (1.f / DM) + EPS);
        float ga[8];
#pragma unroll
        for (int q = 0; q < 8; ++q) ga[q] = 0.f;
        GAS u32x2* o8 = (GAS u32x2*)(hbuf + (size_t)row * DM) + F.lane;
#pragma unroll
        for (int j = 0; j < 4; ++j) {
            const int k0 = 4 * F.lane + 256 * j;
            const f32x4 g = *(const f32x4*)(F.norm1_g + k0), sh = *(const f32x4*)(mod + (size_t)b * 6144 + k0), scl = *(const f32x4*)(mod + (size_t)b * 6144 + 1024 + k0);
            const f32x4 h = v[j] * rstd * g * (scl + 1.f) + sh;
            u32x2 w; w.x = pk2h(h[0], h[1]); w.y = pk2h(h[2], h[3]); o8[64 * j] = w;
#pragma unroll
            for (int i = 0; i < 4; ++i) { const float* wp = F.w_in + (size_t)(k0 + i) * NPROJ_SRC + NPROJ; const f32x4 w0 = *(const f32x4*)wp, w1 = *(const f32x4*)(wp + 4);
                ga[0] += h[i] * w0[0]; ga[1] += h[i] * w0[1]; ga[2] += h[i] * w0[2]; ga[3] += h[i] * w0[3];
                ga[4] += h[i] * w1[0]; ga[5] += h[i] * w1[1]; ga[6] += h[i] * w1[2]; ga[7] += h[i] * w1[3]; }
        }
#pragma unroll
        for (int q = 0; q < 8; ++q) ga[q] = wave_sum(ga[q]);
        if (F.lane == 0) {
#pragma unroll
            for (int q = 0; q < 8; ++q) gates[(size_t)row * 8 + q] = ga[q] + F.b_gate[q];
        }
        if (F.lane < 32) { const float invf = exp2f(-(float)F.lane * (13.287712379549449f / 32.f)); const float ang = (float)F.positions[row] * invf;
            cosT[(size_t)row * 32 + F.lane] = cosf(ang); sinT[(size_t)row * 32 + F.lane] = sinf(ang); }
    }
}

__device__ __forceinline__ void p3_attn_simple(Frame F) {
    F.fresh();
    const f16* proj = (const f16*)(F.ws + WS_PROJ); const float* ksum = (const float*)(F.ws + WS_CTL + CTL_KMEAN); f16* mix = (f16*)(F.ws + WS_A);
    for (int u = blockIdx.x; u < 64 * 8; u += F.G) {
        const int bh = u >> 3, chunk = u & 7, b = bh >> 3, h = bh & 7;
        const int q = chunk * 512 + F.tid, jb = q >> 8, row = b * SEQ + q;
        float qv[64];
        { const f16x8* qp = (const f16x8*)(proj + (size_t)row * NPROJ + C_QA + h * 64);
#pragma unroll
          for (int i = 0; i < 8; ++i) { const f16x8 t = qp[i];
#pragma unroll
              for (int k = 0; k < 8; ++k) qv[8 * i + k] = (float)t[k]; } }
        unsigned sel = 0u;
        { float g[16];
#pragma unroll
          for (int n = 0; n < 16; ++n) { float s = 0.f;
              if (n < jb) { const float* kp = ksum + ((size_t)bh * 16 + n) * 64;
#pragma unroll
                  for (int d = 0; d < 64; ++d) s += qv[d] * kp[d]; }
              g[n] = (n < jb) ? s : -INFINITY; }
#pragma unroll
          for (int r = 0; r < 3; ++r) { float best = -INFINITY; int bi = -1;
#pragma unroll
              for (int n = 0; n < 16; ++n) { const bool ok = !((sel >> n) & 1u) && g[n] > best; best = ok ? g[n] : best; bi = ok ? n : bi; }
              if (bi >= 0) sel |= 1u << bi; } }
        float m = -INFINITY, l = 0.f, acc[64];
#pragma unroll
        for (int d = 0; d < 64; ++d) acc[d] = 0.f;
        for (int n = 0; n <= jb; ++n) {
            const bool own = (n == jb), act = own || ((sel >> n) & 1u);
            for (int kk = 0; kk < 256; ++kk) {
                const bool on = act && (!own || kk <= (q & 255));
                if (!__any(on)) break;
                const size_t krow = (size_t)(b * SEQ + n * 256 + kk) * NPROJ;
                const f16x8* kp = (const f16x8*)(proj + krow + C_KA + h * 64);
                float s = 0.f;
#pragma unroll
                for (int i = 0; i < 8; ++i) { const f16x8 t = kp[i];
#pragma unroll
                    for (int k = 0; k < 8; ++k) s += qv[8 * i + k] * (float)t[k]; }
                if (on) {
                    const float mn = fmaxf(m, s), f = exp2f(m - mn), p = exp2f(s - mn);
                    const f16x8* vp = (const f16x8*)(proj + krow + C_VA + h * 64);
                    l = l * f + p; m = mn;
#pragma unroll
                    for (int i = 0; i < 8; ++i) { const f16x8 t = vp[i];
#pragma unroll
                        for (int k = 0; k < 8; ++k) acc[8 * i + k] = acc[8 * i + k] * f + p * (float)t[k]; }
                }
            }
        }
        const float il = 1.f / l; float ss = 0.f;
#pragma unroll
        for (int d = 0; d < 64; ++d) { acc[d] *= il; ss += acc[d] * acc[d]; }
        const float rs = 1.f / sqrtf(ss * (1.f / 64.f) + EPS);
        u32x4* op = (u32x4*)(mix + (size_t)row * DM + h * 64);
#pragma unroll
        for (int i = 0; i < 8; ++i) { float o[8];
#pragma unroll
            for (int k = 0; k < 8; ++k) o[k] = acc[8 * i + k] * rs * F.attn_g[h * 64 + 8 * i + k];
            u32x4 w; w.x = pk2h(o[0], o[1]); w.y = pk2h(o[2], o[3]); w.z = pk2h(o[4], o[5]); w.w = pk2h(o[6], o[7]); op[i] = w; }
    }
}


__device__ __forceinline__ void p3_attn(Frame F) {
    F.fresh();
    const f16* proj = (const f16*)(F.ws + WS_PROJ); const float* ksum = (const float*)(F.ws + WS_CTL + CTL_KMEAN); f16* mix = (f16*)(F.ws + WS_A);
    const int bh = F.vcu >> 2, s4 = F.vcu & 3;
    if (bh < 64) {
#pragma unroll 1
        for (int i = 0; i < 4; ++i) {
            const int qb = (i == 0) ? s4 : (i == 1) ? 15 - s4 : (i == 2) ? 4 + s4 : 11 - s4;
            moba::sel_unit(bh >> 3, bh & 7, qb, proj + C_QA, ksum, (char*)F.lds);
            moba::attn_unit<8>(bh >> 3, bh & 7, qb, proj + C_QA, proj + C_KA, proj + C_VA, mix, ksum, F.attn_g, (char*)F.lds);
        }
    }
}

__device__ __forceinline__ void p3_mlstm_simple(Frame F) {
    F.fresh();
    const f16* proj = (const f16*)(F.ws + WS_PROJ); const float* gates = (const float*)(F.ws + WS_GATES); f16* mix = (f16*)(F.ws + WS_A);
    LAS float* qs = (LAS float*)F.lds; LAS float* ks = qs + 128; LAS float* vs = qs + 256; LAS float* red = qs + 384;
    for (int bh = blockIdx.x; bh < 32; bh += F.G) {
        const int b = bh >> 2, hm = bh & 3, e = F.tid >> 2, dq = F.tid & 3;
        float Cs[32], nn[32], m = 0.f;
#pragma unroll
        for (int j = 0; j < 32; ++j) { Cs[j] = 0.f; nn[j] = 0.f; }
        const float og = F.mlstm_g[hm * 128 + e];
        for (int t = 0; t < SEQ; ++t) {
            const int row = b * SEQ + t;
            if (F.tid < 256) {
                const bool isk = F.tid >= 128; const int d = F.tid & 127, col = (isk ? C_KM : C_QM) + hm * 128 + d, cc = (isk ? 512 : 0) + hm * 128 + d;
                float val = F.conv_b[cc];
#pragma unroll
                for (int j = 0; j < 4; ++j) { const int tt = t - 3 + j; if (tt >= 0) val += (float)proj[(size_t)(b * SEQ + tt) * NPROJ + col] * F.conv_w[j * 1024 + cc]; }
                val = val / (1.f + __expf(-val));
                if (isk) ks[d] = val * 0.08838834764831845f; else qs[d] = val;
            } else if (F.tid < 384) { const int d = F.tid - 256; vs[d] = (float)proj[(size_t)row * NPROJ + C_VM + hm * 128 + d]; }
            const float ig = gates[(size_t)row * 8 + hm], fg = gates[(size_t)row * 8 + 4 + hm];
            __syncthreads();
            const float logf = fminf(fg, 0.f) - log1pf(__expf(-fabsf(fg)));
            const float mn = fmaxf(logf + m, ig), a = __expf(logf + m - mn), bb = __expf(ig - mn); m = mn;
            const float ve = vs[e] * bb; float pn = 0.f, pd = 0.f;
#pragma unroll
            for (int j = 0; j < 32; ++j) { const int d = 32 * dq + j; const float kd = ks[d], qd = qs[d];
                Cs[j] = a * Cs[j] + ve * kd; nn[j] = a * nn[j] + bb * kd; pn += Cs[j] * qd; pd += nn[j] * qd; }
            pn += __shfl_xor(pn, 1); pn += __shfl_xor(pn, 2); pd += __shfl_xor(pd, 1); pd += __shfl_xor(pd, 2);
            const float hv = pn / fmaxf(fabsf(pd), __expf(-m));
            const float sq = wave_sum(dq == 0 ? hv * hv : 0.f);
            if (F.lane == 0) red[F.wave] = sq;
            __syncthreads();
            float tot = 0.f;
#pragma unroll
            for (int w = 0; w < 8; ++w) tot += red[w];
            if (dq == 0) { const float om = (float)proj[(size_t)row * NPROJ + C_OM + hm * 128 + e];
                const float o = hv / sqrtf(tot * (1.f / 128.f) + EPS) * og * sigmoidf_(om);
                mix[(size_t)row * DM + 512 + hm * 128 + e] = (f16)o; }
            __syncthreads();
        }
    }
}

__device__ __forceinline__ void p5_route(Frame F) {
    F.fresh();
    const int gw = F.vcu * NWAVES + F.wave, NGW = F.G * NWAVES;
    const float* mod = (const float*)(F.ws + WS_MOD);
    f16* h2 = (f16*)(F.ws + WS_H2); int* list = (int*)(F.ws + WS_LIST); int* pos2 = (int*)(F.ws + WS_POS);
    unsigned* cnt = (unsigned*)(F.ws + WS_CTL) + CW_CNT;
    for (int row = gw; row < T; row += NGW) {
        const int b = row / SEQ;
        const GAS f32x4* xr = (const GAS f32x4*)(F.out + (size_t)row * DM) + F.lane;
        f32x4 v[4]; float ss = 0.f;
#pragma unroll
        for (int j = 0; j < 4; ++j) { v[j] = xr[64 * j]; ss += (v[j].x * v[j].x + v[j].y * v[j].y) + (v[j].z * v[j].z + v[j].w * v[j].w); }
        const float rstd = 1.f / sqrtf(wave_sum(ss) * (1.f / DM) + EPS);
        float lg[36];
#pragma unroll
        for (int q = 0; q < 36; ++q) lg[q] = 0.f;
        GAS u32x2* o8 = (GAS u32x2*)(h2 + (size_t)row * DM) + F.lane;
        const float* wgp = F.w_rg + (size_t)F.lane * 16; const float* wep = F.w_re + (size_t)F.lane * 128;
        const float* gp = F.norm2_g + 4 * F.lane; const float* mp = mod + (size_t)b * 6144 + 3072 + 4 * F.lane;
#pragma unroll 1
        for (int j = 0; j < 4; ++j) {
            const f32x4 g = *(const f32x4*)gp, sh = *(const f32x4*)mp, scl = *(const f32x4*)(mp + 1024);
            const f32x4 h = v[0] * rstd * g * (scl + 1.f) + sh;
            v[0] = v[1]; v[1] = v[2]; v[2] = v[3];
            u32x2 w; w.x = pk2h(h[0], h[1]); w.y = pk2h(h[2], h[3]); *o8 = w;
#pragma unroll
            for (int i = 0; i < 4; ++i) {
                const f32x4 wg = *(const f32x4*)(wgp + 4 * i);
#pragma unroll
                for (int q = 0; q < 4; ++q) lg[q] += h[i] * wg[q];
#pragma unroll
                for (int q4 = 0; q4 < 8; ++q4) { const f32x4 we = *(const f32x4*)(wep + 32 * i + 4 * q4);
#pragma unroll
                    for (int q = 0; q < 4; ++q) lg[4 + 4 * q4 + q] += h[i] * we[q]; }
            }
            wgp += 256 * 4; wep += 256 * 32; gp += 256; mp += 256; o8 += 64;
            asm volatile("" ::: "memory");
        }
#pragma unroll
        for (int q = 0; q < 36; ++q) lg[q] = wave_sum(lg[q]);
        float gl[4];
#pragma unroll
        for (int q = 0; q < 4; ++q) gl[q] = lg[q] + F.b_rg[q];
        int gi = 0; float gm = gl[0];
#pragma unroll
        for (int q = 1; q < 4; ++q) if (gl[q] > gm) { gm = gl[q]; gi = q; }
        float gsum = 0.f;
#pragma unroll
        for (int q = 0; q < 4; ++q) gsum += __expf(gl[q] - gm);
        const float pg = 1.f / gsum;
        float el[8];
#pragma unroll
        for (int q = 0; q < 8; ++q) { const float e0 = lg[4 + q], e1 = lg[12 + q], e2 = lg[20 + q], e3 = lg[28 + q]; el[q] = (gi == 0 ? e0 : gi == 1 ? e1 : gi == 2 ? e2 : e3) + F.b_re[gi * 8 + q]; }
        int i1 = 0; float m1 = el[0];
#pragma unroll
        for (int q = 1; q < 8; ++q) if (el[q] > m1) { m1 = el[q]; i1 = q; }
        int i2 = -1; float m2 = -INFINITY;
#pragma unroll
        for (int q = 0; q < 8; ++q) if (q != i1 && el[q] > m2) { m2 = el[q]; i2 = q; }
        const float r = __expf(m2 - m1), w1 = pg / (1.f + r), w2 = pg * r / (1.f + r);
        if (F.lane < 2) { const int e = gi * 8 + (F.lane == 0 ? i1 : i2); const float w = F.lane == 0 ? w1 : w2;
            const unsigned slot = atomicAdd(cnt + e, 1u);
            list[2 * ((size_t)e * LISTCAP + slot)] = row; list[2 * ((size_t)e * LISTCAP + slot) + 1] = __float_as_int(w);
            pos2[2 * row + F.lane] = e * LISTCAP + (int)slot; }
    }
}

__device__ __forceinline__ void moe_tables(Frame F) {
    F.fresh();
    LAS int* tab = (LAS int*)(F.lds + TAB_OFF);
    const unsigned* cnt = (const unsigned*)(F.ws + WS_CTL) + CW_CNT;
    __syncthreads();
    if (F.tid == 0) { int up = 0, rp = 0;
        for (int e = 0; e < 32; ++e) { const int c = (int)__hip_atomic_load(cnt + e, RLX_AGENT); tab[e] = up; tab[40 + e] = rp; tab[80 + e] = c; up += ((c + 255) >> 8) * 4; rp += c; }
        tab[32] = up; tab[72] = rp; }
    __syncthreads();
}

__device__ __forceinline__ void p8_final(Frame F) {
    F.fresh();
    const int gw = F.vcu * NWAVES + F.wave, NGW = F.G * NWAVES;
    const float* mod = (const float*)(F.ws + WS_MOD); const f16* Y = (const f16*)(F.ws + WS_Y); const int* pos2 = (const int*)(F.ws + WS_POS);
    const LAS int* tab = (const LAS int*)(F.lds + TAB_OFF);
    for (int row = gw; row < T; row += NGW) {
        const int b = row / SEQ; const int p0 = pos2[2 * row], p1 = pos2[2 * row + 1];
        const size_t y0 = (size_t)(tab[40 + (p0 >> 15)] + (p0 & 32767)) * DM, y1 = (size_t)(tab[40 + (p1 >> 15)] + (p1 & 32767)) * DM;
        GAS f32x4* xr = (GAS f32x4*)(F.out + (size_t)row * DM) + F.lane;
        f32x4 v[4]; float ss = 0.f;
#pragma unroll
        for (int j = 0; j < 4; ++j) { const int k0 = 4 * F.lane + 256 * j;
            const f16x4 a = *(const f16x4*)(Y + y0 + k0), c = *(const f16x4*)(Y + y1 + k0); const f32x4 g2 = *(const f32x4*)(mod + (size_t)b * 6144 + 5120 + k0);
            f32x4 s; s.x = (float)a[0] + (float)c[0]; s.y = (float)a[1] + (float)c[1]; s.z = (float)a[2] + (float)c[2]; s.w = (float)a[3] + (float)c[3];
            v[j] = xr[64 * j] + g2 * s; ss += (v[j].x * v[j].x + v[j].y * v[j].y) + (v[j].z * v[j].z + v[j].w * v[j].w); }
        const float rstd = 1.f / sqrtf(wave_sum(ss) * (1.f / DM) + EPS);
#pragma unroll
        for (int j = 0; j < 4; ++j) { const int k0 = 4 * F.lane + 256 * j; xr[64 * j] = v[j] * rstd * *(const f32x4*)(F.normf_g + k0); }
    }
}

__global__ void __launch_bounds__(NTHR, 2) fwd_kernel(Args args) {
    extern __shared__ __attribute__((aligned(16))) unsigned char lds_raw[];
    Frame F;
    F.lds = (LAS unsigned char*)lds_raw;
    F.tid = threadIdx.x; F.lane = F.tid & 63; F.wave = __builtin_amdgcn_readfirstlane(F.tid >> 6);
    F.G = gridDim.x; { const int bx = blockIdx.x; F.vcu = (F.G % 8 == 0) ? (bx % 8) * (F.G / 8) + bx / 8 : bx; }
    F.x = (const float*)args.in[0]; F.c = (const float*)args.in[1]; F.positions = (const int*)args.in[2]; F.w_ada = (const float*)args.in[3]; F.b_ada = (const float*)args.in[4];
    F.norm1_g = (const float*)args.in[5]; F.w_in = (const float*)args.in[6]; F.b_gate = (const float*)args.in[7]; F.conv_w = (const float*)args.in[8]; F.conv_b = (const float*)args.in[9];
    F.attn_g = (const float*)args.in[10]; F.mlstm_g = (const float*)args.in[11]; F.w_out = (const float*)args.in[12]; F.norm2_g = (const float*)args.in[13];
    F.w_rg = (const float*)args.in[14]; F.b_rg = (const float*)args.in[15]; F.w_re = (const float*)args.in[16]; F.b_re = (const float*)args.in[17];
    F.w1 = (const float*)args.in[18]; F.w3 = (const float*)args.in[19]; F.w2 = (const float*)args.in[20]; F.normf_g = (const float*)args.in[21];
    F.out = args.out; F.ws = args.ws;
    for (int u = F.tid; u < (LDS_BYTES - LDSCTL_OFF) / 4; u += NTHR) ((LAS unsigned*)(F.lds + LDSCTL_OFF))[u] = 0u;
    __syncthreads();
    unsigned* ctl = (unsigned*)(F.ws + WS_CTL);
    XcdBarrier bar = xcd_barrier_post(ctl + CW_BAR, (volatile LAS unsigned*)(F.lds + MISC_OFF) + 8);

    p0_prologue(F);
    xcd_barrier(bar);
    p1_rows(F);
    xcd_barrier(bar);
    { pg8::DenseSched S; S.init(T, NPROJ, 1024, F.G, (int)blockIdx.x, true);
      pg8::EpiProj E{(f16*)(F.ws + WS_PROJ), (const float*)(F.ws + WS_COS), (const float*)(F.ws + WS_SIN), (float*)(F.ws + WS_CTL + CTL_KMEAN)};
      pg8::gemm_phase<true>(F.lds, (const char*)(F.ws + WS_A), (const char*)(F.ws + WS_WIN), 1024, S, E); }
    xcd_barrier(bar);
    p3_mlstm_simple(F);
    __syncthreads();
    p3_attn(F);
    xcd_barrier(bar);
    { pg8::DenseSched S; S.init(T, DM, 1024, F.G, (int)blockIdx.x, false);
      pg8::EpiOut E{F.x, (const float*)(F.ws + WS_MOD), F.out};
      pg8::gemm_phase<false>(F.lds, (const char*)(F.ws + WS_A), (const char*)(F.ws + WS_WOUT), 1024, S, E); }
    xcd_barrier(bar);
    p5_route(F);
    xcd_barrier(bar);
    moe_tables(F);
    { pg8::MoeSched S{(const LAS int*)(F.lds + TAB_OFF), F.G, F.vcu, 1024, true, (const int*)(F.ws + WS_LIST), 0, 0};
      pg8::EpiMoe1 E{(f16*)(F.ws + WS_HID)};
      pg8::gemm_phase<false>(F.lds, (const char*)(F.ws + WS_H2), (const char*)(F.ws + WS_W1), 1024, S, E); }
    xcd_barrier(bar);
    { pg8::MoeSched S{(const LAS int*)(F.lds + TAB_OFF), F.G, F.vcu, 512, false, (const int*)(F.ws + WS_LIST), 0, 0};
      pg8::EpiMoe2 E{(f16*)(F.ws + WS_Y), (const int*)(F.ws + WS_LIST)};
      pg8::gemm_phase<false>(F.lds, (const char*)(F.ws + WS_HID), (const char*)(F.ws + WS_W2), 512, S, E); }
    xcd_barrier(bar);
    p8_final(F);
}

extern "C" void kernel_launch(void* const* d_in, const int* in_sizes, int n_in, void* d_out, int out_size, void* d_ws, size_t ws_size, hipStream_t stream) {
    static int grid = 0;
    if (grid == 0) {
        if (n_in != 22 || out_size != T * DM || ws_size < WS_END) { fprintf(stderr, "kernel_launch: unexpected problem (n_in %d, out %d, ws %zu)\n", n_in, out_size, ws_size); grid = -1; return; }
        int dev = 0, cus = 0, per_cu = 0;
        if (hipGetDevice(&dev) != hipSuccess || hipDeviceGetAttribute(&cus, hipDeviceAttributeMultiprocessorCount, dev) != hipSuccess) { grid = -1; return; }
        if (hipFuncSetAttribute((const void*)fwd_kernel, hipFuncAttributeMaxDynamicSharedMemorySize, LDS_BYTES) != hipSuccess) { fprintf(stderr, "kernel_launch: hipFuncSetAttribute failed\n"); grid = -1; return; }
        if (hipOccupancyMaxActiveBlocksPerMultiprocessor(&per_cu, (const void*)fwd_kernel, NTHR, LDS_BYTES) != hipSuccess || per_cu < 1) fprintf(stderr, "kernel_launch: occupancy query says %d\n", per_cu);
        (void)hipGetLastError();
        grid = cus;
    }
    if (grid < 0) return;
    (void)hipMemsetAsync((char*)d_ws + WS_CTL, 0, CTL_ZERO_BYTES, stream);
    Args a{};
    for (int i = 0; i < 22; ++i) a.in[i] = d_in[i];
    a.out = (float*)d_out; a.ws = (unsigned char*)d_ws;
    hipLaunchKernelGGL(fwd_kernel, dim3(grid), dim3(NTHR), LDS_BYTES, stream, a);
}
```

```cpp
#include <hip/hip_runtime.h>
#include <cstdio>
#include <cstdint>
#include <cmath>

#define LAS __attribute__((address_space(3)))
#define GAS __attribute__((address_space(1)))
typedef _Float16 f16;
typedef _Float16 f16x8 __attribute__((ext_vector_type(8)));
typedef _Float16 f16x4 __attribute__((ext_vector_type(4)));
typedef _Float16 f16x2 __attribute__((ext_vector_type(2)));
typedef float f32x4 __attribute__((ext_vector_type(4)));
typedef float f32x2 __attribute__((ext_vector_type(2)));
typedef unsigned u32x4 __attribute__((ext_vector_type(4)));
typedef unsigned u32x2 __attribute__((ext_vector_type(2)));

constexpr int NB = 8, SEQ = 4096, DM = 1024, T = NB * SEQ;
constexpr int NPROJ = 3584, NPROJ_SRC = 3592;
constexpr int C_QA = 0, C_KA = 512, C_VA = 1024, C_QM = 1536, C_KM = 2048, C_VM = 2560, C_OM = 3072;
constexpr int NEXP = 32, DEXP = 512, LISTCAP = 32768;
constexpr float EPS = 1e-6f;
constexpr float C2 = 0.125f * 1.4426950408889634f;
constexpr int NWAVES = 8, NTHR = 512;

constexpr size_t MiB = 1u << 20;
constexpr size_t WS_CTL = 0, CTL_ZERO_BYTES = 1 * MiB;
constexpr int CW_BAR = 4096;
constexpr int CW_CNT = 8192;
constexpr size_t CTL_KMEAN = 256 * 1024;
constexpr size_t WS_MOD = 1 * MiB, WS_GATES = 2 * MiB, WS_POS = 3 * MiB, WS_COS = 4 * MiB, WS_SIN = 8 * MiB, WS_LIST = 12 * MiB;
constexpr size_t WS_WIN = 20 * MiB, WS_WOUT = 27 * MiB, WS_W1 = 29 * MiB, WS_W3 = 61 * MiB, WS_W2 = 93 * MiB;
constexpr size_t WS_A = 126 * MiB;
constexpr size_t WS_PROJ = 190 * MiB;
constexpr size_t WS_H2 = 190 * MiB;
constexpr size_t WS_HID = 254 * MiB;
constexpr size_t WS_Y = 320 * MiB;
constexpr size_t WS_END = 450 * MiB;

constexpr int RING_BYTES = 131072;
constexpr int LDSCTL_OFF = RING_BYTES, MISC_OFF = LDSCTL_OFF + 320, TAB_OFF = LDSCTL_OFF + 1024;
constexpr int ARGS_OFF = LDSCTL_OFF + 2048;
constexpr int LDS_BYTES = 147456;

#define RLX_AGENT __ATOMIC_RELAXED, __HIP_MEMORY_SCOPE_AGENT
#define LDS_WAIT() asm volatile("s_waitcnt lgkmcnt(0)" ::: "memory")
__device__ __forceinline__ unsigned pk2h(float a, float b) { f16x2 v = {(f16)a, (f16)b}; return __builtin_bit_cast(unsigned, v); }
__device__ __forceinline__ float wave_sum(float v) {
#pragma unroll
    for (int o = 1; o < 64; o <<= 1) v += __shfl_xor(v, o);
    return v;
}
__device__ __forceinline__ float sigmoidf_(float x) { return 1.f / (1.f + __expf(-x)); }

#define XB_TMO      128
#define XB_XCNT(j)  (256  + 64 * (j))
#define XB_XSUB(j)  (1280 + 64 * (j))
#define XB_XGEN(j)  (2304 + 64 * (j))
#define XB_TOP      3328
#define XB_TOPGEN   3392
#define XCD_BAR_WORDS 3456
#define XB_SPIN_CAP (1u << 22)
__device__ __forceinline__ unsigned xb_ld(unsigned* p)              { return __hip_atomic_load(p, __ATOMIC_RELAXED, __HIP_MEMORY_SCOPE_AGENT); }
__device__ __forceinline__ unsigned xb_add(unsigned* p, unsigned v) { return __hip_atomic_fetch_add(p, v, __ATOMIC_RELAXED, __HIP_MEMORY_SCOPE_AGENT); }
__device__ __forceinline__ unsigned xb_xcc_id() { return (unsigned)__builtin_amdgcn_s_getreg((3 << 11) | 20) & 0xFu; }
#define XB_SPIN(cond, bar) do { unsigned _sp = 0; while (cond) { __builtin_amdgcn_s_sleep(1); \
    if ((++_sp & 255u) == 0u) { if (xb_ld(&(bar)[XB_TMO])) break; if (_sp > XB_SPIN_CAP) { atomicAdd(&(bar)[XB_TMO], 1u); break; } } } } while (0)
struct XcdBarrier { unsigned* bar; unsigned x; volatile LAS unsigned* st; };
__device__ __forceinline__ XcdBarrier xcd_barrier_post(unsigned* bar, volatile LAS unsigned* st) {
    XcdBarrier b; b.bar = bar; b.x = xb_xcc_id(); b.st = st;
    if (threadIdx.x == 0) (void)xb_add(&bar[XB_XCNT(b.x)], 1u);
    return b;
}
__device__ __forceinline__ void xcd_barrier_complete(unsigned* bar, unsigned x, unsigned& nloc, unsigned& nx) {
    const unsigned G = gridDim.x * gridDim.y * gridDim.z;
    unsigned sum, cnt, mine, sp = 0u;
    for (;;) {
        sum = 0u; cnt = 0u; mine = 0u;
#pragma unroll
        for (unsigned j = 0; j < 16; ++j) { const unsigned c = xb_ld(&bar[XB_XCNT(j)]); sum += c; cnt += (c > 0u) ? 1u : 0u; mine = (j == x) ? c : mine; }
        if (sum == G) break;
        __builtin_amdgcn_s_sleep(1);
        if ((++sp & 255u) == 0u) { if (xb_ld(&bar[XB_TMO])) break; if (sp > XB_SPIN_CAP) { atomicAdd(&bar[XB_TMO], 1u); break; } }
    }
    nloc = mine > 0u ? mine : 1u; nx = cnt > 0u ? cnt : 1u;
}
__device__ __forceinline__ void xcd_barrier(const XcdBarrier& b) {
    asm volatile("s_waitcnt vmcnt(0)" ::: "memory");
    __syncthreads();
    if (threadIdx.x == 0) {
        unsigned* bar = b.bar;
        __builtin_amdgcn_s_waitcnt(0);
        unsigned nloc = b.st[0], nx = b.st[1];
        if (nloc == 0u) { xcd_barrier_complete(bar, b.x, nloc, nx); b.st[0] = nloc; b.st[1] = nx; }
        const unsigned old = xb_add(&bar[XB_XSUB(b.x)], 1u);
        const unsigned gen = old / nloc;
        if (old + 1u == (gen + 1u) * nloc) {
            __builtin_amdgcn_fence(__ATOMIC_RELEASE, "agent");
            asm volatile("s_waitcnt vmcnt(0)" ::: "memory");
            const unsigned og = xb_add(&bar[XB_TOP], 1u);
            const unsigned tg = og / nx;
            if (og + 1u == (tg + 1u) * nx) xb_add(&bar[XB_TOPGEN], 1u);
            else XB_SPIN(xb_ld(&bar[XB_TOPGEN]) == tg, bar);
            __builtin_amdgcn_fence(__ATOMIC_ACQUIRE, "agent");
            xb_add(&bar[XB_XGEN(b.x)], 1u);
            asm volatile("s_waitcnt vmcnt(0)" ::: "memory");
        } else {
            XB_SPIN(xb_ld(&bar[XB_XGEN(b.x)]) == gen, bar);
            __builtin_amdgcn_fence(__ATOMIC_ACQUIRE, "agent");
            asm volatile("s_waitcnt vmcnt(0)" ::: "memory");
        }
    }
    __syncthreads();
}

namespace pg8 {
constexpr int BM = 256, BK = 64, HALF = 128, HTB = HALF * BK * 2, STAGE_BYTES = 8 * HTB;
__host__ __device__ __forceinline__ int lds_byte(int r, int c) { const int st = (r >> 4) * 2 + (c >> 5), rr = r & 15, cc = c & 31, ob = rr * 64 + cc * 2; return st * 1024 + (ob ^ (((ob >> 9) & 1) << 5)); }
__host__ __device__ __forceinline__ void stage_rc(int b, int& R, int& C) { const int st = b / 1024, sb = b % 1024, swz = sb ^ (((sb >> 9) & 1) << 5); R = (st >> 1) * 16 + swz / 64; C = (st & 1) * 32 + (swz % 64) / 2; }
__host__ __device__ __forceinline__ int perm32(int rho) { const int n = rho >> 4, i = rho & 15; return 8 * (i >> 2) + 4 * n + (i & 3); }

struct Unit { size_t b0, b1; int pm, pn, e, row0, rows; };

template <bool ROPE, class Epi, class Sched>
__device__ __forceinline__ void gemm_phase(LAS unsigned char* lds, const char* Abase, const char* Bbase, const int K, const Sched& S, const Epi& E) {
    int tid = threadIdx.x; asm volatile("" : "+v"(tid));
    const int wid = __builtin_amdgcn_readfirstlane(tid >> 6), lane = tid & 63, wr = wid >> 2, wc = wid & 3, fr = lane & 15, fq = lane >> 4;
    const int nt = K / BK;
    int R[2], C[2]; unsigned voffB[2];
#pragma unroll
    for (int i = 0; i < 2; ++i) { stage_rc(tid * 16 + i * 8192, R[i], C[i]);
        const int Rb = ROPE ? (64 * (R[i] >> 5) + perm32(R[i] & 31)) : ((R[i] & ~31) + perm32(R[i] & 31));
        voffB[i] = (unsigned)(Rb * K + C[i]) * 2u; }
    const size_t kstep = (size_t)(BK * 2);
    const unsigned ldsw = (unsigned)wid * 1024u;
    const int aoff = lds_byte(wr * 64 + fr, fq * 8), boff = lds_byte(wc * 32 + fr, fq * 8);
#define PG8_SA(b, h) (((b) * 2 + (h)) * HTB)
#define PG8_SB(b, h) ((4 + (b) * 2 + (h)) * HTB)
#define PG8_STG(bufoff, gbase, voff) do { _Pragma("unroll") for (int _i = 0; _i < 2; ++_i) \
        __builtin_amdgcn_global_load_lds((const unsigned*)((const char*)(gbase) + (voff)[_i]), (LAS unsigned*)(lds + (bufoff) + ldsw + _i * 8192), 16, 0, 0); } while (0)
#define PG8_LDA(dst, b, h) do { _Pragma("unroll") for (int m = 0; m < 4; ++m) _Pragma("unroll") for (int k = 0; k < 2; ++k) dst[m][k] = *(const LAS f16x8*)(lds + PG8_SA(b, h) + aoff + m * 2048 + k * 1024); } while (0)
#define PG8_LDB(dst, b, h) do { _Pragma("unroll") for (int n = 0; n < 2; ++n) _Pragma("unroll") for (int k = 0; k < 2; ++k) dst[n][k] = *(const LAS f16x8*)(lds + PG8_SB(b, h) + boff + n * 2048 + k * 1024); } while (0)
#define PG8_MMA(ai, bj, At, Bt) do { __builtin_amdgcn_s_setprio(1); _Pragma("unroll") for (int m = 0; m < 4; ++m) _Pragma("unroll") for (int n = 0; n < 2; ++n) _Pragma("unroll") for (int k = 0; k < 2; ++k) \
        acc[ai][bj][m][n] = __builtin_amdgcn_mfma_f32_16x16x32_f16(Bt[n][k], At[m][k], acc[ai][bj][m][n], 0, 0, 0); __builtin_amdgcn_s_setprio(0); } while (0)
#define PG8_WAIT_V(n) asm volatile("s_waitcnt vmcnt(" #n ")" ::: "memory")
#define PG8_WAIT_L(n) asm volatile("s_waitcnt lgkmcnt(" #n ")" ::: "memory")
#define PG8_BAR __builtin_amdgcn_s_barrier()
#define PG8_SCHED __builtin_amdgcn_sched_barrier(0)
    Unit cur, nxt; int ui = 0;
    if (!S.next(0, cur)) return;
    f32x4 acc[2][2][4][2];
#pragma unroll
    for (int a = 0; a < 2; ++a)
#pragma unroll
        for (int b = 0; b < 2; ++b)
#pragma unroll
            for (int m = 0; m < 4; ++m)
#pragma unroll
                for (int n = 0; n < 2; ++n) acc[a][b][m][n] = (f32x4){0.f, 0.f, 0.f, 0.f};
    f16x8 At[4][2], B0[2][2], B1[2][2];
    unsigned cvA[2][2], nvA[2][2];
    S.avoff(cur, cvA, R, C);
    const char* cB0 = Bbase + cur.b0; const char* cB1 = Bbase + cur.b1;
    PG8_STG(PG8_SB(0, 0), cB0, voffB); PG8_STG(PG8_SB(0, 1), cB1, voffB); PG8_STG(PG8_SA(0, 0), Abase, cvA[0]); PG8_STG(PG8_SA(0, 1), Abase, cvA[1]);
    if (wr == 1) PG8_BAR;
    PG8_WAIT_V(2); PG8_BAR;
    PG8_STG(PG8_SB(1, 0), cB0 + kstep, voffB); PG8_STG(PG8_SA(1, 0), Abase + kstep, cvA[0]); PG8_STG(PG8_SB(1, 1), cB1 + kstep, voffB);
    PG8_WAIT_V(6); PG8_BAR;
    for (;;) {
        const bool has_next = S.next(ui + 1, nxt);
        if (has_next) S.avoff(nxt, nvA, R, C);
        else {
#pragma unroll
            for (int h = 0; h < 2; ++h)
#pragma unroll
                for (int i = 0; i < 2; ++i) nvA[h][i] = cvA[h][i];
        }
        const char* nB0 = has_next ? Bbase + nxt.b0 : cB0; const char* nB1 = has_next ? Bbase + nxt.b1 : cB1;
        for (int t = 0; t < nt; t += 2) {
            const bool last = (t == nt - 2);
            const char* a1 = Abase + (size_t)(t + 1) * kstep;
            const size_t k2 = last ? (size_t)0 : (size_t)(t + 2) * kstep;
            const char* a2 = Abase + k2; const char* a3 = a2 + kstep;
            const char* b20 = (last ? nB0 : cB0) + k2; const char* b21 = (last ? nB1 : cB1) + k2;
            const char* b30 = b20 + kstep; const char* b31 = b21 + kstep;
            unsigned vA2[2][2];
#pragma unroll
            for (int h = 0; h < 2; ++h)
#pragma unroll
                for (int i = 0; i < 2; ++i) vA2[h][i] = last ? nvA[h][i] : cvA[h][i];
            PG8_LDB(B0, 0, 0); PG8_LDB(B1, 0, 1); PG8_SCHED; PG8_LDA(At, 0, 0); PG8_STG(PG8_SA(1, 1), a1, cvA[1]);
            PG8_WAIT_V(8); PG8_WAIT_L(0); PG8_BAR; PG8_MMA(0, 0, At, B0); PG8_MMA(0, 1, At, B1); PG8_BAR; PG8_SCHED;
            PG8_LDA(At, 0, 1); PG8_STG(PG8_SB(0, 0), b20, voffB); PG8_STG(PG8_SB(0, 1), b21, voffB); PG8_STG(PG8_SA(0, 0), a2, vA2[0]);
            PG8_WAIT_V(8); PG8_WAIT_L(0); PG8_BAR; PG8_MMA(1, 0, At, B0); PG8_MMA(1, 1, At, B1); PG8_BAR; PG8_SCHED;
            PG8_LDB(B0, 1, 0); PG8_LDB(B1, 1, 1); PG8_SCHED; PG8_LDA(At, 1, 0); PG8_STG(PG8_SA(0, 1), a2, vA2[1]);
            PG8_WAIT_V(8); PG8_WAIT_L(0); PG8_BAR; PG8_MMA(0, 0, At, B0); PG8_MMA(0, 1, At, B1); PG8_BAR; PG8_SCHED;
            PG8_LDA(At, 1, 1); PG8_STG(PG8_SB(1, 0), b30, voffB); PG8_STG(PG8_SB(1, 1), b31, voffB); PG8_STG(PG8_SA(1, 0), a3, vA2[0]);
            PG8_WAIT_V(8); PG8_WAIT_L(0); PG8_BAR; PG8_MMA(1, 0, At, B0); PG8_MMA(1, 1, At, B1); PG8_BAR; PG8_SCHED;
        }
        if (wr == 0) PG8_BAR;
        E(acc, cur, wr, wc, fr, fq);
        if (!has_next) break;
#pragma unroll
        for (int a = 0; a < 2; ++a)
#pragma unroll
            for (int b = 0; b < 2; ++b)
#pragma unroll
                for (int m = 0; m < 4; ++m)
#pragma unroll
                    for (int n = 0; n < 2; ++n) acc[a][b][m][n] = (f32x4){0.f, 0.f, 0.f, 0.f};
        cur = nxt; cB0 = nB0; cB1 = nB1; ++ui;
#pragma unroll
        for (int h = 0; h < 2; ++h)
#pragma unroll
            for (int i = 0; i < 2; ++i) cvA[h][i] = nvA[h][i];
        if (wr == 1) PG8_BAR;
    }
    PG8_WAIT_V(0);
    PG8_BAR;
#undef PG8_SA
#undef PG8_SB
#undef PG8_STG
#undef PG8_LDA
#undef PG8_LDB
#undef PG8_MMA
#undef PG8_WAIT_V
#undef PG8_WAIT_L
#undef PG8_BAR
#undef PG8_SCHED
}

struct DenseSched {
    int nM, nN, nwg, G, c, K; bool rope;
    __device__ __forceinline__ void init(int M, int N, int K_, int G_, int c_, bool rope_) { nM = M / BM; nN = N / BM; nwg = nM * nN; G = G_; c = c_; K = K_; rope = rope_; }
    __device__ __forceinline__ bool next(int i, Unit& u) const {
        const long L = (long)i * G + c; if (L >= nwg) return false;
        int wgid = (int)L; { const int q = nwg / 8, r = nwg % 8, xcd = wgid % 8, off = wgid / 8; wgid = (xcd < r ? xcd * (q + 1) : r * (q + 1) + (xcd - r) * q) + off; }
        const int WGM = 8, nig = WGM * nN, gid = wgid / nig, fm = gid * WGM, gsz = (nM - fm) < WGM ? (nM - fm) : WGM;
        u.pm = fm + ((wgid % nig) % gsz); u.pn = (wgid % nig) / gsz; u.e = 0; u.row0 = u.pm * BM; u.rows = BM;
        u.b0 = (size_t)(u.pn * BM) * K * 2; u.b1 = u.b0 + (size_t)(rope ? 32 : 128) * K * 2;
        return true;
    }
    __device__ __forceinline__ void avoff(const Unit& u, unsigned (&vo)[2][2], const int (&R)[2], const int (&C)[2]) const {
#pragma unroll
        for (int h = 0; h < 2; ++h)
#pragma unroll
            for (int i = 0; i < 2; ++i) vo[h][i] = (unsigned)((u.row0 + 128 * h + R[i]) * K + C[i]) * 2u;
    }
};
struct MoeSched {
    const LAS int* tab; int G, cv, K; bool gather; const int* list; size_t bstep, bhalf;
    __device__ __forceinline__ bool next(int i, Unit& u) const {
        const int L = i * G + cv; if (L >= tab[32]) return false;
        int e = 0;
#pragma unroll 1
        for (int k = 1; k < 32; ++k) if (tab[k] <= L) e = k;
        const int local = L - tab[e]; u.e = e; u.pm = local >> 2; u.pn = local & 3;
        const int cnt = tab[80 + e]; u.rows = min(256, cnt - u.pm * 256); u.row0 = tab[40 + e] + u.pm * 256;
        if (gather) { u.b0 = ((size_t)e * 512 + 128 * u.pn) * 1024 * 2; u.b1 = u.b0 + (WS_W3 - WS_W1); }
        else        { u.b0 = ((size_t)e * 1024 + 256 * u.pn) * 512 * 2; u.b1 = u.b0 + (size_t)128 * 512 * 2; }
        return true;
    }
    __device__ __forceinline__ void avoff(const Unit& u, unsigned (&vo)[2][2], const int (&R)[2], const int (&C)[2]) const {
#pragma unroll
        for (int h = 0; h < 2; ++h)
#pragma unroll
            for (int i = 0; i < 2; ++i) {
                if (gather) { int r = 128 * h + R[i]; r = r < u.rows ? r : u.rows - 1; const int tok = list[2 * ((size_t)u.e * LISTCAP + u.pm * 256 + r)];
                    vo[h][i] = (unsigned)(tok * 1024 + C[i]) * 2u; }
                else vo[h][i] = (unsigned)((u.row0 + 128 * h + R[i]) * 512 + C[i]) * 2u;
            }
    }
};

struct EpiProj {
    f16* proj; const float* cosT; const float* sinT; float* ksum;
    __device__ __forceinline__ void operator()(const f32x4 (&acc)[2][2][4][2], const Unit& u, int wr, int wc, int fr, int fq) const {
        const int tile = u.pn, row0 = u.row0 + wr * 64 + fr, col0 = tile * 256 + 64 * wc + 8 * fq;
        if (tile < 4) {
            const float sc = tile < 2 ? C2 : 1.f;
            float ks[2][8];
#pragma unroll
            for (int bj = 0; bj < 2; ++bj)
#pragma unroll
                for (int j = 0; j < 8; ++j) ks[bj][j] = 0.f;
#pragma unroll
            for (int ai = 0; ai < 2; ++ai)
#pragma unroll
                for (int m = 0; m < 4; ++m) {
                    const int row = row0 + ai * HALF + m * 16;
                    const f32x4 c0 = *(const f32x4*)(cosT + (size_t)row * 32 + 8 * fq), c1 = *(const f32x4*)(cosT + (size_t)row * 32 + 8 * fq + 4);
                    const f32x4 s0 = *(const f32x4*)(sinT + (size_t)row * 32 + 8 * fq), s1 = *(const f32x4*)(sinT + (size_t)row * 32 + 8 * fq + 4);
                    const f32x4 a0 = acc[ai][0][m][0], a1 = acc[ai][0][m][1], b0 = acc[ai][1][m][0], b1 = acc[ai][1][m][1];
                    const f32x4 o10 = (a0 * c0 - b0 * s0) * sc, o11 = (a1 * c1 - b1 * s1) * sc;
                    const f32x4 o20 = (b0 * c0 + a0 * s0) * sc, o21 = (b1 * c1 + a1 * s1) * sc;
                    u32x4 w1, w2;
                    w1.x = pk2h(o10[0], o10[1]); w1.y = pk2h(o10[2], o10[3]); w1.z = pk2h(o11[0], o11[1]); w1.w = pk2h(o11[2], o11[3]);
                    w2.x = pk2h(o20[0], o20[1]); w2.y = pk2h(o20[2], o20[3]); w2.z = pk2h(o21[0], o21[1]); w2.w = pk2h(o21[2], o21[3]);
                    f16* rp = proj + (size_t)row * NPROJ + col0;
                    *(u32x4*)rp = w1; *(u32x4*)(rp + 32) = w2;
                    if (tile >= 2) {
#pragma unroll
                        for (int j = 0; j < 4; ++j) { ks[0][j] += o10[j]; ks[0][4 + j] += o11[j]; ks[1][j] += o20[j]; ks[1][4 + j] += o21[j]; }
                    }
                }
            if (tile >= 2) {
                const int b = u.pm >> 4, blk = u.pm & 15, head = (tile - 2) * 4 + wc;
                float* kp = ksum + ((size_t)((b * 8 + head) * 16 + blk)) * 64 + 8 * fq;
#pragma unroll
                for (int bj = 0; bj < 2; ++bj)
#pragma unroll
                    for (int j = 0; j < 8; ++j) { float v = ks[bj][j]; v += __shfl_xor(v, 1); v += __shfl_xor(v, 2); v += __shfl_xor(v, 4); v += __shfl_xor(v, 8);
                        if (fr == 0) atomicAdd(kp + 32 * bj + j, v); }
            }
        } else {
#pragma unroll
            for (int ai = 0; ai < 2; ++ai)
#pragma unroll
                for (int m = 0; m < 4; ++m) {
                    f16* rp = proj + (size_t)(row0 + ai * HALF + m * 16) * NPROJ + col0;
#pragma unroll
                    for (int bj = 0; bj < 2; ++bj) { const f32x4 v0 = acc[ai][bj][m][0], v1 = acc[ai][bj][m][1]; u32x4 w;
                        w.x = pk2h(v0[0], v0[1]); w.y = pk2h(v0[2], v0[3]); w.z = pk2h(v1[0], v1[1]); w.w = pk2h(v1[2], v1[3]);
                        *(u32x4*)(rp + 32 * bj) = w; }
                }
        }
    }
};
struct EpiOut {
    const float* x; const float* mod; float* x1;
    __device__ __forceinline__ void operator()(const f32x4 (&acc)[2][2][4][2], const Unit& u, int wr, int wc, int fr, int fq) const {
        const int row0 = u.row0 + wr * 64 + fr, col0 = u.pn * BM + wc * 32 + 8 * fq, b = u.row0 / SEQ;
        const float* g1 = mod + (size_t)b * 6144 + 2048;
#pragma unroll
        for (int bj = 0; bj < 2; ++bj) {
            const f32x4 g0 = *(const f32x4*)(g1 + col0 + bj * HALF), gg1 = *(const f32x4*)(g1 + col0 + bj * HALF + 4);
#pragma unroll
            for (int ai = 0; ai < 2; ++ai)
#pragma unroll
                for (int m = 0; m < 4; ++m) { const size_t off = (size_t)(row0 + ai * HALF + m * 16) * DM + col0 + bj * HALF;
                    const f32x4 x0 = *(const f32x4*)(x + off), xx1 = *(const f32x4*)(x + off + 4);
                    *(f32x4*)(x1 + off) = x0 + g0 * acc[ai][bj][m][0]; *(f32x4*)(x1 + off + 4) = xx1 + gg1 * acc[ai][bj][m][1]; }
        }
    }
};
struct EpiMoe1 {
    f16* H;
    __device__ __forceinline__ void operator()(const f32x4 (&acc)[2][2][4][2], const Unit& u, int wr, int wc, int fr, int fq) const {
        const int r0 = wr * 64 + fr, col0 = u.pn * 128 + wc * 32 + 8 * fq;
#pragma unroll
        for (int ai = 0; ai < 2; ++ai)
#pragma unroll
            for (int m = 0; m < 4; ++m) { const int r = r0 + ai * HALF + m * 16;
                float o[8];
#pragma unroll
                for (int n = 0; n < 2; ++n)
#pragma unroll
                    for (int j = 0; j < 4; ++j) { const float a = acc[ai][0][m][n][j], bb = acc[ai][1][m][n][j]; o[4 * n + j] = a / (1.f + __expf(-a)) * bb; }
                u32x4 w; w.x = pk2h(o[0], o[1]); w.y = pk2h(o[2], o[3]); w.z = pk2h(o[4], o[5]); w.w = pk2h(o[6], o[7]);
                if (r < u.rows) *(u32x4*)(H + (size_t)(u.row0 + r) * DEXP + col0) = w; }
    }
};
struct EpiMoe2 {
    f16* Y; const int* list;
    __device__ __forceinline__ void operator()(const f32x4 (&acc)[2][2][4][2], const Unit& u, int wr, int wc, int fr, int fq) const {
        const int r0 = wr * 64 + fr, col0 = u.pn * BM + wc * 32 + 8 * fq;
#pragma unroll
        for (int ai = 0; ai < 2; ++ai)
#pragma unroll
            for (int m = 0; m < 4; ++m) { const int r = r0 + ai * HALF + m * 16;
                if (r < u.rows) {
                    const float w = __int_as_float(list[2 * ((size_t)u.e * LISTCAP + u.pm * 256 + r) + 1]);
#pragma unroll
                    for (int bj = 0; bj < 2; ++bj) { const f32x4 v0 = acc[ai][bj][m][0] * w, v1 = acc[ai][bj][m][1] * w; u32x4 o;
                        o.x = pk2h(v0[0], v0[1]); o.y = pk2h(v0[2], v0[3]); o.z = pk2h(v1[0], v1[1]); o.w = pk2h(v1[2], v1[3]);
                        *(u32x4*)(Y + (size_t)(u.row0 + r) * DM + col0 + bj * HALF) = o; }
                } }
    }
};
}


namespace moba {
using s16x8=__attribute__((ext_vector_type(8)))short;
using s16x4=__attribute__((ext_vector_type(4)))short;
using f32x16=__attribute__((ext_vector_type(16)))float;
constexpr int D=64, PITCH=NPROJ, OPITCH=DM;
constexpr int NW=8,QBLK=32,QB=QBLK*NW,KVBLK=64;
__device__ __forceinline__ int crow(int r,int hi){return (r&3)+8*(r>>2)+4*hi;}
#define SBAR() __builtin_amdgcn_sched_barrier(0)
#define MF32(a,b,c) __builtin_amdgcn_mfma_f32_32x32x16_f16(__builtin_bit_cast(f16x8,(a)),__builtin_bit_cast(f16x8,(b)),(c),0,0,0)
__device__ __forceinline__ void cmask(f32x16&p0,f32x16&p1,int jb,int qrel,int hi){
  const float NEG=-INFINITY; int kb=64*jb+4*hi;
  #pragma unroll
  for(int r=0;r<16;++r){int kv=kb+(r&3)+8*(r>>2); if(kv>qrel)p0[r]=NEG; if(kv+32>qrel)p1[r]=NEG;}
}
constexpr int NSLOT=3, SLOTB=8192;
constexpr int LDS_K=0, LDS_V=NSLOT*SLOTB, LDS_WS=2*NSLOT*SLOTB, LDS_OST=LDS_WS+NW*64*4, LDS_SEL=LDS_OST+NW*4096, LDS_BYTES_A=LDS_SEL+1024;
__device__ __forceinline__ void glds16(const void*gsrc,unsigned lds_dst){unsigned keep;
  asm volatile("s_mov_b32 %0, m0\n\ts_mov_b32 m0, %2\n\ts_nop 0\n\tglobal_load_lds_dwordx4 %1, off\n\ts_mov_b32 m0, %0":"=&s"(keep):"v"(gsrc),"s"(lds_dst):"memory");}
__device__ __forceinline__ float max3f(float a,float b,float c){float r;asm("v_max3_f32 %0, %1, %2, %3":"=v"(r):"v"(a),"v"(b),"v"(c));return r;}
__device__ __forceinline__ float max2f(float a,float b){float r;asm("v_max_f32_e32 %0, %1, %2":"=v"(r):"v"(a),"v"(b));return r;}
__device__ __forceinline__ float fadd_s(float a,float b){float r;asm("v_add_f32_e32 %0, %1, %2":"=v"(r):"v"(a),"v"(b));return r;}
__device__ __forceinline__ float fsub_s(float a,float b){float r;asm("v_sub_f32_e32 %0, %1, %2":"=v"(r):"v"(a),"v"(b));return r;}
__device__ __forceinline__ unsigned cvtpk_s(float lo,float hi){return __builtin_bit_cast(unsigned,__builtin_amdgcn_cvt_pkrtz(lo,hi));}
#define WAIT_BAR(N) asm volatile("s_waitcnt vmcnt(" #N ") lgkmcnt(0)\n\ts_barrier":::"memory")
__device__ __forceinline__ void qkt(f32x16&p0,f32x16&p1,const char*Kslot,const s16x8*qr,const f32x16&negm,int r32,int hi){
  const char*kb=Kslot+hi*1024+r32*16;
  #pragma unroll
  for(int d0=0;d0<4;++d0){
    const s16x8 b0=*reinterpret_cast<const s16x8*>(kb+d0*2048);
    const s16x8 b1=*reinterpret_cast<const s16x8*>(kb+d0*2048+512);
    if(d0==0){p0=MF32(b0,qr[0],negm);p1=MF32(b1,qr[0],negm);}
    else{p0=MF32(b0,qr[d0],p0);p1=MF32(b1,qr[d0],p1);}}
}
typedef __attribute__((address_space(3))) const char* lds_cptr;
typedef short v4i16_t __attribute__((ext_vector_type(4)));
__device__ __forceinline__ void kload8(s16x8*kf,lds_cptr kp){
  kf[0]=*(const __attribute__((address_space(3))) s16x8*)(kp);      kf[1]=*(const __attribute__((address_space(3))) s16x8*)(kp+512);
  kf[2]=*(const __attribute__((address_space(3))) s16x8*)(kp+2048); kf[3]=*(const __attribute__((address_space(3))) s16x8*)(kp+2560);
  kf[4]=*(const __attribute__((address_space(3))) s16x8*)(kp+4096); kf[5]=*(const __attribute__((address_space(3))) s16x8*)(kp+4608);
  kf[6]=*(const __attribute__((address_space(3))) s16x8*)(kp+6144); kf[7]=*(const __attribute__((address_space(3))) s16x8*)(kp+6656);
}
__device__ __forceinline__ void kload2(s16x8*kf,lds_cptr kp,int j){ kf[2*j]=*(const __attribute__((address_space(3))) s16x8*)(kp+j*2048); kf[2*j+1]=*(const __attribute__((address_space(3))) s16x8*)(kp+j*2048+512); }
__device__ __forceinline__ s16x4 vtr(lds_cptr p){ return __builtin_bit_cast(s16x4,__builtin_amdgcn_ds_read_tr16_b64_v4i16((__attribute__((address_space(3))) v4i16_t*)p)); }
__device__ __forceinline__ float rowmax(const f32x16&p0,const f32x16&p1){
  float a=max3f(p0[0],p0[1],p1[0]),b=max3f(p0[2],p0[3],p1[1]);a=max3f(a,p1[2],p1[3]);
  #pragma unroll
  for(int r=4;r<16;r+=4){a=max3f(a,p0[r],p0[r+1]);b=max3f(b,p0[r+2],p0[r+3]);a=max3f(a,p1[r],p1[r+1]);b=max3f(b,p1[r+2],p1[r+3]);}
  const float m=max2f(a,b);
  auto rr=__builtin_amdgcn_permlane32_swap(__float_as_uint(m),__float_as_uint(m),false,false);
  return max2f(__uint_as_float(rr[0]),__uint_as_float(rr[1]));
}
__device__ __forceinline__ void pv(f32x16*o,int vb,s16x8 pa0,s16x8 pa1,s16x8 pa2,s16x8 pa3){
  #pragma unroll
  for(int d0=0;d0<2;++d0){s16x4 lo[4],hi[4];
    #pragma unroll
    for(int ks=0;ks<4;++ks){
      asm volatile("ds_read_b64_tr_b16 %0,%1 offset:%c2":"=&v"(lo[ks]):"v"(vb),"i"(d0*4096+ks*1024):"memory");
      asm volatile("ds_read_b64_tr_b16 %0,%1 offset:%c2":"=&v"(hi[ks]):"v"(vb),"i"(d0*4096+ks*1024+512):"memory");}
    asm volatile("s_waitcnt lgkmcnt(0)":::"memory");SBAR();
    #define PK(k) (s16x8){lo[k][0],lo[k][1],lo[k][2],lo[k][3],hi[k][0],hi[k][1],hi[k][2],hi[k][3]}
    o[d0]=MF32(pa0,PK(0),o[d0]);
    o[d0]=MF32(pa1,PK(1),o[d0]);
    o[d0]=MF32(pa2,PK(2),o[d0]);
    o[d0]=MF32(pa3,PK(3),o[d0]);
    #undef PK
  }
}
__device__ __forceinline__ void sel_unit(int b,int h,int qb,const f16*Q,const float*ksum,char*shm){
  int tid=threadIdx.x; asm volatile("":"+v"(tid));
  const int row=tid>>1, half=tid&1;
  unsigned sel=0u;
  if(qb>0){
    float qf[32];
    { const f16x8*qp=(const f16x8*)(Q+((long)b*SEQ+qb*QB+row)*PITCH+h*D+32*half);
      #pragma unroll
      for(int i=0;i<4;++i){ const f16x8 t=qp[i];
        #pragma unroll
        for(int j=0;j<8;++j)qf[8*i+j]=(float)t[j]; } }
    float g[15];
    const float*kp=ksum+(size_t)((b*8+h)*16)*64+32*half;
    #pragma unroll
    for(int n=0;n<15;++n){ float s=0.f;
      if(n<qb){
        #pragma unroll
        for(int i=0;i<8;++i){ const f32x4 k4=*(const f32x4*)(kp+n*64+4*i); s+=qf[4*i]*k4[0]+qf[4*i+1]*k4[1]+qf[4*i+2]*k4[2]+qf[4*i+3]*k4[3]; }
        s+=__shfl_xor(s,1); }
      g[n]=(n<qb)?s:-INFINITY; }
    #pragma unroll
    for(int r=0;r<3;++r){ float best=-INFINITY; int bi=-1;
      #pragma unroll
      for(int n=0;n<15;++n){ const bool ok=!((sel>>n)&1u)&&g[n]>best; best=ok?g[n]:best; bi=ok?n:bi; }
      if(bi>=0)sel|=1u<<bi; } }
  if(half==0)((unsigned*)(shm+LDS_SEL))[row]=sel;
  asm volatile("s_waitcnt lgkmcnt(0)\n\ts_barrier":::"memory");
}
constexpr float NEGBIG=-1.0e30f;
template<int THRL> __device__ __forceinline__ void attn_unit(int b,int h,int qb,const f16*Q,const f16*__restrict__ K,const f16*__restrict__ V,f16*O,const float*ksum,const float*gain,char*shm){
  int tid_=threadIdx.x; asm volatile("":"+v"(tid_));
  const int tid=tid_,lane=tid&63,r32=lane&31,hi=lane>>5; const int wid=__builtin_amdgcn_readfirstlane(tid>>6);
  const long rowbase=(long)b*SEQ; const int q0=qb*QB;
  const f16*Qw=Q+(rowbase+q0+wid*QBLK)*PITCH+h*D;
  const f16*Kh=K+rowbase*PITCH+h*D,*Vh=V+rowbase*PITCH+h*D;
  const unsigned lds0=(unsigned)(uintptr_t)shm;
  float*wsf=(float*)(shm+LDS_WS)+wid*64;
  const f16*kptr=Kh+(long)lane*PITCH+wid*8+(long)(4*qb)*KVBLK*PITCH;
  const f16*vptr=Vh+(long)(16*(wid&3)+(lane>>2))*PITCH+(wid>>2)*32+(lane&3)*8+(long)(4*qb)*KVBLK*PITCH;
  const unsigned kdst=lds0+LDS_K+wid*1024, vdst=lds0+LDS_V+wid*1024;
  const long tstep_=(long)KVBLK*PITCH, twrap_=-(long)(4*qb+3)*KVBLK*PITCH;
  #define DMA_K(t,slot) do{ glds16(kptr,(unsigned)__builtin_amdgcn_readfirstlane(kdst+(slot))); kptr+=(((t)==3)?twrap_:tstep_); }while(0)
  #define DMA_V(t,slot) do{ glds16(vptr,(unsigned)__builtin_amdgcn_readfirstlane(vdst+(slot))); vptr+=(((t)==3)?twrap_:tstep_); }while(0)
  const int vb0=(int)(lds0+LDS_V)+((lane>>4)&1)*32+(lane&3)*8+(4*hi+((lane&15)>>2))*64;
  const char*Kbase=shm+LDS_K; s16x8 kf[8];
  const lds_cptr shm3=(lds_cptr)shm; const lds_cptr kp0=shm3+LDS_K+hi*1024+r32*16; const lds_cptr vp0=shm3+LDS_V+((lane>>4)&1)*32+(lane&3)*8+(4*hi+((lane&15)>>2))*64;
  const int NT=4*qb+4;
  DMA_K(0,0);DMA_V(0,0);DMA_K(1,SLOTB);
  s16x8 qr[4];
  #pragma unroll
  for(int d0=0;d0<4;++d0)qr[d0]=*reinterpret_cast<const s16x8*>(&Qw[(long)r32*PITCH+d0*16+hi*8]);
  const unsigned sel=((const unsigned*)(shm+LDS_SEL))[wid*QBLK+r32];
  bool msk=false;
  float mhat=0.f,l_reg=0.f;f32x16 o[2];o[0]=f32x16{};o[1]=f32x16{};f32x16 negm=f32x16{};asm volatile("":"+v"(negm));
  const int qrel=wid*QBLK+r32;
  #define CMASK(P0,P1,t) do{ if((t)<4)cmask(P0,P1,(t),qrel,hi); }while(0)
  #define SELM(t) do{ if((t)>=4&&(((t)&3)==0)){ msk=!((sel>>(((t)-4)>>2))&1u); const float nv_=msk?NEGBIG:-mhat; _Pragma("unroll") for(int r=0;r<16;++r)negm[r]=nv_; asm volatile("":"+v"(negm)); } }while(0)
  bool resc=false;
  #define START(P0,P1) do{ const float rm=rowmax(P0,P1); resc=false; \
    { const float dl=rm; mhat=fadd_s(mhat,dl); \
      _Pragma("unroll") for(int r=0;r<16;++r){P0[r]=fsub_s(P0[r],dl);P1[r]=fsub_s(P1[r],dl);} \
      _Pragma("unroll") for(int r=0;r<16;++r)negm[r]=-mhat; asm volatile("":"+v"(negm)); } \
    _Pragma("unroll") for(int r=0;r<16;++r)P0[r]=__builtin_amdgcn_exp2f(P0[r]); }while(0)
  #define RESC() do{ if(resc){ asm volatile("s_waitcnt lgkmcnt(0)":::"memory"); \
      _Pragma("unroll") for(int d_=0;d_<2;++d_) _Pragma("unroll") for(int r=0;r<16;++r)o[d_][r]*=wsf[crow(r,hi)]; } }while(0)
  f32x16 pA0,pA1,pB0,pB1;
  int sl_prev=0,sl_cur=0,sl_next=SLOTB;
  #define ROT() do{sl_prev=sl_cur;sl_cur=sl_next;sl_next=(sl_next==(NSLOT-1)*SLOTB)?0:sl_next+SLOTB;}while(0)
  DMA_K(2,2*SLOTB);
  WAIT_BAR(3);
  qkt(pA0,pA1,Kbase,qr,negm,r32,hi);asm volatile("s_nop 15\n\ts_nop 7":"+v"(pA0),"+v"(pA1));CMASK(pA0,pA1,0);
  START(pA0,pA1);
  _Pragma("unroll") for(int r=0;r<16;++r)pA1[r]=__builtin_amdgcn_exp2f(pA1[r]);
  WAIT_BAR(0);
  DMA_K(3,0);DMA_V(1,SLOTB);
  ROT();
  kload8(kf,kp0+sl_cur);
  WAIT_BAR(2);
  s16x4 vlo[8],vhi[8]; u32x4 pw0,pw1,pw2,pw3;
  #define PKW(P,B) cvtpk_s(P[B],P[B+1])
  #define PAF(k) __builtin_bit_cast(s16x8,pw##k)
  #define VFR(i) (s16x8){vlo[i][0],vlo[i][1],vlo[i][2],vlo[i][3],vhi[i][0],vhi[i][1],vhi[i][2],vhi[i][3]}
  #define PIN(x) asm volatile("":"+v"(x))
  #define MX3(a,b,c) __builtin_fmaxf(__builtin_fmaxf((a),(b)),(c))
  #define GAPA(MF,A0,A1,A2,A3,W0,W1,PW) do{ MF; sacc+=A0; sacc+=A1; sacc+=A2; sacc+=A3; PIN(sacc); W0; W1; PIN(PW); SBAR(); }while(0)
  #define EX(v) __builtin_amdgcn_exp2f(v)
  #define GAPB(MF,X,B) do{ MF; X[B]=EX(X[B]); X[B+1]=EX(X[B+1]); X[B+2]=EX(X[B+2]); X[B+3]=EX(X[B+3]); PIN(X); SBAR(); }while(0)
  #define VRD(i) do{ vlo[i]=vtr(vp_+(((i)>>2)*4096+((i)&3)*1024)); vhi[i]=vtr(vp_+(((i)>>2)*4096+((i)&3)*1024+512)); }while(0)
  #define KRD(G,j) do{ if(G){ kload2(kf,kp0+sl_next,j); SBAR(); } }while(0)
  #define STEP(C0,C1,P0,P1,t,GK,GV,GL) do{ SELM(t); SBAR(); \
    const lds_cptr vp_=vp0+sl_prev; \
    VRD(0); SBAR(); float sacc=(P0[0]+P0[1]); \
    GAPA(C0=MF32(kf[0],qr[0],negm), P0[2],P0[3],P0[4],P0[5],     pw0[0]=PKW(P0,0), pw0[1]=PKW(P0,2), pw0); \
    VRD(4); SBAR(); GAPA(C1=MF32(kf[1],qr[0],negm), P0[6],P0[7],P0[8],P0[9],     pw0[2]=PKW(P0,4), pw0[3]=PKW(P0,6), pw0); \
    VRD(1); SBAR(); GAPA(C0=MF32(kf[2],qr[1],C0),   P0[10],P0[11],P0[12],P0[13], pw1[0]=PKW(P0,8), pw1[1]=PKW(P0,10), pw1); \
    VRD(5); SBAR(); GAPA(C1=MF32(kf[3],qr[1],C1),   P0[14],P0[15],P1[0],P1[1],   pw1[2]=PKW(P0,12),pw1[3]=PKW(P0,14), pw1); \
    VRD(2); SBAR(); GAPA(C0=MF32(kf[4],qr[2],C0),   P1[2],P1[3],P1[4],P1[5],     pw2[0]=PKW(P1,0), pw2[1]=PKW(P1,2), pw2); \
    VRD(6); SBAR(); GAPA(C1=MF32(kf[5],qr[2],C1),   P1[6],P1[7],P1[8],P1[9],     pw2[2]=PKW(P1,4), pw2[3]=PKW(P1,6), pw2); \
    VRD(3); SBAR(); GAPA(C0=MF32(kf[6],qr[3],C0),   P1[10],P1[11],P1[12],P1[13], pw3[0]=PKW(P1,8), pw3[1]=PKW(P1,10), pw3); \
    VRD(7); SBAR(); GAPA(C1=MF32(kf[7],qr[3],C1),   P1[14],P1[15],0.f,0.f,       pw3[2]=PKW(P1,12),pw3[3]=PKW(P1,14), pw3); \
    l_reg+=sacc; \
    if(GK){DMA_K((t)+3,sl_cur);} if(GV){DMA_V((t)+1,sl_next);} \
    CMASK(C0,C1,t); \
    { float a=MX3(C0[0],C0[1],C1[0]),b=MX3(C0[2],C0[3],C1[1]); a=MX3(a,C1[2],C1[3]); \
      _Pragma("unroll") for(int r=4;r<16;r+=4){a=MX3(a,C0[r],C0[r+1]);b=MX3(b,C0[r+2],C0[r+3]);a=MX3(a,C1[r],C1[r+1]);b=MX3(b,C1[r+2],C1[r+3]);} \
      float rm=__builtin_fmaxf(a,b); { auto rr=__builtin_amdgcn_permlane32_swap(__float_as_uint(rm),__float_as_uint(rm),false,false); rm=__builtin_fmaxf(__uint_as_float(rr[0]),__uint_as_float(rr[1])); } \
      resc=false; \
      if(__builtin_expect(__any(rm>(float)THRL),0)){ const float dl=__builtin_fmaxf(rm,0.f); mhat+=dl; \
        _Pragma("unroll") for(int r=0;r<16;++r){C0[r]-=dl;C1[r]-=dl;} \
        { const float nv_=msk?NEGBIG:-mhat; _Pragma("unroll") for(int r=0;r<16;++r)negm[r]=nv_; } asm volatile("":"+v"(negm)); \
        const float f=__builtin_amdgcn_exp2f(-dl); l_reg*=f; if(hi==0)wsf[r32]=f; resc=true; } } \
    SBAR(); \
    GAPB(o[0]=MF32(PAF(0),VFR(0),o[0]), C0,0); \
    GAPB(o[1]=MF32(PAF(0),VFR(4),o[1]), C0,4); \
    KRD(GL,0); GAPB(o[0]=MF32(PAF(1),VFR(1),o[0]), C0,8); \
    KRD(GL,1); GAPB(o[1]=MF32(PAF(1),VFR(5),o[1]), C0,12); \
    KRD(GL,2); GAPB(o[0]=MF32(PAF(2),VFR(2),o[0]), C1,0); \
    KRD(GL,3); GAPB(o[1]=MF32(PAF(2),VFR(6),o[1]), C1,4); \
    GAPB(o[0]=MF32(PAF(3),VFR(3),o[0]), C1,8); \
    GAPB(o[1]=MF32(PAF(3),VFR(7),o[1]), C1,12); \
    }while(0)
  int t=1;
  for(;t+5<NT;t+=2){
    STEP(pB0,pB1,pA0,pA1,t,true,true,true);     WAIT_BAR(2); RESC(); ROT();
    STEP(pA0,pA1,pB0,pB1,t+1,true,true,true);   WAIT_BAR(2); RESC(); ROT();
  }
  #define ENDW(tt) do{ if((tt)+3<NT){WAIT_BAR(2);} else if((tt)+2<NT){WAIT_BAR(1);} else {WAIT_BAR(0);} }while(0)
  for(;t+1<NT;t+=2){
    STEP(pB0,pB1,pA0,pA1,t,(t+3<NT),(t+1<NT),(t+1<NT));       ENDW(t);   RESC(); ROT();
    STEP(pA0,pA1,pB0,pB1,t+1,(t+4<NT),(t+2<NT),(t+2<NT));     ENDW(t+1); RESC(); ROT();
  }
  STEP(pB0,pB1,pA0,pA1,NT-1,false,false,false); RESC();
  { float sacc=pB0[0]+pB0[1]; _Pragma("unroll") for(int r=2;r<16;++r)sacc+=pB0[r]; _Pragma("unroll") for(int r=0;r<16;++r)sacc+=pB1[r]; l_reg+=sacc;
    pw0=(u32x4){PKW(pB0,0),PKW(pB0,2),PKW(pB0,4),PKW(pB0,6)};pw1=(u32x4){PKW(pB0,8),PKW(pB0,10),PKW(pB0,12),PKW(pB0,14)};pw2=(u32x4){PKW(pB1,0),PKW(pB1,2),PKW(pB1,4),PKW(pB1,6)};pw3=(u32x4){PKW(pB1,8),PKW(pB1,10),PKW(pB1,12),PKW(pB1,14)};
    SBAR(); pv(o,vb0+sl_cur,PAF(0),PAF(1),PAF(2),PAF(3)); }
  #undef PKW
  #undef PAF
  #undef VFR
  #undef PIN
  #undef MX3
  #undef GAPA
  #undef GAPB
  #undef EX
  #undef VRD
  #undef KRD
  #undef STEP
  #undef ENDW
  {auto rr=__builtin_amdgcn_permlane32_swap(__float_as_uint(l_reg),__float_as_uint(l_reg),false,false);l_reg=__uint_as_float(rr[0])+__uint_as_float(rr[1]);}
  if(hi==0)wsf[32+r32]=l_reg;asm volatile("s_waitcnt lgkmcnt(0)":::"memory");
  float rli[16];
  #pragma unroll
  for(int r=0;r<16;++r)rli[r]=__builtin_amdgcn_rcpf(wsf[32+crow(r,hi)]);
  f16*Ow=O+(rowbase+q0+wid*QBLK)*OPITCH+h*D;
  { float*stg=(float*)(shm+LDS_OST)+wid*1024;
    #pragma unroll
    for(int half=0;half<2;++half){
      #pragma unroll
      for(int r=0;r<16;++r){ const int orow=crow(r,hi);
        if((orow>>4)==half){
          #pragma unroll
          for(int d0=0;d0<2;++d0)stg[(orow&15)*64+d0*32+r32]=o[d0][r]*rli[r]; } }
      asm volatile("s_waitcnt lgkmcnt(0)":::"memory");
      #pragma unroll
      for(int i=0;i<2;++i){ const int row=i*8+(lane>>3),ch=lane&7; const f32x4 v0=*(const f32x4*)(stg+row*64+ch*8),v1=*(const f32x4*)(stg+row*64+ch*8+4);
        float ss=(v0[0]*v0[0]+v0[1]*v0[1])+(v0[2]*v0[2]+v0[3]*v0[3])+(v1[0]*v1[0]+v1[1]*v1[1])+(v1[2]*v1[2]+v1[3]*v1[3]);
        ss+=__shfl_xor(ss,1); ss+=__shfl_xor(ss,2); ss+=__shfl_xor(ss,4);
        const float rs=1.f/sqrtf(ss*(1.f/64.f)+EPS);
        const f32x4 g0=*(const f32x4*)(gain+h*D+ch*8),g1=*(const f32x4*)(gain+h*D+ch*8+4);
        u32x4 w; w.x=pk2h(v0[0]*rs*g0[0],v0[1]*rs*g0[1]); w.y=pk2h(v0[2]*rs*g0[2],v0[3]*rs*g0[3]); w.z=pk2h(v1[0]*rs*g1[0],v1[1]*rs*g1[1]); w.w=pk2h(v1[2]*rs*g1[2],v1[3]*rs*g1[3]);
        *(u32x4*)(Ow+(long)(half*16+row)*OPITCH+ch*8)=w; }
      asm volatile("s_waitcnt lgkmcnt(0)":::"memory"); } }
  asm volatile("s_waitcnt lgkmcnt(0)\n\ts_barrier":::"memory");
  #undef DMA_K
  #undef DMA_V
  #undef CMASK
  #undef SELM
  #undef START
  #undef RESC
  #undef ROT
}
#undef SBAR
#undef WAIT_BAR
#undef MF32
}


namespace mlstm {
constexpr int L=64, DH=128;
constexpr int QS=0, KS=17408, KT=34816, VT=53248, CS=71680, PS=106496, VEC=115712;
constexpr int RS1=136, RS2=72;
#define ML_BAR() asm volatile("s_waitcnt lgkmcnt(0)\n\ts_barrier" ::: "memory")
#define MF16(a,b,c) __builtin_amdgcn_mfma_f32_16x16x32_f16((a),(b),(c),0,0,0)
__device__ __forceinline__ void unit(int b,int hm,const f16*proj,const float*gates,const float*conv_w,const float*conv_b,const float*gain,f16*mix,LAS unsigned char*lds){
  int tid_=threadIdx.x; asm volatile("":"+v"(tid_));
  const int tid=tid_,lane=tid&63,wid=__builtin_amdgcn_readfirstlane(tid>>6),fr=lane&15,fq=lane>>4,ts=wid>>1,hx=wid&1;
  LAS f16*Qs=(LAS f16*)(lds+QS); LAS f16*Ks=(LAS f16*)(lds+KS); LAS f16*KTs=(LAS f16*)(lds+KT); LAS f16*VTs=(LAS f16*)(lds+VT); LAS f16*Cs=(LAS f16*)(lds+CS); LAS f16*Ps=(LAS f16*)(lds+PS);
  LAS float*vec=(LAS float*)(lds+VEC); LAS f16*wph=(LAS f16*)(vec+776);
  const long rowbase=(long)b*SEQ;
  const int cg=tid&31,tq=tid>>5; const bool isk=cg>=16; const int ch0=8*(cg&15);
  const f16*qkp=proj+(isk?C_KM:C_QM)+hm*DH+ch0;
  float cw[4][8],cb[8];
  { const int cc=(isk?512:0)+hm*DH+ch0;
    #pragma unroll
    for(int tp=0;tp<4;++tp){ const f32x4 a=*(const f32x4*)(conv_w+tp*1024+cc),c=*(const f32x4*)(conv_w+tp*1024+cc+4);
      cw[tp][0]=a[0];cw[tp][1]=a[1];cw[tp][2]=a[2];cw[tp][3]=a[3];cw[tp][4]=c[0];cw[tp][5]=c[1];cw[tp][6]=c[2];cw[tp][7]=c[3]; }
    const f32x4 a=*(const f32x4*)(conv_b+cc),c=*(const f32x4*)(conv_b+cc+4); cb[0]=a[0];cb[1]=a[1];cb[2]=a[2];cb[3]=a[3];cb[4]=c[0];cb[5]=c[1];cb[6]=c[2];cb[7]=c[3]; }
  const int eg=tid&15,sq=tid>>4;
  const f16*vp=proj+C_VM+hm*DH+8*eg;
  f32x4 accC[8];
  #pragma unroll
  for(int i=0;i<8;++i)accC[i]=(f32x4){0.f,0.f,0.f,0.f};
  for(int i=tid;i<DH*RS1/2;i+=NTHR)((LAS unsigned*)Cs)[i]=0u;
  if(tid<DH)vec[640+tid]=0.f;
  float mprev=0.f;
  f16x8 rq[7],rv[2]; float rig=0.f,rfg=0.f;
  #define LOAD_RAW(c) do{ const int t0_=(c)*L; \
    _Pragma("unroll") for(int i=0;i<7;++i){ const int t_=t0_+4*tq-3+i; rq[i]=(t_>=0)?*(const f16x8*)(qkp+(rowbase+t_)*NPROJ):(f16x8){0,0,0,0,0,0,0,0}; } \
    _Pragma("unroll") for(int i=0;i<2;++i) rv[i]=*(const f16x8*)(vp+(rowbase+t0_+2*sq+i)*NPROJ); \
    if(wid==0){ rig=gates[(rowbase+t0_+lane)*8+hm]; rfg=gates[(rowbase+t0_+lane)*8+4+hm]; } }while(0)
  LOAD_RAW(0);
  ML_BAR();
  #pragma unroll 1
  for(int c=0;c<SEQ/L;++c){
    const int t0=c*L;
    {
      #pragma unroll
      for(int i=0;i<4;++i){ const int t=4*tq+i; float o[8];
        #pragma unroll
        for(int j=0;j<8;++j){ float v=cb[j];
          #pragma unroll
          for(int tp=0;tp<4;++tp)v+=cw[tp][j]*(float)rq[i+tp][j];
          v=v/(1.f+__expf(-v)); o[j]=isk?v*0.08838834764831845f:v; }
        u32x4 w; w.x=pk2h(o[0],o[1]); w.y=pk2h(o[2],o[3]); w.z=pk2h(o[4],o[5]); w.w=pk2h(o[6],o[7]);
        if(isk){ *(LAS u32x4*)(Ks+t*RS1+ch0)=w;
          #pragma unroll
          for(int j=0;j<8;++j)KTs[(ch0+j)*RS2+t]=(f16)o[j]; }
        else *(LAS u32x4*)(Qs+t*RS1+ch0)=w; }
      #pragma unroll
      for(int j=0;j<8;++j){ f16x2 pr={rv[0][j],rv[1][j]}; *(LAS f16x2*)(VTs+(8*eg+j)*RS2+2*sq)=pr; }
      if(wid==0){
        const float logf=fminf(rfg,0.f)-log1pf(__expf(-fabsf(rfg)));
        float cum=logf;
        #pragma unroll
        for(int o=1;o<64;o<<=1){ const float tmp=__shfl_up(cum,o); if(lane>=o)cum+=tmp; }
        const float a=__shfl(cum,63), colf=rig-cum;
        float pm=colf;
        #pragma unroll
        for(int o=1;o<64;o<<=1){ const float tmp=__shfl_up(pm,o); if(lane>=o)pm=fmaxf(pm,tmp); }
        const float mx=fmaxf(mprev,pm);
        const float mloc=a+__shfl(pm,63), mnew=fmaxf(a+mprev,mloc), sprev=__expf(a+mprev-mnew), wpv=__expf(a+colf-mnew);
        vec[lane]=colf; vec[64+lane]=-mx; vec[128+lane]=__expf(mprev-mx); vec[192+lane]=__expf(-(cum+mx)); vec[256+lane]=wpv; wph[lane]=(f16)wpv;
        if(lane==0)vec[768]=sprev;
        mprev=mnew; }
    }
    ML_BAR();
    if(c+1<SEQ/L) LOAD_RAW(c+1);
    f16 om[4][4];
    #pragma unroll
    for(int et=0;et<4;++et)
      #pragma unroll
      for(int r=0;r<4;++r) om[et][r]=proj[(rowbase+t0+16*ts+4*fq+r)*NPROJ+C_OM+hm*DH+16*(4*hx+et)+fr];
    { const int t=tid>>3,dg=tid&7; float s=0.f;
      const f16x8 q0=*(const LAS f16x8*)(Qs+t*RS1+16*dg),q1=*(const LAS f16x8*)(Qs+t*RS1+16*dg+8);
      #pragma unroll
      for(int j=0;j<8;++j){ s+=(float)q0[j]*vec[640+16*dg+j]+(float)q1[j]*vec[640+16*dg+8+j]; }
      s+=__shfl_xor(s,1); s+=__shfl_xor(s,2); s+=__shfl_xor(s,4);
      if(dg==0)vec[448+t]=s; }
    f16x8 qa[4];
    #pragma unroll
    for(int ks=0;ks<4;++ks)qa[ks]=*(const LAS f16x8*)(Qs+(16*ts+fr)*RS1+32*ks+8*fq);
    { float rsum[4]={0.f,0.f,0.f,0.f};
      #pragma unroll
      for(int st2=0;st2<2;++st2){ const int stile=2*hx+st2; f32x4 acc={0.f,0.f,0.f,0.f};
        #pragma unroll
        for(int ks=0;ks<4;++ks){ const f16x8 kb=*(const LAS f16x8*)(Ks+(16*stile+fr)*RS1+32*ks+8*fq); acc=MF16(qa[ks],kb,acc); }
        const int sidx=16*stile+fr; const float cf=vec[sidx];
        #pragma unroll
        for(int r=0;r<4;++r){ const int t=16*ts+4*fq+r; const float pv_=(sidx<=t)?acc[r]*__expf(vec[64+t]+cf):0.f; rsum[r]+=pv_; Ps[t*RS2+sidx]=(f16)pv_; } }
      #pragma unroll
      for(int r=0;r<4;++r){ float v=rsum[r]; v+=__shfl_xor(v,1); v+=__shfl_xor(v,2); v+=__shfl_xor(v,4); v+=__shfl_xor(v,8); if(fr==0)vec[320+64*hx+16*ts+4*fq+r]=v; } }
    f32x4 accI[4];
    #pragma unroll
    for(int et=0;et<4;++et){ accI[et]=(f32x4){0.f,0.f,0.f,0.f};
      #pragma unroll
      for(int ks=0;ks<4;++ks){ const f16x8 cbf=*(const LAS f16x8*)(Cs+(16*(4*hx+et)+fr)*RS1+32*ks+8*fq); accI[et]=MF16(qa[ks],cbf,accI[et]); } }
    ML_BAR();
    float wi[4],inv[4];
    #pragma unroll
    for(int r=0;r<4;++r){ const int t=16*ts+4*fq+r; wi[r]=vec[128+t]; const float den=vec[320+t]+vec[384+t]+wi[r]*vec[448+t]; inv[r]=1.f/fmaxf(fabsf(den),vec[192+t]); }
    #pragma unroll
    for(int et=0;et<4;++et)
      #pragma unroll
      for(int r=0;r<4;++r)accI[et][r]*=wi[r];
    { f16x8 pa[2];
      #pragma unroll
      for(int ks=0;ks<2;++ks)pa[ks]=*(const LAS f16x8*)(Ps+(16*ts+fr)*RS2+32*ks+8*fq);
      #pragma unroll
      for(int et=0;et<4;++et)
        #pragma unroll
        for(int ks=0;ks<2;++ks){ const f16x8 vb=*(const LAS f16x8*)(VTs+(16*(4*hx+et)+fr)*RS2+32*ks+8*fq); accI[et]=MF16(pa[ks],vb,accI[et]); } }
    { float sqp[4]={0.f,0.f,0.f,0.f};
      #pragma unroll
      for(int et=0;et<4;++et)
        #pragma unroll
        for(int r=0;r<4;++r){ accI[et][r]*=inv[r]; sqp[r]+=accI[et][r]*accI[et][r]; }
      #pragma unroll
      for(int r=0;r<4;++r){ float v=sqp[r]; v+=__shfl_xor(v,1); v+=__shfl_xor(v,2); v+=__shfl_xor(v,4); v+=__shfl_xor(v,8); if(fr==0)vec[512+64*hx+16*ts+4*fq+r]=v; } }
    ML_BAR();
    {
      #pragma unroll
      for(int r=0;r<4;++r){ const int t=16*ts+4*fq+r; const float rs=1.f/sqrtf((vec[512+t]+vec[576+t])*(1.f/128.f)+EPS);
        #pragma unroll
        for(int et=0;et<4;++et){ const int e=16*(4*hx+et)+fr; const float o=accI[et][r]*rs*gain[hm*DH+e]*sigmoidf_((float)om[et][r]);
          mix[(rowbase+t0+t)*DM+512+hm*DH+e]=(f16)o; } } }
    { const float sprev=vec[768];
      #pragma unroll
      for(int dt=0;dt<8;++dt)accC[dt]*=sprev;
      #pragma unroll
      for(int ks=0;ks<2;++ks){ const f16x8 va=*(const LAS f16x8*)(VTs+(16*wid+fr)*RS2+32*ks+8*fq) * *(const LAS f16x8*)(wph+32*ks+8*fq);
        #pragma unroll
        for(int dt=0;dt<8;++dt){ const f16x8 kb=*(const LAS f16x8*)(KTs+(16*dt+fr)*RS2+32*ks+8*fq); accC[dt]=MF16(va,kb,accC[dt]); } }
      #pragma unroll
      for(int dt=0;dt<8;++dt)
        #pragma unroll
        for(int r=0;r<4;++r)Cs[(16*wid+4*fq+r)*RS1+16*dt+fr]=(f16)accC[dt][r];
      const int d=tid>>2,sg=tid&3; float sn=0.f;
      const f16x8 k0=*(const LAS f16x8*)(KTs+d*RS2+16*sg),k1=*(const LAS f16x8*)(KTs+d*RS2+16*sg+8);
      #pragma unroll
      for(int j=0;j<8;++j)sn+=(float)k0[j]*vec[256+16*sg+j]+(float)k1[j]*vec[256+16*sg+8+j];
      sn+=__shfl_xor(sn,1); sn+=__shfl_xor(sn,2);
      if(sg==0)vec[640+d]=sprev*vec[640+d]+sn; }
    ML_BAR();
  }
  #undef LOAD_RAW
}
#undef ML_BAR
#undef MF16
}

struct Args { const void* in[22]; float* out; unsigned char* ws; };
struct Frame {
    LAS unsigned char* lds; int tid, lane, wave, vcu, G; float* out; unsigned char* ws;
    __device__ __forceinline__ void fresh() { int t = threadIdx.x; asm volatile("" : "+v"(t)); tid = t; lane = t & 63; wave = __builtin_amdgcn_readfirstlane(t >> 6); }
    template <class Tp> __device__ __forceinline__ const Tp* in(int k) const { const LAS unsigned* p = (const LAS unsigned*)(lds + ARGS_OFF) + 2 * k;
        const unsigned lo = __builtin_amdgcn_readfirstlane(p[0]), hi = __builtin_amdgcn_readfirstlane(p[1]); return (const Tp*)(((unsigned long long)hi << 32) | lo); }
    __device__ __forceinline__ const float* x() const { return in<float>(0); }
    __device__ __forceinline__ const float* c() const { return in<float>(1); }
    __device__ __forceinline__ const int* positions() const { return in<int>(2); }
    __device__ __forceinline__ const float* w_ada() const { return in<float>(3); }
    __device__ __forceinline__ const float* b_ada() const { return in<float>(4); }
    __device__ __forceinline__ const float* norm1_g() const { return in<float>(5); }
    __device__ __forceinline__ const float* w_in() const { return in<float>(6); }
    __device__ __forceinline__ const float* b_gate() const { return in<float>(7); }
    __device__ __forceinline__ const float* conv_w() const { return in<float>(8); }
    __device__ __forceinline__ const float* conv_b() const { return in<float>(9); }
    __device__ __forceinline__ const float* attn_g() const { return in<float>(10); }
    __device__ __forceinline__ const float* mlstm_g() const { return in<float>(11); }
    __device__ __forceinline__ const float* w_out() const { return in<float>(12); }
    __device__ __forceinline__ const float* norm2_g() const { return in<float>(13); }
    __device__ __forceinline__ const float* w_rg() const { return in<float>(14); }
    __device__ __forceinline__ const float* b_rg() const { return in<float>(15); }
    __device__ __forceinline__ const float* w_re() const { return in<float>(16); }
    __device__ __forceinline__ const float* b_re() const { return in<float>(17); }
    __device__ __forceinline__ const float* w1() const { return in<float>(18); }
    __device__ __forceinline__ const float* w3() const { return in<float>(19); }
    __device__ __forceinline__ const float* w2() const { return in<float>(20); }
    __device__ __forceinline__ const float* normf_g() const { return in<float>(21); }
};

__device__ __forceinline__ void p0_transpose_item(const float* W, int K, int ldw, int nblk, f16* WT, LAS float* scr, int item, int lane) {
    const int kb = item / nblk, nb = item % nblk, k0 = 64 * kb, n0 = 32 * nb;
#pragma unroll 8
    for (int i = 0; i < 32; ++i) { const int kk = 2 * i + (lane >> 5); scr[kk * 33 + (lane & 31)] = W[(size_t)(k0 + kk) * ldw + n0 + (lane & 31)]; }
    LDS_WAIT(); asm volatile("" ::: "memory");
    const int c = lane & 7;
#pragma unroll
    for (int j = 0; j < 4; ++j) { const int n = (lane >> 3) + 8 * j; const LAS float* s = scr + (8 * c) * 33 + n;
        u32x4 o; o.x = pk2h(s[0 * 33], s[1 * 33]); o.y = pk2h(s[2 * 33], s[3 * 33]); o.z = pk2h(s[4 * 33], s[5 * 33]); o.w = pk2h(s[6 * 33], s[7 * 33]);
        *(GAS u32x4*)(WT + (size_t)(n0 + n) * K + k0 + 8 * c) = o; }
    LDS_WAIT(); asm volatile("" ::: "memory");
}

__device__ __forceinline__ void p0_prologue(Frame F) {
    F.fresh();
    LAS float* sc = (LAS float*)F.lds; LAS float* part = (LAS float*)(F.lds + 32768);
    float* mod = (float*)(F.ws + WS_MOD);
    if ((int)blockIdx.x < 192) {
        for (int i = F.tid; i < 8 * 1024; i += NTHR) { const float v = F.c()[i]; sc[i] = v / (1.f + __expf(-v)); }
        __syncthreads();
        for (int jb = blockIdx.x; jb < 192; jb += F.G) {
            const int jj = F.tid & 31, kc = F.tid >> 5, j0 = jb * 32;
            float a[8];
#pragma unroll
            for (int b = 0; b < 8; ++b) a[b] = 0.f;
            for (int kk = 0; kk < 64; ++kk) { const int k = kc * 64 + kk; const float w = F.w_ada()[(size_t)k * 6144 + j0 + jj];
#pragma unroll
                for (int b = 0; b < 8; ++b) a[b] += sc[b * 1024 + k] * w; }
#pragma unroll
            for (int b = 0; b < 8; ++b) part[(kc * 8 + b) * 32 + jj] = a[b];
            __syncthreads();
            if (F.tid < 256) { const int b = F.tid >> 5; float s = F.b_ada()[j0 + jj];
                for (int k2 = 0; k2 < 16; ++k2) s += part[(k2 * 8 + b) * 32 + jj];
                mod[(size_t)b * 6144 + j0 + jj] = s; }
            __syncthreads();
        }
    }
    __syncthreads();
    LAS float* scr = (LAS float*)(F.lds + F.wave * 16384);
    const int gw = F.vcu * NWAVES + F.wave, NGW = F.G * NWAVES;
    constexpr int I_IN = 16 * 112, I_OUT = 16 * 32, I_E13 = 16 * 16, I_E2 = 8 * 32;
    constexpr int NITEMS = I_IN + I_OUT + NEXP * (2 * I_E13 + I_E2);
    for (int it = gw; it < NITEMS; it += NGW) {
        int r = it;
        if (r < I_IN) { p0_transpose_item(F.w_in(), 1024, NPROJ_SRC, 112, (f16*)(F.ws + WS_WIN), scr, r, F.lane); continue; } r -= I_IN;
        if (r < I_OUT) { p0_transpose_item(F.w_out(), 1024, 1024, 32, (f16*)(F.ws + WS_WOUT), scr, r, F.lane); continue; } r -= I_OUT;
        const int per = 2 * I_E13 + I_E2, e = r / per; r -= e * per;
        if (r < I_E13) { p0_transpose_item(F.w1() + (size_t)e * 1024 * 512, 1024, 512, 16, (f16*)(F.ws + WS_W1) + (size_t)e * 512 * 1024, scr, r, F.lane); continue; } r -= I_E13;
        if (r < I_E13) { p0_transpose_item(F.w3() + (size_t)e * 1024 * 512, 1024, 512, 16, (f16*)(F.ws + WS_W3) + (size_t)e * 512 * 1024, scr, r, F.lane); continue; } r -= I_E13;
        p0_transpose_item(F.w2() + (size_t)e * 512 * 1024, 512, 1024, 32, (f16*)(F.ws + WS_W2) + (size_t)e * 1024 * 512, scr, r, F.lane);
    }
}

__device__ __forceinline__ void p1_rows(Frame F) {
    F.fresh();
    const int gw = F.vcu * NWAVES + F.wave, NGW = F.G * NWAVES;
    const float* mod = (const float*)(F.ws + WS_MOD);
    f16* hbuf = (f16*)(F.ws + WS_A); float* gates = (float*)(F.ws + WS_GATES);
    float* cosT = (float*)(F.ws + WS_COS); float* sinT = (float*)(F.ws + WS_SIN);
    for (int row = gw; row < T; row += NGW) {
        const int b = row / SEQ;
        const GAS f32x4* xr = (const GAS f32x4*)(F.x() + (size_t)row * DM) + F.lane;
        f32x4 v[4]; float ss = 0.f;
#pragma unroll
        for (int j = 0; j < 4; ++j) { v[j] = xr[64 * j]; ss += (v[j].x * v[j].x + v[j].y * v[j].y) + (v[j].z * v[j].z + v[j].w * v[j].w); }
        const float rstd = 1.f / sqrtf(wave_sum(ss) * (1.f / DM) + EPS);
        float ga[8];
#pragma unroll
        for (int q = 0; q < 8; ++q) ga[q] = 0.f;
        GAS u32x2* o8 = (GAS u32x2*)(hbuf + (size_t)row * DM) + F.lane;
#pragma unroll
        for (int j = 0; j < 4; ++j) {
            const int k0 = 4 * F.lane + 256 * j;
            const f32x4 g = *(const f32x4*)(F.norm1_g() + k0), sh = *(const f32x4*)(mod + (size_t)b * 6144 + k0), scl = *(const f32x4*)(mod + (size_t)b * 6144 + 1024 + k0);
            const f32x4 h = v[j] * rstd * g * (scl + 1.f) + sh;
            u32x2 w; w.x = pk2h(h[0], h[1]); w.y = pk2h(h[2], h[3]); o8[64 * j] = w;
#pragma unroll
            for (int i = 0; i < 4; ++i) { const float* wp = F.w_in() + (size_t)(k0 + i) * NPROJ_SRC + NPROJ; const f32x4 w0 = *(const f32x4*)wp, w1 = *(const f32x4*)(wp + 4);
                ga[0] += h[i] * w0[0]; ga[1] += h[i] * w0[1]; ga[2] += h[i] * w0[2]; ga[3] += h[i] * w0[3];
                ga[4] += h[i] * w1[0]; ga[5] += h[i] * w1[1]; ga[6] += h[i] * w1[2]; ga[7] += h[i] * w1[3]; }
        }
#pragma unroll
        for (int q = 0; q < 8; ++q) ga[q] = wave_sum(ga[q]);
        if (F.lane == 0) {
#pragma unroll
            for (int q = 0; q < 8; ++q) gates[(size_t)row * 8 + q] = ga[q] + F.b_gate()[q];
        }
        if (F.lane < 32) { const float invf = exp2f(-(float)F.lane * (13.287712379549449f / 32.f)); const float ang = (float)F.positions()[row] * invf;
            cosT[(size_t)row * 32 + F.lane] = cosf(ang); sinT[(size_t)row * 32 + F.lane] = sinf(ang); }
    }
}

__device__ __forceinline__ void p3_attn_simple(Frame F) {
    F.fresh();
    const f16* proj = (const f16*)(F.ws + WS_PROJ); const float* ksum = (const float*)(F.ws + WS_CTL + CTL_KMEAN); f16* mix = (f16*)(F.ws + WS_A);
    for (int u = blockIdx.x; u < 64 * 8; u += F.G) {
        const int bh = u >> 3, chunk = u & 7, b = bh >> 3, h = bh & 7;
        const int q = chunk * 512 + F.tid, jb = q >> 8, row = b * SEQ + q;
        float qv[64];
        { const f16x8* qp = (const f16x8*)(proj + (size_t)row * NPROJ + C_QA + h * 64);
#pragma unroll
          for (int i = 0; i < 8; ++i) { const f16x8 t = qp[i];
#pragma unroll
              for (int k = 0; k < 8; ++k) qv[8 * i + k] = (float)t[k]; } }
        unsigned sel = 0u;
        { float g[16];
#pragma unroll
          for (int n = 0; n < 16; ++n) { float s = 0.f;
              if (n < jb) { const float* kp = ksum + ((size_t)bh * 16 + n) * 64;
#pragma unroll
                  for (int d = 0; d < 64; ++d) s += qv[d] * kp[d]; }
              g[n] = (n < jb) ? s : -INFINITY; }
#pragma unroll
          for (int r = 0; r < 3; ++r) { float best = -INFINITY; int bi = -1;
#pragma unroll
              for (int n = 0; n < 16; ++n) { const bool ok = !((sel >> n) & 1u) && g[n] > best; best = ok ? g[n] : best; bi = ok ? n : bi; }
              if (bi >= 0) sel |= 1u << bi; } }
        float m = -INFINITY, l = 0.f, acc[64];
#pragma unroll
        for (int d = 0; d < 64; ++d) acc[d] = 0.f;
        for (int n = 0; n <= jb; ++n) {
            const bool own = (n == jb), act = own || ((sel >> n) & 1u);
            for (int kk = 0; kk < 256; ++kk) {
                const bool on = act && (!own || kk <= (q & 255));
                if (!__any(on)) break;
                const size_t krow = (size_t)(b * SEQ + n * 256 + kk) * NPROJ;
                const f16x8* kp = (const f16x8*)(proj + krow + C_KA + h * 64);
                float s = 0.f;
#pragma unroll
                for (int i = 0; i < 8; ++i) { const f16x8 t = kp[i];
#pragma unroll
                    for (int k = 0; k < 8; ++k) s += qv[8 * i + k] * (float)t[k]; }
                if (on) {
                    const float mn = fmaxf(m, s), f = exp2f(m - mn), p = exp2f(s - mn);
                    const f16x8* vp = (const f16x8*)(proj + krow + C_VA + h * 64);
                    l = l * f + p; m = mn;
#pragma unroll
                    for (int i = 0; i < 8; ++i) { const f16x8 t = vp[i];
#pragma unroll
                        for (int k = 0; k < 8; ++k) acc[8 * i + k] = acc[8 * i + k] * f + p * (float)t[k]; }
                }
            }
        }
        const float il = 1.f / l; float ss = 0.f;
#pragma unroll
        for (int d = 0; d < 64; ++d) { acc[d] *= il; ss += acc[d] * acc[d]; }
        const float rs = 1.f / sqrtf(ss * (1.f / 64.f) + EPS);
        u32x4* op = (u32x4*)(mix + (size_t)row * DM + h * 64);
#pragma unroll
        for (int i = 0; i < 8; ++i) { float o[8];
#pragma unroll
            for (int k = 0; k < 8; ++k) o[k] = acc[8 * i + k] * rs * F.attn_g()[h * 64 + 8 * i + k];
            u32x4 w; w.x = pk2h(o[0], o[1]); w.y = pk2h(o[2], o[3]); w.z = pk2h(o[4], o[5]); w.w = pk2h(o[6], o[7]); op[i] = w; }
    }
}


__device__ __forceinline__ void p3_attn(Frame F) {
    F.fresh();
    const f16* proj = (const f16*)(F.ws + WS_PROJ); const float* ksum = (const float*)(F.ws + WS_CTL + CTL_KMEAN); f16* mix = (f16*)(F.ws + WS_A);
    const int bh = F.vcu >> 2, s4 = F.vcu & 3;
    if (bh < 64) {
#pragma unroll 1
        for (int i = 0; i < 4; ++i) {
            const int qb = (i == 0) ? s4 : (i == 1) ? 15 - s4 : (i == 2) ? 4 + s4 : 11 - s4;
            moba::sel_unit(bh >> 3, bh & 7, qb, proj + C_QA, ksum, (char*)F.lds);
            moba::attn_unit<8>(bh >> 3, bh & 7, qb, proj + C_QA, proj + C_KA, proj + C_VA, mix, ksum, F.attn_g(), (char*)F.lds);
        }
    }
}


constexpr int CW_Q = 12288;
__device__ __forceinline__ void p3_mixers(Frame F) {
    F.fresh();
    const f16* proj = (const f16*)(F.ws + WS_PROJ); const float* ksum = (const float*)(F.ws + WS_CTL + CTL_KMEAN); f16* mix = (f16*)(F.ws + WS_A);
    unsigned* ctl = (unsigned*)(F.ws + WS_CTL);
    const int q = blockIdx.x & 7;
    LAS int* slot = (LAS int*)(F.lds + TAB_OFF + 512);
    for (;;) {
        if (F.tid == 0) *slot = (int)__hip_atomic_fetch_add(ctl + CW_Q + 64 * q, 1u, RLX_AGENT);
        __syncthreads();
        const int it = *slot;
        __syncthreads();
        if (it >= 132) break;
        if (it < 4) { mlstm::unit(q, it, proj, (const float*)(F.ws + WS_GATES), F.conv_w(), F.conv_b(), F.mlstm_g(), mix, F.lds); }
        else { const int j = it - 4, qb = 15 - (j >> 3), bh = 8 * q + (j & 7);
            moba::sel_unit(bh >> 3, bh & 7, qb, proj + C_QA, ksum, (char*)F.lds);
            moba::attn_unit<8>(bh >> 3, bh & 7, qb, proj + C_QA, proj + C_KA, proj + C_VA, mix, ksum, F.attn_g(), (char*)F.lds); }
    }
}

__device__ __forceinline__ void p3_mlstm_simple(Frame F) {
    F.fresh();
    const f16* proj = (const f16*)(F.ws + WS_PROJ); const float* gates = (const float*)(F.ws + WS_GATES); f16* mix = (f16*)(F.ws + WS_A);
    LAS float* qs = (LAS float*)F.lds; LAS float* ks = qs + 128; LAS float* vs = qs + 256; LAS float* red = qs + 384;
    for (int bh = blockIdx.x; bh < 32; bh += F.G) {
        const int b = bh >> 2, hm = bh & 3, e = F.tid >> 2, dq = F.tid & 3;
        float Cs[32], nn[32], m = 0.f;
#pragma unroll
        for (int j = 0; j < 32; ++j) { Cs[j] = 0.f; nn[j] = 0.f; }
        const float og = F.mlstm_g()[hm * 128 + e];
        for (int t = 0; t < SEQ; ++t) {
            const int row = b * SEQ + t;
            if (F.tid < 256) {
                const bool isk = F.tid >= 128; const int d = F.tid & 127, col = (isk ? C_KM : C_QM) + hm * 128 + d, cc = (isk ? 512 : 0) + hm * 128 + d;
                float val = F.conv_b()[cc];
#pragma unroll
                for (int j = 0; j < 4; ++j) { const int tt = t - 3 + j; if (tt >= 0) val += (float)proj[(size_t)(b * SEQ + tt) * NPROJ + col] * F.conv_w()[j * 1024 + cc]; }
                val = val / (1.f + __expf(-val));
                if (isk) ks[d] = val * 0.08838834764831845f; else qs[d] = val;
            } else if (F.tid < 384) { const int d = F.tid - 256; vs[d] = (float)proj[(size_t)row * NPROJ + C_VM + hm * 128 + d]; }
            const float ig = gates[(size_t)row * 8 + hm], fg = gates[(size_t)row * 8 + 4 + hm];
            __syncthreads();
            const float logf = fminf(fg, 0.f) - log1pf(__expf(-fabsf(fg)));
            const float mn = fmaxf(logf + m, ig), a = __expf(logf + m - mn), bb = __expf(ig - mn); m = mn;
            const float ve = vs[e] * bb; float pn = 0.f, pd = 0.f;
#pragma unroll
            for (int j = 0; j < 32; ++j) { const int d = 32 * dq + j; const float kd = ks[d], qd = qs[d];
                Cs[j] = a * Cs[j] + ve * kd; nn[j] = a * nn[j] + bb * kd; pn += Cs[j] * qd; pd += nn[j] * qd; }
            pn += __shfl_xor(pn, 1); pn += __shfl_xor(pn, 2); pd += __shfl_xor(pd, 1); pd += __shfl_xor(pd, 2);
            const float hv = pn / fmaxf(fabsf(pd), __expf(-m));
            const float sq = wave_sum(dq == 0 ? hv * hv : 0.f);
            if (F.lane == 0) red[F.wave] = sq;
            __syncthreads();
            float tot = 0.f;
#pragma unroll
            for (int w = 0; w < 8; ++w) tot += red[w];
            if (dq == 0) { const float om = (float)proj[(size_t)row * NPROJ + C_OM + hm * 128 + e];
                const float o = hv / sqrtf(tot * (1.f / 128.f) + EPS) * og * sigmoidf_(om);
                mix[(size_t)row * DM + 512 + hm * 128 + e] = (f16)o; }
            __syncthreads();
        }
    }
}

__device__ __forceinline__ void p5_route(Frame F) {
    F.fresh();
    const int gw = F.vcu * NWAVES + F.wave, NGW = F.G * NWAVES;
    const float* mod = (const float*)(F.ws + WS_MOD);
    f16* h2 = (f16*)(F.ws + WS_H2); int* list = (int*)(F.ws + WS_LIST); int* pos2 = (int*)(F.ws + WS_POS);
    unsigned* cnt = (unsigned*)(F.ws + WS_CTL) + CW_CNT;
    for (int row = gw; row < T; row += NGW) {
        const int b = row / SEQ;
        const GAS f32x4* xr = (const GAS f32x4*)(F.out + (size_t)row * DM) + F.lane;
        f32x4 v[4]; float ss = 0.f;
#pragma unroll
        for (int j = 0; j < 4; ++j) { v[j] = xr[64 * j]; ss += (v[j].x * v[j].x + v[j].y * v[j].y) + (v[j].z * v[j].z + v[j].w * v[j].w); }
        const float rstd = 1.f / sqrtf(wave_sum(ss) * (1.f / DM) + EPS);
        float lg[36];
#pragma unroll
        for (int q = 0; q < 36; ++q) lg[q] = 0.f;
        GAS u32x2* o8 = (GAS u32x2*)(h2 + (size_t)row * DM) + F.lane;
        const float* wgp = F.w_rg() + (size_t)F.lane * 16; const float* wep = F.w_re() + (size_t)F.lane * 128;
        const float* gp = F.norm2_g() + 4 * F.lane; const float* mp = mod + (size_t)b * 6144 + 3072 + 4 * F.lane;
#pragma unroll 1
        for (int j = 0; j < 4; ++j) {
            const f32x4 g = *(const f32x4*)gp, sh = *(const f32x4*)mp, scl = *(const f32x4*)(mp + 1024);
            const f32x4 h = v[0] * rstd * g * (scl + 1.f) + sh;
            v[0] = v[1]; v[1] = v[2]; v[2] = v[3];
            u32x2 w; w.x = pk2h(h[0], h[1]); w.y = pk2h(h[2], h[3]); *o8 = w;
#pragma unroll
            for (int i = 0; i < 4; ++i) {
                const f32x4 wg = *(const f32x4*)(wgp + 4 * i);
#pragma unroll
                for (int q = 0; q < 4; ++q) lg[q] += h[i] * wg[q];
#pragma unroll
                for (int q4 = 0; q4 < 8; ++q4) { const f32x4 we = *(const f32x4*)(wep + 32 * i + 4 * q4);
#pragma unroll
                    for (int q = 0; q < 4; ++q) lg[4 + 4 * q4 + q] += h[i] * we[q]; }
            }
            wgp += 256 * 4; wep += 256 * 32; gp += 256; mp += 256; o8 += 64;
            asm volatile("" ::: "memory");
        }
#pragma unroll
        for (int q = 0; q < 36; ++q) lg[q] = wave_sum(lg[q]);
        float gl[4];
#pragma unroll
        for (int q = 0; q < 4; ++q) gl[q] = lg[q] + F.b_rg()[q];
        int gi = 0; float gm = gl[0];
#pragma unroll
        for (int q = 1; q < 4; ++q) if (gl[q] > gm) { gm = gl[q]; gi = q; }
        float gsum = 0.f;
#pragma unroll
        for (int q = 0; q < 4; ++q) gsum += __expf(gl[q] - gm);
        const float pg = 1.f / gsum;
        float el[8];
#pragma unroll
        for (int q = 0; q < 8; ++q) { const float e0 = lg[4 + q], e1 = lg[12 + q], e2 = lg[20 + q], e3 = lg[28 + q]; el[q] = (gi == 0 ? e0 : gi == 1 ? e1 : gi == 2 ? e2 : e3) + F.b_re()[gi * 8 + q]; }
        int i1 = 0; float m1 = el[0];
#pragma unroll
        for (int q = 1; q < 8; ++q) if (el[q] > m1) { m1 = el[q]; i1 = q; }
        int i2 = -1; float m2 = -INFINITY;
#pragma unroll
        for (int q = 0; q < 8; ++q) if (q != i1 && el[q] > m2) { m2 = el[q]; i2 = q; }
        const float r = __expf(m2 - m1), w1 = pg / (1.f + r), w2 = pg * r / (1.f + r);
        if (F.lane < 2) { const int e = gi * 8 + (F.lane == 0 ? i1 : i2); const float w = F.lane == 0 ? w1 : w2;
            const unsigned slot = atomicAdd(cnt + e, 1u);
            list[2 * ((size_t)e * LISTCAP + slot)] = row; list[2 * ((size_t)e * LISTCAP + slot) + 1] = __float_as_int(w);
            pos2[2 * row + F.lane] = e * LISTCAP + (int)slot; }
    }
}

__device__ __forceinline__ void moe_tables(Frame F) {
    F.fresh();
    LAS int* tab = (LAS int*)(F.lds + TAB_OFF);
    const unsigned* cnt = (const unsigned*)(F.ws + WS_CTL) + CW_CNT;
    __syncthreads();
    if (F.tid == 0) { int up = 0, rp = 0;
        for (int e = 0; e < 32; ++e) { const int c = (int)__hip_atomic_load(cnt + e, RLX_AGENT); tab[e] = up; tab[40 + e] = rp; tab[80 + e] = c; up += ((c + 255) >> 8) * 4; rp += c; }
        tab[32] = up; tab[72] = rp; }
    __syncthreads();
}

__device__ __forceinline__ void p8_final(Frame F) {
    F.fresh();
    const int gw = F.vcu * NWAVES + F.wave, NGW = F.G * NWAVES;
    const float* mod = (const float*)(F.ws + WS_MOD); const f16* Y = (const f16*)(F.ws + WS_Y); const int* pos2 = (const int*)(F.ws + WS_POS);
    const LAS int* tab = (const LAS int*)(F.lds + TAB_OFF);
    for (int row = gw; row < T; row += NGW) {
        const int b = row / SEQ; const int p0 = pos2[2 * row], p1 = pos2[2 * row + 1];
        const size_t y0 = (size_t)(tab[40 + (p0 >> 15)] + (p0 & 32767)) * DM, y1 = (size_t)(tab[40 + (p1 >> 15)] + (p1 & 32767)) * DM;
        GAS f32x4* xr = (GAS f32x4*)(F.out + (size_t)row * DM) + F.lane;
        f32x4 v[4]; float ss = 0.f;
#pragma unroll
        for (int j = 0; j < 4; ++j) { const int k0 = 4 * F.lane + 256 * j;
            const f16x4 a = *(const f16x4*)(Y + y0 + k0), c = *(const f16x4*)(Y + y1 + k0); const f32x4 g2 = *(const f32x4*)(mod + (size_t)b * 6144 + 5120 + k0);
            f32x4 s; s.x = (float)a[0] + (float)c[0]; s.y = (float)a[1] + (float)c[1]; s.z = (float)a[2] + (float)c[2]; s.w = (float)a[3] + (float)c[3];
            v[j] = xr[64 * j] + g2 * s; ss += (v[j].x * v[j].x + v[j].y * v[j].y) + (v[j].z * v[j].z + v[j].w * v[j].w); }
        const float rstd = 1.f / sqrtf(wave_sum(ss) * (1.f / DM) + EPS);
#pragma unroll
        for (int j = 0; j < 4; ++j) { const int k0 = 4 * F.lane + 256 * j; xr[64 * j] = v[j] * rstd * *(const f32x4*)(F.normf_g() + k0); }
    }
}

__global__ void __launch_bounds__(NTHR, 2) fwd_kernel(Args args) {
    extern __shared__ __attribute__((aligned(16))) unsigned char lds_raw[];
    Frame F;
    F.lds = (LAS unsigned char*)lds_raw;
    F.tid = threadIdx.x; F.lane = F.tid & 63; F.wave = __builtin_amdgcn_readfirstlane(F.tid >> 6);
    F.G = gridDim.x; { const int bx = blockIdx.x; F.vcu = (F.G % 8 == 0) ? (bx % 8) * (F.G / 8) + bx / 8 : bx; }
    F.out = args.out; F.ws = args.ws;
    for (int u = F.tid; u < (LDS_BYTES - LDSCTL_OFF) / 4; u += NTHR) ((LAS unsigned*)(F.lds + LDSCTL_OFF))[u] = 0u;
    __syncthreads();
    if (F.tid < 44) ((LAS unsigned*)(F.lds + ARGS_OFF))[F.tid] = ((const __attribute__((address_space(4))) unsigned*)__builtin_amdgcn_kernarg_segment_ptr())[F.tid];
    __syncthreads();
    unsigned* ctl = (unsigned*)(F.ws + WS_CTL);
    XcdBarrier bar = xcd_barrier_post(ctl + CW_BAR, (volatile LAS unsigned*)(F.lds + MISC_OFF) + 8);

    p0_prologue(F);
    xcd_barrier(bar);
    p1_rows(F);
    xcd_barrier(bar);
    { pg8::DenseSched S; S.init(T, NPROJ, 1024, F.G, (int)blockIdx.x, true);
      pg8::EpiProj E{(f16*)(F.ws + WS_PROJ), (const float*)(F.ws + WS_COS), (const float*)(F.ws + WS_SIN), (float*)(F.ws + WS_CTL + CTL_KMEAN)};
      pg8::gemm_phase<true>(F.lds, (const char*)(F.ws + WS_A), (const char*)(F.ws + WS_WIN), 1024, S, E); }
    xcd_barrier(bar);
    p3_mixers(F);
    xcd_barrier(bar);
    { pg8::DenseSched S; S.init(T, DM, 1024, F.G, (int)blockIdx.x, false);
      pg8::EpiOut E{F.x(), (const float*)(F.ws + WS_MOD), F.out};
      pg8::gemm_phase<false>(F.lds, (const char*)(F.ws + WS_A), (const char*)(F.ws + WS_WOUT), 1024, S, E); }
    xcd_barrier(bar);
    p5_route(F);
    xcd_barrier(bar);
    moe_tables(F);
    { pg8::MoeSched S{(const LAS int*)(F.lds + TAB_OFF), F.G, F.vcu, 1024, true, (const int*)(F.ws + WS_LIST), 0, 0};
      pg8::EpiMoe1 E{(f16*)(F.ws + WS_HID)};
      pg8::gemm_phase<false>(F.lds, (const char*)(F.ws + WS_H2), (const char*)(F.ws + WS_W1), 1024, S, E); }
    xcd_barrier(bar);
    { pg8::MoeSched S{(const LAS int*)(F.lds + TAB_OFF), F.G, F.vcu, 512, false, (const int*)(F.ws + WS_LIST), 0, 0};
      pg8::EpiMoe2 E{(f16*)(F.ws + WS_Y), (const int*)(F.ws + WS_LIST)};
      pg8::gemm_phase<false>(F.lds, (const char*)(F.ws + WS_HID), (const char*)(F.ws + WS_W2), 512, S, E); }
    xcd_barrier(bar);
    p8_final(F);
}

extern "C" void kernel_launch(void* const* d_in, const int* in_sizes, int n_in, void* d_out, int out_size, void* d_ws, size_t ws_size, hipStream_t stream) {
    static int grid = 0;
    if (grid == 0) {
        if (n_in != 22 || out_size != T * DM || ws_size < WS_END) { fprintf(stderr, "kernel_launch: unexpected problem (n_in %d, out %d, ws %zu)\n", n_in, out_size, ws_size); grid = -1; return; }
        int dev = 0, cus = 0, per_cu = 0;
        if (hipGetDevice(&dev) != hipSuccess || hipDeviceGetAttribute(&cus, hipDeviceAttributeMultiprocessorCount, dev) != hipSuccess) { grid = -1; return; }
        if (hipFuncSetAttribute((const void*)fwd_kernel, hipFuncAttributeMaxDynamicSharedMemorySize, LDS_BYTES) != hipSuccess) { fprintf(stderr, "kernel_launch: hipFuncSetAttribute failed\n"); grid = -1; return; }
        if (hipOccupancyMaxActiveBlocksPerMultiprocessor(&per_cu, (const void*)fwd_kernel, NTHR, LDS_BYTES) != hipSuccess || per_cu < 1) fprintf(stderr, "kernel_launch: occupancy query says %d\n", per_cu);
        (void)hipGetLastError();
        grid = cus;
    }
    if (grid < 0) return;
    (void)hipMemsetAsync((char*)d_ws + WS_CTL, 0, CTL_ZERO_BYTES, stream);
    Args a{};
    for (int i = 0; i < 22; ++i) a.in[i] = d_in[i];
    a.out = (float*)d_out; a.ws = (unsigned char*)d_ws;
    hipLaunchKernelGGL(fwd_kernel, dim3(grid), dim3(NTHR), LDS_BYTES, stream, a);
}
```

```cpp
#include <hip/hip_runtime.h>
#include <cstdio>
#include <cstdint>
#include <cmath>

#define LAS __attribute__((address_space(3)))
#define GAS __attribute__((address_space(1)))
typedef _Float16 f16;
typedef _Float16 f16x8 __attribute__((ext_vector_type(8)));
typedef _Float16 f16x4 __attribute__((ext_vector_type(4)));
typedef _Float16 f16x2 __attribute__((ext_vector_type(2)));
typedef float f32x4 __attribute__((ext_vector_type(4)));
typedef float f32x2 __attribute__((ext_vector_type(2)));
typedef unsigned u32x4 __attribute__((ext_vector_type(4)));
typedef unsigned u32x2 __attribute__((ext_vector_type(2)));

constexpr int NB = 8, SEQ = 4096, DM = 1024, T = NB * SEQ;
constexpr int NPROJ = 3584, NPROJ_SRC = 3592;
constexpr int C_QA = 0, C_KA = 512, C_VA = 1024, C_QM = 1536, C_KM = 2048, C_VM = 2560, C_OM = 3072;
constexpr int NEXP = 32, DEXP = 512, LISTCAP = 32768;
constexpr float EPS = 1e-6f;
constexpr float C2 = 0.125f * 1.4426950408889634f;
constexpr int NWAVES = 8, NTHR = 512;

constexpr size_t MiB = 1u << 20;
constexpr size_t WS_CTL = 0, CTL_ZERO_BYTES = 1 * MiB;
constexpr int CW_BAR = 4096;
constexpr int CW_MT = 28672;
constexpr int CW_CNT = 8192;
constexpr size_t CTL_KMEAN = 256 * 1024;
constexpr size_t WS_WGT = 1 * MiB + 256 * 1024, WS_WRT = 1 * MiB + 320 * 1024;
constexpr size_t WS_MOD = 1 * MiB, WS_GATES = 2 * MiB, WS_POS = 3 * MiB, WS_COS = 4 * MiB, WS_SIN = 8 * MiB, WS_LIST = 12 * MiB;
constexpr size_t WS_WIN = 20 * MiB, WS_WOUT = 27 * MiB, WS_W1 = 29 * MiB, WS_W3 = 61 * MiB, WS_W2 = 93 * MiB;
constexpr size_t WS_A = 126 * MiB;
constexpr size_t WS_PROJ = 190 * MiB;
constexpr size_t WS_H2 = 190 * MiB;
constexpr size_t WS_HID = 254 * MiB;
constexpr size_t WS_Y = 320 * MiB;
constexpr size_t WS_MLS = 414 * MiB;
constexpr size_t WS_GPM = 512 * 1024;
constexpr size_t WS_CLOC = 416 * MiB;
constexpr size_t WS_CPREV = 432 * MiB;
constexpr size_t WS_QKC = 448 * MiB;
constexpr size_t WS_END = 512 * MiB;

constexpr int RING_BYTES = 133120;
constexpr int LDSCTL_OFF = RING_BYTES, MISC_OFF = LDSCTL_OFF + 320, TAB_OFF = LDSCTL_OFF + 1024;
constexpr int ARGS_OFF = LDSCTL_OFF + 2048;
constexpr int LDS_BYTES = 147456;

#define RLX_AGENT __ATOMIC_RELAXED, __HIP_MEMORY_SCOPE_AGENT
#define LDS_WAIT() asm volatile("s_waitcnt lgkmcnt(0)" ::: "memory")
__device__ __forceinline__ unsigned pk2h(float a, float b) { f16x2 v = {(f16)a, (f16)b}; return __builtin_bit_cast(unsigned, v); }
template <int M> __device__ __forceinline__ float xsum(float v) {
    const int iv = __builtin_bit_cast(int, v);
    if constexpr (M == 1) return v + __builtin_bit_cast(float, __builtin_amdgcn_mov_dpp(iv, 0xB1, 0xF, 0xF, true));
    else if constexpr (M == 2) return v + __builtin_bit_cast(float, __builtin_amdgcn_mov_dpp(iv, 0x4E, 0xF, 0xF, true));
    else if constexpr (M == 32) { const auto r = __builtin_amdgcn_permlane32_swap((unsigned)iv, (unsigned)iv, false, false); return __uint_as_float(r[0]) + __uint_as_float(r[1]); }
    else return v + __builtin_bit_cast(float, __builtin_amdgcn_ds_swizzle(iv, (M << 10) | 0x1F));
}
__device__ __forceinline__ float wave_sum(float v) { v = xsum<1>(v); v = xsum<2>(v); v = xsum<4>(v); v = xsum<8>(v); v = xsum<16>(v); return xsum<32>(v); }
typedef int i32x8 __attribute__((ext_vector_type(8)));
typedef int i32x4 __attribute__((ext_vector_type(4)));
__device__ __forceinline__ u32x2 pk8_fp8(const float (&o)[8]) {
    float c[8];
#pragma unroll
    for (int j = 0; j < 8; ++j) c[j] = fminf(fmaxf(o[j], -448.f), 448.f);
    int lo = __builtin_amdgcn_cvt_pk_fp8_f32(c[0], c[1], 0, false); lo = __builtin_amdgcn_cvt_pk_fp8_f32(c[2], c[3], lo, true);
    int hi = __builtin_amdgcn_cvt_pk_fp8_f32(c[4], c[5], 0, false); hi = __builtin_amdgcn_cvt_pk_fp8_f32(c[6], c[7], hi, true);
    return (u32x2){(unsigned)lo, (unsigned)hi};
}
#ifndef MOE_FP8
#define MOE_FP8 1
#endif
constexpr bool MOE8 = MOE_FP8 != 0;
constexpr float W8SCALE = MOE8 ? 16.f : 1.f;
__device__ __forceinline__ float sigmoidf_(float x) { return 1.f / (1.f + __expf(-x)); }

__device__ __forceinline__ int tid_of(int w0) { unsigned z = 0u; asm volatile("" : "+v"(z));
    return w0 * 64 + (int)__builtin_amdgcn_mbcnt_hi(~0u, __builtin_amdgcn_mbcnt_lo(~0u, z)); }
__device__ __forceinline__ void st16_wt(void* base_uniform, unsigned byte_off, u32x4 v) {
    const __amdgpu_buffer_rsrc_t r = __builtin_amdgcn_make_buffer_rsrc(base_uniform, (short)0, 0x7fffffff, 0x00020000);
    __builtin_amdgcn_raw_buffer_store_b128(v, r, (int)byte_off, 0, 16);
}
__device__ __forceinline__ void st4_wt(float* p, float v) { __hip_atomic_store((unsigned*)p, __float_as_uint(v), __ATOMIC_RELAXED, __HIP_MEMORY_SCOPE_AGENT); }
#define XB_TMO      128
#define XB_XCNT(j)  (256  + 64 * (j))
#define XB_XSUB(j)  (1280 + 64 * (j))
#define XB_XGEN(j)  (2304 + 64 * (j))
#define XB_TOP      3328
#define XB_TOPGEN   3392
#define XCD_BAR_WORDS 3456
#define XB_SPIN_CAP (1u << 22)
__device__ __forceinline__ unsigned xb_ld(unsigned* p)              { return __hip_atomic_load(p, __ATOMIC_RELAXED, __HIP_MEMORY_SCOPE_AGENT); }
__device__ __forceinline__ unsigned xb_add(unsigned* p, unsigned v) { return __hip_atomic_fetch_add(p, v, __ATOMIC_RELAXED, __HIP_MEMORY_SCOPE_AGENT); }
__device__ __forceinline__ unsigned xb_xcc_id() { return (unsigned)__builtin_amdgcn_s_getreg((3 << 11) | 20) & 0xFu; }
#define XB_SPIN(cond, bar) do { unsigned _sp = 0; while (cond) { __builtin_amdgcn_s_sleep(1); \
    if ((++_sp & 255u) == 0u) { if (xb_ld(&(bar)[XB_TMO])) break; if (_sp > XB_SPIN_CAP) { atomicAdd(&(bar)[XB_TMO], 1u); break; } } } } while (0)
struct XcdBarrier { unsigned* bar; unsigned x; volatile LAS unsigned* st; };
__device__ __forceinline__ XcdBarrier xcd_barrier_post(unsigned* bar, volatile LAS unsigned* st, const bool leader) {
    XcdBarrier b; b.bar = bar; b.x = xb_xcc_id(); b.st = st;
    if (leader) (void)xb_add(&bar[XB_XCNT(b.x)], 1u);
    return b;
}
__device__ __forceinline__ void xcd_barrier_complete(unsigned* bar, unsigned x, unsigned& nloc, unsigned& nx) {
    const unsigned G = gridDim.x * gridDim.y * gridDim.z;
    unsigned sum, cnt, mine, sp = 0u;
    for (;;) {
        sum = 0u; cnt = 0u; mine = 0u;
#pragma unroll
        for (unsigned j = 0; j < 16; ++j) { const unsigned c = xb_ld(&bar[XB_XCNT(j)]); sum += c; cnt += (c > 0u) ? 1u : 0u; mine = (j == x) ? c : mine; }
        if (sum == G) break;
        __builtin_amdgcn_s_sleep(1);
        if ((++sp & 255u) == 0u) { if (xb_ld(&bar[XB_TMO])) break; if (sp > XB_SPIN_CAP) { atomicAdd(&bar[XB_TMO], 1u); break; } }
    }
    nloc = mine > 0u ? mine : 1u; nx = cnt > 0u ? cnt : 1u;
}
__device__ __forceinline__ void xcd_barrier(const XcdBarrier& b, const int w0) {
    asm volatile("s_waitcnt vmcnt(0)" ::: "memory");
    __syncthreads();
    if (tid_of(w0) == 0) {
        unsigned* bar = b.bar;
        __builtin_amdgcn_s_waitcnt(0);
        unsigned nloc = b.st[0], nx = b.st[1];
        if (nloc == 0u) { xcd_barrier_complete(bar, b.x, nloc, nx); b.st[0] = nloc; b.st[1] = nx; }
        const unsigned old = xb_add(&bar[XB_XSUB(b.x)], 1u);
        const unsigned gen = old / nloc;
        if (old + 1u == (gen + 1u) * nloc) {
            __builtin_amdgcn_fence(__ATOMIC_RELEASE, "agent");
            asm volatile("s_waitcnt vmcnt(0)" ::: "memory");
            const unsigned og = xb_add(&bar[XB_TOP], 1u);
            const unsigned tg = og / nx;
            if (og + 1u == (tg + 1u) * nx) xb_add(&bar[XB_TOPGEN], 1u);
            else XB_SPIN(xb_ld(&bar[XB_TOPGEN]) == tg, bar);
            __builtin_amdgcn_fence(__ATOMIC_ACQUIRE, "agent");
            xb_add(&bar[XB_XGEN(b.x)], 1u);
            asm volatile("s_waitcnt vmcnt(0)" ::: "memory");
        } else {
            XB_SPIN(xb_ld(&bar[XB_XGEN(b.x)]) == gen, bar);
            __builtin_amdgcn_fence(__ATOMIC_ACQUIRE, "agent");
            asm volatile("s_waitcnt vmcnt(0)" ::: "memory");
        }
    }
    __syncthreads();
}

namespace pg8 {
constexpr int BM = 256, BK = 64, HALF = 128, HTB = HALF * BK * 2, STAGE_BYTES = 8 * HTB;
__host__ __device__ __forceinline__ int lds_byte(int r, int c) { const int st = (r >> 4) * 2 + (c >> 5), rr = r & 15, cc = c & 31, ob = rr * 64 + cc * 2; return st * 1024 + (ob ^ (((ob >> 9) & 1) << 5)); }
__host__ __device__ __forceinline__ void stage_rc(int b, int& R, int& C) { const int st = b / 1024, sb = b % 1024, swz = sb ^ (((sb >> 9) & 1) << 5); R = (st >> 1) * 16 + swz / 64; C = (st & 1) * 32 + (swz % 64) / 2; }
__host__ __device__ __forceinline__ int perm32(int rho) { const int n = rho >> 4, i = rho & 15; return 8 * (i >> 2) + 4 * n + (i & 3); }

struct Unit { size_t b0, b1; int pm, pn, e, row0, rows, gt; };

template <bool ROPE, bool FP8, class Epi, class Sched>
__device__ __forceinline__ void gemm_phase(LAS unsigned char* lds, const char* Abase, const char* Bbase, const int K, const Sched& S, const Epi& E, const int w0) {
    const int tid = tid_of(w0);
    const int wid = w0, lane = tid & 63, wr = wid >> 2, wc = wid & 3, fr = lane & 15, fq = lane >> 4;
    const int Kb = FP8 ? K : 2 * K;
    int nt = Kb / 128; asm volatile("" : "+s"(nt));
    int R[2], C[2]; unsigned voffB[2];
#pragma unroll
    for (int i = 0; i < 2; ++i) { stage_rc(tid * 16 + i * 8192, R[i], C[i]);
        const int Rb = ROPE ? (64 * (R[i] >> 5) + perm32(R[i] & 31)) : ((R[i] & ~31) + perm32(R[i] & 31));
        voffB[i] = (unsigned)(Rb * Kb + C[i] * 2); }
    const size_t kstep = (size_t)(BK * 2);
    const unsigned ldsw = (unsigned)wid * 1024u;
    const int aoff = FP8 ? lds_byte(wr * 64 + fr, fq * 16) : lds_byte(wr * 64 + fr, fq * 8), boff = FP8 ? lds_byte(wc * 32 + fr, fq * 16) : lds_byte(wc * 32 + fr, fq * 8);
#define PG8_SA(b, h) (((b) * 2 + (h)) * HTB)
#define PG8_SB(b, h) ((4 + (b) * 2 + (h)) * HTB)
#define PG8_STG(bufoff, gbase, voff) do { _Pragma("unroll") for (int _i = 0; _i < 2; ++_i) \
        __builtin_amdgcn_global_load_lds((const unsigned*)((const char*)(gbase) + (voff)[_i]), (LAS unsigned*)(lds + (bufoff) + ldsw + _i * 8192), 16, 0, 0); } while (0)
#define PG8_LDA(dst, b, h) do { _Pragma("unroll") for (int m = 0; m < 4; ++m) { dst[m].lo = *(const LAS i32x4*)(lds + PG8_SA(b, h) + aoff + m * 2048); dst[m].hi = *(const LAS i32x4*)(lds + PG8_SA(b, h) + aoff + m * 2048 + (FP8 ? 16 : 1024)); } } while (0)
#define PG8_LDB(dst, b, h) do { _Pragma("unroll") for (int n = 0; n < 2; ++n) { dst[n].lo = *(const LAS i32x4*)(lds + PG8_SB(b, h) + boff + n * 2048); dst[n].hi = *(const LAS i32x4*)(lds + PG8_SB(b, h) + boff + n * 2048 + (FP8 ? 16 : 1024)); } } while (0)
#define PG8_MMA(ai, bj, At, Bt) do { __builtin_amdgcn_s_setprio(1); _Pragma("unroll") for (int m = 0; m < 4; ++m) _Pragma("unroll") for (int n = 0; n < 2; ++n) { \
        if constexpr (FP8) acc[ai][bj][m][n] = __builtin_amdgcn_mfma_scale_f32_16x16x128_f8f6f4(Bt[n], At[m], acc[ai][bj][m][n], 0, 0, 0, 0x7f7f7f7f, 0, 0x7f7f7f7f); \
        else { const i32x4 bl_ = Bt[n].lo, bh_ = Bt[n].hi, al_ = At[m].lo, ah_ = At[m].hi;        \
               acc[ai][bj][m][n] = __builtin_amdgcn_mfma_f32_16x16x32_f16(__builtin_bit_cast(f16x8, bl_), __builtin_bit_cast(f16x8, al_), acc[ai][bj][m][n], 0, 0, 0); \
               acc[ai][bj][m][n] = __builtin_amdgcn_mfma_f32_16x16x32_f16(__builtin_bit_cast(f16x8, bh_), __builtin_bit_cast(f16x8, ah_), acc[ai][bj][m][n], 0, 0, 0); } } \
        if constexpr (FP8) { _Pragma("unroll") for (int m = 0; m < 4; ++m) _Pragma("unroll") for (int n = 0; n < 2; ++n) asm volatile("" : "+v"(acc[ai][bj][m][n])); }     \
        __builtin_amdgcn_s_setprio(0); } while (0)
#define PG8_WAIT_V(n) asm volatile("s_waitcnt vmcnt(" #n ")" ::: "memory")
#define PG8_WAIT_L(n) asm volatile("s_waitcnt lgkmcnt(" #n ")" ::: "memory")
#define PG8_BAR __builtin_amdgcn_s_barrier()
#define PG8_SCHED __builtin_amdgcn_sched_barrier(0)
#define PG8_PIN do { if constexpr (FP8) __builtin_amdgcn_sched_barrier(0); } while (0)
    Unit cur, nxt; int ui = 0;
    if (!S.next(0, cur)) return;
    f32x4 acc[2][2][4][2];
#pragma unroll
    for (int a = 0; a < 2; ++a)
#pragma unroll
        for (int b = 0; b < 2; ++b)
#pragma unroll
            for (int m = 0; m < 4; ++m)
#pragma unroll
                for (int n = 0; n < 2; ++n) acc[a][b][m][n] = (f32x4){0.f, 0.f, 0.f, 0.f};
    i32x8 At[4], B0[2], B1[2];
    unsigned cvA[2][2], nvA[2][2];
    S.a_ready(cur, wid);
    S.avoff(cur, cvA, R, C);
    const char* cB0 = Bbase + cur.b0; const char* cB1 = Bbase + cur.b1;
    PG8_STG(PG8_SB(0, 0), cB0, voffB); PG8_STG(PG8_SB(0, 1), cB1, voffB); PG8_STG(PG8_SA(0, 0), Abase, cvA[0]); PG8_STG(PG8_SA(0, 1), Abase, cvA[1]);
    if (wr == 1) PG8_BAR;
    PG8_WAIT_V(2); PG8_BAR;
    PG8_STG(PG8_SB(1, 0), cB0 + kstep, voffB); PG8_STG(PG8_SA(1, 0), Abase + kstep, cvA[0]); PG8_STG(PG8_SB(1, 1), cB1 + kstep, voffB);
    PG8_WAIT_V(6); PG8_BAR;
    for (;;) {
        const bool has_next = S.next(ui + 1, nxt);
        if (has_next) S.avoff(nxt, nvA, R, C);
        else {
#pragma unroll
            for (int h = 0; h < 2; ++h)
#pragma unroll
                for (int i = 0; i < 2; ++i) nvA[h][i] = cvA[h][i];
        }
        const char* nB0 = has_next ? Bbase + nxt.b0 : cB0; const char* nB1 = has_next ? Bbase + nxt.b1 : cB1;
        for (int t = 0; t < nt; t += 2) {
            const bool last = (t == nt - 2);
            if (last && has_next) S.a_ready(nxt, wid);
            const char* a1 = Abase + (size_t)(t + 1) * kstep;
            const size_t k2 = last ? (size_t)0 : (size_t)(t + 2) * kstep;
            const char* a2 = Abase + k2; const char* a3 = a2 + kstep;
            const char* b20 = (last ? nB0 : cB0) + k2; const char* b21 = (last ? nB1 : cB1) + k2;
            const char* b30 = b20 + kstep; const char* b31 = b21 + kstep;
            unsigned vA2[2][2];
#pragma unroll
            for (int h = 0; h < 2; ++h)
#pragma unroll
                for (int i = 0; i < 2; ++i) vA2[h][i] = last ? nvA[h][i] : cvA[h][i];
            PG8_LDB(B0, 0, 0); PG8_LDB(B1, 0, 1); PG8_SCHED; PG8_LDA(At, 0, 0); PG8_STG(PG8_SA(1, 1), a1, cvA[1]);
            PG8_WAIT_V(8); PG8_WAIT_L(0); PG8_BAR; PG8_PIN; PG8_MMA(0, 0, At, B0); PG8_MMA(0, 1, At, B1); PG8_PIN; PG8_BAR; PG8_SCHED;
            PG8_LDA(At, 0, 1); PG8_STG(PG8_SB(0, 0), b20, voffB); PG8_STG(PG8_SB(0, 1), b21, voffB); PG8_STG(PG8_SA(0, 0), a2, vA2[0]);
            PG8_WAIT_V(8); PG8_WAIT_L(0); PG8_BAR; PG8_PIN; PG8_MMA(1, 0, At, B0); PG8_MMA(1, 1, At, B1); PG8_PIN; PG8_BAR; PG8_SCHED;
            PG8_LDB(B0, 1, 0); PG8_LDB(B1, 1, 1); PG8_SCHED; PG8_LDA(At, 1, 0); PG8_STG(PG8_SA(0, 1), a2, vA2[1]);
            PG8_WAIT_V(8); PG8_WAIT_L(0); PG8_BAR; PG8_PIN; PG8_MMA(0, 0, At, B0); PG8_MMA(0, 1, At, B1); PG8_PIN; PG8_BAR; PG8_SCHED;
            PG8_LDA(At, 1, 1); PG8_STG(PG8_SB(1, 0), b30, voffB); PG8_STG(PG8_SB(1, 1), b31, voffB); PG8_STG(PG8_SA(1, 0), a3, vA2[0]);
            PG8_WAIT_V(8); PG8_WAIT_L(0); PG8_BAR; PG8_PIN; PG8_MMA(1, 0, At, B0); PG8_MMA(1, 1, At, B1); PG8_PIN; PG8_BAR; PG8_SCHED;
        }
        if (wr == 0) PG8_BAR;
        E(acc, cur, wr, wc, fr, fq); S.done(cur, lane);
        if (!has_next) break;
#pragma unroll
        for (int a = 0; a < 2; ++a)
#pragma unroll
            for (int b = 0; b < 2; ++b)
#pragma unroll
                for (int m = 0; m < 4; ++m)
#pragma unroll
                    for (int n = 0; n < 2; ++n) acc[a][b][m][n] = (f32x4){0.f, 0.f, 0.f, 0.f};
        cur = nxt; cB0 = nB0; cB1 = nB1; ++ui;
#pragma unroll
        for (int h = 0; h < 2; ++h)
#pragma unroll
            for (int i = 0; i < 2; ++i) cvA[h][i] = nvA[h][i];
        if (wr == 1) PG8_BAR;
    }
    PG8_WAIT_V(0);
    PG8_BAR;
#undef PG8_SA
#undef PG8_SB
#undef PG8_STG
#undef PG8_LDA
#undef PG8_LDB
#undef PG8_MMA
#undef PG8_WAIT_V
#undef PG8_WAIT_L
#undef PG8_BAR
#undef PG8_SCHED
#undef PG8_PIN
}

struct DenseSched {
    int nM, nN, nwg, G, c, K; bool rope;
    __device__ __forceinline__ void init(int M, int N, int K_, int G_, int c_, bool rope_) { nM = M / BM; nN = N / BM; nwg = nM * nN; G = G_; c = c_; K = K_; rope = rope_; }
    __device__ __forceinline__ bool next(int i, Unit& u) const {
        const long L = (long)i * G + c; if (L >= nwg) return false;
        int wgid = (int)L; { const int q = nwg / 8, r = nwg % 8, xcd = wgid % 8, off = wgid / 8; wgid = (xcd < r ? xcd * (q + 1) : r * (q + 1) + (xcd - r) * q) + off; }
        const int WGM = 8, nig = WGM * nN, gid = wgid / nig, fm = gid * WGM, gsz = (nM - fm) < WGM ? (nM - fm) : WGM;
        u.pm = fm + ((wgid % nig) % gsz); u.pn = (wgid % nig) / gsz; u.e = 0; u.row0 = u.pm * BM; u.rows = BM;
        u.b0 = (size_t)(u.pn * BM) * K * 2; u.b1 = u.b0 + (size_t)(rope ? 32 : 128) * K * 2;
        return true;
    }
    __device__ __forceinline__ void avoff(const Unit& u, unsigned (&vo)[2][2], const int (&R)[2], const int (&C)[2]) const {
#pragma unroll
        for (int h = 0; h < 2; ++h)
#pragma unroll
            for (int i = 0; i < 2; ++i) vo[h][i] = (unsigned)((u.row0 + 128 * h + R[i]) * K + C[i]) * 2u;
    }
    __device__ __forceinline__ void a_ready(const Unit&, int) const {}
    __device__ __forceinline__ void done(const Unit&, int) const {}
};
struct MoeSched {
    const LAS int* tab; int G, cv, K; bool gather; const int* list; unsigned* mtc;
    __device__ __forceinline__ bool next(int i, Unit& u) const {
        const int L = i * G + cv; if (L >= tab[32]) return false;
        int e = 0;
#pragma unroll 1
        for (int k = 1; k < 32; ++k) if (tab[k] <= L) e = k;
        const int local = L - tab[e]; u.e = e; u.pm = local >> 2; u.pn = local & 3; u.gt = (tab[e] >> 2) + u.pm;
        const int cnt = tab[80 + e]; u.rows = min(256, cnt - u.pm * 256); u.row0 = tab[40 + e] + u.pm * 256;
        constexpr size_t EB = MOE8 ? 1 : 2;
        if (gather) { u.b0 = ((size_t)e * 512 + 128 * u.pn) * 1024 * EB; u.b1 = u.b0 + (WS_W3 - WS_W1); }
        else        { u.b0 = ((size_t)e * 1024 + 256 * u.pn) * 512 * EB; u.b1 = u.b0 + (size_t)128 * 512 * EB; }
        return true;
    }
    __device__ __forceinline__ void avoff(const Unit& u, unsigned (&vo)[2][2], const int (&R)[2], const int (&C)[2]) const {
#pragma unroll
        for (int h = 0; h < 2; ++h)
#pragma unroll
            for (int i = 0; i < 2; ++i) {
                if (gather) { int r = 128 * h + R[i]; r = r < u.rows ? r : u.rows - 1; const int tok = list[2 * ((size_t)u.e * LISTCAP + u.pm * 256 + r)];
                    vo[h][i] = MOE8 ? (unsigned)(tok * 1024 + C[i] * 2) : (unsigned)(tok * 1024 + C[i]) * 2u; }
                else vo[h][i] = MOE8 ? (unsigned)((u.row0 + 128 * h + R[i]) * 512 + C[i] * 2) : (unsigned)((u.row0 + 128 * h + R[i]) * 512 + C[i]) * 2u;
            }
    }
    __device__ __forceinline__ void a_ready(const Unit& u, int wid) const {
        if (gather) return;
        if (wid == 0) { unsigned sp = 0;
            while ((unsigned)__builtin_amdgcn_readfirstlane(__hip_atomic_load(mtc + 64 * u.gt, __ATOMIC_RELAXED, __HIP_MEMORY_SCOPE_AGENT)) < 32u) { __builtin_amdgcn_s_sleep(2); if (++sp > (1u << 22)) break; }
            __builtin_amdgcn_fence(__ATOMIC_ACQUIRE, "agent");
            asm volatile("s_waitcnt vmcnt(0)" ::: "memory"); }
        asm volatile("" ::: "memory"); __builtin_amdgcn_s_barrier(); asm volatile("" ::: "memory");
    }
    __device__ __forceinline__ void done(const Unit& u, int lane) const {
        if (!gather) return;
        asm volatile("s_waitcnt vmcnt(0)" ::: "memory");
        if (lane == 0) __hip_atomic_fetch_add(mtc + 64 * u.gt, 1u, __ATOMIC_RELAXED, __HIP_MEMORY_SCOPE_AGENT);
    }
};

struct EpiProj {
    f16* proj; const float* cosT; const float* sinT; float* ksum;
    __device__ __forceinline__ void operator()(const f32x4 (&acc)[2][2][4][2], const Unit& u, int wr, int wc, int fr, int fq) const {
        const int tile = u.pn, row0 = u.row0 + wr * 64 + fr, col0 = tile * 256 + 64 * wc + 8 * fq;
        if (tile < 4) {
            const float sc = tile < 2 ? C2 : 1.f;
            float ks[2][8];
#pragma unroll
            for (int bj = 0; bj < 2; ++bj)
#pragma unroll
                for (int j = 0; j < 8; ++j) ks[bj][j] = 0.f;
#pragma unroll
            for (int ai = 0; ai < 2; ++ai)
#pragma unroll
                for (int m = 0; m < 4; ++m) {
                    const int row = row0 + ai * HALF + m * 16;
                    const f32x4 c0 = *(const f32x4*)(cosT + (size_t)row * 32 + 8 * fq), c1 = *(const f32x4*)(cosT + (size_t)row * 32 + 8 * fq + 4);
                    const f32x4 s0 = *(const f32x4*)(sinT + (size_t)row * 32 + 8 * fq), s1 = *(const f32x4*)(sinT + (size_t)row * 32 + 8 * fq + 4);
                    const f32x4 a0 = acc[ai][0][m][0], a1 = acc[ai][0][m][1], b0 = acc[ai][1][m][0], b1 = acc[ai][1][m][1];
                    const f32x4 o10 = (a0 * c0 - b0 * s0) * sc, o11 = (a1 * c1 - b1 * s1) * sc;
                    const f32x4 o20 = (b0 * c0 + a0 * s0) * sc, o21 = (b1 * c1 + a1 * s1) * sc;
                    u32x4 w1, w2;
                    w1.x = pk2h(o10[0], o10[1]); w1.y = pk2h(o10[2], o10[3]); w1.z = pk2h(o11[0], o11[1]); w1.w = pk2h(o11[2], o11[3]);
                    w2.x = pk2h(o20[0], o20[1]); w2.y = pk2h(o20[2], o20[3]); w2.z = pk2h(o21[0], o21[1]); w2.w = pk2h(o21[2], o21[3]);
                    f16* rp = proj + (size_t)row * NPROJ + col0;
                    *(u32x4*)rp = w1; *(u32x4*)(rp + 32) = w2;
                    if (tile >= 2) {
#pragma unroll
                        for (int j = 0; j < 4; ++j) { ks[0][j] += o10[j]; ks[0][4 + j] += o11[j]; ks[1][j] += o20[j]; ks[1][4 + j] += o21[j]; }
                    }
                }
            if (tile >= 2) {
                const int b = u.pm >> 4, blk = u.pm & 15, head = (tile - 2) * 4 + wc;
                float* kp = ksum + ((size_t)((b * 8 + head) * 16 + blk)) * 64 + 8 * fq;
#pragma unroll
                for (int bj = 0; bj < 2; ++bj)
#pragma unroll
                    for (int j = 0; j < 8; ++j) { float v = ks[bj][j]; v = xsum<1>(v); v = xsum<2>(v); v = xsum<4>(v); v = xsum<8>(v);
                        if (fr == 0) atomicAdd(kp + 32 * bj + j, v); }
            }
        } else {
#pragma unroll
            for (int ai = 0; ai < 2; ++ai)
#pragma unroll
                for (int m = 0; m < 4; ++m) {
                    f16* rp = proj + (size_t)(row0 + ai * HALF + m * 16) * NPROJ + col0;
#pragma unroll
                    for (int bj = 0; bj < 2; ++bj) { const f32x4 v0 = acc[ai][bj][m][0], v1 = acc[ai][bj][m][1]; u32x4 w;
                        w.x = pk2h(v0[0], v0[1]); w.y = pk2h(v0[2], v0[3]); w.z = pk2h(v1[0], v1[1]); w.w = pk2h(v1[2], v1[3]);
                        *(u32x4*)(rp + 32 * bj) = w; }
                }
        }
    }
};
struct EpiOut {
    const float* x; const float* mod; f16* x1; float* ssb;
    __device__ __forceinline__ void operator()(const f32x4 (&acc)[2][2][4][2], const Unit& u, int wr, int wc, int fr, int fq) const {
        const int row0 = u.row0 + wr * 64 + fr, col0 = u.pn * BM + wc * 32 + 8 * fq, b = u.row0 / SEQ;
        const float* g1 = mod + (size_t)b * 6144 + 2048;
        float sq[2][4] = {{0.f, 0.f, 0.f, 0.f}, {0.f, 0.f, 0.f, 0.f}};
#pragma unroll
        for (int bj = 0; bj < 2; ++bj) {
            const f32x4 g0 = *(const f32x4*)(g1 + col0 + bj * HALF), gg1 = *(const f32x4*)(g1 + col0 + bj * HALF + 4);
#pragma unroll
            for (int ai = 0; ai < 2; ++ai)
#pragma unroll
                for (int m = 0; m < 4; ++m) { const int row = row0 + ai * HALF + m * 16; const size_t off = (size_t)row * DM + col0 + bj * HALF;
                    const f32x4 x0 = *(const GAS f32x4*)(x + off), xx1 = *(const GAS f32x4*)(x + off + 4);
                    const f32x4 v0 = x0 + g0 * acc[ai][bj][m][0], v1 = xx1 + gg1 * acc[ai][bj][m][1];
                    u32x4 w; w.x = pk2h(v0[0], v0[1]); w.y = pk2h(v0[2], v0[3]); w.z = pk2h(v1[0], v1[1]); w.w = pk2h(v1[2], v1[3]);
                    *(u32x4*)(x1 + (size_t)row * 2048 + col0 + bj * HALF) = w;
                    sq[ai][m] += (v0[0] * v0[0] + v0[1] * v0[1]) + (v0[2] * v0[2] + v0[3] * v0[3]) + (v1[0] * v1[0] + v1[1] * v1[1]) + (v1[2] * v1[2] + v1[3] * v1[3]); }
        }
#pragma unroll
        for (int ai = 0; ai < 2; ++ai)
#pragma unroll
            for (int m = 0; m < 4; ++m) { float q = sq[ai][m]; q = xsum<16>(q); q = xsum<32>(q);
                if (fq == 0) ssb[(size_t)(row0 + ai * HALF + m * 16) * 16 + u.pn * 4 + wc] = q; }
    }
};
struct EpiMoe1 {
    unsigned char* H;
    __device__ __forceinline__ void operator()(const f32x4 (&acc)[2][2][4][2], const Unit& u, int wr, int wc, int fr, int fq) const {
        const int r0 = wr * 64 + fr, col0 = u.pn * 128 + wc * 32 + 8 * fq;
        const __amdgpu_buffer_rsrc_t rs = __builtin_amdgcn_make_buffer_rsrc(H, (short)0, 0x7fffffff, 0x00020000);
#pragma unroll
        for (int ai = 0; ai < 2; ++ai)
#pragma unroll
            for (int m = 0; m < 4; ++m) { const int r = r0 + ai * HALF + m * 16;
                float o[8];
#pragma unroll
                for (int n = 0; n < 2; ++n)
#pragma unroll
                    for (int j = 0; j < 4; ++j) { const float a = acc[ai][0][m][n][j] * (1.f / W8SCALE), bb = acc[ai][1][m][n][j] * (1.f / W8SCALE); o[4 * n + j] = a * __builtin_amdgcn_rcpf(1.f + __expf(-a)) * bb; }
                if (r < u.rows) {
                    if constexpr (MOE8) __builtin_amdgcn_raw_buffer_store_b64(pk8_fp8(o), rs, (int)((u.row0 + r) * DEXP + col0), 0, 16);
                    else { u32x4 w; w.x = pk2h(o[0], o[1]); w.y = pk2h(o[2], o[3]); w.z = pk2h(o[4], o[5]); w.w = pk2h(o[6], o[7]); __builtin_amdgcn_raw_buffer_store_b128(w, rs, (int)(((u.row0 + r) * DEXP + col0) * 2), 0, 16); } } }
    }
};
struct EpiMoe2 {
    unsigned char* Y; const int* list;
    __device__ __forceinline__ void operator()(const f32x4 (&acc)[2][2][4][2], const Unit& u, int wr, int wc, int fr, int fq) const {
        const int r0 = wr * 64 + fr, col0 = u.pn * BM + wc * 32 + 8 * fq;
#pragma unroll
        for (int ai = 0; ai < 2; ++ai)
#pragma unroll
            for (int m = 0; m < 4; ++m) { const int r = r0 + ai * HALF + m * 16;
                if (r < u.rows) {
                    const float w = __int_as_float(list[2 * ((size_t)u.e * LISTCAP + u.pm * 256 + r) + 1]) * (1.f / W8SCALE);
#pragma unroll
                    for (int bj = 0; bj < 2; ++bj) { const f32x4 v0 = acc[ai][bj][m][0] * w, v1 = acc[ai][bj][m][1] * w;
                        const float o8[8] = {v0[0], v0[1], v0[2], v0[3], v1[0], v1[1], v1[2], v1[3]};
                        *(u32x2*)(Y + (size_t)(u.row0 + r) * DM + col0 + bj * HALF) = pk8_fp8(o8); }
                } }
    }
};
}


namespace moba {
using s16x8=__attribute__((ext_vector_type(8)))short;
using s16x4=__attribute__((ext_vector_type(4)))short;
using f32x16=__attribute__((ext_vector_type(16)))float;
constexpr int D=64, PITCH=NPROJ, OPITCH=DM;
constexpr int NW=8,QBLK=32,QB=QBLK*NW,KVBLK=64;
__device__ __forceinline__ int crow(int r,int hi){return (r&3)+8*(r>>2)+4*hi;}
#define SBAR() __builtin_amdgcn_sched_barrier(0)
#define MF32(a,b,c) __builtin_amdgcn_mfma_f32_32x32x16_f16(__builtin_bit_cast(f16x8,(a)),__builtin_bit_cast(f16x8,(b)),(c),0,0,0)
__device__ __forceinline__ void cmask(f32x16&p0,f32x16&p1,int jb,int qrel,int hi){
  const float NEG=-INFINITY; int kb=64*jb+4*hi;
  #pragma unroll
  for(int r=0;r<16;++r){int kv=kb+(r&3)+8*(r>>2); if(kv>qrel)p0[r]=NEG; if(kv+32>qrel)p1[r]=NEG;}
}
constexpr int NSLOT=3, SLOTB=8192;
constexpr int LDS_K=0, LDS_V=NSLOT*SLOTB, LDS_WS=2*NSLOT*SLOTB, LDS_OST=LDS_WS+NW*64*4, LDS_SEL=LDS_OST+NW*4096, LDS_KS=LDS_SEL+1024, LDS_BYTES_A=LDS_KS+4096;
__device__ __forceinline__ void glds16(const void*gsrc,unsigned lds_dst){unsigned keep;
  asm volatile("s_mov_b32 %0, m0\n\ts_mov_b32 m0, %2\n\ts_nop 0\n\tglobal_load_lds_dwordx4 %1, off\n\ts_mov_b32 m0, %0":"=&s"(keep):"v"(gsrc),"s"(lds_dst):"memory");}
__device__ __forceinline__ float max3f(float a,float b,float c){float r;asm("v_max3_f32 %0, %1, %2, %3":"=v"(r):"v"(a),"v"(b),"v"(c));return r;}
__device__ __forceinline__ float max2f(float a,float b){float r;asm("v_max_f32_e32 %0, %1, %2":"=v"(r):"v"(a),"v"(b));return r;}
__device__ __forceinline__ float fadd_s(float a,float b){float r;asm("v_add_f32_e32 %0, %1, %2":"=v"(r):"v"(a),"v"(b));return r;}
__device__ __forceinline__ float fsub_s(float a,float b){float r;asm("v_sub_f32_e32 %0, %1, %2":"=v"(r):"v"(a),"v"(b));return r;}
__device__ __forceinline__ unsigned cvtpk_s(float lo,float hi){return __builtin_bit_cast(unsigned,__builtin_amdgcn_cvt_pkrtz(lo,hi));}
#define WAIT_BAR(N) asm volatile("s_waitcnt vmcnt(" #N ") lgkmcnt(0)\n\ts_barrier":::"memory")
__device__ __forceinline__ void qkt(f32x16&p0,f32x16&p1,const char*Kslot,const s16x8*qr,const f32x16&negm,int r32,int hi){
  const char*kb=Kslot+hi*1024+r32*16;
  #pragma unroll
  for(int d0=0;d0<4;++d0){
    const s16x8 b0=*reinterpret_cast<const s16x8*>(kb+d0*2048);
    const s16x8 b1=*reinterpret_cast<const s16x8*>(kb+d0*2048+512);
    if(d0==0){p0=MF32(b0,qr[0],negm);p1=MF32(b1,qr[0],negm);}
    else{p0=MF32(b0,qr[d0],p0);p1=MF32(b1,qr[d0],p1);}}
}
typedef __attribute__((address_space(3))) const char* lds_cptr;
typedef short v4i16_t __attribute__((ext_vector_type(4)));
__device__ __forceinline__ void kload8(s16x8*kf,lds_cptr kp){
  kf[0]=*(const __attribute__((address_space(3))) s16x8*)(kp);      kf[1]=*(const __attribute__((address_space(3))) s16x8*)(kp+512);
  kf[2]=*(const __attribute__((address_space(3))) s16x8*)(kp+2048); kf[3]=*(const __attribute__((address_space(3))) s16x8*)(kp+2560);
  kf[4]=*(const __attribute__((address_space(3))) s16x8*)(kp+4096); kf[5]=*(const __attribute__((address_space(3))) s16x8*)(kp+4608);
  kf[6]=*(const __attribute__((address_space(3))) s16x8*)(kp+6144); kf[7]=*(const __attribute__((address_space(3))) s16x8*)(kp+6656);
}
__device__ __forceinline__ void kload2(s16x8*kf,lds_cptr kp,int j){ kf[2*j]=*(const __attribute__((address_space(3))) s16x8*)(kp+j*2048); kf[2*j+1]=*(const __attribute__((address_space(3))) s16x8*)(kp+j*2048+512); }
__device__ __forceinline__ s16x4 vtr(lds_cptr p){ return __builtin_bit_cast(s16x4,__builtin_amdgcn_ds_read_tr16_b64_v4i16((__attribute__((address_space(3))) v4i16_t*)p)); }
__device__ __forceinline__ float rowmax(const f32x16&p0,const f32x16&p1){
  float a=max3f(p0[0],p0[1],p1[0]),b=max3f(p0[2],p0[3],p1[1]);a=max3f(a,p1[2],p1[3]);
  #pragma unroll
  for(int r=4;r<16;r+=4){a=max3f(a,p0[r],p0[r+1]);b=max3f(b,p0[r+2],p0[r+3]);a=max3f(a,p1[r],p1[r+1]);b=max3f(b,p1[r+2],p1[r+3]);}
  const float m=max2f(a,b);
  auto rr=__builtin_amdgcn_permlane32_swap(__float_as_uint(m),__float_as_uint(m),false,false);
  return max2f(__uint_as_float(rr[0]),__uint_as_float(rr[1]));
}
__device__ __forceinline__ void pv(f32x16*o,int vb,s16x8 pa0,s16x8 pa1,s16x8 pa2,s16x8 pa3){
  #pragma unroll
  for(int d0=0;d0<2;++d0){s16x4 lo[4],hi[4];
    #pragma unroll
    for(int ks=0;ks<4;++ks){
      asm volatile("ds_read_b64_tr_b16 %0,%1 offset:%c2":"=&v"(lo[ks]):"v"(vb),"i"(d0*4096+ks*1024):"memory");
      asm volatile("ds_read_b64_tr_b16 %0,%1 offset:%c2":"=&v"(hi[ks]):"v"(vb),"i"(d0*4096+ks*1024+512):"memory");}
    asm volatile("s_waitcnt lgkmcnt(0)":::"memory");SBAR();
    #define PK(k) (s16x8){lo[k][0],lo[k][1],lo[k][2],lo[k][3],hi[k][0],hi[k][1],hi[k][2],hi[k][3]}
    o[d0]=MF32(pa0,PK(0),o[d0]);
    o[d0]=MF32(pa1,PK(1),o[d0]);
    o[d0]=MF32(pa2,PK(2),o[d0]);
    o[d0]=MF32(pa3,PK(3),o[d0]);
    #undef PK
  }
}
__device__ __forceinline__ void sel_unit(int b,int h,int qb,const f16*Q,const float*ksum,char*shm,const int w0){
  const int tid=tid_of(w0);
  const int row=tid>>1, half=tid&1;
  unsigned sel=0u;
  if(qb>0){
    float*ks=(float*)(shm+LDS_KS);
    if(tid<256)*(f32x4*)(ks+4*tid)=*(const f32x4*)(ksum+(size_t)((b*8+h)*16)*64+4*tid);
    float qf[32];
    { const f16x8*qp=(const f16x8*)(Q+((long)b*SEQ+qb*QB+row)*PITCH+h*D+32*half);
      #pragma unroll
      for(int i=0;i<4;++i){ const f16x8 t=qp[i];
        #pragma unroll
        for(int j=0;j<8;++j)qf[8*i+j]=(float)t[j]; } }
    asm volatile("s_waitcnt lgkmcnt(0)\n\ts_barrier":::"memory");
    float g[15];
    const float*kp=ks+32*half;
    #pragma unroll
    for(int n=0;n<15;++n){ float s=0.f;
      if(n<qb){
        #pragma unroll
        for(int i=0;i<8;++i){ const f32x4 k4=*(const f32x4*)(kp+n*64+4*i); s+=qf[4*i]*k4[0]+qf[4*i+1]*k4[1]+qf[4*i+2]*k4[2]+qf[4*i+3]*k4[3]; }
        s = xsum<1>(s); }
      g[n]=(n<qb)?s:-INFINITY; }
    #pragma unroll
    for(int r=0;r<3;++r){ float best=-INFINITY; int bi=-1;
      #pragma unroll
      for(int n=0;n<15;++n){ const bool ok=!((sel>>n)&1u)&&g[n]>best; best=ok?g[n]:best; bi=ok?n:bi; }
      if(bi>=0)sel|=1u<<bi; } }
  if(half==0)((unsigned*)(shm+LDS_SEL))[row]=sel;
  asm volatile("s_waitcnt lgkmcnt(0)\n\ts_barrier":::"memory");
}
constexpr float NEGBIG=-1.0e30f;
template<int THRL> __device__ __forceinline__ void attn_unit(int b,int h,int qb,const f16*Q,const f16*__restrict__ K,const f16*__restrict__ V,f16*O,const float*ksum,const float*gain,char*shm,const int w0){
  const int tid=tid_of(w0),lane=tid&63,r32=lane&31,hi=lane>>5; const int wid=w0;
  const long rowbase=(long)b*SEQ; const int q0=qb*QB;
  const f16*Qw=Q+(rowbase+q0+wid*QBLK)*PITCH+h*D;
  const f16*Kh=K+rowbase*PITCH+h*D,*Vh=V+rowbase*PITCH+h*D;
  const unsigned lds0=(unsigned)(uintptr_t)shm;
  float*wsf=(float*)(shm+LDS_WS)+wid*64;
  const f16*kptr=Kh+(long)lane*PITCH+wid*8+(long)(4*qb)*KVBLK*PITCH;
  const f16*vptr=Vh+(long)(16*(wid&3)+(lane>>2))*PITCH+(wid>>2)*32+(lane&3)*8+(long)(4*qb)*KVBLK*PITCH;
  const unsigned kdst=lds0+LDS_K+wid*1024, vdst=lds0+LDS_V+wid*1024;
  const long tstep_=(long)KVBLK*PITCH, twrap_=-(long)(4*qb+3)*KVBLK*PITCH;
  #define DMA_K(t,slot) do{ glds16(kptr,(unsigned)__builtin_amdgcn_readfirstlane(kdst+(slot))); kptr+=(((t)==3)?twrap_:tstep_); }while(0)
  #define DMA_V(t,slot) do{ glds16(vptr,(unsigned)__builtin_amdgcn_readfirstlane(vdst+(slot))); vptr+=(((t)==3)?twrap_:tstep_); }while(0)
  const int vb0=(int)(lds0+LDS_V)+((lane>>4)&1)*32+(lane&3)*8+(4*hi+((lane&15)>>2))*64;
  const char*Kbase=shm+LDS_K; s16x8 kf[8];
  const lds_cptr shm3=(lds_cptr)shm; const lds_cptr kp0=shm3+LDS_K+hi*1024+r32*16; const lds_cptr vp0=shm3+LDS_V+((lane>>4)&1)*32+(lane&3)*8+(4*hi+((lane&15)>>2))*64;
  const int NT=4*qb+4;
  DMA_K(0,0);DMA_V(0,0);DMA_K(1,SLOTB);
  s16x8 qr[4];
  #pragma unroll
  for(int d0=0;d0<4;++d0)qr[d0]=*reinterpret_cast<const s16x8*>(&Qw[(long)r32*PITCH+d0*16+hi*8]);
  const unsigned sel=((const unsigned*)(shm+LDS_SEL))[wid*QBLK+r32];
  bool msk=false;
  float mhat=0.f,l_reg=0.f;f32x16 o[2];o[0]=f32x16{};o[1]=f32x16{};f32x16 negm=f32x16{};asm volatile("":"+v"(negm));
  const int qrel=wid*QBLK+r32;
  #define CMASK(P0,P1,t) do{ if((t)<4)cmask(P0,P1,(t),qrel,hi); }while(0)
  #define SELM(t) do{ if((t)>=4&&(((t)&3)==0)){ msk=!((sel>>(((t)-4)>>2))&1u); const float nv_=msk?NEGBIG:-mhat; _Pragma("unroll") for(int r=0;r<16;++r)negm[r]=nv_; asm volatile("":"+v"(negm)); } }while(0)
  bool resc=false;
  #define START(P0,P1) do{ const float rm=rowmax(P0,P1); resc=false; \
    { const float dl=rm; mhat=fadd_s(mhat,dl); \
      _Pragma("unroll") for(int r=0;r<16;++r){P0[r]=fsub_s(P0[r],dl);P1[r]=fsub_s(P1[r],dl);} \
      _Pragma("unroll") for(int r=0;r<16;++r)negm[r]=-mhat; asm volatile("":"+v"(negm)); } \
    _Pragma("unroll") for(int r=0;r<16;++r)P0[r]=__builtin_amdgcn_exp2f(P0[r]); }while(0)
  #define RESC() do{ if(resc){ asm volatile("s_waitcnt lgkmcnt(0)":::"memory"); \
      _Pragma("unroll") for(int d_=0;d_<2;++d_) _Pragma("unroll") for(int r=0;r<16;++r)o[d_][r]*=wsf[crow(r,hi)]; } }while(0)
  f32x16 pA0,pA1,pB0,pB1;
  int sl_prev=0,sl_cur=0,sl_next=SLOTB;
  #define ROT() do{sl_prev=sl_cur;sl_cur=sl_next;sl_next=(sl_next==(NSLOT-1)*SLOTB)?0:sl_next+SLOTB;}while(0)
  DMA_K(2,2*SLOTB);
  WAIT_BAR(3);
  qkt(pA0,pA1,Kbase,qr,negm,r32,hi);asm volatile("s_nop 15\n\ts_nop 7":"+v"(pA0),"+v"(pA1));CMASK(pA0,pA1,0);
  START(pA0,pA1);
  _Pragma("unroll") for(int r=0;r<16;++r)pA1[r]=__builtin_amdgcn_exp2f(pA1[r]);
  WAIT_BAR(0);
  DMA_K(3,0);DMA_V(1,SLOTB);
  ROT();
  kload8(kf,kp0+sl_cur);
  WAIT_BAR(2);
  s16x4 vlo[8],vhi[8]; u32x4 pw0,pw1,pw2,pw3;
  #define PKW(P,B) cvtpk_s(P[B],P[B+1])
  #define PAF(k) __builtin_bit_cast(s16x8,pw##k)
  #define VFR(i) (s16x8){vlo[i][0],vlo[i][1],vlo[i][2],vlo[i][3],vhi[i][0],vhi[i][1],vhi[i][2],vhi[i][3]}
  #define PIN(x) asm volatile("":"+v"(x))
  #define MX3(a,b,c) __builtin_fmaxf(__builtin_fmaxf((a),(b)),(c))
  #define GAPA(MF,A0,A1,A2,A3,W0,W1,PW) do{ MF; sacc+=A0; sacc+=A1; sacc+=A2; sacc+=A3; PIN(sacc); W0; W1; PIN(PW); SBAR(); }while(0)
  #define EX(v) __builtin_amdgcn_exp2f(v)
  #define GAPB(MF,X,B) do{ MF; X[B]=EX(X[B]); X[B+1]=EX(X[B+1]); X[B+2]=EX(X[B+2]); X[B+3]=EX(X[B+3]); PIN(X); SBAR(); }while(0)
  #define VRD(i) do{ vlo[i]=vtr(vp_+(((i)>>2)*4096+((i)&3)*1024)); vhi[i]=vtr(vp_+(((i)>>2)*4096+((i)&3)*1024+512)); }while(0)
  #define KRD(G,j) do{ if(G){ kload2(kf,kp0+sl_next,j); SBAR(); } }while(0)
  #define STEP(C0,C1,P0,P1,t,GK,GV,GL) do{ SELM(t); SBAR(); \
    const lds_cptr vp_=vp0+sl_prev; \
    VRD(0); SBAR(); float sacc=(P0[0]+P0[1]); \
    GAPA(C0=MF32(kf[0],qr[0],negm), P0[2],P0[3],P0[4],P0[5],     pw0[0]=PKW(P0,0), pw0[1]=PKW(P0,2), pw0); \
    VRD(4); SBAR(); GAPA(C1=MF32(kf[1],qr[0],negm), P0[6],P0[7],P0[8],P0[9],     pw0[2]=PKW(P0,4), pw0[3]=PKW(P0,6), pw0); \
    VRD(1); SBAR(); GAPA(C0=MF32(kf[2],qr[1],C0),   P0[10],P0[11],P0[12],P0[13], pw1[0]=PKW(P0,8), pw1[1]=PKW(P0,10), pw1); \
    VRD(5); SBAR(); GAPA(C1=MF32(kf[3],qr[1],C1),   P0[14],P0[15],P1[0],P1[1],   pw1[2]=PKW(P0,12),pw1[3]=PKW(P0,14), pw1); \
    VRD(2); SBAR(); GAPA(C0=MF32(kf[4],qr[2],C0),   P1[2],P1[3],P1[4],P1[5],     pw2[0]=PKW(P1,0), pw2[1]=PKW(P1,2), pw2); \
    VRD(6); SBAR(); GAPA(C1=MF32(kf[5],qr[2],C1),   P1[6],P1[7],P1[8],P1[9],     pw2[2]=PKW(P1,4), pw2[3]=PKW(P1,6), pw2); \
    VRD(3); SBAR(); GAPA(C0=MF32(kf[6],qr[3],C0),   P1[10],P1[11],P1[12],P1[13], pw3[0]=PKW(P1,8), pw3[1]=PKW(P1,10), pw3); \
    VRD(7); SBAR(); GAPA(C1=MF32(kf[7],qr[3],C1),   P1[14],P1[15],0.f,0.f,       pw3[2]=PKW(P1,12),pw3[3]=PKW(P1,14), pw3); \
    l_reg+=sacc; \
    if(GK){DMA_K((t)+3,sl_cur);} if(GV){DMA_V((t)+1,sl_next);} \
    CMASK(C0,C1,t); \
    { float a=MX3(C0[0],C0[1],C1[0]),b=MX3(C0[2],C0[3],C1[1]); a=MX3(a,C1[2],C1[3]); \
      _Pragma("unroll") for(int r=4;r<16;r+=4){a=MX3(a,C0[r],C0[r+1]);b=MX3(b,C0[r+2],C0[r+3]);a=MX3(a,C1[r],C1[r+1]);b=MX3(b,C1[r+2],C1[r+3]);} \
      float rm=__builtin_fmaxf(a,b); { auto rr=__builtin_amdgcn_permlane32_swap(__float_as_uint(rm),__float_as_uint(rm),false,false); rm=__builtin_fmaxf(__uint_as_float(rr[0]),__uint_as_float(rr[1])); } \
      resc=false; \
      if(__builtin_expect(__any(rm>(float)THRL),0)){ const float dl=__builtin_fmaxf(rm,0.f); mhat+=dl; \
        _Pragma("unroll") for(int r=0;r<16;++r){C0[r]-=dl;C1[r]-=dl;} \
        { const float nv_=msk?NEGBIG:-mhat; _Pragma("unroll") for(int r=0;r<16;++r)negm[r]=nv_; } asm volatile("":"+v"(negm)); \
        const float f=__builtin_amdgcn_exp2f(-dl); l_reg*=f; if(hi==0)wsf[r32]=f; resc=true; } } \
    SBAR(); \
    GAPB(o[0]=MF32(PAF(0),VFR(0),o[0]), C0,0); \
    GAPB(o[1]=MF32(PAF(0),VFR(4),o[1]), C0,4); \
    KRD(GL,0); GAPB(o[0]=MF32(PAF(1),VFR(1),o[0]), C0,8); \
    KRD(GL,1); GAPB(o[1]=MF32(PAF(1),VFR(5),o[1]), C0,12); \
    KRD(GL,2); GAPB(o[0]=MF32(PAF(2),VFR(2),o[0]), C1,0); \
    KRD(GL,3); GAPB(o[1]=MF32(PAF(2),VFR(6),o[1]), C1,4); \
    GAPB(o[0]=MF32(PAF(3),VFR(3),o[0]), C1,8); \
    GAPB(o[1]=MF32(PAF(3),VFR(7),o[1]), C1,12); \
    }while(0)
  int t=1;
  for(;t+5<NT;t+=2){
    STEP(pB0,pB1,pA0,pA1,t,true,true,true);     WAIT_BAR(2); RESC(); ROT();
    STEP(pA0,pA1,pB0,pB1,t+1,true,true,true);   WAIT_BAR(2); RESC(); ROT();
  }
  #define ENDW(tt) do{ if((tt)+3<NT){WAIT_BAR(2);} else if((tt)+2<NT){WAIT_BAR(1);} else {WAIT_BAR(0);} }while(0)
  for(;t+1<NT;t+=2){
    STEP(pB0,pB1,pA0,pA1,t,(t+3<NT),(t+1<NT),(t+1<NT));       ENDW(t);   RESC(); ROT();
    STEP(pA0,pA1,pB0,pB1,t+1,(t+4<NT),(t+2<NT),(t+2<NT));     ENDW(t+1); RESC(); ROT();
  }
  STEP(pB0,pB1,pA0,pA1,NT-1,false,false,false); RESC();
  { float sacc=pB0[0]+pB0[1]; _Pragma("unroll") for(int r=2;r<16;++r)sacc+=pB0[r]; _Pragma("unroll") for(int r=0;r<16;++r)sacc+=pB1[r]; l_reg+=sacc;
    pw0=(u32x4){PKW(pB0,0),PKW(pB0,2),PKW(pB0,4),PKW(pB0,6)};pw1=(u32x4){PKW(pB0,8),PKW(pB0,10),PKW(pB0,12),PKW(pB0,14)};pw2=(u32x4){PKW(pB1,0),PKW(pB1,2),PKW(pB1,4),PKW(pB1,6)};pw3=(u32x4){PKW(pB1,8),PKW(pB1,10),PKW(pB1,12),PKW(pB1,14)};
    SBAR(); pv(o,vb0+sl_cur,PAF(0),PAF(1),PAF(2),PAF(3)); }
  #undef PKW
  #undef PAF
  #undef VFR
  #undef PIN
  #undef MX3
  #undef GAPA
  #undef GAPB
  #undef EX
  #undef VRD
  #undef KRD
  #undef STEP
  #undef ENDW
  {auto rr=__builtin_amdgcn_permlane32_swap(__float_as_uint(l_reg),__float_as_uint(l_reg),false,false);l_reg=__uint_as_float(rr[0])+__uint_as_float(rr[1]);}
  if(hi==0)wsf[32+r32]=l_reg;asm volatile("s_waitcnt lgkmcnt(0)":::"memory");
  float rli[16];
  #pragma unroll
  for(int r=0;r<16;++r)rli[r]=__builtin_amdgcn_rcpf(wsf[32+crow(r,hi)]);
  f16*Ow=O+(rowbase+q0+wid*QBLK)*OPITCH+h*D;
  { float*stg=(float*)(shm+LDS_OST)+wid*1024;
    #pragma unroll
    for(int half=0;half<2;++half){
      #pragma unroll
      for(int r=0;r<16;++r){ const int orow=crow(r,hi);
        if((orow>>4)==half){
          #pragma unroll
          for(int d0=0;d0<2;++d0)stg[(orow&15)*64+d0*32+r32]=o[d0][r]*rli[r]; } }
      asm volatile("s_waitcnt lgkmcnt(0)":::"memory");
      #pragma unroll
      for(int i=0;i<2;++i){ const int row=i*8+(lane>>3),ch=lane&7; const f32x4 v0=*(const f32x4*)(stg+row*64+ch*8),v1=*(const f32x4*)(stg+row*64+ch*8+4);
        float ss=(v0[0]*v0[0]+v0[1]*v0[1])+(v0[2]*v0[2]+v0[3]*v0[3])+(v1[0]*v1[0]+v1[1]*v1[1])+(v1[2]*v1[2]+v1[3]*v1[3]);
        ss = xsum<1>(ss); ss = xsum<2>(ss); ss = xsum<4>(ss);
        const float rs=1.f/sqrtf(ss*(1.f/64.f)+EPS);
        const f32x4 g0=*(const f32x4*)(gain+h*D+ch*8),g1=*(const f32x4*)(gain+h*D+ch*8+4);
        u32x4 w; w.x=pk2h(v0[0]*rs*g0[0],v0[1]*rs*g0[1]); w.y=pk2h(v0[2]*rs*g0[2],v0[3]*rs*g0[3]); w.z=pk2h(v1[0]*rs*g1[0],v1[1]*rs*g1[1]); w.w=pk2h(v1[2]*rs*g1[2],v1[3]*rs*g1[3]);
        *(u32x4*)(Ow+(long)(half*16+row)*OPITCH+ch*8)=w; }
      asm volatile("s_waitcnt lgkmcnt(0)":::"memory"); } }
  asm volatile("s_waitcnt lgkmcnt(0)\n\ts_barrier":::"memory");
  #undef DMA_K
  #undef DMA_V
  #undef CMASK
  #undef SELM
  #undef START
  #undef RESC
  #undef ROT
}
#undef SBAR
#undef WAIT_BAR
#undef MF32
}


namespace mlstm {
constexpr int L=64, DH=128, NCH=16;
constexpr int RS1=136, RS2=72;
#define ML_BAR() asm volatile("s_waitcnt lgkmcnt(0)\n\ts_barrier" ::: "memory")
#define MF16(a,b,c) __builtin_amdgcn_mfma_f32_16x16x32_f16((a),(b),(c),0,0,0)
typedef short v4i16_t __attribute__((ext_vector_type(4)));
__device__ __forceinline__ f16x4 trd(const LAS f16* p){ return __builtin_bit_cast(f16x4,__builtin_amdgcn_ds_read_tr16_b64_v4i16((LAS v4i16_t*)p)); }
__device__ __forceinline__ f16x8 cat8(f16x4 a,f16x4 c){ return (f16x8){a[0],a[1],a[2],a[3],c[0],c[1],c[2],c[3]}; }
__device__ __forceinline__ float frcp(float x){ return __builtin_amdgcn_rcpf(x); }
struct Glob { f16* cloc; f16* cprev; float* nloc; float* nprev; float* sa; float* smloc; float* smprev;
              f16* qkc;
              float* gcolf; float* gcum; float* gpm;
              float* sca; float* scpm; };

__device__ __forceinline__ void prep(int b,int sc,const Glob G,const f16*proj,const float*gates,const float*conv_w,const float*conv_b,const int w0){
  const int tid=tid_of(w0),lane=tid&63,wid=w0;
  const int cg=tid&127,tq=tid>>7; const long rowbase=(long)b*SEQ; const int t0=sc*L+16*tq;
  const f16*src=proj+C_QM+8*cg;
  f16x8 raw[19];
  #pragma unroll
  for(int i=0;i<19;++i){ const int t_=t0-3+i; raw[i]=(t_>=0)?*(const f16x8*)(src+(rowbase+t_)*NPROJ):(f16x8){0,0,0,0,0,0,0,0}; }
  float cw[4][8],cb[8];
  #pragma unroll
  for(int tp=0;tp<4;++tp){ const f32x4 a=*(const f32x4*)(conv_w+tp*1024+8*cg),c=*(const f32x4*)(conv_w+tp*1024+8*cg+4);
    cw[tp][0]=a[0];cw[tp][1]=a[1];cw[tp][2]=a[2];cw[tp][3]=a[3];cw[tp][4]=c[0];cw[tp][5]=c[1];cw[tp][6]=c[2];cw[tp][7]=c[3]; }
  { const f32x4 a=*(const f32x4*)(conv_b+8*cg),c=*(const f32x4*)(conv_b+8*cg+4); cb[0]=a[0];cb[1]=a[1];cb[2]=a[2];cb[3]=a[3];cb[4]=c[0];cb[5]=c[1];cb[6]=c[2];cb[7]=c[3]; }
  const float ksc=(cg>=64)?0.08838834764831845f:1.f;
  const unsigned dsto=(unsigned)(((rowbase+t0)*1024+8*cg)*2);
  #pragma unroll
  for(int i=0;i<16;++i){ float o[8];
    #pragma unroll
    for(int j=0;j<8;++j){ float v=cb[j];
      #pragma unroll
      for(int tp=0;tp<4;++tp)v+=cw[tp][j]*(float)raw[i+tp][j];
      o[j]=v*frcp(1.f+__expf(-v))*ksc; }
    u32x4 w; w.x=pk2h(o[0],o[1]); w.y=pk2h(o[2],o[3]); w.z=pk2h(o[4],o[5]); w.w=pk2h(o[6],o[7]);
    st16_wt(G.qkc,dsto+(unsigned)i*2048u,w); }
  if(wid<4){ const int hm=wid; const long row=rowbase+sc*L+lane;
    const float ig=gates[row*8+hm],fg=gates[row*8+4+hm];
    const float logf=fminf(fg,0.f)-log1pf(__expf(-fabsf(fg)));
    float cum=logf;
    #pragma unroll
    for(int o=1;o<64;o<<=1){ const float tmp=__builtin_bit_cast(float,__builtin_amdgcn_ds_bpermute((lane-o)<<2,__builtin_bit_cast(int,cum))); if(lane>=o)cum+=tmp; }
    const float colf=ig-cum; float pm=colf;
    #pragma unroll
    for(int o=1;o<64;o<<=1){ const float tmp=__builtin_bit_cast(float,__builtin_amdgcn_ds_bpermute((lane-o)<<2,__builtin_bit_cast(int,pm))); if(lane>=o)pm=fmaxf(pm,tmp); }
    const size_t gi=(size_t)(b*4+hm)*SEQ+sc*L+lane;
    st4_wt(G.gcolf+gi,colf); st4_wt(G.gcum+gi,cum); st4_wt(G.gpm+gi,pm);
    if(lane==63){ st4_wt(G.sca+(b*4+hm)*64+sc,cum); st4_wt(G.scpm+(b*4+hm)*64+sc,pm); } }
}

__device__ __forceinline__ void contrib(int b,int hm,int c,const Glob G,const f16*proj,LAS unsigned char*lds,const int w0){
  constexpr int KS0=0,VS0=34816,CS=69632,VEC=104448;
  const int tid=tid_of(w0),lane=tid&63,wid=w0,fr=lane&15,fq=lane>>4;
  LAS f16*Cs=(LAS f16*)(lds+CS); LAS float*vec=(LAS float*)(lds+VEC); LAS f16*wph=(LAS f16*)(vec+128);
  const int seq=b*4+hm,item=seq*NCH+c; const long rowbase=(long)b*SEQ; const int tc=256*c;
  const int eg=tid&15,sq=tid>>4;
  const f16*kp=G.qkc+512+hm*DH+8*eg; const f16*vp=proj+C_VM+hm*DH+8*eg;
  const int trb=(8*fq+(fr>>2))*RS1+4*(fr&3);
  float aj[4],pj[4],off[4];
  #pragma unroll
  for(int j=0;j<4;++j){ aj[j]=G.sca[seq*64+4*c+j]; pj[j]=G.scpm[seq*64+4*c+j]; }
  off[0]=0.f; off[1]=aj[0]; off[2]=aj[0]+aj[1]; off[3]=off[2]+aj[2];
  const float a256=off[3]+aj[3];
  const float mloc=a256+fmaxf(fmaxf(pj[0]-off[0],pj[1]-off[1]),fmaxf(pj[2]-off[2],pj[3]-off[3]));
  f32x4 accC[8];
  #pragma unroll
  for(int i=0;i<8;++i)accC[i]=(f32x4){0.f,0.f,0.f,0.f};
  float nacc=0.f;
  f16x8 rk[2],rv[2]; float rcolf=0.f;
  #define LOADP(j) do{ const long r0_=rowbase+tc+64*(j)+2*sq; \
    rk[0]=*(const f16x8*)(kp+r0_*1024); rk[1]=*(const f16x8*)(kp+(r0_+1)*1024); rv[0]=*(const f16x8*)(vp+r0_*NPROJ); rv[1]=*(const f16x8*)(vp+(r0_+1)*NPROJ); \
    if(wid==0) rcolf=G.gcolf[(size_t)seq*SEQ+tc+64*(j)+lane]; }while(0)
  LOADP(0);
  #pragma unroll
  for(int j=0;j<4;++j){ const int buf=j&1;
    LAS f16*Ks=(LAS f16*)(lds+KS0+buf*17408); LAS f16*Vs=(LAS f16*)(lds+VS0+buf*17408);
    *(LAS f16x8*)(Ks+(2*sq)*RS1+8*eg)=rk[0]; *(LAS f16x8*)(Ks+(2*sq+1)*RS1+8*eg)=rk[1];
    *(LAS f16x8*)(Vs+(2*sq)*RS1+8*eg)=rv[0]; *(LAS f16x8*)(Vs+(2*sq+1)*RS1+8*eg)=rv[1];
    if(wid==0){ const float wpv=__expf(a256+(rcolf-off[j])-mloc); vec[64*buf+lane]=wpv; wph[64*buf+lane]=(f16)wpv; }
    ML_BAR();
    if(j<3) LOADP(j+1);
    #pragma unroll
    for(int ks=0;ks<2;++ks){ const LAS f16*ap=Ks+trb+32*ks*RS1+16*wid; const f16x8 kfa=cat8(trd(ap),trd(ap+4*RS1)) * *(const LAS f16x8*)(wph+64*buf+32*ks+8*fq);
      #pragma unroll
      for(int et=0;et<8;++et){ const LAS f16*bp=Vs+trb+32*ks*RS1+16*et; const f16x8 vfb=cat8(trd(bp),trd(bp+4*RS1)); accC[et]=MF16(kfa,vfb,accC[et]); } }
    { const int d=tid>>2,sg=tid&3; float sn=0.f;
      #pragma unroll
      for(int i=0;i<16;++i)sn+=(float)Ks[(16*sg+i)*RS1+d]*vec[64*buf+16*sg+i];
      sn=xsum<1>(sn); sn=xsum<2>(sn); nacc+=sn; } }
  #undef LOADP
  #pragma unroll
  for(int et=0;et<8;++et){ u32x2 w; w.x=pk2h(accC[et][0],accC[et][1]); w.y=pk2h(accC[et][2],accC[et][3]); *(LAS u32x2*)(Cs+(16*et+fr)*RS1+16*wid+4*fq)=w; }
  ML_BAR();
  { f16*dst=G.cloc+(size_t)item*DH*DH;
    #pragma unroll
    for(int i=0;i<4;++i){ const int idx=tid+NTHR*i, e=idx>>4, ch=idx&15; st16_wt(dst,(unsigned)((e*DH+8*ch)*2),*(const LAS u32x4*)(Cs+e*RS1+8*ch)); }
    if((tid&3)==0)st4_wt(G.nloc+(size_t)item*DH+(tid>>2),nacc);
    if(tid==0){ st4_wt(G.sa+item,a256); st4_wt(G.smloc+item,mloc); } }
  ML_BAR();
}

__device__ __forceinline__ void scan(int seq,const Glob G,const int w0){
  const int tid=tid_of(w0); const int e=tid>>2,d0=32*(tid&3);
  float C[32];
  #pragma unroll
  for(int j=0;j<32;++j)C[j]=0.f;
  float nv=0.f,mst=0.f;
  u32x4 in4[4],nx4[4]; float a,ml,nl,an=0.f,mln=0.f,nln=0.f;
  { const int item=seq*NCH; const u32x4*src=(const u32x4*)(G.cloc+(size_t)item*DH*DH+e*DH+d0);
    #pragma unroll
    for(int i=0;i<4;++i)in4[i]=src[i];
    a=G.sa[item]; ml=G.smloc[item]; nl=(tid<DH)?G.nloc[(size_t)item*DH+tid]:0.f; }
  #pragma unroll 1
  for(int c=0;c<NCH;++c){ const int item=seq*NCH+c;
    if(c+1<NCH){ const u32x4*src=(const u32x4*)(G.cloc+(size_t)(item+1)*DH*DH+e*DH+d0);
      #pragma unroll
      for(int i=0;i<4;++i)nx4[i]=src[i];
      an=G.sa[item+1]; mln=G.smloc[item+1]; nln=(tid<DH)?G.nloc[(size_t)(item+1)*DH+tid]:0.f; }
    f16*dstb=G.cprev+(size_t)item*DH*DH; const unsigned dsto=(unsigned)((e*DH+d0)*2);
    #pragma unroll
    for(int i=0;i<4;++i){ u32x4 o; o.x=pk2h(C[8*i],C[8*i+1]); o.y=pk2h(C[8*i+2],C[8*i+3]); o.z=pk2h(C[8*i+4],C[8*i+5]); o.w=pk2h(C[8*i+6],C[8*i+7]); st16_wt(dstb,dsto+16u*i,o); }
    if(tid<DH)st4_wt(G.nprev+(size_t)item*DH+tid,nv);
    if(tid==0)st4_wt(G.smprev+item,mst);
    const float mn=fmaxf(a+mst,ml),sp=__expf(a+mst-mn),sl=__expf(ml-mn);
    #pragma unroll
    for(int i=0;i<4;++i){ const f16x8 h8=__builtin_bit_cast(f16x8,in4[i]);
      #pragma unroll
      for(int j=0;j<8;++j)C[8*i+j]=sp*C[8*i+j]+sl*(float)h8[j]; }
    nv=sp*nv+sl*nl; mst=mn;
    #pragma unroll
    for(int i=0;i<4;++i)in4[i]=nx4[i];
    a=an; ml=mln; nl=nln; }
}

__device__ __forceinline__ void unit(int b,int hm,int c,const Glob G,const f16*proj,const float*gain,f16*mix,LAS unsigned char*lds,const int w0){
  constexpr int QS=0, KS=17408, VS=34816, CS=52224, PS=87040, VEC=96256;
  const int tid=tid_of(w0),lane=tid&63,wid=w0,fr=lane&15,fq=lane>>4;
  LAS f16*Qs=(LAS f16*)(lds+QS); LAS f16*Ks=(LAS f16*)(lds+KS); LAS f16*Vs=(LAS f16*)(lds+VS); LAS f16*Cs=(LAS f16*)(lds+CS); LAS f16*Ps=(LAS f16*)(lds+PS);
  LAS float*vec=(LAS float*)(lds+VEC); LAS f16*wph=(LAS f16*)(vec+1288);
  const int seq=b*4+hm,item=seq*NCH+c; const long rowbase=(long)b*SEQ;
  const int eg=tid&15,sq=tid>>4;
  const f16*qp=G.qkc+hm*DH+8*eg; const f16*kp=qp+512; const f16*vp=proj+C_VM+hm*DH+8*eg;
  const f32x4 gn=*(const f32x4*)(gain+hm*DH+16*wid+4*fq);
  const f16*omp=proj+C_OM+hm*DH+16*wid+4*fq; f16*outp=mix+512+hm*DH+16*wid+4*fq;
  const int trb=(8*fq+(fr>>2))*RS1+4*(fr&3);
  { const f16*src=G.cprev+(size_t)item*DH*DH;
    #pragma unroll
    for(int i=0;i<4;++i){ const int idx=tid+NTHR*i, e=idx>>4, ch=idx&15; *(LAS u32x4*)(Cs+e*RS1+8*ch)=*(const u32x4*)(src+e*DH+8*ch); }
    if(tid<DH)vec[1152+tid]=G.nprev[(size_t)item*DH+tid]; }
  float mprev=G.smprev[item];
  f16x8 rq[2],rk[2],rv[2]; f16x4 omn[4]; float rcolf=0.f,rcum=0.f,rpm=0.f,ra=0.f,rpx=0.f;
  #define LOAD_RAW(sc) do{ const long r0_=rowbase+(sc)*L+2*sq; \
    rq[0]=*(const f16x8*)(qp+r0_*1024); rq[1]=*(const f16x8*)(qp+(r0_+1)*1024); rk[0]=*(const f16x8*)(kp+r0_*1024); rk[1]=*(const f16x8*)(kp+(r0_+1)*1024); \
    rv[0]=*(const f16x8*)(vp+r0_*NPROJ); rv[1]=*(const f16x8*)(vp+(r0_+1)*NPROJ); \
    _Pragma("unroll") for(int tt=0;tt<4;++tt) omn[tt]=*(const f16x4*)(omp+(rowbase+(sc)*L+16*tt+fr)*NPROJ); \
    if(wid==0){ const size_t gi_=(size_t)seq*SEQ+(sc)*L+lane; rcolf=G.gcolf[gi_]; rcum=G.gcum[gi_]; rpm=G.gpm[gi_]; ra=G.sca[seq*64+(sc)]; rpx=G.scpm[seq*64+(sc)]; } }while(0)
  LOAD_RAW(4*c);
  ML_BAR();
  f32x4 accC[8];
  #pragma unroll
  for(int et=0;et<8;++et){ const f16x4 t4=*(const LAS f16x4*)(Cs+(16*et+fr)*RS1+16*wid+4*fq); accC[et]=(f32x4){(float)t4[0],(float)t4[1],(float)t4[2],(float)t4[3]}; }
  #pragma unroll 1
  for(int sc=4*c;sc<4*c+4;++sc){
    const int t0=sc*L;
    *(LAS f16x8*)(Qs+(2*sq)*RS1+8*eg)=rq[0]; *(LAS f16x8*)(Qs+(2*sq+1)*RS1+8*eg)=rq[1];
    *(LAS f16x8*)(Ks+(2*sq)*RS1+8*eg)=rk[0]; *(LAS f16x8*)(Ks+(2*sq+1)*RS1+8*eg)=rk[1];
    *(LAS f16x8*)(Vs+(2*sq)*RS1+8*eg)=rv[0]; *(LAS f16x8*)(Vs+(2*sq+1)*RS1+8*eg)=rv[1];
    f16x4 om[4];
    #pragma unroll
    for(int tt=0;tt<4;++tt)om[tt]=omn[tt];
    if(wid==0){
      const float mx=fmaxf(mprev,rpm);
      const float mloc=ra+rpx, mnew=fmaxf(ra+mprev,mloc), sprev=__expf(ra+mprev-mnew), wpv=__expf(ra+rcolf-mnew);
      vec[lane]=rcolf; vec[64+lane]=-mx; vec[128+lane]=__expf(mprev-mx); vec[192+lane]=__expf(-(rcum+mx)); vec[256+lane]=wpv; wph[lane]=(f16)wpv;
      if(lane==0)vec[1280]=sprev;
      mprev=mnew; }
    ML_BAR();
    if(sc<4*c+3) LOAD_RAW(sc+1);
    { const int t=tid>>3,dg=tid&7; float sv=0.f;
      const f16x8 q0=*(const LAS f16x8*)(Qs+t*RS1+16*dg),q1=*(const LAS f16x8*)(Qs+t*RS1+16*dg+8);
      #pragma unroll
      for(int j=0;j<8;++j){ sv+=(float)q0[j]*vec[1152+16*dg+j]+(float)q1[j]*vec[1152+16*dg+8+j]; }
      sv=xsum<1>(sv); sv=xsum<2>(sv); sv=xsum<4>(sv);
      if(dg==0)vec[320+t]=sv; }
    { const int sA=wid>>1;
      f16x8 ka[4];
      #pragma unroll
      for(int ks=0;ks<4;++ks)ka[ks]=*(const LAS f16x8*)(Ks+(16*sA+fr)*RS1+32*ks+8*fq);
      const f32x4 cf4=*(const LAS f32x4*)(vec+16*sA+4*fq);
      #pragma unroll
      for(int t2=0;t2<2;++t2){ const int tt=2*(wid&1)+t2; f32x4 acc={0.f,0.f,0.f,0.f};
        #pragma unroll
        for(int ks=0;ks<4;++ks){ const f16x8 qb=*(const LAS f16x8*)(Qs+(16*tt+fr)*RS1+32*ks+8*fq); acc=MF16(ka[ks],qb,acc); }
        const int t=16*tt+fr; const float rf=vec[64+t]; float p[4],rsum=0.f;
        #pragma unroll
        for(int r=0;r<4;++r){ const int sidx=16*sA+4*fq+r; p[r]=(sidx<=t)?acc[r]*__expf(rf+cf4[r]):0.f; rsum+=p[r]; }
        u32x2 w; w.x=pk2h(p[0],p[1]); w.y=pk2h(p[2],p[3]); *(LAS u32x2*)(Ps+t*RS2+16*sA+4*fq)=w;
        rsum=xsum<16>(rsum); rsum=xsum<32>(rsum);
        if(fq==0)vec[384+64*sA+t]=rsum; } }
    f32x4 accN[4];
    { f16x8 ca[4];
      #pragma unroll
      for(int ks=0;ks<4;++ks)ca[ks]=*(const LAS f16x8*)(Cs+(16*wid+fr)*RS1+32*ks+8*fq);
      #pragma unroll
      for(int tt=0;tt<4;++tt){ accN[tt]=(f32x4){0.f,0.f,0.f,0.f};
        #pragma unroll
        for(int ks=0;ks<4;++ks){ const f16x8 qb=*(const LAS f16x8*)(Qs+(16*tt+fr)*RS1+32*ks+8*fq); accN[tt]=MF16(ca[ks],qb,accN[tt]); } } }
    f16x8 vfa[2];
    #pragma unroll
    for(int ks=0;ks<2;++ks){ const LAS f16*ap=Vs+trb+32*ks*RS1+16*wid; vfa[ks]=cat8(trd(ap),trd(ap+4*RS1)); }
    ML_BAR();
    float inv[4];
    #pragma unroll
    for(int tt=0;tt<4;++tt){ const int t=16*tt+fr; const float wi=vec[128+t]; const float den=(vec[384+t]+vec[448+t])+(vec[512+t]+vec[576+t])+wi*vec[320+t]; inv[tt]=frcp(fmaxf(fabsf(den),vec[192+t]));
      accN[tt]*=wi; }
    #pragma unroll
    for(int tt=0;tt<4;++tt)
      #pragma unroll
      for(int ks=0;ks<2;++ks){ const f16x8 pb=*(const LAS f16x8*)(Ps+(16*tt+fr)*RS2+32*ks+8*fq); accN[tt]=MF16(vfa[ks],pb,accN[tt]); }
    #pragma unroll
    for(int tt=0;tt<4;++tt){ accN[tt]*=inv[tt]; float q2=(accN[tt][0]*accN[tt][0]+accN[tt][1]*accN[tt][1])+(accN[tt][2]*accN[tt][2]+accN[tt][3]*accN[tt][3]);
      q2=xsum<16>(q2); q2=xsum<32>(q2); if(fq==0)vec[640+64*wid+16*tt+fr]=q2; }
    ML_BAR();
    #pragma unroll
    for(int tt=0;tt<4;++tt){ const int t=16*tt+fr; float tot=0.f;
      #pragma unroll
      for(int w=0;w<8;++w)tot+=vec[640+64*w+t];
      const float rs=1.f/sqrtf(tot*(1.f/128.f)+EPS);
      float o[4];
      #pragma unroll
      for(int r=0;r<4;++r)o[r]=accN[tt][r]*rs*gn[r]*frcp(1.f+__expf(-(float)om[tt][r]));
      u32x2 w; w.x=pk2h(o[0],o[1]); w.y=pk2h(o[2],o[3]); *(u32x2*)(outp+(rowbase+t0+t)*DM)=w; }
    if(sc<4*c+3){ const float sprev=vec[1280];
      #pragma unroll
      for(int et=0;et<8;++et)accC[et]*=sprev;
      #pragma unroll
      for(int ks=0;ks<2;++ks){ const LAS f16*ap=Ks+trb+32*ks*RS1+16*wid; const f16x8 kfa=cat8(trd(ap),trd(ap+4*RS1)) * *(const LAS f16x8*)(wph+32*ks+8*fq);
        #pragma unroll
        for(int et=0;et<8;++et){ const LAS f16*bp=Vs+trb+32*ks*RS1+16*et; const f16x8 vfb=cat8(trd(bp),trd(bp+4*RS1)); accC[et]=MF16(kfa,vfb,accC[et]); } }
      #pragma unroll
      for(int et=0;et<8;++et){ u32x2 w; w.x=pk2h(accC[et][0],accC[et][1]); w.y=pk2h(accC[et][2],accC[et][3]); *(LAS u32x2*)(Cs+(16*et+fr)*RS1+16*wid+4*fq)=w; }
      const int d=tid>>2,sg=tid&3; float sn=0.f;
      #pragma unroll
      for(int j=0;j<16;++j)sn+=(float)Ks[(16*sg+j)*RS1+d]*vec[256+16*sg+j];
      sn=xsum<1>(sn); sn=xsum<2>(sn);
      if(sg==0)vec[1152+d]=sprev*vec[1152+d]+sn; }
    ML_BAR();
  }
  #undef LOAD_RAW
}
__device__ __forceinline__ void publish(unsigned*cnt,const bool leader){
  asm volatile("s_waitcnt vmcnt(0)":::"memory"); __syncthreads();
  if(leader) __hip_atomic_fetch_add(cnt,1u,__ATOMIC_RELAXED,__HIP_MEMORY_SCOPE_AGENT);
}
__device__ __forceinline__ void await(unsigned*cnt,const unsigned want,const bool leader){
  if(leader){ unsigned sp=0; while(__hip_atomic_load(cnt,__ATOMIC_RELAXED,__HIP_MEMORY_SCOPE_AGENT)<want){ __builtin_amdgcn_s_sleep(8); if(++sp>(1u<<22))break; }
    __builtin_amdgcn_fence(__ATOMIC_ACQUIRE,"agent"); asm volatile("s_waitcnt vmcnt(0)":::"memory"); }
  __syncthreads();
}
#undef ML_BAR
#undef MF16
}

struct Args { const void* in[22]; float* out; unsigned char* ws; };
struct Frame {
    LAS unsigned char* lds; int tid, lane, wave, vcu, G, w0; float* out; unsigned char* ws;
    __device__ __forceinline__ void fresh() { const int t = tid_of(w0); tid = t; lane = t & 63; wave = w0; }
    template <class Tp> __device__ __forceinline__ const Tp* in(int k) const { const LAS unsigned* p = (const LAS unsigned*)(lds + ARGS_OFF) + 2 * k;
        const unsigned lo = __builtin_amdgcn_readfirstlane(p[0]), hi = __builtin_amdgcn_readfirstlane(p[1]); return (const Tp*)(((unsigned long long)hi << 32) | lo); }
    __device__ __forceinline__ const float* x() const { return in<float>(0); }
    __device__ __forceinline__ const float* c() const { return in<float>(1); }
    __device__ __forceinline__ const int* positions() const { return in<int>(2); }
    __device__ __forceinline__ const float* w_ada() const { return in<float>(3); }
    __device__ __forceinline__ const float* b_ada() const { return in<float>(4); }
    __device__ __forceinline__ const float* norm1_g() const { return in<float>(5); }
    __device__ __forceinline__ const float* w_in() const { return in<float>(6); }
    __device__ __forceinline__ const float* b_gate() const { return in<float>(7); }
    __device__ __forceinline__ const float* conv_w() const { return in<float>(8); }
    __device__ __forceinline__ const float* conv_b() const { return in<float>(9); }
    __device__ __forceinline__ const float* attn_g() const { return in<float>(10); }
    __device__ __forceinline__ const float* mlstm_g() const { return in<float>(11); }
    __device__ __forceinline__ const float* w_out() const { return in<float>(12); }
    __device__ __forceinline__ const float* norm2_g() const { return in<float>(13); }
    __device__ __forceinline__ const float* w_rg() const { return in<float>(14); }
    __device__ __forceinline__ const float* b_rg() const { return in<float>(15); }
    __device__ __forceinline__ const float* w_re() const { return in<float>(16); }
    __device__ __forceinline__ const float* b_re() const { return in<float>(17); }
    __device__ __forceinline__ const float* w1() const { return in<float>(18); }
    __device__ __forceinline__ const float* w3() const { return in<float>(19); }
    __device__ __forceinline__ const float* w2() const { return in<float>(20); }
    __device__ __forceinline__ const float* normf_g() const { return in<float>(21); }
};

struct TItem { const GAS float* W; unsigned char* WT; int K, ldw, k0, n0; bool f8; };
__device__ __forceinline__ bool p0_item(const Frame& F, int it, TItem& t) {
    constexpr int I_IN = 16 * 7, I_OUT = 16 * 2, I_E13 = 16, I_E2 = 8 * 2;
    constexpr int NITEMS = I_IN + I_OUT + NEXP * (2 * I_E13 + I_E2);
    if (it >= NITEMS) return false;
    int r = it, nnb; t.f8 = false;
    if (r < I_IN) { t.W = (const GAS float*)F.w_in(); t.WT = F.ws + WS_WIN; t.K = 1024; t.ldw = NPROJ_SRC; nnb = 7; }
    else if ((r -= I_IN) < I_OUT) { t.W = (const GAS float*)F.w_out(); t.WT = F.ws + WS_WOUT; t.K = 1024; t.ldw = 1024; nnb = 2; }
    else { r -= I_OUT; const int per = 2 * I_E13 + I_E2, e = r / per; r -= e * per;
        t.f8 = MOE8; const size_t eb = MOE8 ? 1 : 2;
        if (r < I_E13) { t.W = (const GAS float*)F.w1() + (size_t)e * 1024 * 512; t.WT = F.ws + WS_W1 + (size_t)e * 512 * 1024 * eb; t.K = 1024; t.ldw = 512; nnb = 1; }
        else if ((r -= I_E13) < I_E13) { t.W = (const GAS float*)F.w3() + (size_t)e * 1024 * 512; t.WT = F.ws + WS_W3 + (size_t)e * 512 * 1024 * eb; t.K = 1024; t.ldw = 512; nnb = 1; }
        else { r -= I_E13; t.W = (const GAS float*)F.w2() + (size_t)e * 512 * 1024; t.WT = F.ws + WS_W2 + (size_t)e * 1024 * 512 * eb; t.K = 512; t.ldw = 1024; nnb = 2; } }
    t.k0 = 64 * (r / nnb); t.n0 = 512 * (r % nnb);
    return true;
}
__device__ __forceinline__ void p0_load(const TItem& t, f32x4 (&v)[16], int wave, int lane) {
    const GAS float* p = t.W + (size_t)(t.k0 + 8 * wave) * t.ldw + t.n0 + 4 * lane;
#pragma unroll
    for (int r = 0; r < 8; ++r) { v[2 * r] = *(const GAS f32x4*)(p + (size_t)r * t.ldw); v[2 * r + 1] = *(const GAS f32x4*)(p + (size_t)r * t.ldw + 256); }
}
__device__ __forceinline__ void p0_park(const TItem& t, const f32x4 (&v)[16], LAS f16* Ts, int wave, int lane) {
    const float sc = t.f8 ? W8SCALE : 1.f;
#pragma unroll
    for (int r = 0; r < 8; ++r)
#pragma unroll
        for (int j = 0; j < 2; ++j) { const f32x4 x = v[2 * r + j] * sc; LAS unsigned* q = (LAS unsigned*)(Ts + (8 * wave + r) * 514 + 4 * lane + 256 * j); q[0] = pk2h(x[0], x[1]); q[1] = pk2h(x[2], x[3]); }
}
__device__ __forceinline__ void p0_emit(const TItem& t, const LAS f16* Ts, int tid) {
    const int kc = tid & 7;
#pragma unroll
    for (int jj = 0; jj < 8; ++jj) { const int n = (tid >> 3) + 64 * jj; const LAS f16* q = Ts + (8 * kc) * 514 + n;
        if (t.f8) { const float o8[8] = {(float)q[0], (float)q[514], (float)q[2 * 514], (float)q[3 * 514], (float)q[4 * 514], (float)q[5 * 514], (float)q[6 * 514], (float)q[7 * 514]};
            *(GAS u32x2*)(t.WT + (size_t)(t.n0 + n) * t.K + t.k0 + 8 * kc) = pk8_fp8(o8); }
        else { const f16x8 o = {q[0], q[514], q[2 * 514], q[3 * 514], q[4 * 514], q[5 * 514], q[6 * 514], q[7 * 514]};
            *(GAS f16x8*)((f16*)t.WT + (size_t)(t.n0 + n) * t.K + t.k0 + 8 * kc) = o; } }
}

__device__ __forceinline__ void p0_prologue(Frame F) {
    F.fresh();
    LAS float* sc = (LAS float*)F.lds; LAS float* part = (LAS float*)(F.lds + 32768);
    float* mod = (float*)(F.ws + WS_MOD);
    if ((int)blockIdx.x < 192) {
        { const GAS float* cg = (const GAS float*)F.c(); float cv[16];
#pragma unroll
          for (int u = 0; u < 16; ++u) cv[u] = cg[F.tid + NTHR * u];
#pragma unroll
          for (int u = 0; u < 16; ++u) sc[F.tid + NTHR * u] = cv[u] / (1.f + __expf(-cv[u])); }
        __syncthreads();
        for (int jb = blockIdx.x; jb < 192; jb += F.G) {
            const int jj = F.tid & 31, kc = F.tid >> 5, j0 = jb * 32;
            float a[8];
#pragma unroll
            for (int b = 0; b < 8; ++b) a[b] = 0.f;
            const GAS float* wad = (const GAS float*)F.w_ada() + (size_t)(kc * 64) * 6144 + j0 + jj;
#pragma unroll 1
            for (int k16 = 0; k16 < 64; k16 += 16) { float w[16];
#pragma unroll
                for (int u = 0; u < 16; ++u) w[u] = wad[(size_t)(k16 + u) * 6144];
#pragma unroll
                for (int u = 0; u < 16; ++u) { const int k = kc * 64 + k16 + u;
#pragma unroll
                    for (int b = 0; b < 8; ++b) a[b] += sc[b * 1024 + k] * w[u]; } }
#pragma unroll
            for (int b = 0; b < 8; ++b) part[(kc * 8 + b) * 32 + jj] = a[b];
            __syncthreads();
            if (F.tid < 256) { const int b = F.tid >> 5; float s = ((const GAS float*)F.b_ada())[j0 + jj];
                for (int k2 = 0; k2 < 16; ++k2) s += part[(k2 * 8 + b) * 32 + jj];
                mod[(size_t)b * 6144 + j0 + jj] = s; }
            __syncthreads();
        }
    }
    __syncthreads();
    const int gw = F.vcu * NWAVES + F.wave, NGW = F.G * NWAVES;
    { f16* wg = (f16*)(F.ws + WS_WGT); f16* wr = (f16*)(F.ws + WS_WRT); const GAS float* w_in = (const GAS float*)F.w_in(); const GAS float* w_rg = (const GAS float*)F.w_rg(); const GAS float* w_re = (const GAS float*)F.w_re();
      for (int i = gw * 64 + F.lane; i < 64 * 1024; i += NGW * 64) { const int n = i >> 10, k = i & 1023;
          if (n < 16) wg[n * 1024 + k] = (f16)(n < 8 ? w_in[(size_t)k * NPROJ_SRC + NPROJ + n] : 0.f);
          else { const int m = n - 16; wr[m * 1024 + k] = (f16)(m < 4 ? w_rg[k * 4 + m] : m < 36 ? w_re[k * 32 + (m - 4)] : 0.f); } } }
}


__device__ __forceinline__ void p1_weights(Frame F) {
    F.fresh();
    LAS f16* Ts = (LAS f16*)F.lds;
    TItem cur, nxt; f32x4 va[16], vb[16];
    bool have = p0_item(F, F.vcu, cur);
    if (have) p0_load(cur, va, F.wave, F.lane);
    for (int it = F.vcu; have; it += 2 * F.G) {
        const bool hn = p0_item(F, it + F.G, nxt);
        if (hn) p0_load(nxt, vb, F.wave, F.lane);
        p0_park(cur, va, Ts, F.wave, F.lane); __syncthreads(); p0_emit(cur, Ts, F.tid); __syncthreads();
        if (!hn) break;
        have = p0_item(F, it + 2 * F.G, cur);
        if (have) p0_load(cur, va, F.wave, F.lane);
        p0_park(nxt, vb, Ts, F.wave, F.lane); __syncthreads(); p0_emit(nxt, Ts, F.tid); __syncthreads();
    }
}

template <int NCT, bool SRC16, bool OUT8 = false>
__device__ __forceinline__ void modproj_tile(const void* xsrc_, const int row0, const LAS float* scl, const LAS float* sft, const f16* WT, f16* hout, f32x4 (&acc)[NCT], const int lane, const float* ssb = nullptr) {
    const int fr = lane & 15, fq = lane >> 4;
    const float* xp = (const float*)xsrc_ + (size_t)(row0 + fr) * DM + 8 * fq;
    const f16* xh = (const f16*)xsrc_ + (size_t)(row0 + fr) * 2048 + 8 * fq;
    float ss = 0.f;
    if (ssb) { const f32x4* sp = (const f32x4*)(ssb + (size_t)(row0 + fr) * 16); const f32x4 p0 = sp[0], p1 = sp[1], p2 = sp[2], p3 = sp[3];
        ss = ((p0[0] + p0[1]) + (p0[2] + p0[3])) + ((p1[0] + p1[1]) + (p1[2] + p1[3])) + ((p2[0] + p2[1]) + (p2[2] + p2[3])) + ((p3[0] + p3[1]) + (p3[2] + p3[3])); }
    else {
#pragma unroll 16
    for (int ks = 0; ks < 32; ++ks) {
        f32x4 a, c;
        if (SRC16) { const f16x8 t = *(const f16x8*)(xh + 32 * ks); a = (f32x4){(float)t[0], (float)t[1], (float)t[2], (float)t[3]}; c = (f32x4){(float)t[4], (float)t[5], (float)t[6], (float)t[7]}; }
        else { a = *(const f32x4*)(xp + 32 * ks); c = *(const f32x4*)(xp + 32 * ks + 4); }
        ss += (a[0] * a[0] + a[1] * a[1]) + (a[2] * a[2] + a[3] * a[3]) + (c[0] * c[0] + c[1] * c[1]) + (c[2] * c[2] + c[3] * c[3]); }
    ss = xsum<16>(ss); ss = xsum<32>(ss); }
    const float rstd = 1.f / sqrtf(ss * (1.f / DM) + EPS);
#pragma unroll
    for (int ct = 0; ct < NCT; ++ct) acc[ct] = (f32x4){0.f, 0.f, 0.f, 0.f};
    f16* hp = hout + (size_t)(row0 + fr) * DM + 8 * fq;
    const f16* wp = WT + (size_t)fr * DM + 8 * fq;
    constexpr int PF = 8;
    f32x4 ba[PF], bc[PF]; f16x8 bh[PF];
#define MP_LOAD(slot, ks) do { if (SRC16) bh[slot] = *(const f16x8*)(xh + 32 * (ks)); else { ba[slot] = *(const f32x4*)(xp + 32 * (ks)); bc[slot] = *(const f32x4*)(xp + 32 * (ks) + 4); } } while (0)
#pragma unroll
    for (int u = 0; u < PF; ++u) MP_LOAD(u, u);
#pragma unroll 1
    for (int k8 = 0; k8 < 32; k8 += PF) {
        f16x8 bf[PF][NCT];
#pragma unroll
        for (int u = 0; u < PF; ++u)
#pragma unroll
            for (int ct = 0; ct < NCT; ++ct) bf[u][ct] = *(const f16x8*)(wp + (size_t)ct * 16 * DM + 32 * (k8 + u));
#pragma unroll
        for (int u = 0; u < PF; ++u) { const int ks = k8 + u, k0 = 32 * ks + 8 * fq;
            f32x4 a, c;
            if (SRC16) { const f16x8 t = bh[u]; a = (f32x4){(float)t[0], (float)t[1], (float)t[2], (float)t[3]}; c = (f32x4){(float)t[4], (float)t[5], (float)t[6], (float)t[7]}; }
            else { a = ba[u]; c = bc[u]; }
            if (k8 + PF < 32) MP_LOAD(u, ks + PF);
            const f32x4 s0 = *(const LAS f32x4*)(scl + k0), s1 = *(const LAS f32x4*)(scl + k0 + 4), h0 = *(const LAS f32x4*)(sft + k0), h1 = *(const LAS f32x4*)(sft + k0 + 4);
            const f32x4 y0 = a * rstd * s0 + h0, y1 = c * rstd * s1 + h1;
            const f16x8 af = {(f16)y0[0], (f16)y0[1], (f16)y0[2], (f16)y0[3], (f16)y1[0], (f16)y1[1], (f16)y1[2], (f16)y1[3]};
            if (OUT8) { const float o8[8] = {y0[0], y0[1], y0[2], y0[3], y1[0], y1[1], y1[2], y1[3]}; *(u32x2*)((unsigned char*)hout + (size_t)(row0 + fr) * DM + 8 * fq + 32 * ks) = pk8_fp8(o8); }
            else *(f16x8*)(hp + 32 * ks) = af;
#pragma unroll
            for (int ct = 0; ct < NCT; ++ct) acc[ct] = __builtin_amdgcn_mfma_f32_16x16x32_f16(af, bf[u][ct], acc[ct], 0, 0, 0);
        }
    }
#undef MP_LOAD
}
__device__ __forceinline__ void stage_mod(LAS float* dst, const float* g, const float* sh, const float* sc, int tid) {
    for (int i = tid; i < 256; i += NTHR) { const f32x4 gv = *(const f32x4*)(g + 4 * i), sv = *(const f32x4*)(sc + 4 * i), hv = *(const f32x4*)(sh + 4 * i);
        *(LAS f32x4*)(dst + 4 * i) = gv * (sv + 1.f); *(LAS f32x4*)(dst + 1024 + 4 * i) = hv; }
}

__device__ __forceinline__ void p1_rows(Frame F) {
    F.fresh();
    const float* mod = (const float*)(F.ws + WS_MOD);
    f16* hbuf = (f16*)(F.ws + WS_A); float* gates = (float*)(F.ws + WS_GATES);
    float* cosT = (float*)(F.ws + WS_COS); float* sinT = (float*)(F.ws + WS_SIN);
    const float* x = F.x(); const float* g1n = F.norm1_g(); const float* bg = F.b_gate(); const int* pos = F.positions();
    const f16* WT = (const f16*)(F.ws + WS_WGT);
    const int lane = F.lane, w = F.wave, fr = lane & 15, fq = lane >> 4;
    constexpr int RSX = 1032;
    LAS f16* Xs = (LAS f16*)F.lds; LAS float* part = (LAS float*)(F.lds + 66048); LAS float* rsv = part + 1024; LAS float* smod = (LAS float*)(F.lds + 73728);
    int sb = -1;
    const int NT32 = T / 32;
    f32x4 rx[4][4];
#define P1_LOAD(t) do { _Pragma("unroll") for (int r = 0; r < 4; ++r) { const GAS f32x4* xr = (const GAS f32x4*)(x + (size_t)((t) * 32 + 4 * w + r) * DM) + lane; \
        _Pragma("unroll") for (int j = 0; j < 4; ++j) rx[r][j] = xr[64 * j]; } } while (0)
    int tile = F.vcu;
    if (tile < NT32) P1_LOAD(tile);
    for (; tile < NT32; tile += F.G) {
        const int row0 = tile * 32, b = row0 / SEQ;
        if (b != sb) { __syncthreads(); stage_mod(smod, g1n, mod + (size_t)b * 6144, mod + (size_t)b * 6144 + 1024, F.tid); sb = b; }
#pragma unroll
        for (int r = 0; r < 4; ++r) { float ss = 0.f;
#pragma unroll
            for (int j = 0; j < 4; ++j) { const f32x4 v = rx[r][j]; ss += (v.x * v.x + v.y * v.y) + (v.z * v.z + v.w * v.w);
                u32x2 pk; pk.x = pk2h(v.x, v.y); pk.y = pk2h(v.z, v.w); *(LAS u32x2*)(Xs + (4 * w + r) * RSX + 4 * lane + 256 * j) = pk; }
            ss = wave_sum(ss);
            if (lane == 0) rsv[4 * w + r] = 1.f / sqrtf(ss * (1.f / DM) + EPS); }
        __syncthreads();
        if (tile + F.G < NT32) P1_LOAD(tile + F.G);
        { const int rt = w >> 2, kq = w & 3, row = 16 * rt + fr; const float rs = rsv[row];
          f32x4 acc = {0.f, 0.f, 0.f, 0.f};
          f16* hp = hbuf + (size_t)(row0 + row) * DM + 8 * fq;
#pragma unroll
          for (int u = 0; u < 8; ++u) { const int ks = 8 * kq + u, k0 = 32 * ks + 8 * fq;
              const f16x8 xv = *(const LAS f16x8*)(Xs + row * RSX + k0);
              const f32x4 s0 = *(const LAS f32x4*)(smod + k0), s1 = *(const LAS f32x4*)(smod + k0 + 4), h0 = *(const LAS f32x4*)(smod + 1024 + k0), h1 = *(const LAS f32x4*)(smod + 1024 + k0 + 4);
              const f32x4 a = {(float)xv[0], (float)xv[1], (float)xv[2], (float)xv[3]}, c = {(float)xv[4], (float)xv[5], (float)xv[6], (float)xv[7]};
              const f32x4 y0 = a * rs * s0 + h0, y1 = c * rs * s1 + h1;
              const f16x8 af = {(f16)y0[0], (f16)y0[1], (f16)y0[2], (f16)y0[3], (f16)y1[0], (f16)y1[1], (f16)y1[2], (f16)y1[3]};
              *(f16x8*)(hp + 32 * ks) = af;
              const f16x8 bf = *(const f16x8*)(WT + (size_t)fr * DM + 32 * ks + 8 * fq);
              acc = __builtin_amdgcn_mfma_f32_16x16x32_f16(af, bf, acc, 0, 0, 0); }
          if (fr < 8) {
#pragma unroll
              for (int r = 0; r < 4; ++r) part[(w * 16 + 4 * fq + r) * 8 + fr] = acc[r]; } }
        __syncthreads();
        if (F.tid < 256) { const int r = F.tid >> 3, q = F.tid & 7, rt = r >> 4, rr = r & 15;
            float g = bg[q];
#pragma unroll
            for (int kq = 0; kq < 4; ++kq) g += part[((4 * rt + kq) * 16 + rr) * 8 + q];
            gates[(size_t)(row0 + r) * 8 + q] = g; }
#pragma unroll
        for (int i = 0; i < 2; ++i) { const int idx = F.tid + NTHR * i, r = idx >> 5, f = idx & 31;
            const float invf = exp2f(-(float)f * (13.287712379549449f / 32.f)); const float ang = (float)pos[row0 + r] * invf;
            cosT[(size_t)(row0 + r) * 32 + f] = cosf(ang); sinT[(size_t)(row0 + r) * 32 + f] = sinf(ang); }
        __syncthreads();
    }
#undef P1_LOAD
}

#if defined(PROBE_K) && PROBE_K == 33
#define ML_REP 2
#else
#define ML_REP 1
#endif
#if defined(PROBE_K) && PROBE_K == 34
#define AT_REP 2
#else
#define AT_REP 1
#endif
constexpr int CW_Q = 12288;
constexpr int CW_DEPA = 16384, CW_DEPB = 20480, CW_DEPC = 49152;
__device__ __forceinline__ void p3_mixers(Frame F) {
    F.fresh();
    const f16* proj = (const f16*)(F.ws + WS_PROJ); const float* ksum = (const float*)(F.ws + WS_CTL + CTL_KMEAN); f16* mix = (f16*)(F.ws + WS_A);
    unsigned* ctl = (unsigned*)(F.ws + WS_CTL);
    const int q = blockIdx.x & 7;
    LAS int* slot = (LAS int*)(F.lds + TAB_OFF + 512);
    float* mls = (float*)(F.ws + WS_MLS);
    const mlstm::Glob G{(f16*)(F.ws + WS_CLOC), (f16*)(F.ws + WS_CPREV), mls, mls + 65536, mls + 131072, mls + 131584, mls + 132096,
                        (f16*)(F.ws + WS_QKC), mls + 132608, mls + 132608 + 131072, (float*)(F.ws + WS_GPM), mls + 132608 + 262144, mls + 132608 + 262144 + 2048};
    int tk = 0;
    if (F.tid == 0) tk = (int)__hip_atomic_fetch_add(ctl + CW_Q + 64 * q, 1u, RLX_AGENT);
    for (;;) {
        if (F.tid == 0) *slot = tk;
        __syncthreads();
        const int it = *slot;
        __syncthreads();
        if (it >= 324) break;
        if (F.tid == 0) tk = (int)__hip_atomic_fetch_add(ctl + CW_Q + 64 * q, 1u, RLX_AGENT);
        int aj = -1;
        if (it < 64) { mlstm::prep(q, it, G, proj, (const float*)(F.ws + WS_GATES), F.conv_w(), F.conv_b(), F.w0);
            mlstm::publish(ctl + CW_DEPC + 64 * (q * 16 + (it >> 2)), F.tid == 0); }
        else if (it < 128) { const int j = it - 64, hm = j >> 4, c = j & 15;
            mlstm::await(ctl + CW_DEPC + 64 * (q * 16 + c), 4u, F.tid == 0);
            for (int rep = 0; rep < ML_REP; ++rep) mlstm::contrib(q, hm, c, G, proj, F.lds, F.w0);
            mlstm::publish(ctl + CW_DEPA + 64 * (q * 4 + hm), F.tid == 0); }
        else if (it < 132) { const int seq = q * 4 + (it - 128);
            mlstm::await(ctl + CW_DEPA + 64 * seq, 16u, F.tid == 0);
            for (int rep = 0; rep < ML_REP; ++rep) mlstm::scan(seq, G, F.w0);
            mlstm::publish(ctl + CW_DEPB + 64 * seq, F.tid == 0); }
        else if (it < 164) aj = it - 132;
        else if (it < 228) { const int j = it - 164, hm = j >> 4, c = j & 15;
            mlstm::await(ctl + CW_DEPB + 64 * (q * 4 + hm), 1u, F.tid == 0);
            for (int rep = 0; rep < ML_REP; ++rep) mlstm::unit(q, hm, c, G, proj, F.mlstm_g(), mix, F.lds, F.w0); }
        else if (it < 260) aj = 32 + (it - 228);
        else aj = 64 + (it - 260);
        if (aj >= 0) { const int qb = 15 - (aj >> 3), bh = 8 * q + (aj & 7);
            for (int rep = 0; rep < AT_REP; ++rep) {
            moba::sel_unit(bh >> 3, bh & 7, qb, proj + C_QA, ksum, (char*)F.lds, F.w0);
            moba::attn_unit<8>(bh >> 3, bh & 7, qb, proj + C_QA, proj + C_KA, proj + C_VA, mix, ksum, F.attn_g(), (char*)F.lds, F.w0); } }
    }
}

__device__ __forceinline__ void p5_route(Frame F) {
    F.fresh();
    const int gw = F.vcu * NWAVES + F.wave, NGW = F.G * NWAVES;
    const float* mod = (const float*)(F.ws + WS_MOD);
    f16* h2 = (f16*)(F.ws + WS_H2); int* list = (int*)(F.ws + WS_LIST); int* pos2 = (int*)(F.ws + WS_POS);
    unsigned* cnt = (unsigned*)(F.ws + WS_CTL) + CW_CNT;
    LAS int* hist = (LAS int*)F.lds; LAS int* rec = (LAS int*)(F.lds + 1024);
    LAS float* lgs = (LAS float*)(F.lds + 16384) + F.wave * 16 * 49;
    const float* g2n = F.norm2_g(); const float* brg = F.b_rg(); const float* bre = F.b_re();
    const int fr = F.lane & 15, fq = F.lane >> 4;
    if (F.tid < 64) hist[F.tid] = 0;
    __syncthreads();
    int nloc = 0;
    LAS float* smod = (LAS float*)(F.lds + 65536); int sb = -1;
    for (int tile0 = F.vcu * NWAVES; tile0 < T / 16; tile0 += NGW) {
        const int tile = tile0 + F.wave, row0 = tile * 16, b = (tile0 * 16) / SEQ;
        if (b != sb) { __syncthreads(); stage_mod(smod, g2n, mod + (size_t)b * 6144 + 3072, mod + (size_t)b * 6144 + 4096, F.tid); __syncthreads(); sb = b; }
        f32x4 acc[3];
        modproj_tile<3, true, MOE8>(F.out, row0, smod, smod + 1024, (const f16*)(F.ws + WS_WRT), h2, acc, F.lane, (const float*)(F.ws + WS_MLS));
#pragma unroll
        for (int ct = 0; ct < 3; ++ct)
#pragma unroll
            for (int r = 0; r < 4; ++r) lgs[(4 * fq + r) * 49 + 16 * ct + fr] = acc[ct][r];
        LDS_WAIT(); asm volatile("" ::: "memory");
        if (F.lane < 16) {
            const int row = row0 + F.lane; const LAS float* lg = lgs + F.lane * 49;
            float gl[4];
#pragma unroll
            for (int q = 0; q < 4; ++q) gl[q] = lg[q] + brg[q];
            int gi = 0; float gm = gl[0];
#pragma unroll
            for (int q = 1; q < 4; ++q) if (gl[q] > gm) { gm = gl[q]; gi = q; }
            float gsum = 0.f;
#pragma unroll
            for (int q = 0; q < 4; ++q) gsum += __expf(gl[q] - gm);
            const float pg = 1.f / gsum;
            float el[8];
#pragma unroll
            for (int q = 0; q < 8; ++q) el[q] = lg[4 + 8 * gi + q] + bre[gi * 8 + q];
            int i1 = 0; float m1 = el[0];
#pragma unroll
            for (int q = 1; q < 8; ++q) if (el[q] > m1) { m1 = el[q]; i1 = q; }
            int i2 = -1; float m2 = -INFINITY;
#pragma unroll
            for (int q = 0; q < 8; ++q) if (q != i1 && el[q] > m2) { m2 = el[q]; i2 = q; }
            const float rr = __expf(m2 - m1), w1 = pg / (1.f + rr), w2 = pg * rr / (1.f + rr);
#pragma unroll
            for (int k = 0; k < 2; ++k) { const int e = gi * 8 + (k == 0 ? i1 : i2); const float w = k == 0 ? w1 : w2;
                const int rank = (int)__hip_atomic_fetch_add((LAS unsigned*)hist + e, 1u, __ATOMIC_RELAXED, __HIP_MEMORY_SCOPE_WORKGROUP);
                LAS int* rp = rec + (F.wave * 64 + 32 * nloc + 2 * F.lane + k) * 4; rp[0] = row; rp[1] = e; rp[2] = rank; rp[3] = __float_as_int(w); }
        }
        ++nloc;
        LDS_WAIT(); asm volatile("" ::: "memory");
    }
    __syncthreads();
    if (F.tid < 32) hist[32 + F.tid] = (int)atomicAdd(cnt + 64 * F.tid, (unsigned)hist[F.tid]);
    __syncthreads();
    for (int i = F.lane; i < 32 * nloc; i += 64) { const LAS int* rp = rec + (F.wave * 64 + i) * 4; const int row = rp[0], e = rp[1], slot = hist[32 + e] + rp[2];
        list[2 * ((size_t)e * LISTCAP + slot)] = row; list[2 * ((size_t)e * LISTCAP + slot) + 1] = rp[3];
        pos2[2 * row + (i & 1)] = e * LISTCAP + slot; }
}

__device__ __forceinline__ void moe_tables(Frame F) {
    F.fresh();
    LAS int* tab = (LAS int*)(F.lds + TAB_OFF);
    const unsigned* cnt = (const unsigned*)(F.ws + WS_CTL) + CW_CNT;
    __syncthreads();
    if (F.tid < 32) tab[80 + F.tid] = (int)__hip_atomic_load(cnt + 64 * F.tid, RLX_AGENT);
    __syncthreads();
    if (F.tid == 0) { int up = 0, rp = 0;
        for (int e = 0; e < 32; ++e) { const int c = tab[80 + e]; tab[e] = up; tab[40 + e] = rp; up += ((c + 255) >> 8) * 4; rp += c; }
        tab[32] = up; tab[72] = rp; }
    __syncthreads();
}

struct P8Row { unsigned ya[4], yb[4]; f16x4 xh[4]; };
__device__ __forceinline__ void p8_load(P8Row& R, const unsigned char* Y, const f16* x1h, const LAS int* tab, int row, int p0, int p1, int lane) {
    const size_t y0 = (size_t)(tab[40 + (p0 >> 15)] + (p0 & 32767)) * DM, y1 = (size_t)(tab[40 + (p1 >> 15)] + (p1 & 32767)) * DM;
#pragma unroll
    for (int j = 0; j < 4; ++j) { const int k0 = 4 * lane + 256 * j; R.ya[j] = *(const unsigned*)(Y + y0 + k0); R.yb[j] = *(const unsigned*)(Y + y1 + k0); R.xh[j] = *(const f16x4*)(x1h + (size_t)row * 2048 + k0); }
}
__device__ __forceinline__ void p8_row(const P8Row& R, float* out, const float* g2, const float* gf, int row, int lane) {
    f32x4 v[4]; float ss = 0.f;
#pragma unroll
    for (int j = 0; j < 4; ++j) { const int k0 = 4 * lane + 256 * j; const f32x4 g = *(const f32x4*)(g2 + k0);
        const auto a01 = __builtin_amdgcn_cvt_pk_f32_fp8((int)R.ya[j], false), a23 = __builtin_amdgcn_cvt_pk_f32_fp8((int)R.ya[j], true), b01 = __builtin_amdgcn_cvt_pk_f32_fp8((int)R.yb[j], false), b23 = __builtin_amdgcn_cvt_pk_f32_fp8((int)R.yb[j], true);
        f32x4 sv; sv.x = a01[0] + b01[0]; sv.y = a01[1] + b01[1]; sv.z = a23[0] + b23[0]; sv.w = a23[1] + b23[1];
        v[j] = (f32x4){(float)R.xh[j][0], (float)R.xh[j][1], (float)R.xh[j][2], (float)R.xh[j][3]} + g * sv; ss += (v[j].x * v[j].x + v[j].y * v[j].y) + (v[j].z * v[j].z + v[j].w * v[j].w); }
    const float rstd = 1.f / sqrtf(wave_sum(ss) * (1.f / DM) + EPS);
    GAS f32x4* xr = (GAS f32x4*)(out + (size_t)row * DM) + lane;
#pragma unroll
    for (int j = 0; j < 4; ++j) { const int k0 = 4 * lane + 256 * j; xr[64 * j] = v[j] * rstd * *(const f32x4*)(gf + k0); }
}
__device__ __forceinline__ void p8_final(Frame F) {
    F.fresh();
    const int gw = F.vcu * NWAVES + F.wave, NGW = F.G * NWAVES;
    const float* mod = (const float*)(F.ws + WS_MOD); const unsigned char* Y = (const unsigned char*)(F.ws + WS_Y); const int* pos2 = (const int*)(F.ws + WS_POS);
    const LAS int* tab = (const LAS int*)(F.lds + TAB_OFF);
    const float* gf = F.normf_g(); const f16* x1h = (const f16*)F.out;
    const int RPW = (T + NGW - 1) / NGW, r0 = gw * RPW, r1 = min(T, r0 + RPW);
    if (r0 >= r1) return;
    P8Row A, B;
    int pa0 = pos2[2 * r0], pa1 = pos2[2 * r0 + 1], pb0 = 0, pb1 = 0;
    if (r0 + 1 < r1) { pb0 = pos2[2 * r0 + 2]; pb1 = pos2[2 * r0 + 3]; }
    p8_load(A, Y, x1h, tab, r0, pa0, pa1, F.lane);
    for (int row = r0; row < r1; row += 2) {
        const bool hb = row + 1 < r1;
        if (hb) p8_load(B, Y, x1h, tab, row + 1, pb0, pb1, F.lane);
        if (row + 2 < r1) { pa0 = pos2[2 * row + 4]; pa1 = pos2[2 * row + 5]; }
        p8_row(A, F.out, mod + (size_t)(row / SEQ) * 6144 + 5120, gf, row, F.lane);
        if (!hb) break;
        if (row + 2 < r1) p8_load(A, Y, x1h, tab, row + 2, pa0, pa1, F.lane);
        if (row + 3 < r1) { pb0 = pos2[2 * row + 6]; pb1 = pos2[2 * row + 7]; }
        p8_row(B, F.out, mod + (size_t)((row + 1) / SEQ) * 6144 + 5120, gf, row + 1, F.lane);
    }
}

#ifdef PROBE_K
#define PROBE_PH ((PROBE_K == 33 || PROBE_K == 34) ? 3 : (PROBE_K == 40) ? 100 : (PROBE_K == 41) ? 101 : PROBE_K)
#define PSTAMP(k) do { if ((k) == PROBE_PH || (k) == PROBE_PH + 1) { const unsigned long long t_ = __builtin_amdgcn_s_memrealtime(); if (F.tid == 0) ((LAS unsigned long long*)(F.lds + TAB_OFF + 768))[(k) - PROBE_PH] = t_; } } while (0)
#else
#define PSTAMP(k) do {} while (0)
#endif
__global__ void __launch_bounds__(NTHR, 2) fwd_kernel(Args args) {
    extern __shared__ __attribute__((aligned(16))) unsigned char lds_raw[];
    Frame F;
    F.lds = (LAS unsigned char*)lds_raw;
    F.w0 = __builtin_amdgcn_readfirstlane((int)threadIdx.x >> 6); F.fresh();
    F.G = gridDim.x; { const int bx = blockIdx.x; F.vcu = (F.G % 8 == 0) ? (bx % 8) * (F.G / 8) + bx / 8 : bx; }
    F.out = args.out; F.ws = args.ws;
    for (int u = F.tid; u < (LDS_BYTES - LDSCTL_OFF) / 4; u += NTHR) ((LAS unsigned*)(F.lds + LDSCTL_OFF))[u] = 0u;
    __syncthreads();
    if (F.tid < 44) ((LAS unsigned*)(F.lds + ARGS_OFF))[F.tid] = ((const __attribute__((address_space(4))) unsigned*)__builtin_amdgcn_kernarg_segment_ptr())[F.tid];
    __syncthreads();
    unsigned* ctl = (unsigned*)(F.ws + WS_CTL);
    XcdBarrier bar = xcd_barrier_post(ctl + CW_BAR, (volatile LAS unsigned*)(F.lds + MISC_OFF) + 8, F.tid == 0);

    PSTAMP(0);
    PSTAMP(100);
    p0_prologue(F);
    __syncthreads();
    PSTAMP(101);
    p1_weights(F);
    PSTAMP(102);
    xcd_barrier(bar, F.w0);
    PSTAMP(1);
    p1_rows(F);
    xcd_barrier(bar, F.w0);
    PSTAMP(2);
    { pg8::DenseSched S; S.init(T, NPROJ, 1024, F.G, (int)blockIdx.x, true);
      pg8::EpiProj E{(f16*)(F.ws + WS_PROJ), (const float*)(F.ws + WS_COS), (const float*)(F.ws + WS_SIN), (float*)(F.ws + WS_CTL + CTL_KMEAN)};
      pg8::gemm_phase<true, false>(F.lds, (const char*)(F.ws + WS_A), (const char*)(F.ws + WS_WIN), 1024, S, E, F.w0); }
    xcd_barrier(bar, F.w0);
    PSTAMP(3);
    p3_mixers(F);
    xcd_barrier(bar, F.w0);
    PSTAMP(4);
    { pg8::DenseSched S; S.init(T, DM, 1024, F.G, (int)blockIdx.x, false);
      pg8::EpiOut E{F.x(), (const float*)(F.ws + WS_MOD), (f16*)F.out, (float*)(F.ws + WS_MLS)};
      pg8::gemm_phase<false, false>(F.lds, (const char*)(F.ws + WS_A), (const char*)(F.ws + WS_WOUT), 1024, S, E, F.w0); }
    xcd_barrier(bar, F.w0);
    PSTAMP(5);
    p5_route(F);
    xcd_barrier(bar, F.w0);
    PSTAMP(6);
    moe_tables(F);
    { pg8::MoeSched S{(const LAS int*)(F.lds + TAB_OFF), F.G, F.vcu, 1024, true, (const int*)(F.ws + WS_LIST), (unsigned*)(F.ws + WS_CTL) + CW_MT};
      pg8::EpiMoe1 E{(unsigned char*)(F.ws + WS_HID)};
      pg8::gemm_phase<false, MOE8>(F.lds, (const char*)(F.ws + WS_H2), (const char*)(F.ws + WS_W1), 1024, S, E, F.w0); }
    PSTAMP(7);
    { pg8::MoeSched S{(const LAS int*)(F.lds + TAB_OFF), F.G, F.G - 1 - F.vcu, 512, false, (const int*)(F.ws + WS_LIST), (unsigned*)(F.ws + WS_CTL) + CW_MT};
      pg8::EpiMoe2 E{(unsigned char*)(F.ws + WS_Y), (const int*)(F.ws + WS_LIST)};
      pg8::gemm_phase<false, MOE8>(F.lds, (const char*)(F.ws + WS_HID), (const char*)(F.ws + WS_W2), 512, S, E, F.w0); }
    xcd_barrier(bar, F.w0);
    PSTAMP(8);
    p8_final(F);
#ifdef PROBE_K
    __syncthreads(); PSTAMP(9); __syncthreads();
    if (blockIdx.x == 0) { const unsigned long long tp0 = ((LAS unsigned long long*)(F.lds + TAB_OFF + 768))[0], tp1 = ((LAS unsigned long long*)(F.lds + TAB_OFF + 768))[1]; const unsigned long long te = __builtin_amdgcn_s_memrealtime(); while (__builtin_amdgcn_s_memrealtime() - te < 8ull * (tp1 - tp0)) __builtin_amdgcn_s_sleep(20); }
#endif
}

extern "C" void kernel_launch(void* const* d_in, const int* in_sizes, int n_in, void* d_out, int out_size, void* d_ws, size_t ws_size, hipStream_t stream) {
    static int grid = 0;
    if (grid == 0) {
        if (n_in != 22 || out_size != T * DM || ws_size < WS_END) { fprintf(stderr, "kernel_launch: unexpected problem (n_in %d, out %d, ws %zu)\n", n_in, out_size, ws_size); grid = -1; return; }
        int dev = 0, cus = 0, per_cu = 0;
        if (hipGetDevice(&dev) != hipSuccess || hipDeviceGetAttribute(&cus, hipDeviceAttributeMultiprocessorCount, dev) != hipSuccess) { grid = -1; return; }
        if (hipFuncSetAttribute((const void*)fwd_kernel, hipFuncAttributeMaxDynamicSharedMemorySize, LDS_BYTES) != hipSuccess) { fprintf(stderr, "kernel_launch: hipFuncSetAttribute failed\n"); grid = -1; return; }
        if (hipOccupancyMaxActiveBlocksPerMultiprocessor(&per_cu, (const void*)fwd_kernel, NTHR, LDS_BYTES) != hipSuccess || per_cu < 1) fprintf(stderr, "kernel_launch: occupancy query says %d\n", per_cu);
        (void)hipGetLastError();
        grid = cus;
    }
    if (grid < 0) return;
    (void)hipMemsetAsync((char*)d_ws + WS_CTL, 0, CTL_ZERO_BYTES, stream);
    Args a{};
    for (int i = 0; i < 22; ++i) a.in[i] = d_in[i];
    a.out = (float*)d_out; a.ws = (unsigned char*)d_ws;
    hipLaunchKernelGGL(fwd_kernel, dim3(grid), dim3(NTHR), LDS_BYTES, stream, a);
}
```

```cpp
#include <hip/hip_runtime.h>
#include <cstdio>
#include <cstdint>
#include <cmath>

#define LAS __attribute__((address_space(3)))
#define GAS __attribute__((address_space(1)))
typedef _Float16 f16;
typedef _Float16 f16x8 __attribute__((ext_vector_type(8)));
typedef _Float16 f16x4 __attribute__((ext_vector_type(4)));
typedef _Float16 f16x2 __attribute__((ext_vector_type(2)));
typedef float f32x4 __attribute__((ext_vector_type(4)));
typedef float f32x2 __attribute__((ext_vector_type(2)));
typedef unsigned u32x4 __attribute__((ext_vector_type(4)));
typedef unsigned u32x2 __attribute__((ext_vector_type(2)));

constexpr int NB = 8, SEQ = 4096, DM = 1024, T = NB * SEQ;
constexpr int NPROJ = 3584, NPROJ_SRC = 3592;
constexpr int C_QA = 0, C_KA = 512, C_VA = 1024, C_QM = 1536, C_KM = 2048, C_VM = 2560, C_OM = 3072;
constexpr int NEXP = 32, DEXP = 512, LISTCAP = 32768;
constexpr float EPS = 1e-6f;
constexpr float C2 = 0.125f * 1.4426950408889634f;
constexpr int NWAVES = 8, NTHR = 512;

constexpr size_t MiB = 1u << 20;
constexpr size_t WS_CTL = 0, CTL_ZERO_BYTES = 1 * MiB;
constexpr int CW_BAR = 4096;
constexpr int CW_MT = 28672;
constexpr int CW_CNT = 8192;
constexpr size_t CTL_KMEAN = 256 * 1024;
constexpr size_t WS_WGT = 1 * MiB + 256 * 1024, WS_WRT = 1 * MiB + 320 * 1024;
constexpr size_t WS_MOD = 1 * MiB, WS_GATES = 2 * MiB, WS_POS = 3 * MiB, WS_COS = 4 * MiB, WS_SIN = 8 * MiB, WS_LIST = 12 * MiB;
constexpr size_t WS_WIN = 20 * MiB, WS_WOUT = 27 * MiB, WS_W1 = 29 * MiB, WS_W3 = 61 * MiB, WS_W2 = 93 * MiB;
constexpr size_t WS_A = 126 * MiB;
constexpr size_t WS_PROJ = 190 * MiB;
constexpr size_t WS_H2 = 190 * MiB;
constexpr size_t WS_HID = 254 * MiB;
constexpr size_t WS_Y = 320 * MiB;
constexpr size_t WS_MLS = 414 * MiB;
constexpr size_t WS_GPM = 512 * 1024;
constexpr size_t WS_CLOC = 416 * MiB;
constexpr size_t WS_CPREV = 432 * MiB;
constexpr size_t WS_QKC = 448 * MiB;
constexpr size_t WS_END = 512 * MiB;

constexpr int RING_BYTES = 133120;
constexpr int LDSCTL_OFF = RING_BYTES, MISC_OFF = LDSCTL_OFF + 320, TAB_OFF = LDSCTL_OFF + 1024;
constexpr int ARGS_OFF = LDSCTL_OFF + 2048;
constexpr int LDS_BYTES = 147456;

#define RLX_AGENT __ATOMIC_RELAXED, __HIP_MEMORY_SCOPE_AGENT
#define LDS_WAIT() asm volatile("s_waitcnt lgkmcnt(0)" ::: "memory")
__device__ __forceinline__ unsigned pk2h(float a, float b) { f16x2 v = {(f16)a, (f16)b}; return __builtin_bit_cast(unsigned, v); }
template <int M> __device__ __forceinline__ float xsum(float v) {
    const int iv = __builtin_bit_cast(int, v);
    if constexpr (M == 1) return v + __builtin_bit_cast(float, __builtin_amdgcn_mov_dpp(iv, 0xB1, 0xF, 0xF, true));
    else if constexpr (M == 2) return v + __builtin_bit_cast(float, __builtin_amdgcn_mov_dpp(iv, 0x4E, 0xF, 0xF, true));
    else if constexpr (M == 32) { const auto r = __builtin_amdgcn_permlane32_swap((unsigned)iv, (unsigned)iv, false, false); return __uint_as_float(r[0]) + __uint_as_float(r[1]); }
    else return v + __builtin_bit_cast(float, __builtin_amdgcn_ds_swizzle(iv, (M << 10) | 0x1F));
}
__device__ __forceinline__ float wave_sum(float v) { v = xsum<1>(v); v = xsum<2>(v); v = xsum<4>(v); v = xsum<8>(v); v = xsum<16>(v); return xsum<32>(v); }
typedef int i32x8 __attribute__((ext_vector_type(8)));
typedef int i32x4 __attribute__((ext_vector_type(4)));
__device__ __forceinline__ u32x2 pk8_fp8(const float (&o)[8]) {
    float c[8];
#pragma unroll
    for (int j = 0; j < 8; ++j) c[j] = fminf(fmaxf(o[j], -448.f), 448.f);
    int lo = __builtin_amdgcn_cvt_pk_fp8_f32(c[0], c[1], 0, false); lo = __builtin_amdgcn_cvt_pk_fp8_f32(c[2], c[3], lo, true);
    int hi = __builtin_amdgcn_cvt_pk_fp8_f32(c[4], c[5], 0, false); hi = __builtin_amdgcn_cvt_pk_fp8_f32(c[6], c[7], hi, true);
    return (u32x2){(unsigned)lo, (unsigned)hi};
}
#ifndef MOE_FP8
#define MOE_FP8 1
#endif
constexpr bool MOE8 = MOE_FP8 != 0;
constexpr float W8SCALE = MOE8 ? 16.f : 1.f;
__device__ __forceinline__ float sigmoidf_(float x) { return 1.f / (1.f + __expf(-x)); }

__device__ __forceinline__ int tid_of(int w0) { unsigned z = 0u; asm volatile("" : "+v"(z));
    return w0 * 64 + (int)__builtin_amdgcn_mbcnt_hi(~0u, __builtin_amdgcn_mbcnt_lo(~0u, z)); }
__device__ __forceinline__ void st16_wt(void* base_uniform, unsigned byte_off, u32x4 v) {
    const __amdgpu_buffer_rsrc_t r = __builtin_amdgcn_make_buffer_rsrc(base_uniform, (short)0, 0x7fffffff, 0x00020000);
    __builtin_amdgcn_raw_buffer_store_b128(v, r, (int)byte_off, 0, 16);
}
__device__ __forceinline__ void st4_wt(float* p, float v) { __hip_atomic_store((unsigned*)p, __float_as_uint(v), __ATOMIC_RELAXED, __HIP_MEMORY_SCOPE_AGENT); }
#define XB_TMO      128
#define XB_XCNT(j)  (256  + 64 * (j))
#define XB_XSUB(j)  (1280 + 64 * (j))
#define XB_XGEN(j)  (2304 + 64 * (j))
#define XB_TOP      3328
#define XB_TOPGEN   3392
#define XCD_BAR_WORDS 3456
#define XB_SPIN_CAP (1u << 22)
__device__ __forceinline__ unsigned xb_ld(unsigned* p)              { return __hip_atomic_load(p, __ATOMIC_RELAXED, __HIP_MEMORY_SCOPE_AGENT); }
__device__ __forceinline__ unsigned xb_add(unsigned* p, unsigned v) { return __hip_atomic_fetch_add(p, v, __ATOMIC_RELAXED, __HIP_MEMORY_SCOPE_AGENT); }
__device__ __forceinline__ unsigned xb_xcc_id() { return (unsigned)__builtin_amdgcn_s_getreg((3 << 11) | 20) & 0xFu; }
#define XB_SPIN(cond, bar) do { unsigned _sp = 0; while (cond) { __builtin_amdgcn_s_sleep(1); \
    if ((++_sp & 255u) == 0u) { if (xb_ld(&(bar)[XB_TMO])) break; if (_sp > XB_SPIN_CAP) { atomicAdd(&(bar)[XB_TMO], 1u); break; } } } } while (0)
struct XcdBarrier { unsigned* bar; unsigned x; volatile LAS unsigned* st; };
__device__ __forceinline__ XcdBarrier xcd_barrier_post(unsigned* bar, volatile LAS unsigned* st, const bool leader) {
    XcdBarrier b; b.bar = bar; b.x = xb_xcc_id(); b.st = st;
    if (leader) (void)xb_add(&bar[XB_XCNT(b.x)], 1u);
    return b;
}
__device__ __forceinline__ void xcd_barrier_complete(unsigned* bar, unsigned x, unsigned& nloc, unsigned& nx) {
    const unsigned G = gridDim.x * gridDim.y * gridDim.z;
    unsigned sum, cnt, mine, sp = 0u;
    for (;;) {
        sum = 0u; cnt = 0u; mine = 0u;
#pragma unroll
        for (unsigned j = 0; j < 16; ++j) { const unsigned c = xb_ld(&bar[XB_XCNT(j)]); sum += c; cnt += (c > 0u) ? 1u : 0u; mine = (j == x) ? c : mine; }
        if (sum == G) break;
        __builtin_amdgcn_s_sleep(1);
        if ((++sp & 255u) == 0u) { if (xb_ld(&bar[XB_TMO])) break; if (sp > XB_SPIN_CAP) { atomicAdd(&bar[XB_TMO], 1u); break; } }
    }
    nloc = mine > 0u ? mine : 1u; nx = cnt > 0u ? cnt : 1u;
}
__device__ __forceinline__ void xcd_barrier(const XcdBarrier& b, const int w0) {
    asm volatile("s_waitcnt vmcnt(0)" ::: "memory");
    __syncthreads();
    if (tid_of(w0) == 0) {
        unsigned* bar = b.bar;
        __builtin_amdgcn_s_waitcnt(0);
        unsigned nloc = b.st[0], nx = b.st[1];
        if (nloc == 0u) { xcd_barrier_complete(bar, b.x, nloc, nx); b.st[0] = nloc; b.st[1] = nx; }
        const unsigned old = xb_add(&bar[XB_XSUB(b.x)], 1u);
        const unsigned gen = old / nloc;
        if (old + 1u == (gen + 1u) * nloc) {
            __builtin_amdgcn_fence(__ATOMIC_RELEASE, "agent");
            asm volatile("s_waitcnt vmcnt(0)" ::: "memory");
            const unsigned og = xb_add(&bar[XB_TOP], 1u);
            const unsigned tg = og / nx;
            if (og + 1u == (tg + 1u) * nx) xb_add(&bar[XB_TOPGEN], 1u);
            else XB_SPIN(xb_ld(&bar[XB_TOPGEN]) == tg, bar);
            __builtin_amdgcn_fence(__ATOMIC_ACQUIRE, "agent");
            xb_add(&bar[XB_XGEN(b.x)], 1u);
            asm volatile("s_waitcnt vmcnt(0)" ::: "memory");
        } else {
            XB_SPIN(xb_ld(&bar[XB_XGEN(b.x)]) == gen, bar);
            __builtin_amdgcn_fence(__ATOMIC_ACQUIRE, "agent");
            asm volatile("s_waitcnt vmcnt(0)" ::: "memory");
        }
    }
    __syncthreads();
}

namespace pg8 {
constexpr int BM = 256, BK = 64, HALF = 128, HTB = HALF * BK * 2, STAGE_BYTES = 8 * HTB;
__host__ __device__ __forceinline__ int lds_byte(int r, int c) { const int st = (r >> 4) * 2 + (c >> 5), rr = r & 15, cc = c & 31, ob = rr * 64 + cc * 2; return st * 1024 + (ob ^ (((ob >> 9) & 1) << 5)); }
__host__ __device__ __forceinline__ void stage_rc(int b, int& R, int& C) { const int st = b / 1024, sb = b % 1024, swz = sb ^ (((sb >> 9) & 1) << 5); R = (st >> 1) * 16 + swz / 64; C = (st & 1) * 32 + (swz % 64) / 2; }
__host__ __device__ __forceinline__ int perm32(int rho) { const int n = rho >> 4, i = rho & 15; return 8 * (i >> 2) + 4 * n + (i & 3); }

struct Unit { size_t b0, b1; int pm, pn, e, row0, rows, gt; };

template <bool ROPE, bool FP8, class Epi, class Sched>
__device__ __forceinline__ void gemm_phase(LAS unsigned char* lds, const char* Abase, const char* Bbase, const int K, const Sched& S, const Epi& E, const int w0) {
    const int tid = tid_of(w0);
    const int wid = w0, lane = tid & 63, wr = wid >> 2, wc = wid & 3, fr = lane & 15, fq = lane >> 4;
    const int Kb = FP8 ? K : 2 * K;
    int nt = Kb / 128; asm volatile("" : "+s"(nt));
    int R[2], C[2]; unsigned voffB[2];
#pragma unroll
    for (int i = 0; i < 2; ++i) { stage_rc(tid * 16 + i * 8192, R[i], C[i]);
        const int Rb = ROPE ? (64 * (R[i] >> 5) + perm32(R[i] & 31)) : ((R[i] & ~31) + perm32(R[i] & 31));
        voffB[i] = (unsigned)(Rb * Kb + C[i] * 2); }
    const size_t kstep = (size_t)(BK * 2);
    const unsigned ldsw = (unsigned)wid * 1024u;
    const int aoff = FP8 ? lds_byte(wr * 64 + fr, fq * 16) : lds_byte(wr * 64 + fr, fq * 8), boff = FP8 ? lds_byte(wc * 32 + fr, fq * 16) : lds_byte(wc * 32 + fr, fq * 8);
#define PG8_SA(b, h) (((b) * 2 + (h)) * HTB)
#define PG8_SB(b, h) ((4 + (b) * 2 + (h)) * HTB)
#define PG8_STG(bufoff, gbase, voff) do { _Pragma("unroll") for (int _i = 0; _i < 2; ++_i) \
        __builtin_amdgcn_global_load_lds((const unsigned*)((const char*)(gbase) + (voff)[_i]), (LAS unsigned*)(lds + (bufoff) + ldsw + _i * 8192), 16, 0, 0); } while (0)
#define PG8_LDA(dst, b, h) do { _Pragma("unroll") for (int m = 0; m < 4; ++m) { dst[m].lo = *(const LAS i32x4*)(lds + PG8_SA(b, h) + aoff + m * 2048); dst[m].hi = *(const LAS i32x4*)(lds + PG8_SA(b, h) + aoff + m * 2048 + (FP8 ? 16 : 1024)); } } while (0)
#define PG8_LDB(dst, b, h) do { _Pragma("unroll") for (int n = 0; n < 2; ++n) { dst[n].lo = *(const LAS i32x4*)(lds + PG8_SB(b, h) + boff + n * 2048); dst[n].hi = *(const LAS i32x4*)(lds + PG8_SB(b, h) + boff + n * 2048 + (FP8 ? 16 : 1024)); } } while (0)
#define PG8_MMA(ai, bj, At, Bt) do { __builtin_amdgcn_s_setprio(1); _Pragma("unroll") for (int m = 0; m < 4; ++m) _Pragma("unroll") for (int n = 0; n < 2; ++n) { \
        if constexpr (FP8) acc[ai][bj][m][n] = __builtin_amdgcn_mfma_scale_f32_16x16x128_f8f6f4(Bt[n], At[m], acc[ai][bj][m][n], 0, 0, 0, 0x7f7f7f7f, 0, 0x7f7f7f7f); \
        else { const i32x4 bl_ = Bt[n].lo, bh_ = Bt[n].hi, al_ = At[m].lo, ah_ = At[m].hi;        \
               acc[ai][bj][m][n] = __builtin_amdgcn_mfma_f32_16x16x32_f16(__builtin_bit_cast(f16x8, bl_), __builtin_bit_cast(f16x8, al_), acc[ai][bj][m][n], 0, 0, 0); \
               acc[ai][bj][m][n] = __builtin_amdgcn_mfma_f32_16x16x32_f16(__builtin_bit_cast(f16x8, bh_), __builtin_bit_cast(f16x8, ah_), acc[ai][bj][m][n], 0, 0, 0); } } \
        if constexpr (FP8) { _Pragma("unroll") for (int m = 0; m < 4; ++m) _Pragma("unroll") for (int n = 0; n < 2; ++n) asm volatile("" : "+v"(acc[ai][bj][m][n])); }     \
        __builtin_amdgcn_s_setprio(0); } while (0)
#define PG8_WAIT_V(n) asm volatile("s_waitcnt vmcnt(" #n ")" ::: "memory")
#define PG8_WAIT_L(n) asm volatile("s_waitcnt lgkmcnt(" #n ")" ::: "memory")
#define PG8_BAR __builtin_amdgcn_s_barrier()
#define PG8_SCHED __builtin_amdgcn_sched_barrier(0)
#define PG8_PIN do { if constexpr (FP8) __builtin_amdgcn_sched_barrier(0); } while (0)
    Unit cur, nxt; int ui = 0;
    if (!S.next(0, cur)) return;
    f32x4 acc[2][2][4][2];
#pragma unroll
    for (int a = 0; a < 2; ++a)
#pragma unroll
        for (int b = 0; b < 2; ++b)
#pragma unroll
            for (int m = 0; m < 4; ++m)
#pragma unroll
                for (int n = 0; n < 2; ++n) acc[a][b][m][n] = (f32x4){0.f, 0.f, 0.f, 0.f};
    i32x8 At[4], B0[2], B1[2];
    unsigned cvA[2][2], nvA[2][2];
    S.a_ready(cur, wid);
    S.avoff(cur, cvA, R, C);
    const char* cB0 = Bbase + cur.b0; const char* cB1 = Bbase + cur.b1;
    PG8_STG(PG8_SB(0, 0), cB0, voffB); PG8_STG(PG8_SB(0, 1), cB1, voffB); PG8_STG(PG8_SA(0, 0), Abase, cvA[0]); PG8_STG(PG8_SA(0, 1), Abase, cvA[1]);
    if (wr == 1) PG8_BAR;
    PG8_WAIT_V(2); PG8_BAR;
    PG8_STG(PG8_SB(1, 0), cB0 + kstep, voffB); PG8_STG(PG8_SA(1, 0), Abase + kstep, cvA[0]); PG8_STG(PG8_SB(1, 1), cB1 + kstep, voffB);
    PG8_WAIT_V(6); PG8_BAR;
    for (;;) {
        const bool has_next = S.next(ui + 1, nxt);
        if (has_next) S.avoff(nxt, nvA, R, C);
        else {
#pragma unroll
            for (int h = 0; h < 2; ++h)
#pragma unroll
                for (int i = 0; i < 2; ++i) nvA[h][i] = cvA[h][i];
        }
        const char* nB0 = has_next ? Bbase + nxt.b0 : cB0; const char* nB1 = has_next ? Bbase + nxt.b1 : cB1;
        for (int t = 0; t < nt; t += 2) {
            const bool last = (t == nt - 2);
            if (last && has_next) S.a_ready(nxt, wid);
            const char* a1 = Abase + (size_t)(t + 1) * kstep;
            const size_t k2 = last ? (size_t)0 : (size_t)(t + 2) * kstep;
            const char* a2 = Abase + k2; const char* a3 = a2 + kstep;
            const char* b20 = (last ? nB0 : cB0) + k2; const char* b21 = (last ? nB1 : cB1) + k2;
            const char* b30 = b20 + kstep; const char* b31 = b21 + kstep;
            unsigned vA2[2][2];
#pragma unroll
            for (int h = 0; h < 2; ++h)
#pragma unroll
                for (int i = 0; i < 2; ++i) vA2[h][i] = last ? nvA[h][i] : cvA[h][i];
            PG8_LDB(B0, 0, 0); PG8_LDB(B1, 0, 1); PG8_SCHED; PG8_LDA(At, 0, 0); PG8_STG(PG8_SA(1, 1), a1, cvA[1]);
            PG8_WAIT_V(8); PG8_WAIT_L(0); PG8_BAR; PG8_PIN; PG8_MMA(0, 0, At, B0); PG8_MMA(0, 1, At, B1); PG8_PIN; PG8_BAR; PG8_SCHED;
            PG8_LDA(At, 0, 1); PG8_STG(PG8_SB(0, 0), b20, voffB); PG8_STG(PG8_SB(0, 1), b21, voffB); PG8_STG(PG8_SA(0, 0), a2, vA2[0]);
            PG8_WAIT_V(8); PG8_WAIT_L(0); PG8_BAR; PG8_PIN; PG8_MMA(1, 0, At, B0); PG8_MMA(1, 1, At, B1); PG8_PIN; PG8_BAR; PG8_SCHED;
            PG8_LDB(B0, 1, 0); PG8_LDB(B1, 1, 1); PG8_SCHED; PG8_LDA(At, 1, 0); PG8_STG(PG8_SA(0, 1), a2, vA2[1]);
            PG8_WAIT_V(8); PG8_WAIT_L(0); PG8_BAR; PG8_PIN; PG8_MMA(0, 0, At, B0); PG8_MMA(0, 1, At, B1); PG8_PIN; PG8_BAR; PG8_SCHED;
            PG8_LDA(At, 1, 1); PG8_STG(PG8_SB(1, 0), b30, voffB); PG8_STG(PG8_SB(1, 1), b31, voffB); PG8_STG(PG8_SA(1, 0), a3, vA2[0]);
            PG8_WAIT_V(8); PG8_WAIT_L(0); PG8_BAR; PG8_PIN; PG8_MMA(1, 0, At, B0); PG8_MMA(1, 1, At, B1); PG8_PIN; PG8_BAR; PG8_SCHED;
        }
        if (wr == 0) PG8_BAR;
        E(acc, cur, wr, wc, fr, fq); S.done(cur, lane);
        if (!has_next) break;
#pragma unroll
        for (int a = 0; a < 2; ++a)
#pragma unroll
            for (int b = 0; b < 2; ++b)
#pragma unroll
                for (int m = 0; m < 4; ++m)
#pragma unroll
                    for (int n = 0; n < 2; ++n) acc[a][b][m][n] = (f32x4){0.f, 0.f, 0.f, 0.f};
        cur = nxt; cB0 = nB0; cB1 = nB1; ++ui;
#pragma unroll
        for (int h = 0; h < 2; ++h)
#pragma unroll
            for (int i = 0; i < 2; ++i) cvA[h][i] = nvA[h][i];
        if (wr == 1) PG8_BAR;
    }
    PG8_WAIT_V(0);
    PG8_BAR;
#undef PG8_SA
#undef PG8_SB
#undef PG8_STG
#undef PG8_LDA
#undef PG8_LDB
#undef PG8_MMA
#undef PG8_WAIT_V
#undef PG8_WAIT_L
#undef PG8_BAR
#undef PG8_SCHED
#undef PG8_PIN
}

struct DenseSched {
    int nM, nN, nwg, G, c, K; bool rope;
    __device__ __forceinline__ void init(int M, int N, int K_, int G_, int c_, bool rope_) { nM = M / BM; nN = N / BM; nwg = nM * nN; G = G_; c = c_; K = K_; rope = rope_; }
    __device__ __forceinline__ bool next(int i, Unit& u) const {
        const long L = (long)i * G + c; if (L >= nwg) return false;
        int wgid = (int)L; { const int q = nwg / 8, r = nwg % 8, xcd = wgid % 8, off = wgid / 8; wgid = (xcd < r ? xcd * (q + 1) : r * (q + 1) + (xcd - r) * q) + off; }
        const int WGM = 8, nig = WGM * nN, gid = wgid / nig, fm = gid * WGM, gsz = (nM - fm) < WGM ? (nM - fm) : WGM;
        u.pm = fm + ((wgid % nig) % gsz); u.pn = (wgid % nig) / gsz; u.e = 0; u.row0 = u.pm * BM; u.rows = BM;
        u.b0 = (size_t)(u.pn * BM) * K * 2; u.b1 = u.b0 + (size_t)(rope ? 32 : 128) * K * 2;
        return true;
    }
    __device__ __forceinline__ void avoff(const Unit& u, unsigned (&vo)[2][2], const int (&R)[2], const int (&C)[2]) const {
#pragma unroll
        for (int h = 0; h < 2; ++h)
#pragma unroll
            for (int i = 0; i < 2; ++i) vo[h][i] = (unsigned)((u.row0 + 128 * h + R[i]) * K + C[i]) * 2u;
    }
    __device__ __forceinline__ void a_ready(const Unit&, int) const {}
    __device__ __forceinline__ void done(const Unit&, int) const {}
};
struct MoeSched {
    const LAS int* tab; int G, cv, K; bool gather; const int* list; unsigned* mtc;
    __device__ __forceinline__ bool next(int i, Unit& u) const {
        const int L = i * G + cv; if (L >= tab[32]) return false;
        int e = 0;
#pragma unroll 1
        for (int k = 1; k < 32; ++k) if (tab[k] <= L) e = k;
        const int local = L - tab[e]; u.e = e; u.pm = local >> 2; u.pn = local & 3; u.gt = (tab[e] >> 2) + u.pm;
        const int cnt = tab[80 + e]; u.rows = min(256, cnt - u.pm * 256); u.row0 = tab[40 + e] + u.pm * 256;
        constexpr size_t EB = MOE8 ? 1 : 2;
        if (gather) { u.b0 = ((size_t)e * 512 + 128 * u.pn) * 1024 * EB; u.b1 = u.b0 + (WS_W3 - WS_W1); }
        else        { u.b0 = ((size_t)e * 1024 + 256 * u.pn) * 512 * EB; u.b1 = u.b0 + (size_t)128 * 512 * EB; }
        return true;
    }
    __device__ __forceinline__ void avoff(const Unit& u, unsigned (&vo)[2][2], const int (&R)[2], const int (&C)[2]) const {
#pragma unroll
        for (int h = 0; h < 2; ++h)
#pragma unroll
            for (int i = 0; i < 2; ++i) {
                if (gather) { int r = 128 * h + R[i]; r = r < u.rows ? r : u.rows - 1; const int tok = list[2 * ((size_t)u.e * LISTCAP + u.pm * 256 + r)];
                    vo[h][i] = MOE8 ? (unsigned)(tok * 1024 + C[i] * 2) : (unsigned)(tok * 1024 + C[i]) * 2u; }
                else vo[h][i] = MOE8 ? (unsigned)((u.row0 + 128 * h + R[i]) * 512 + C[i] * 2) : (unsigned)((u.row0 + 128 * h + R[i]) * 512 + C[i]) * 2u;
            }
    }
    __device__ __forceinline__ void a_ready(const Unit& u, int wid) const {
        if (gather) return;
        if (wid == 0) { unsigned sp = 0;
            while ((unsigned)__builtin_amdgcn_readfirstlane(__hip_atomic_load(mtc + 64 * u.gt, __ATOMIC_RELAXED, __HIP_MEMORY_SCOPE_AGENT)) < 32u) { __builtin_amdgcn_s_sleep(2); if (++sp > (1u << 22)) break; }
            __builtin_amdgcn_fence(__ATOMIC_ACQUIRE, "agent");
            asm volatile("s_waitcnt vmcnt(0)" ::: "memory"); }
        asm volatile("" ::: "memory"); __builtin_amdgcn_s_barrier(); asm volatile("" ::: "memory");
    }
    __device__ __forceinline__ void done(const Unit& u, int lane) const {
        if (!gather) return;
        asm volatile("s_waitcnt vmcnt(0)" ::: "memory");
        if (lane == 0) __hip_atomic_fetch_add(mtc + 64 * u.gt, 1u, __ATOMIC_RELAXED, __HIP_MEMORY_SCOPE_AGENT);
    }
};

struct EpiProj {
    f16* proj; const float* cosT; const float* sinT; float* ksum;
    __device__ __forceinline__ void operator()(const f32x4 (&acc)[2][2][4][2], const Unit& u, int wr, int wc, int fr, int fq) const {
        const int tile = u.pn, row0 = u.row0 + wr * 64 + fr, col0 = tile * 256 + 64 * wc + 8 * fq;
        if (tile < 4) {
            const float sc = tile < 2 ? C2 : 1.f;
            float ks[2][8];
#pragma unroll
            for (int bj = 0; bj < 2; ++bj)
#pragma unroll
                for (int j = 0; j < 8; ++j) ks[bj][j] = 0.f;
#pragma unroll
            for (int ai = 0; ai < 2; ++ai)
#pragma unroll
                for (int m = 0; m < 4; ++m) {
                    const int row = row0 + ai * HALF + m * 16;
                    const f32x4 c0 = *(const f32x4*)(cosT + (size_t)row * 32 + 8 * fq), c1 = *(const f32x4*)(cosT + (size_t)row * 32 + 8 * fq + 4);
                    const f32x4 s0 = *(const f32x4*)(sinT + (size_t)row * 32 + 8 * fq), s1 = *(const f32x4*)(sinT + (size_t)row * 32 + 8 * fq + 4);
                    const f32x4 a0 = acc[ai][0][m][0], a1 = acc[ai][0][m][1], b0 = acc[ai][1][m][0], b1 = acc[ai][1][m][1];
                    const f32x4 o10 = (a0 * c0 - b0 * s0) * sc, o11 = (a1 * c1 - b1 * s1) * sc;
                    const f32x4 o20 = (b0 * c0 + a0 * s0) * sc, o21 = (b1 * c1 + a1 * s1) * sc;
                    u32x4 w1, w2;
                    w1.x = pk2h(o10[0], o10[1]); w1.y = pk2h(o10[2], o10[3]); w1.z = pk2h(o11[0], o11[1]); w1.w = pk2h(o11[2], o11[3]);
                    w2.x = pk2h(o20[0], o20[1]); w2.y = pk2h(o20[2], o20[3]); w2.z = pk2h(o21[0], o21[1]); w2.w = pk2h(o21[2], o21[3]);
                    f16* rp = proj + (size_t)row * NPROJ + col0;
                    *(u32x4*)rp = w1; *(u32x4*)(rp + 32) = w2;
                    if (tile >= 2) {
#pragma unroll
                        for (int j = 0; j < 4; ++j) { ks[0][j] += o10[j]; ks[0][4 + j] += o11[j]; ks[1][j] += o20[j]; ks[1][4 + j] += o21[j]; }
                    }
                }
            if (tile >= 2) {
                const int b = u.pm >> 4, blk = u.pm & 15, head = (tile - 2) * 4 + wc;
                float* kp = ksum + ((size_t)((b * 8 + head) * 16 + blk)) * 64 + 8 * fq;
#pragma unroll
                for (int bj = 0; bj < 2; ++bj)
#pragma unroll
                    for (int j = 0; j < 8; ++j) { float v = ks[bj][j]; v = xsum<1>(v); v = xsum<2>(v); v = xsum<4>(v); v = xsum<8>(v);
                        if (fr == 0) atomicAdd(kp + 32 * bj + j, v); }
            }
        } else {
#pragma unroll
            for (int ai = 0; ai < 2; ++ai)
#pragma unroll
                for (int m = 0; m < 4; ++m) {
                    f16* rp = proj + (size_t)(row0 + ai * HALF + m * 16) * NPROJ + col0;
#pragma unroll
                    for (int bj = 0; bj < 2; ++bj) { const f32x4 v0 = acc[ai][bj][m][0], v1 = acc[ai][bj][m][1]; u32x4 w;
                        w.x = pk2h(v0[0], v0[1]); w.y = pk2h(v0[2], v0[3]); w.z = pk2h(v1[0], v1[1]); w.w = pk2h(v1[2], v1[3]);
                        *(u32x4*)(rp + 32 * bj) = w; }
                }
        }
    }
};
struct EpiOut {
    const float* x; const float* mod; f16* x1; float* ssb;
    __device__ __forceinline__ void operator()(const f32x4 (&acc)[2][2][4][2], const Unit& u, int wr, int wc, int fr, int fq) const {
        const int row0 = u.row0 + wr * 64 + fr, col0 = u.pn * BM + wc * 32 + 8 * fq, b = u.row0 / SEQ;
        const float* g1 = mod + (size_t)b * 6144 + 2048;
        float sq[2][4] = {{0.f, 0.f, 0.f, 0.f}, {0.f, 0.f, 0.f, 0.f}};
#pragma unroll
        for (int bj = 0; bj < 2; ++bj) {
            const f32x4 g0 = *(const f32x4*)(g1 + col0 + bj * HALF), gg1 = *(const f32x4*)(g1 + col0 + bj * HALF + 4);
#pragma unroll
            for (int ai = 0; ai < 2; ++ai)
#pragma unroll
                for (int m = 0; m < 4; ++m) { const int row = row0 + ai * HALF + m * 16; const size_t off = (size_t)row * DM + col0 + bj * HALF;
                    const f32x4 x0 = *(const GAS f32x4*)(x + off), xx1 = *(const GAS f32x4*)(x + off + 4);
                    const f32x4 v0 = x0 + g0 * acc[ai][bj][m][0], v1 = xx1 + gg1 * acc[ai][bj][m][1];
                    u32x4 w; w.x = pk2h(v0[0], v0[1]); w.y = pk2h(v0[2], v0[3]); w.z = pk2h(v1[0], v1[1]); w.w = pk2h(v1[2], v1[3]);
                    *(u32x4*)(x1 + (size_t)row * 2048 + col0 + bj * HALF) = w;
                    sq[ai][m] += (v0[0] * v0[0] + v0[1] * v0[1]) + (v0[2] * v0[2] + v0[3] * v0[3]) + (v1[0] * v1[0] + v1[1] * v1[1]) + (v1[2] * v1[2] + v1[3] * v1[3]); }
        }
#pragma unroll
        for (int ai = 0; ai < 2; ++ai)
#pragma unroll
            for (int m = 0; m < 4; ++m) { float q = sq[ai][m]; q = xsum<16>(q); q = xsum<32>(q);
                if (fq == 0) ssb[(size_t)(row0 + ai * HALF + m * 16) * 16 + u.pn * 4 + wc] = q; }
    }
};
struct EpiMoe1 {
    unsigned char* H;
    __device__ __forceinline__ void operator()(const f32x4 (&acc)[2][2][4][2], const Unit& u, int wr, int wc, int fr, int fq) const {
        const int r0 = wr * 64 + fr, col0 = u.pn * 128 + wc * 32 + 8 * fq;
        const __amdgpu_buffer_rsrc_t rs = __builtin_amdgcn_make_buffer_rsrc(H, (short)0, 0x7fffffff, 0x00020000);
#pragma unroll
        for (int ai = 0; ai < 2; ++ai)
#pragma unroll
            for (int m = 0; m < 4; ++m) { const int r = r0 + ai * HALF + m * 16;
                float o[8];
#pragma unroll
                for (int n = 0; n < 2; ++n)
#pragma unroll
                    for (int j = 0; j < 4; ++j) { const float a = acc[ai][0][m][n][j] * (1.f / W8SCALE), bb = acc[ai][1][m][n][j] * (1.f / W8SCALE); o[4 * n + j] = a * __builtin_amdgcn_rcpf(1.f + __expf(-a)) * bb; }
                if (r < u.rows) {
                    if constexpr (MOE8) __builtin_amdgcn_raw_buffer_store_b64(pk8_fp8(o), rs, (int)((u.row0 + r) * DEXP + col0), 0, 16);
                    else { u32x4 w; w.x = pk2h(o[0], o[1]); w.y = pk2h(o[2], o[3]); w.z = pk2h(o[4], o[5]); w.w = pk2h(o[6], o[7]); __builtin_amdgcn_raw_buffer_store_b128(w, rs, (int)(((u.row0 + r) * DEXP + col0) * 2), 0, 16); } } }
    }
};
struct EpiMoe2 {
    unsigned char* Y; const int* list;
    __device__ __forceinline__ void operator()(const f32x4 (&acc)[2][2][4][2], const Unit& u, int wr, int wc, int fr, int fq) const {
        const int r0 = wr * 64 + fr, col0 = u.pn * BM + wc * 32 + 8 * fq;
#pragma unroll
        for (int ai = 0; ai < 2; ++ai)
#pragma unroll
            for (int m = 0; m < 4; ++m) { const int r = r0 + ai * HALF + m * 16;
                if (r < u.rows) {
                    const float w = __int_as_float(list[2 * ((size_t)u.e * LISTCAP + u.pm * 256 + r) + 1]) * (1.f / W8SCALE);
#pragma unroll
                    for (int bj = 0; bj < 2; ++bj) { const f32x4 v0 = acc[ai][bj][m][0] * w, v1 = acc[ai][bj][m][1] * w;
                        const float o8[8] = {v0[0], v0[1], v0[2], v0[3], v1[0], v1[1], v1[2], v1[3]};
                        *(u32x2*)(Y + (size_t)(u.row0 + r) * DM + col0 + bj * HALF) = pk8_fp8(o8); }
                } }
    }
};
}


namespace moba {
using s16x8=__attribute__((ext_vector_type(8)))short;
using s16x4=__attribute__((ext_vector_type(4)))short;
using f32x16=__attribute__((ext_vector_type(16)))float;
constexpr int D=64, PITCH=NPROJ, OPITCH=DM;
constexpr int NW=8,QBLK=32,QB=QBLK*NW,KVBLK=64;
__device__ __forceinline__ int crow(int r,int hi){return (r&3)+8*(r>>2)+4*hi;}
#define SBAR() __builtin_amdgcn_sched_barrier(0)
#define MF32(a,b,c) __builtin_amdgcn_mfma_f32_32x32x16_f16(__builtin_bit_cast(f16x8,(a)),__builtin_bit_cast(f16x8,(b)),(c),0,0,0)
__device__ __forceinline__ void cmask(f32x16&p0,f32x16&p1,int jb,int qrel,int hi){
  const float NEG=-INFINITY; int kb=64*jb+4*hi;
  #pragma unroll
  for(int r=0;r<16;++r){int kv=kb+(r&3)+8*(r>>2); if(kv>qrel)p0[r]=NEG; if(kv+32>qrel)p1[r]=NEG;}
}
constexpr int NSLOT=4, SLOTB=8192;
constexpr int LDS_K=0, LDS_V=NSLOT*SLOTB, LDS_WS=2*NSLOT*SLOTB, LDS_OST=LDS_WS+NW*64*4, LDS_SEL=LDS_OST+NW*4096, LDS_KS=LDS_SEL+1024, LDS_BYTES_A=LDS_KS+4096;
__device__ __forceinline__ void glds16(const void*gsrc,unsigned lds_dst){unsigned keep;
  asm volatile("s_mov_b32 %0, m0\n\ts_mov_b32 m0, %2\n\ts_nop 0\n\tglobal_load_lds_dwordx4 %1, off\n\ts_mov_b32 m0, %0":"=&s"(keep):"v"(gsrc),"s"(lds_dst):"memory");}
__device__ __forceinline__ float max3f(float a,float b,float c){float r;asm("v_max3_f32 %0, %1, %2, %3":"=v"(r):"v"(a),"v"(b),"v"(c));return r;}
__device__ __forceinline__ float max2f(float a,float b){float r;asm("v_max_f32_e32 %0, %1, %2":"=v"(r):"v"(a),"v"(b));return r;}
__device__ __forceinline__ float fadd_s(float a,float b){float r;asm("v_add_f32_e32 %0, %1, %2":"=v"(r):"v"(a),"v"(b));return r;}
__device__ __forceinline__ float fsub_s(float a,float b){float r;asm("v_sub_f32_e32 %0, %1, %2":"=v"(r):"v"(a),"v"(b));return r;}
__device__ __forceinline__ unsigned cvtpk_s(float lo,float hi){return __builtin_bit_cast(unsigned,__builtin_amdgcn_cvt_pkrtz(lo,hi));}
#define WAIT_BAR(N) asm volatile("s_waitcnt vmcnt(" #N ") lgkmcnt(0)\n\ts_barrier":::"memory")
typedef __attribute__((address_space(3))) const char* lds_cptr;
__device__ __forceinline__ void qkt(f32x16&p0,f32x16&p1,lds_cptr kb,const s16x8*qr,const f32x16&negm){
  #pragma unroll
  for(int d0=0;d0<4;++d0){
    const s16x8 b0=*(const __attribute__((address_space(3))) s16x8*)(kb+d0*2048);
    const s16x8 b1=*(const __attribute__((address_space(3))) s16x8*)(kb+d0*2048+512);
    if(d0==0){p0=MF32(b0,qr[0],negm);p1=MF32(b1,qr[0],negm);}
    else{p0=MF32(b0,qr[d0],p0);p1=MF32(b1,qr[d0],p1);}}
}
typedef short v4i16_t __attribute__((ext_vector_type(4)));
__device__ __forceinline__ void kload8(s16x8*kf,lds_cptr kp){
  kf[0]=*(const __attribute__((address_space(3))) s16x8*)(kp);      kf[1]=*(const __attribute__((address_space(3))) s16x8*)(kp+512);
  kf[2]=*(const __attribute__((address_space(3))) s16x8*)(kp+2048); kf[3]=*(const __attribute__((address_space(3))) s16x8*)(kp+2560);
  kf[4]=*(const __attribute__((address_space(3))) s16x8*)(kp+4096); kf[5]=*(const __attribute__((address_space(3))) s16x8*)(kp+4608);
  kf[6]=*(const __attribute__((address_space(3))) s16x8*)(kp+6144); kf[7]=*(const __attribute__((address_space(3))) s16x8*)(kp+6656);
}
__device__ __forceinline__ void kload2(s16x8*kf,lds_cptr kp,int j){ kf[2*j]=*(const __attribute__((address_space(3))) s16x8*)(kp+j*2048); kf[2*j+1]=*(const __attribute__((address_space(3))) s16x8*)(kp+j*2048+512); }
__device__ __forceinline__ s16x4 vtr(lds_cptr p){ return __builtin_bit_cast(s16x4,__builtin_amdgcn_ds_read_tr16_b64_v4i16((__attribute__((address_space(3))) v4i16_t*)p)); }
__device__ __forceinline__ float rowmax(const f32x16&p0,const f32x16&p1){
  float a=max3f(p0[0],p0[1],p1[0]),b=max3f(p0[2],p0[3],p1[1]);a=max3f(a,p1[2],p1[3]);
  #pragma unroll
  for(int r=4;r<16;r+=4){a=max3f(a,p0[r],p0[r+1]);b=max3f(b,p0[r+2],p0[r+3]);a=max3f(a,p1[r],p1[r+1]);b=max3f(b,p1[r+2],p1[r+3]);}
  const float m=max2f(a,b);
  auto rr=__builtin_amdgcn_permlane32_swap(__float_as_uint(m),__float_as_uint(m),false,false);
  return max2f(__uint_as_float(rr[0]),__uint_as_float(rr[1]));
}
__device__ __forceinline__ void pv(f32x16*o,int vb,s16x8 pa0,s16x8 pa1,s16x8 pa2,s16x8 pa3){
  #pragma unroll
  for(int d0=0;d0<2;++d0){s16x4 lo[4],hi[4];
    #pragma unroll
    for(int ks=0;ks<4;++ks){
      asm volatile("ds_read_b64_tr_b16 %0,%1 offset:%c2":"=&v"(lo[ks]):"v"(vb),"i"(d0*4096+ks*1024):"memory");
      asm volatile("ds_read_b64_tr_b16 %0,%1 offset:%c2":"=&v"(hi[ks]):"v"(vb),"i"(d0*4096+ks*1024+512):"memory");}
    asm volatile("s_waitcnt lgkmcnt(0)":::"memory");SBAR();
    #define PK(k) (s16x8){lo[k][0],lo[k][1],lo[k][2],lo[k][3],hi[k][0],hi[k][1],hi[k][2],hi[k][3]}
    o[d0]=MF32(pa0,PK(0),o[d0]);
    o[d0]=MF32(pa1,PK(1),o[d0]);
    o[d0]=MF32(pa2,PK(2),o[d0]);
    o[d0]=MF32(pa3,PK(3),o[d0]);
    #undef PK
  }
}
__device__ __forceinline__ void sel_list(int b,int h,int qb,const f16*Q,const float*ksum,int*alist,unsigned*acnt,char*shm,const int w0,unsigned*pend){
  const int tid=tid_of(w0);
  const int row=tid>>1, half=tid&1, bh=b*8+h;
  unsigned sel=0u;
  LAS unsigned*hist=(LAS unsigned*)(shm+LDS_SEL);
  {
    float*ks=(float*)(shm+LDS_KS);
    if(tid<256)*(f32x4*)(ks+4*tid)=*(const f32x4*)(ksum+(size_t)(bh*16)*64+4*tid);
    if(tid<32)hist[tid]=0u;
    float qf[32];
    { const f16x8*qp=(const f16x8*)(Q+((long)b*SEQ+qb*QB+row)*PITCH+h*D+32*half);
      #pragma unroll
      for(int i=0;i<4;++i){ const f16x8 t=qp[i];
        #pragma unroll
        for(int j=0;j<8;++j)qf[8*i+j]=(float)t[j]; } }
    asm volatile("s_waitcnt lgkmcnt(0)\n\ts_barrier":::"memory");
    float g[15];
    const float*kp=ks+32*half;
    #pragma unroll
    for(int n=0;n<15;++n){ float s=0.f;
      if(n<qb){
        #pragma unroll
        for(int i=0;i<8;++i){ const f32x4 k4=*(const f32x4*)(kp+n*64+4*i); s+=qf[4*i]*k4[0]+qf[4*i+1]*k4[1]+qf[4*i+2]*k4[2]+qf[4*i+3]*k4[3]; }
        s = xsum<1>(s); }
      g[n]=(n<qb)?s:-INFINITY; }
    #pragma unroll
    for(int r=0;r<3;++r){ float best=-INFINITY; int bi=-1;
      #pragma unroll
      for(int n=0;n<15;++n){ const bool ok=!((sel>>n)&1u)&&g[n]>best; best=ok?g[n]:best; bi=ok?n:bi; }
      if(bi>=0)sel|=1u<<bi; } }
  int n0=-1,n1=-1,n2=-1; unsigned r0=0u,r1=0u,r2=0u;
  if(half==0){ unsigned s_=sel;
    if(s_){ n0=__builtin_ctz(s_); s_&=s_-1u; r0=__hip_atomic_fetch_add(hist+n0,1u,__ATOMIC_RELAXED,__HIP_MEMORY_SCOPE_WORKGROUP); }
    if(s_){ n1=__builtin_ctz(s_); s_&=s_-1u; r1=__hip_atomic_fetch_add(hist+n1,1u,__ATOMIC_RELAXED,__HIP_MEMORY_SCOPE_WORKGROUP); }
    if(s_){ n2=__builtin_ctz(s_);            r2=__hip_atomic_fetch_add(hist+n2,1u,__ATOMIC_RELAXED,__HIP_MEMORY_SCOPE_WORKGROUP); } }
  asm volatile("s_waitcnt vmcnt(0) lgkmcnt(0)\n\ts_barrier":::"memory");
  if(pend!=nullptr&&tid==0)__hip_atomic_fetch_add(pend,1u,__ATOMIC_RELAXED,__HIP_MEMORY_SCOPE_AGENT);
  if(tid<qb)hist[16+tid]=__hip_atomic_fetch_add(acnt+bh*16+tid,hist[tid],__ATOMIC_RELAXED,__HIP_MEMORY_SCOPE_AGENT);
  asm volatile("s_waitcnt vmcnt(0) lgkmcnt(0)\n\ts_barrier":::"memory");
  if(half==0){ const unsigned rv=(unsigned)(qb*QB+row);
    if(n0>=0)__hip_atomic_store((unsigned*)alist+(size_t)(bh*16+n0)*4096+hist[16+n0]+r0,rv,           __ATOMIC_RELAXED,__HIP_MEMORY_SCOPE_AGENT);
    if(n1>=0)__hip_atomic_store((unsigned*)alist+(size_t)(bh*16+n1)*4096+hist[16+n1]+r1,rv|(1u<<12),__ATOMIC_RELAXED,__HIP_MEMORY_SCOPE_AGENT);
    if(n2>=0)__hip_atomic_store((unsigned*)alist+(size_t)(bh*16+n2)*4096+hist[16+n2]+r2,rv|(2u<<12),__ATOMIC_RELAXED,__HIP_MEMORY_SCOPE_AGENT); }
}
template<int THRL,int MODE> __device__ __forceinline__ void attn_pass(int b,int h,int kb,int r0,int r1,int npk,const int*alist,const f16*Q,const f16*__restrict__ K,const f16*__restrict__ V,f16*O,f16*part,float*lseb,const float*gain,char*shm,const int w0,unsigned*pend){
  __builtin_assume((unsigned)w0<8u);
  const int tid=tid_of(w0),lane=tid&63,r32=lane&31,hi=lane>>5; const int wid=w0;
  const long rowbase=(long)b*SEQ; const int q0=kb*QB;
  const unsigned lds0=(unsigned)(uintptr_t)shm;
  float*wsf=(float*)(shm+LDS_WS)+wid*64;
  int*entl=(int*)(shm+LDS_KS)+wid*128;
  const int ngrp=(MODE==1)?((r1-r0+31)>>5):8;
  {
    const f16*kptr=K+rowbase*PITCH+h*D+(long)lane*PITCH+wid*8+(long)(4*kb)*KVBLK*PITCH;
    const f16*vptr=V+rowbase*PITCH+h*D+(long)(16*(wid&3)+(lane>>2))*PITCH+(wid>>2)*32+(lane&3)*8+(long)(4*kb)*KVBLK*PITCH;
    const unsigned kdst=lds0+LDS_K+wid*1024, vdst=lds0+LDS_V+wid*1024;
    #pragma unroll
    for(int t=0;t<4;++t){ glds16(kptr,(unsigned)__builtin_amdgcn_readfirstlane(kdst+t*SLOTB)); glds16(vptr,(unsigned)__builtin_amdgcn_readfirstlane(vdst+t*SLOTB)); kptr+=(long)KVBLK*PITCH; vptr+=(long)KVBLK*PITCH; } }
  if(MODE==1){
    #pragma unroll
    for(int gi=0;gi<4;++gi){ if(hi==0){ int idx=r0+32*(wid+8*gi)+r32; const bool ok=idx<r1; idx=ok?idx:r0;
        int e=alist[(size_t)((b*8+h)*16+kb)*4096+idx]&0x3fff; if(!ok)e|=(int)0x80000000; entl[gi*32+r32]=e; } }
    asm volatile("s_waitcnt lgkmcnt(0)":::"memory"); }
  const int vb0=(int)(lds0+LDS_V)+((lane>>4)&1)*32+(lane&3)*8+(4*hi+((lane&15)>>2))*64;
  s16x8 kf[8];
  const lds_cptr shm3=(lds_cptr)shm; const lds_cptr kp0=shm3+LDS_K+hi*1024+r32*16; const lds_cptr vp0=shm3+LDS_V+((lane>>4)&1)*32+(lane&3)*8+(4*hi+((lane&15)>>2))*64;
  s16x8 qr[4];
  #define LOADQ(gi_) do{ const f16*Qrow_; \
    if(MODE==1){ const int e_=entl[(gi_)*32+r32]; Qrow_=Q+(rowbase+(e_&4095))*PITCH+h*D; } else Qrow_=Q+(rowbase+q0+wid*QBLK+r32)*PITCH+h*D; \
    _Pragma("unroll") for(int d0=0;d0<4;++d0)qr[d0]=*reinterpret_cast<const s16x8*>(&Qrow_[d0*16+hi*8]); }while(0)
  int g=wid, gi=0;
  if(g<ngrp)LOADQ(0);
  asm volatile("s_waitcnt vmcnt(0)\n\ts_barrier":::"memory");
  if(pend!=nullptr&&tid==0)__hip_atomic_fetch_add(pend,1u,__ATOMIC_RELAXED,__HIP_MEMORY_SCOPE_AGENT);
  const int qrel=wid*QBLK+r32;
  #define CMASK(P0,P1,t) do{ if(MODE==0)cmask(P0,P1,(t),qrel,hi); }while(0)
  for(;g<ngrp;g+=8,++gi){
  float mhat=0.f,l_reg=0.f;f32x16 o[2];o[0]=f32x16{};o[1]=f32x16{};f32x16 negm=f32x16{};asm volatile("":"+v"(negm));
  bool resc=false;
  #define START(P0,P1) do{ const float rm=rowmax(P0,P1); resc=false; \
    { const float dl=rm; mhat=fadd_s(mhat,dl); \
      _Pragma("unroll") for(int r=0;r<16;++r){P0[r]=fsub_s(P0[r],dl);P1[r]=fsub_s(P1[r],dl);} \
      _Pragma("unroll") for(int r=0;r<16;++r)negm[r]=-mhat; asm volatile("":"+v"(negm)); } \
    _Pragma("unroll") for(int r=0;r<16;++r)P0[r]=__builtin_amdgcn_exp2f(P0[r]); }while(0)
  #define RESC() do{ if(resc){ asm volatile("s_waitcnt lgkmcnt(0)":::"memory"); \
      _Pragma("unroll") for(int d_=0;d_<2;++d_) _Pragma("unroll") for(int r=0;r<16;++r)o[d_][r]*=wsf[crow(r,hi)]; } }while(0)
  f32x16 pA0,pA1,pB0,pB1;
  int sl_prev=0,sl_cur=0,sl_next=SLOTB;
  #define ROT() do{sl_prev=sl_cur;sl_cur=sl_next;sl_next=(sl_next==(NSLOT-1)*SLOTB)?0:sl_next+SLOTB;}while(0)
  qkt(pA0,pA1,kp0,qr,negm);asm volatile("s_nop 15\n\ts_nop 7":"+v"(pA0),"+v"(pA1));CMASK(pA0,pA1,0);
  START(pA0,pA1);
  _Pragma("unroll") for(int r=0;r<16;++r)pA1[r]=__builtin_amdgcn_exp2f(pA1[r]);
  ROT();
  kload8(kf,kp0+sl_cur);
  s16x4 vlo[8],vhi[8]; u32x4 pw0,pw1,pw2,pw3;
  #define PKW(P,B) cvtpk_s(P[B],P[B+1])
  #define PAF(k) __builtin_bit_cast(s16x8,pw##k)
  #define VFR(i) (s16x8){vlo[i][0],vlo[i][1],vlo[i][2],vlo[i][3],vhi[i][0],vhi[i][1],vhi[i][2],vhi[i][3]}
  #define PIN(x) asm volatile("":"+v"(x))
  #define MX3(a,b,c) __builtin_fmaxf(__builtin_fmaxf((a),(b)),(c))
  #define GAPA(MF,A0,A1,A2,A3,W0,W1,PW) do{ MF; sacc+=A0; sacc+=A1; sacc+=A2; sacc+=A3; PIN(sacc); W0; W1; PIN(PW); SBAR(); }while(0)
  #define EX(v) __builtin_amdgcn_exp2f(v)
  #define GAPB(MF,X,B) do{ MF; X[B]=EX(X[B]); X[B+1]=EX(X[B+1]); X[B+2]=EX(X[B+2]); X[B+3]=EX(X[B+3]); PIN(X); SBAR(); }while(0)
  #define VRD(i) do{ vlo[i]=vtr(vp_+(((i)>>2)*4096+((i)&3)*1024)); vhi[i]=vtr(vp_+(((i)>>2)*4096+((i)&3)*1024+512)); }while(0)
  #define KRD(G,j) do{ if(G){ kload2(kf,kp0+sl_next,j); SBAR(); } }while(0)
  #define STEP(C0,C1,P0,P1,t,GL) do{ SBAR(); \
    const lds_cptr vp_=vp0+sl_prev; \
    VRD(0); SBAR(); float sacc=(P0[0]+P0[1]); \
    GAPA(C0=MF32(kf[0],qr[0],negm), P0[2],P0[3],P0[4],P0[5],     pw0[0]=PKW(P0,0), pw0[1]=PKW(P0,2), pw0); \
    VRD(4); SBAR(); GAPA(C1=MF32(kf[1],qr[0],negm), P0[6],P0[7],P0[8],P0[9],     pw0[2]=PKW(P0,4), pw0[3]=PKW(P0,6), pw0); \
    VRD(1); SBAR(); GAPA(C0=MF32(kf[2],qr[1],C0),   P0[10],P0[11],P0[12],P0[13], pw1[0]=PKW(P0,8), pw1[1]=PKW(P0,10), pw1); \
    VRD(5); SBAR(); GAPA(C1=MF32(kf[3],qr[1],C1),   P0[14],P0[15],P1[0],P1[1],   pw1[2]=PKW(P0,12),pw1[3]=PKW(P0,14), pw1); \
    VRD(2); SBAR(); GAPA(C0=MF32(kf[4],qr[2],C0),   P1[2],P1[3],P1[4],P1[5],     pw2[0]=PKW(P1,0), pw2[1]=PKW(P1,2), pw2); \
    VRD(6); SBAR(); GAPA(C1=MF32(kf[5],qr[2],C1),   P1[6],P1[7],P1[8],P1[9],     pw2[2]=PKW(P1,4), pw2[3]=PKW(P1,6), pw2); \
    VRD(3); SBAR(); GAPA(C0=MF32(kf[6],qr[3],C0),   P1[10],P1[11],P1[12],P1[13], pw3[0]=PKW(P1,8), pw3[1]=PKW(P1,10), pw3); \
    VRD(7); SBAR(); GAPA(C1=MF32(kf[7],qr[3],C1),   P1[14],P1[15],0.f,0.f,       pw3[2]=PKW(P1,12),pw3[3]=PKW(P1,14), pw3); \
    l_reg+=sacc; \
    CMASK(C0,C1,t); \
    { float a=MX3(C0[0],C0[1],C1[0]),b=MX3(C0[2],C0[3],C1[1]); a=MX3(a,C1[2],C1[3]); \
      _Pragma("unroll") for(int r=4;r<16;r+=4){a=MX3(a,C0[r],C0[r+1]);b=MX3(b,C0[r+2],C0[r+3]);a=MX3(a,C1[r],C1[r+1]);b=MX3(b,C1[r+2],C1[r+3]);} \
      float rm=__builtin_fmaxf(a,b); { auto rr=__builtin_amdgcn_permlane32_swap(__float_as_uint(rm),__float_as_uint(rm),false,false); rm=__builtin_fmaxf(__uint_as_float(rr[0]),__uint_as_float(rr[1])); } \
      resc=false; \
      if(__builtin_expect(__any(rm>(float)THRL),0)){ const float dl=__builtin_fmaxf(rm,0.f); mhat+=dl; \
        _Pragma("unroll") for(int r=0;r<16;++r){C0[r]-=dl;C1[r]-=dl;} \
        { const float nv_=-mhat; _Pragma("unroll") for(int r=0;r<16;++r)negm[r]=nv_; } asm volatile("":"+v"(negm)); \
        const float f=__builtin_amdgcn_exp2f(-dl); l_reg*=f; if(hi==0)wsf[r32]=f; resc=true; } } \
    SBAR(); \
    GAPB(o[0]=MF32(PAF(0),VFR(0),o[0]), C0,0); \
    GAPB(o[1]=MF32(PAF(0),VFR(4),o[1]), C0,4); \
    KRD(GL,0); GAPB(o[0]=MF32(PAF(1),VFR(1),o[0]), C0,8); \
    KRD(GL,1); GAPB(o[1]=MF32(PAF(1),VFR(5),o[1]), C0,12); \
    KRD(GL,2); GAPB(o[0]=MF32(PAF(2),VFR(2),o[0]), C1,0); \
    KRD(GL,3); GAPB(o[1]=MF32(PAF(2),VFR(6),o[1]), C1,4); \
    GAPB(o[0]=MF32(PAF(3),VFR(3),o[0]), C1,8); \
    GAPB(o[1]=MF32(PAF(3),VFR(7),o[1]), C1,12); \
    }while(0)
  STEP(pB0,pB1,pA0,pA1,1,true);   RESC(); ROT();
  STEP(pA0,pA1,pB0,pB1,2,true);   RESC(); ROT();
  STEP(pB0,pB1,pA0,pA1,3,false);  RESC();
  { float sacc=pB0[0]+pB0[1]; _Pragma("unroll") for(int r=2;r<16;++r)sacc+=pB0[r]; _Pragma("unroll") for(int r=0;r<16;++r)sacc+=pB1[r]; l_reg+=sacc;
    pw0=(u32x4){PKW(pB0,0),PKW(pB0,2),PKW(pB0,4),PKW(pB0,6)};pw1=(u32x4){PKW(pB0,8),PKW(pB0,10),PKW(pB0,12),PKW(pB0,14)};pw2=(u32x4){PKW(pB1,0),PKW(pB1,2),PKW(pB1,4),PKW(pB1,6)};pw3=(u32x4){PKW(pB1,8),PKW(pB1,10),PKW(pB1,12),PKW(pB1,14)};
    SBAR(); pv(o,vb0+sl_cur,PAF(0),PAF(1),PAF(2),PAF(3)); }
  #undef PKW
  #undef PAF
  #undef VFR
  #undef PIN
  #undef MX3
  #undef GAPA
  #undef GAPB
  #undef EX
  #undef VRD
  #undef KRD
  #undef STEP
  if(MODE==1&&g+8<ngrp)LOADQ(gi+1);
  unsigned zz_=0u; asm volatile("":"+v"(zz_)); const int lane_e=(lane+(int)zz_)&63, r32e=lane_e&31, hie=lane_e>>5;
  {auto rr=__builtin_amdgcn_permlane32_swap(__float_as_uint(l_reg),__float_as_uint(l_reg),false,false);l_reg=__uint_as_float(rr[0])+__uint_as_float(rr[1]);}
  const float lse_=mhat+__builtin_amdgcn_logf(l_reg);
  if(hie==0){ wsf[32+r32e]=__builtin_amdgcn_rcpf(l_reg); wsf[r32e]=lse_; }
  u32x4 pj[2][2][3]; float lj[2][2][3];
  const unsigned prow0=(unsigned)(rowbase+q0+wid*QBLK)+(unsigned)(lane_e>>3);
  if(MODE==0){
    #pragma unroll
    for(int hf=0;hf<2;++hf)
      #pragma unroll
      for(int i=0;i<2;++i)
        #pragma unroll
        for(int j=0;j<3;++j){ const unsigned rg=(prow0+hf*16+i*8)*8u+(unsigned)h; pj[hf][i][j]=*(const u32x4*)(part+(size_t)(rg*3u+j)*64+(lane_e&7)*8); lj[hf][i][j]=lseb[rg*4u+j]; } }
  asm volatile("s_waitcnt lgkmcnt(0)":::"memory");
  float rli[16];
  #pragma unroll
  for(int r=0;r<16;++r)rli[r]=wsf[32+crow(r,hie)];
  f16*Ow=O+(rowbase+q0+wid*QBLK)*OPITCH+h*D;
  { float*stg=(float*)(shm+LDS_OST)+wid*1024;
    #pragma unroll
    for(int half=0;half<2;++half){
      #pragma unroll
      for(int r=0;r<16;++r){ const int orow=crow(r,hie);
        if((orow>>4)==half){
          #pragma unroll
          for(int d0=0;d0<2;++d0)stg[(orow&15)*64+d0*32+r32e]=o[d0][r]*rli[r]; } }
      asm volatile("s_waitcnt lgkmcnt(0)":::"memory");
      #pragma unroll
      for(int i=0;i<2;++i){ const int row=i*8+(lane_e>>3),ch=lane_e&7; f32x4 v0=*(const f32x4*)(stg+row*64+ch*8),v1=*(const f32x4*)(stg+row*64+ch*8+4);
        if(MODE==1){ const int e=entl[gi*32+half*16+row];
          if(e>=0){ const unsigned rg=((unsigned)rowbase+(unsigned)(e&4095))*8u+(unsigned)h, sj=(unsigned)(e>>12)&3u;
            u32x4 w; w.x=pk2h(v0[0],v0[1]); w.y=pk2h(v0[2],v0[3]); w.z=pk2h(v1[0],v1[1]); w.w=pk2h(v1[2],v1[3]);
            st16_wt(part,(rg*3u+sj)*128u+(unsigned)ch*16u,w);
            if(ch==0)st4_wt(lseb+rg*4u+sj,wsf[half*16+row]); } }
        else{
          { const float lo=wsf[half*16+row];
            float M=lo;
            #pragma unroll
            for(int j=0;j<3;++j)M=__builtin_fmaxf(M,lj[half][i][j]);
            const float w0_=__builtin_amdgcn_exp2f(lo-M); float den=w0_; v0*=w0_; v1*=w0_;
            #pragma unroll
            for(int j=0;j<3;++j){ const float wj=__builtin_amdgcn_exp2f(lj[half][i][j]-M); den+=wj;
              const f16x8 pv_=__builtin_bit_cast(f16x8,pj[half][i][j]);
              v0[0]+=wj*(float)pv_[0]; v0[1]+=wj*(float)pv_[1]; v0[2]+=wj*(float)pv_[2]; v0[3]+=wj*(float)pv_[3];
              v1[0]+=wj*(float)pv_[4]; v1[1]+=wj*(float)pv_[5]; v1[2]+=wj*(float)pv_[6]; v1[3]+=wj*(float)pv_[7]; }
            const float rd=1.f/den; v0*=rd; v1*=rd; }
          float ss=(v0[0]*v0[0]+v0[1]*v0[1])+(v0[2]*v0[2]+v0[3]*v0[3])+(v1[0]*v1[0]+v1[1]*v1[1])+(v1[2]*v1[2]+v1[3]*v1[3]);
          ss = xsum<1>(ss); ss = xsum<2>(ss); ss = xsum<4>(ss);
          const float rs=1.f/sqrtf(ss*(1.f/64.f)+EPS);
          const f32x4 g0=*(const f32x4*)(gain+h*D+ch*8),g1=*(const f32x4*)(gain+h*D+ch*8+4);
          u32x4 w; w.x=pk2h(v0[0]*rs*g0[0],v0[1]*rs*g0[1]); w.y=pk2h(v0[2]*rs*g0[2],v0[3]*rs*g0[3]); w.z=pk2h(v1[0]*rs*g1[0],v1[1]*rs*g1[1]); w.w=pk2h(v1[2]*rs*g1[2],v1[3]*rs*g1[3]);
          *(u32x4*)(Ow+(long)(half*16+row)*OPITCH+ch*8)=w; } }
      asm volatile("s_waitcnt lgkmcnt(0)":::"memory"); } }
  #undef START
  #undef RESC
  #undef ROT
  }
  asm volatile("s_waitcnt lgkmcnt(0)\n\ts_barrier":::"memory");
  #undef LOADQ
  #undef CMASK
}
#undef SBAR
#undef WAIT_BAR
#undef MF32
}


namespace mobad {
using s16x8=__attribute__((ext_vector_type(8)))short;
using s16x4=__attribute__((ext_vector_type(4)))short;
using f32x16=__attribute__((ext_vector_type(16)))float;
constexpr int D=64, PITCH=NPROJ, OPITCH=DM;
constexpr int NW=8,QBLK=32,QB=QBLK*NW,KVBLK=64;
__device__ __forceinline__ int crow(int r,int hi){return (r&3)+8*(r>>2)+4*hi;}
#define SBAR() __builtin_amdgcn_sched_barrier(0)
#define MF32(a,b,c) __builtin_amdgcn_mfma_f32_32x32x16_f16(__builtin_bit_cast(f16x8,(a)),__builtin_bit_cast(f16x8,(b)),(c),0,0,0)
__device__ __forceinline__ void cmask(f32x16&p0,f32x16&p1,int jb,int qrel,int hi){
  const float NEG=-INFINITY; int kb=64*jb+4*hi;
  #pragma unroll
  for(int r=0;r<16;++r){int kv=kb+(r&3)+8*(r>>2); if(kv>qrel)p0[r]=NEG; if(kv+32>qrel)p1[r]=NEG;}
}
constexpr int NSLOT=3, SLOTB=8192;
constexpr int LDS_K=0, LDS_V=NSLOT*SLOTB, LDS_WS=2*NSLOT*SLOTB, LDS_OST=LDS_WS+NW*64*4, LDS_SEL=LDS_OST+NW*4096, LDS_KS=LDS_SEL+1024, LDS_BYTES_A=LDS_KS+4096;
__device__ __forceinline__ void glds16(const void*gsrc,unsigned lds_dst){unsigned keep;
  asm volatile("s_mov_b32 %0, m0\n\ts_mov_b32 m0, %2\n\ts_nop 0\n\tglobal_load_lds_dwordx4 %1, off\n\ts_mov_b32 m0, %0":"=&s"(keep):"v"(gsrc),"s"(lds_dst):"memory");}
__device__ __forceinline__ float max3f(float a,float b,float c){float r;asm("v_max3_f32 %0, %1, %2, %3":"=v"(r):"v"(a),"v"(b),"v"(c));return r;}
__device__ __forceinline__ float max2f(float a,float b){float r;asm("v_max_f32_e32 %0, %1, %2":"=v"(r):"v"(a),"v"(b));return r;}
__device__ __forceinline__ float fadd_s(float a,float b){float r;asm("v_add_f32_e32 %0, %1, %2":"=v"(r):"v"(a),"v"(b));return r;}
__device__ __forceinline__ float fsub_s(float a,float b){float r;asm("v_sub_f32_e32 %0, %1, %2":"=v"(r):"v"(a),"v"(b));return r;}
__device__ __forceinline__ unsigned cvtpk_s(float lo,float hi){return __builtin_bit_cast(unsigned,__builtin_amdgcn_cvt_pkrtz(lo,hi));}
#define WAIT_BAR(N) asm volatile("s_waitcnt vmcnt(" #N ") lgkmcnt(0)\n\ts_barrier":::"memory")
__device__ __forceinline__ void qkt(f32x16&p0,f32x16&p1,const char*Kslot,const s16x8*qr,const f32x16&negm,int r32,int hi){
  const char*kb=Kslot+hi*1024+r32*16;
  #pragma unroll
  for(int d0=0;d0<4;++d0){
    const s16x8 b0=*reinterpret_cast<const s16x8*>(kb+d0*2048);
    const s16x8 b1=*reinterpret_cast<const s16x8*>(kb+d0*2048+512);
    if(d0==0){p0=MF32(b0,qr[0],negm);p1=MF32(b1,qr[0],negm);}
    else{p0=MF32(b0,qr[d0],p0);p1=MF32(b1,qr[d0],p1);}}
}
typedef __attribute__((address_space(3))) const char* lds_cptr;
typedef short v4i16_t __attribute__((ext_vector_type(4)));
__device__ __forceinline__ void kload8(s16x8*kf,lds_cptr kp){
  kf[0]=*(const __attribute__((address_space(3))) s16x8*)(kp);      kf[1]=*(const __attribute__((address_space(3))) s16x8*)(kp+512);
  kf[2]=*(const __attribute__((address_space(3))) s16x8*)(kp+2048); kf[3]=*(const __attribute__((address_space(3))) s16x8*)(kp+2560);
  kf[4]=*(const __attribute__((address_space(3))) s16x8*)(kp+4096); kf[5]=*(const __attribute__((address_space(3))) s16x8*)(kp+4608);
  kf[6]=*(const __attribute__((address_space(3))) s16x8*)(kp+6144); kf[7]=*(const __attribute__((address_space(3))) s16x8*)(kp+6656);
}
__device__ __forceinline__ void kload2(s16x8*kf,lds_cptr kp,int j){ kf[2*j]=*(const __attribute__((address_space(3))) s16x8*)(kp+j*2048); kf[2*j+1]=*(const __attribute__((address_space(3))) s16x8*)(kp+j*2048+512); }
__device__ __forceinline__ s16x4 vtr(lds_cptr p){ return __builtin_bit_cast(s16x4,__builtin_amdgcn_ds_read_tr16_b64_v4i16((__attribute__((address_space(3))) v4i16_t*)p)); }
__device__ __forceinline__ float rowmax(const f32x16&p0,const f32x16&p1){
  float a=max3f(p0[0],p0[1],p1[0]),b=max3f(p0[2],p0[3],p1[1]);a=max3f(a,p1[2],p1[3]);
  #pragma unroll
  for(int r=4;r<16;r+=4){a=max3f(a,p0[r],p0[r+1]);b=max3f(b,p0[r+2],p0[r+3]);a=max3f(a,p1[r],p1[r+1]);b=max3f(b,p1[r+2],p1[r+3]);}
  const float m=max2f(a,b);
  auto rr=__builtin_amdgcn_permlane32_swap(__float_as_uint(m),__float_as_uint(m),false,false);
  return max2f(__uint_as_float(rr[0]),__uint_as_float(rr[1]));
}
__device__ __forceinline__ void pv(f32x16*o,int vb,s16x8 pa0,s16x8 pa1,s16x8 pa2,s16x8 pa3){
  #pragma unroll
  for(int d0=0;d0<2;++d0){s16x4 lo[4],hi[4];
    #pragma unroll
    for(int ks=0;ks<4;++ks){
      asm volatile("ds_read_b64_tr_b16 %0,%1 offset:%c2":"=&v"(lo[ks]):"v"(vb),"i"(d0*4096+ks*1024):"memory");
      asm volatile("ds_read_b64_tr_b16 %0,%1 offset:%c2":"=&v"(hi[ks]):"v"(vb),"i"(d0*4096+ks*1024+512):"memory");}
    asm volatile("s_waitcnt lgkmcnt(0)":::"memory");SBAR();
    #define PK(k) (s16x8){lo[k][0],lo[k][1],lo[k][2],lo[k][3],hi[k][0],hi[k][1],hi[k][2],hi[k][3]}
    o[d0]=MF32(pa0,PK(0),o[d0]);
    o[d0]=MF32(pa1,PK(1),o[d0]);
    o[d0]=MF32(pa2,PK(2),o[d0]);
    o[d0]=MF32(pa3,PK(3),o[d0]);
    #undef PK
  }
}
__device__ __forceinline__ void sel_unit(int b,int h,int qb,const f16*Q,const float*ksum,char*shm,const int w0){
  const int tid=tid_of(w0);
  const int row=tid>>1, half=tid&1;
  unsigned sel=0u;
  if(qb>0){
    float*ks=(float*)(shm+LDS_KS);
    if(tid<256)*(f32x4*)(ks+4*tid)=*(const f32x4*)(ksum+(size_t)((b*8+h)*16)*64+4*tid);
    float qf[32];
    { const f16x8*qp=(const f16x8*)(Q+((long)b*SEQ+qb*QB+row)*PITCH+h*D+32*half);
      #pragma unroll
      for(int i=0;i<4;++i){ const f16x8 t=qp[i];
        #pragma unroll
        for(int j=0;j<8;++j)qf[8*i+j]=(float)t[j]; } }
    asm volatile("s_waitcnt lgkmcnt(0)\n\ts_barrier":::"memory");
    float g[15];
    const float*kp=ks+32*half;
    #pragma unroll
    for(int n=0;n<15;++n){ float s=0.f;
      if(n<qb){
        #pragma unroll
        for(int i=0;i<8;++i){ const f32x4 k4=*(const f32x4*)(kp+n*64+4*i); s+=qf[4*i]*k4[0]+qf[4*i+1]*k4[1]+qf[4*i+2]*k4[2]+qf[4*i+3]*k4[3]; }
        s = xsum<1>(s); }
      g[n]=(n<qb)?s:-INFINITY; }
    #pragma unroll
    for(int r=0;r<3;++r){ float best=-INFINITY; int bi=-1;
      #pragma unroll
      for(int n=0;n<15;++n){ const bool ok=!((sel>>n)&1u)&&g[n]>best; best=ok?g[n]:best; bi=ok?n:bi; }
      if(bi>=0)sel|=1u<<bi; } }
  if(half==0)((unsigned*)(shm+LDS_SEL))[row]=sel;
  asm volatile("s_waitcnt lgkmcnt(0)\n\ts_barrier":::"memory");
}
constexpr float NEGBIG=-1.0e30f;
template<int THRL> __device__ __forceinline__ void attn_unit(int b,int h,int qb,const f16*Q,const f16*__restrict__ K,const f16*__restrict__ V,f16*O,const float*ksum,const float*gain,char*shm,const int w0){
  const int tid=tid_of(w0),lane=tid&63,r32=lane&31,hi=lane>>5; const int wid=w0;
  const long rowbase=(long)b*SEQ; const int q0=qb*QB;
  const f16*Qw=Q+(rowbase+q0+wid*QBLK)*PITCH+h*D;
  const f16*Kh=K+rowbase*PITCH+h*D,*Vh=V+rowbase*PITCH+h*D;
  const unsigned lds0=(unsigned)(uintptr_t)shm;
  float*wsf=(float*)(shm+LDS_WS)+wid*64;
  const f16*kptr=Kh+(long)lane*PITCH+wid*8+(long)(4*qb)*KVBLK*PITCH;
  const f16*vptr=Vh+(long)(16*(wid&3)+(lane>>2))*PITCH+(wid>>2)*32+(lane&3)*8+(long)(4*qb)*KVBLK*PITCH;
  const unsigned kdst=lds0+LDS_K+wid*1024, vdst=lds0+LDS_V+wid*1024;
  const long tstep_=(long)KVBLK*PITCH, twrap_=-(long)(4*qb+3)*KVBLK*PITCH;
  #define DMA_K(t,slot) do{ glds16(kptr,(unsigned)__builtin_amdgcn_readfirstlane(kdst+(slot))); kptr+=(((t)==3)?twrap_:tstep_); }while(0)
  #define DMA_V(t,slot) do{ glds16(vptr,(unsigned)__builtin_amdgcn_readfirstlane(vdst+(slot))); vptr+=(((t)==3)?twrap_:tstep_); }while(0)
  const int vb0=(int)(lds0+LDS_V)+((lane>>4)&1)*32+(lane&3)*8+(4*hi+((lane&15)>>2))*64;
  const char*Kbase=shm+LDS_K; s16x8 kf[8];
  const lds_cptr shm3=(lds_cptr)shm; const lds_cptr kp0=shm3+LDS_K+hi*1024+r32*16; const lds_cptr vp0=shm3+LDS_V+((lane>>4)&1)*32+(lane&3)*8+(4*hi+((lane&15)>>2))*64;
  const int NT=4*qb+4;
  DMA_K(0,0);DMA_V(0,0);DMA_K(1,SLOTB);
  s16x8 qr[4];
  #pragma unroll
  for(int d0=0;d0<4;++d0)qr[d0]=*reinterpret_cast<const s16x8*>(&Qw[(long)r32*PITCH+d0*16+hi*8]);
  const unsigned sel=((const unsigned*)(shm+LDS_SEL))[wid*QBLK+r32];
  bool msk=false;
  float mhat=0.f,l_reg=0.f;f32x16 o[2];o[0]=f32x16{};o[1]=f32x16{};f32x16 negm=f32x16{};asm volatile("":"+v"(negm));
  const int qrel=wid*QBLK+r32;
  #define CMASK(P0,P1,t) do{ if((t)<4)cmask(P0,P1,(t),qrel,hi); }while(0)
  #define SELM(t) do{ if((t)>=4&&(((t)&3)==0)){ msk=!((sel>>(((t)-4)>>2))&1u); const float nv_=msk?NEGBIG:-mhat; _Pragma("unroll") for(int r=0;r<16;++r)negm[r]=nv_; asm volatile("":"+v"(negm)); } }while(0)
  bool resc=false;
  #define START(P0,P1) do{ const float rm=rowmax(P0,P1); resc=false; \
    { const float dl=rm; mhat=fadd_s(mhat,dl); \
      _Pragma("unroll") for(int r=0;r<16;++r){P0[r]=fsub_s(P0[r],dl);P1[r]=fsub_s(P1[r],dl);} \
      _Pragma("unroll") for(int r=0;r<16;++r)negm[r]=-mhat; asm volatile("":"+v"(negm)); } \
    _Pragma("unroll") for(int r=0;r<16;++r)P0[r]=__builtin_amdgcn_exp2f(P0[r]); }while(0)
  #define RESC() do{ if(resc){ asm volatile("s_waitcnt lgkmcnt(0)":::"memory"); \
      _Pragma("unroll") for(int d_=0;d_<2;++d_) _Pragma("unroll") for(int r=0;r<16;++r)o[d_][r]*=wsf[crow(r,hi)]; } }while(0)
  f32x16 pA0,pA1,pB0,pB1;
  int sl_prev=0,sl_cur=0,sl_next=SLOTB;
  #define ROT() do{sl_prev=sl_cur;sl_cur=sl_next;sl_next=(sl_next==(NSLOT-1)*SLOTB)?0:sl_next+SLOTB;}while(0)
  DMA_K(2,2*SLOTB);
  WAIT_BAR(3);
  qkt(pA0,pA1,Kbase,qr,negm,r32,hi);asm volatile("s_nop 15\n\ts_nop 7":"+v"(pA0),"+v"(pA1));CMASK(pA0,pA1,0);
  START(pA0,pA1);
  _Pragma("unroll") for(int r=0;r<16;++r)pA1[r]=__builtin_amdgcn_exp2f(pA1[r]);
  WAIT_BAR(0);
  DMA_K(3,0);DMA_V(1,SLOTB);
  ROT();
  kload8(kf,kp0+sl_cur);
  WAIT_BAR(2);
  s16x4 vlo[8],vhi[8]; u32x4 pw0,pw1,pw2,pw3;
  #define PKW(P,B) cvtpk_s(P[B],P[B+1])
  #define PAF(k) __builtin_bit_cast(s16x8,pw##k)
  #define VFR(i) (s16x8){vlo[i][0],vlo[i][1],vlo[i][2],vlo[i][3],vhi[i][0],vhi[i][1],vhi[i][2],vhi[i][3]}
  #define PIN(x) asm volatile("":"+v"(x))
  #define MX3(a,b,c) __builtin_fmaxf(__builtin_fmaxf((a),(b)),(c))
  #define GAPA(MF,A0,A1,A2,A3,W0,W1,PW) do{ MF; sacc+=A0; sacc+=A1; sacc+=A2; sacc+=A3; PIN(sacc); W0; W1; PIN(PW); SBAR(); }while(0)
  #define EX(v) __builtin_amdgcn_exp2f(v)
  #define GAPB(MF,X,B) do{ MF; X[B]=EX(X[B]); X[B+1]=EX(X[B+1]); X[B+2]=EX(X[B+2]); X[B+3]=EX(X[B+3]); PIN(X); SBAR(); }while(0)
  #define VRD(i) do{ vlo[i]=vtr(vp_+(((i)>>2)*4096+((i)&3)*1024)); vhi[i]=vtr(vp_+(((i)>>2)*4096+((i)&3)*1024+512)); }while(0)
  #define KRD(G,j) do{ if(G){ kload2(kf,kp0+sl_next,j); SBAR(); } }while(0)
  #define STEP(C0,C1,P0,P1,t,GK,GV,GL) do{ SELM(t); SBAR(); \
    const lds_cptr vp_=vp0+sl_prev; \
    VRD(0); SBAR(); float sacc=(P0[0]+P0[1]); \
    GAPA(C0=MF32(kf[0],qr[0],negm), P0[2],P0[3],P0[4],P0[5],     pw0[0]=PKW(P0,0), pw0[1]=PKW(P0,2), pw0); \
    VRD(4); SBAR(); GAPA(C1=MF32(kf[1],qr[0],negm), P0[6],P0[7],P0[8],P0[9],     pw0[2]=PKW(P0,4), pw0[3]=PKW(P0,6), pw0); \
    VRD(1); SBAR(); GAPA(C0=MF32(kf[2],qr[1],C0),   P0[10],P0[11],P0[12],P0[13], pw1[0]=PKW(P0,8), pw1[1]=PKW(P0,10), pw1); \
    VRD(5); SBAR(); GAPA(C1=MF32(kf[3],qr[1],C1),   P0[14],P0[15],P1[0],P1[1],   pw1[2]=PKW(P0,12),pw1[3]=PKW(P0,14), pw1); \
    VRD(2); SBAR(); GAPA(C0=MF32(kf[4],qr[2],C0),   P1[2],P1[3],P1[4],P1[5],     pw2[0]=PKW(P1,0), pw2[1]=PKW(P1,2), pw2); \
    VRD(6); SBAR(); GAPA(C1=MF32(kf[5],qr[2],C1),   P1[6],P1[7],P1[8],P1[9],     pw2[2]=PKW(P1,4), pw2[3]=PKW(P1,6), pw2); \
    VRD(3); SBAR(); GAPA(C0=MF32(kf[6],qr[3],C0),   P1[10],P1[11],P1[12],P1[13], pw3[0]=PKW(P1,8), pw3[1]=PKW(P1,10), pw3); \
    VRD(7); SBAR(); GAPA(C1=MF32(kf[7],qr[3],C1),   P1[14],P1[15],0.f,0.f,       pw3[2]=PKW(P1,12),pw3[3]=PKW(P1,14), pw3); \
    l_reg+=sacc; \
    if(GK){DMA_K((t)+3,sl_cur);} if(GV){DMA_V((t)+1,sl_next);} \
    CMASK(C0,C1,t); \
    { float a=MX3(C0[0],C0[1],C1[0]),b=MX3(C0[2],C0[3],C1[1]); a=MX3(a,C1[2],C1[3]); \
      _Pragma("unroll") for(int r=4;r<16;r+=4){a=MX3(a,C0[r],C0[r+1]);b=MX3(b,C0[r+2],C0[r+3]);a=MX3(a,C1[r],C1[r+1]);b=MX3(b,C1[r+2],C1[r+3]);} \
      float rm=__builtin_fmaxf(a,b); { auto rr=__builtin_amdgcn_permlane32_swap(__float_as_uint(rm),__float_as_uint(rm),false,false); rm=__builtin_fmaxf(__uint_as_float(rr[0]),__uint_as_float(rr[1])); } \
      resc=false; \
      if(__builtin_expect(__any(rm>(float)THRL),0)){ const float dl=__builtin_fmaxf(rm,0.f); mhat+=dl; \
        _Pragma("unroll") for(int r=0;r<16;++r){C0[r]-=dl;C1[r]-=dl;} \
        { const float nv_=msk?NEGBIG:-mhat; _Pragma("unroll") for(int r=0;r<16;++r)negm[r]=nv_; } asm volatile("":"+v"(negm)); \
        const float f=__builtin_amdgcn_exp2f(-dl); l_reg*=f; if(hi==0)wsf[r32]=f; resc=true; } } \
    SBAR(); \
    GAPB(o[0]=MF32(PAF(0),VFR(0),o[0]), C0,0); \
    GAPB(o[1]=MF32(PAF(0),VFR(4),o[1]), C0,4); \
    KRD(GL,0); GAPB(o[0]=MF32(PAF(1),VFR(1),o[0]), C0,8); \
    KRD(GL,1); GAPB(o[1]=MF32(PAF(1),VFR(5),o[1]), C0,12); \
    KRD(GL,2); GAPB(o[0]=MF32(PAF(2),VFR(2),o[0]), C1,0); \
    KRD(GL,3); GAPB(o[1]=MF32(PAF(2),VFR(6),o[1]), C1,4); \
    GAPB(o[0]=MF32(PAF(3),VFR(3),o[0]), C1,8); \
    GAPB(o[1]=MF32(PAF(3),VFR(7),o[1]), C1,12); \
    }while(0)
  int t=1;
  for(;t+5<NT;t+=2){
    STEP(pB0,pB1,pA0,pA1,t,true,true,true);     WAIT_BAR(2); RESC(); ROT();
    STEP(pA0,pA1,pB0,pB1,t+1,true,true,true);   WAIT_BAR(2); RESC(); ROT();
  }
  #define ENDW(tt) do{ if((tt)+3<NT){WAIT_BAR(2);} else if((tt)+2<NT){WAIT_BAR(1);} else {WAIT_BAR(0);} }while(0)
  for(;t+1<NT;t+=2){
    STEP(pB0,pB1,pA0,pA1,t,(t+3<NT),(t+1<NT),(t+1<NT));       ENDW(t);   RESC(); ROT();
    STEP(pA0,pA1,pB0,pB1,t+1,(t+4<NT),(t+2<NT),(t+2<NT));     ENDW(t+1); RESC(); ROT();
  }
  STEP(pB0,pB1,pA0,pA1,NT-1,false,false,false); RESC();
  { float sacc=pB0[0]+pB0[1]; _Pragma("unroll") for(int r=2;r<16;++r)sacc+=pB0[r]; _Pragma("unroll") for(int r=0;r<16;++r)sacc+=pB1[r]; l_reg+=sacc;
    pw0=(u32x4){PKW(pB0,0),PKW(pB0,2),PKW(pB0,4),PKW(pB0,6)};pw1=(u32x4){PKW(pB0,8),PKW(pB0,10),PKW(pB0,12),PKW(pB0,14)};pw2=(u32x4){PKW(pB1,0),PKW(pB1,2),PKW(pB1,4),PKW(pB1,6)};pw3=(u32x4){PKW(pB1,8),PKW(pB1,10),PKW(pB1,12),PKW(pB1,14)};
    SBAR(); pv(o,vb0+sl_cur,PAF(0),PAF(1),PAF(2),PAF(3)); }
  #undef PKW
  #undef PAF
  #undef VFR
  #undef PIN
  #undef MX3
  #undef GAPA
  #undef GAPB
  #undef EX
  #undef VRD
  #undef KRD
  #undef STEP
  #undef ENDW
  {auto rr=__builtin_amdgcn_permlane32_swap(__float_as_uint(l_reg),__float_as_uint(l_reg),false,false);l_reg=__uint_as_float(rr[0])+__uint_as_float(rr[1]);}
  if(hi==0)wsf[32+r32]=l_reg;asm volatile("s_waitcnt lgkmcnt(0)":::"memory");
  float rli[16];
  #pragma unroll
  for(int r=0;r<16;++r)rli[r]=__builtin_amdgcn_rcpf(wsf[32+crow(r,hi)]);
  f16*Ow=O+(rowbase+q0+wid*QBLK)*OPITCH+h*D;
  { float*stg=(float*)(shm+LDS_OST)+wid*1024;
    #pragma unroll
    for(int half=0;half<2;++half){
      #pragma unroll
      for(int r=0;r<16;++r){ const int orow=crow(r,hi);
        if((orow>>4)==half){
          #pragma unroll
          for(int d0=0;d0<2;++d0)stg[(orow&15)*64+d0*32+r32]=o[d0][r]*rli[r]; } }
      asm volatile("s_waitcnt lgkmcnt(0)":::"memory");
      #pragma unroll
      for(int i=0;i<2;++i){ const int row=i*8+(lane>>3),ch=lane&7; const f32x4 v0=*(const f32x4*)(stg+row*64+ch*8),v1=*(const f32x4*)(stg+row*64+ch*8+4);
        float ss=(v0[0]*v0[0]+v0[1]*v0[1])+(v0[2]*v0[2]+v0[3]*v0[3])+(v1[0]*v1[0]+v1[1]*v1[1])+(v1[2]*v1[2]+v1[3]*v1[3]);
        ss = xsum<1>(ss); ss = xsum<2>(ss); ss = xsum<4>(ss);
        const float rs=1.f/sqrtf(ss*(1.f/64.f)+EPS);
        const f32x4 g0=*(const f32x4*)(gain+h*D+ch*8),g1=*(const f32x4*)(gain+h*D+ch*8+4);
        u32x4 w; w.x=pk2h(v0[0]*rs*g0[0],v0[1]*rs*g0[1]); w.y=pk2h(v0[2]*rs*g0[2],v0[3]*rs*g0[3]); w.z=pk2h(v1[0]*rs*g1[0],v1[1]*rs*g1[1]); w.w=pk2h(v1[2]*rs*g1[2],v1[3]*rs*g1[3]);
        *(u32x4*)(Ow+(long)(half*16+row)*OPITCH+ch*8)=w; }
      asm volatile("s_waitcnt lgkmcnt(0)":::"memory"); } }
  asm volatile("s_waitcnt lgkmcnt(0)\n\ts_barrier":::"memory");
  #undef DMA_K
  #undef DMA_V
  #undef CMASK
  #undef SELM
  #undef START
  #undef RESC
  #undef ROT
}
#undef SBAR
#undef WAIT_BAR
#undef MF32
}


namespace mlstm {
constexpr int L=64, DH=128, NCH=16;
constexpr int RS1=136, RS2=72;
#define ML_BAR() asm volatile("s_waitcnt lgkmcnt(0)\n\ts_barrier" ::: "memory")
#define MF16(a,b,c) __builtin_amdgcn_mfma_f32_16x16x32_f16((a),(b),(c),0,0,0)
typedef short v4i16_t __attribute__((ext_vector_type(4)));
__device__ __forceinline__ f16x4 trd(const LAS f16* p){ return __builtin_bit_cast(f16x4,__builtin_amdgcn_ds_read_tr16_b64_v4i16((LAS v4i16_t*)p)); }
__device__ __forceinline__ f16x8 cat8(f16x4 a,f16x4 c){ return (f16x8){a[0],a[1],a[2],a[3],c[0],c[1],c[2],c[3]}; }
__device__ __forceinline__ float frcp(float x){ return __builtin_amdgcn_rcpf(x); }
struct Glob { f16* cloc; f16* cprev; float* nloc; float* nprev; float* sa; float* smloc; float* smprev;
              f16* qkc;
              float* gcolf; float* gcum; float* gpm;
              float* sca; float* scpm; };

__device__ __forceinline__ void prep(int b,int sc,const Glob G,const f16*proj,const float*gates,const float*conv_w,const float*conv_b,const int w0){
  const int tid=tid_of(w0),lane=tid&63,wid=w0;
  const int cg=tid&127,tq=tid>>7; const long rowbase=(long)b*SEQ; const int t0=sc*L+16*tq;
  const f16*src=proj+C_QM+8*cg;
  f16x8 raw[19];
  #pragma unroll
  for(int i=0;i<19;++i){ const int t_=t0-3+i; raw[i]=(t_>=0)?*(const f16x8*)(src+(rowbase+t_)*NPROJ):(f16x8){0,0,0,0,0,0,0,0}; }
  float cw[4][8],cb[8];
  #pragma unroll
  for(int tp=0;tp<4;++tp){ const f32x4 a=*(const f32x4*)(conv_w+tp*1024+8*cg),c=*(const f32x4*)(conv_w+tp*1024+8*cg+4);
    cw[tp][0]=a[0];cw[tp][1]=a[1];cw[tp][2]=a[2];cw[tp][3]=a[3];cw[tp][4]=c[0];cw[tp][5]=c[1];cw[tp][6]=c[2];cw[tp][7]=c[3]; }
  { const f32x4 a=*(const f32x4*)(conv_b+8*cg),c=*(const f32x4*)(conv_b+8*cg+4); cb[0]=a[0];cb[1]=a[1];cb[2]=a[2];cb[3]=a[3];cb[4]=c[0];cb[5]=c[1];cb[6]=c[2];cb[7]=c[3]; }
  const float ksc=(cg>=64)?0.08838834764831845f:1.f;
  const unsigned dsto=(unsigned)(((rowbase+t0)*1024+8*cg)*2);
  #pragma unroll
  for(int i=0;i<16;++i){ float o[8];
    #pragma unroll
    for(int j=0;j<8;++j){ float v=cb[j];
      #pragma unroll
      for(int tp=0;tp<4;++tp)v+=cw[tp][j]*(float)raw[i+tp][j];
      o[j]=v*frcp(1.f+__expf(-v))*ksc; }
    u32x4 w; w.x=pk2h(o[0],o[1]); w.y=pk2h(o[2],o[3]); w.z=pk2h(o[4],o[5]); w.w=pk2h(o[6],o[7]);
    st16_wt(G.qkc,dsto+(unsigned)i*2048u,w); }
  if(wid<4){ const int hm=wid; const long row=rowbase+sc*L+lane;
    const float ig=gates[row*8+hm],fg=gates[row*8+4+hm];
    const float logf=fminf(fg,0.f)-log1pf(__expf(-fabsf(fg)));
    float cum=logf;
    #pragma unroll
    for(int o=1;o<64;o<<=1){ const float tmp=__builtin_bit_cast(float,__builtin_amdgcn_ds_bpermute((lane-o)<<2,__builtin_bit_cast(int,cum))); if(lane>=o)cum+=tmp; }
    const float colf=ig-cum; float pm=colf;
    #pragma unroll
    for(int o=1;o<64;o<<=1){ const float tmp=__builtin_bit_cast(float,__builtin_amdgcn_ds_bpermute((lane-o)<<2,__builtin_bit_cast(int,pm))); if(lane>=o)pm=fmaxf(pm,tmp); }
    const size_t gi=(size_t)(b*4+hm)*SEQ+sc*L+lane;
    st4_wt(G.gcolf+gi,colf); st4_wt(G.gcum+gi,cum); st4_wt(G.gpm+gi,pm);
    if(lane==63){ st4_wt(G.sca+(b*4+hm)*64+sc,cum); st4_wt(G.scpm+(b*4+hm)*64+sc,pm); } }
}

__device__ __forceinline__ void contrib(int b,int hm,int c,const Glob G,const f16*proj,LAS unsigned char*lds,const int w0){
  constexpr int KS0=0,VS0=34816,CS=69632,VEC=104448;
  const int tid=tid_of(w0),lane=tid&63,wid=w0,fr=lane&15,fq=lane>>4;
  LAS f16*Cs=(LAS f16*)(lds+CS); LAS float*vec=(LAS float*)(lds+VEC); LAS f16*wph=(LAS f16*)(vec+128);
  const int seq=b*4+hm,item=seq*NCH+c; const long rowbase=(long)b*SEQ; const int tc=256*c;
  const int eg=tid&15,sq=tid>>4;
  const f16*kp=G.qkc+512+hm*DH+8*eg; const f16*vp=proj+C_VM+hm*DH+8*eg;
  const int trb=(8*fq+(fr>>2))*RS1+4*(fr&3);
  float aj[4],pj[4],off[4];
  #pragma unroll
  for(int j=0;j<4;++j){ aj[j]=G.sca[seq*64+4*c+j]; pj[j]=G.scpm[seq*64+4*c+j]; }
  off[0]=0.f; off[1]=aj[0]; off[2]=aj[0]+aj[1]; off[3]=off[2]+aj[2];
  const float a256=off[3]+aj[3];
  const float mloc=a256+fmaxf(fmaxf(pj[0]-off[0],pj[1]-off[1]),fmaxf(pj[2]-off[2],pj[3]-off[3]));
  f32x4 accC[8];
  #pragma unroll
  for(int i=0;i<8;++i)accC[i]=(f32x4){0.f,0.f,0.f,0.f};
  float nacc=0.f;
  f16x8 rk[2],rv[2]; float rcolf=0.f;
  #define LOADP(j) do{ const long r0_=rowbase+tc+64*(j)+2*sq; \
    rk[0]=*(const f16x8*)(kp+r0_*1024); rk[1]=*(const f16x8*)(kp+(r0_+1)*1024); rv[0]=*(const f16x8*)(vp+r0_*NPROJ); rv[1]=*(const f16x8*)(vp+(r0_+1)*NPROJ); \
    if(wid==0) rcolf=G.gcolf[(size_t)seq*SEQ+tc+64*(j)+lane]; }while(0)
  LOADP(0);
  #pragma unroll
  for(int j=0;j<4;++j){ const int buf=j&1;
    LAS f16*Ks=(LAS f16*)(lds+KS0+buf*17408); LAS f16*Vs=(LAS f16*)(lds+VS0+buf*17408);
    *(LAS f16x8*)(Ks+(2*sq)*RS1+8*eg)=rk[0]; *(LAS f16x8*)(Ks+(2*sq+1)*RS1+8*eg)=rk[1];
    *(LAS f16x8*)(Vs+(2*sq)*RS1+8*eg)=rv[0]; *(LAS f16x8*)(Vs+(2*sq+1)*RS1+8*eg)=rv[1];
    if(wid==0){ const float wpv=__expf(a256+(rcolf-off[j])-mloc); vec[64*buf+lane]=wpv; wph[64*buf+lane]=(f16)wpv; }
    ML_BAR();
    if(j<3) LOADP(j+1);
    #pragma unroll
    for(int ks=0;ks<2;++ks){ const LAS f16*ap=Ks+trb+32*ks*RS1+16*wid; const f16x8 kfa=cat8(trd(ap),trd(ap+4*RS1)) * *(const LAS f16x8*)(wph+64*buf+32*ks+8*fq);
      #pragma unroll
      for(int et=0;et<8;++et){ const LAS f16*bp=Vs+trb+32*ks*RS1+16*et; const f16x8 vfb=cat8(trd(bp),trd(bp+4*RS1)); accC[et]=MF16(kfa,vfb,accC[et]); } }
    { const int d=tid>>2,sg=tid&3; float sn=0.f;
      #pragma unroll
      for(int i=0;i<16;++i)sn+=(float)Ks[(16*sg+i)*RS1+d]*vec[64*buf+16*sg+i];
      sn=xsum<1>(sn); sn=xsum<2>(sn); nacc+=sn; } }
  #undef LOADP
  #pragma unroll
  for(int et=0;et<8;++et){ u32x2 w; w.x=pk2h(accC[et][0],accC[et][1]); w.y=pk2h(accC[et][2],accC[et][3]); *(LAS u32x2*)(Cs+(16*et+fr)*RS1+16*wid+4*fq)=w; }
  ML_BAR();
  { f16*dst=G.cloc+(size_t)item*DH*DH;
    #pragma unroll
    for(int i=0;i<4;++i){ const int idx=tid+NTHR*i, e=idx>>4, ch=idx&15; st16_wt(dst,(unsigned)((e*DH+8*ch)*2),*(const LAS u32x4*)(Cs+e*RS1+8*ch)); }
    if((tid&3)==0)st4_wt(G.nloc+(size_t)item*DH+(tid>>2),nacc);
    if(tid==0){ st4_wt(G.sa+item,a256); st4_wt(G.smloc+item,mloc); } }
  ML_BAR();
}

__device__ __forceinline__ void scan(int seq,const Glob G,const int w0){
  const int tid=tid_of(w0); const int e=tid>>2,d0=32*(tid&3);
  float C[32];
  #pragma unroll
  for(int j=0;j<32;++j)C[j]=0.f;
  float nv=0.f,mst=0.f;
  u32x4 in4[4],nx4[4]; float a,ml,nl,an=0.f,mln=0.f,nln=0.f;
  { const int item=seq*NCH; const u32x4*src=(const u32x4*)(G.cloc+(size_t)item*DH*DH+e*DH+d0);
    #pragma unroll
    for(int i=0;i<4;++i)in4[i]=src[i];
    a=G.sa[item]; ml=G.smloc[item]; nl=(tid<DH)?G.nloc[(size_t)item*DH+tid]:0.f; }
  #pragma unroll 1
  for(int c=0;c<NCH;++c){ const int item=seq*NCH+c;
    if(c+1<NCH){ const u32x4*src=(const u32x4*)(G.cloc+(size_t)(item+1)*DH*DH+e*DH+d0);
      #pragma unroll
      for(int i=0;i<4;++i)nx4[i]=src[i];
      an=G.sa[item+1]; mln=G.smloc[item+1]; nln=(tid<DH)?G.nloc[(size_t)(item+1)*DH+tid]:0.f; }
    f16*dstb=G.cprev+(size_t)item*DH*DH; const unsigned dsto=(unsigned)((e*DH+d0)*2);
    #pragma unroll
    for(int i=0;i<4;++i){ u32x4 o; o.x=pk2h(C[8*i],C[8*i+1]); o.y=pk2h(C[8*i+2],C[8*i+3]); o.z=pk2h(C[8*i+4],C[8*i+5]); o.w=pk2h(C[8*i+6],C[8*i+7]); st16_wt(dstb,dsto+16u*i,o); }
    if(tid<DH)st4_wt(G.nprev+(size_t)item*DH+tid,nv);
    if(tid==0)st4_wt(G.smprev+item,mst);
    const float mn=fmaxf(a+mst,ml),sp=__expf(a+mst-mn),sl=__expf(ml-mn);
    #pragma unroll
    for(int i=0;i<4;++i){ const f16x8 h8=__builtin_bit_cast(f16x8,in4[i]);
      #pragma unroll
      for(int j=0;j<8;++j)C[8*i+j]=sp*C[8*i+j]+sl*(float)h8[j]; }
    nv=sp*nv+sl*nl; mst=mn;
    #pragma unroll
    for(int i=0;i<4;++i)in4[i]=nx4[i];
    a=an; ml=mln; nl=nln; }
}

__device__ __forceinline__ void unit(int b,int hm,int c,const Glob G,const f16*proj,const float*gain,f16*mix,LAS unsigned char*lds,const int w0){
  constexpr int QS=0, KS=17408, VS=34816, CS=52224, PS=87040, VEC=96256;
  const int tid=tid_of(w0),lane=tid&63,wid=w0,fr=lane&15,fq=lane>>4;
  LAS f16*Qs=(LAS f16*)(lds+QS); LAS f16*Ks=(LAS f16*)(lds+KS); LAS f16*Vs=(LAS f16*)(lds+VS); LAS f16*Cs=(LAS f16*)(lds+CS); LAS f16*Ps=(LAS f16*)(lds+PS);
  LAS float*vec=(LAS float*)(lds+VEC); LAS f16*wph=(LAS f16*)(vec+1288);
  const int seq=b*4+hm,item=seq*NCH+c; const long rowbase=(long)b*SEQ;
  const int eg=tid&15,sq=tid>>4;
  const f16*qp=G.qkc+hm*DH+8*eg; const f16*kp=qp+512; const f16*vp=proj+C_VM+hm*DH+8*eg;
  const f32x4 gn=*(const f32x4*)(gain+hm*DH+16*wid+4*fq);
  const f16*omp=proj+C_OM+hm*DH+16*wid+4*fq; f16*outp=mix+512+hm*DH+16*wid+4*fq;
  const int trb=(8*fq+(fr>>2))*RS1+4*(fr&3);
  { const f16*src=G.cprev+(size_t)item*DH*DH;
    #pragma unroll
    for(int i=0;i<4;++i){ const int idx=tid+NTHR*i, e=idx>>4, ch=idx&15; *(LAS u32x4*)(Cs+e*RS1+8*ch)=*(const u32x4*)(src+e*DH+8*ch); }
    if(tid<DH)vec[1152+tid]=G.nprev[(size_t)item*DH+tid]; }
  float mprev=G.smprev[item];
  f16x8 rq[2],rk[2],rv[2]; f16x4 omn[4]; float rcolf=0.f,rcum=0.f,rpm=0.f,ra=0.f,rpx=0.f;
  #define LOAD_RAW(sc) do{ const long r0_=rowbase+(sc)*L+2*sq; \
    rq[0]=*(const f16x8*)(qp+r0_*1024); rq[1]=*(const f16x8*)(qp+(r0_+1)*1024); rk[0]=*(const f16x8*)(kp+r0_*1024); rk[1]=*(const f16x8*)(kp+(r0_+1)*1024); \
    rv[0]=*(const f16x8*)(vp+r0_*NPROJ); rv[1]=*(const f16x8*)(vp+(r0_+1)*NPROJ); \
    _Pragma("unroll") for(int tt=0;tt<4;++tt) omn[tt]=*(const f16x4*)(omp+(rowbase+(sc)*L+16*tt+fr)*NPROJ); \
    if(wid==0){ const size_t gi_=(size_t)seq*SEQ+(sc)*L+lane; rcolf=G.gcolf[gi_]; rcum=G.gcum[gi_]; rpm=G.gpm[gi_]; ra=G.sca[seq*64+(sc)]; rpx=G.scpm[seq*64+(sc)]; } }while(0)
  LOAD_RAW(4*c);
  ML_BAR();
  f32x4 accC[8];
  #pragma unroll
  for(int et=0;et<8;++et){ const f16x4 t4=*(const LAS f16x4*)(Cs+(16*et+fr)*RS1+16*wid+4*fq); accC[et]=(f32x4){(float)t4[0],(float)t4[1],(float)t4[2],(float)t4[3]}; }
  #pragma unroll 1
  for(int sc=4*c;sc<4*c+4;++sc){
    const int t0=sc*L;
    *(LAS f16x8*)(Qs+(2*sq)*RS1+8*eg)=rq[0]; *(LAS f16x8*)(Qs+(2*sq+1)*RS1+8*eg)=rq[1];
    *(LAS f16x8*)(Ks+(2*sq)*RS1+8*eg)=rk[0]; *(LAS f16x8*)(Ks+(2*sq+1)*RS1+8*eg)=rk[1];
    *(LAS f16x8*)(Vs+(2*sq)*RS1+8*eg)=rv[0]; *(LAS f16x8*)(Vs+(2*sq+1)*RS1+8*eg)=rv[1];
    f16x4 om[4];
    #pragma unroll
    for(int tt=0;tt<4;++tt)om[tt]=omn[tt];
    if(wid==0){
      const float mx=fmaxf(mprev,rpm);
      const float mloc=ra+rpx, mnew=fmaxf(ra+mprev,mloc), sprev=__expf(ra+mprev-mnew), wpv=__expf(ra+rcolf-mnew);
      vec[lane]=rcolf; vec[64+lane]=-mx; vec[128+lane]=__expf(mprev-mx); vec[192+lane]=__expf(-(rcum+mx)); vec[256+lane]=wpv; wph[lane]=(f16)wpv;
      if(lane==0)vec[1280]=sprev;
      mprev=mnew; }
    ML_BAR();
    if(sc<4*c+3) LOAD_RAW(sc+1);
    { const int t=tid>>3,dg=tid&7; float sv=0.f;
      const f16x8 q0=*(const LAS f16x8*)(Qs+t*RS1+16*dg),q1=*(const LAS f16x8*)(Qs+t*RS1+16*dg+8);
      #pragma unroll
      for(int j=0;j<8;++j){ sv+=(float)q0[j]*vec[1152+16*dg+j]+(float)q1[j]*vec[1152+16*dg+8+j]; }
      sv=xsum<1>(sv); sv=xsum<2>(sv); sv=xsum<4>(sv);
      if(dg==0)vec[320+t]=sv; }
    { const int sA=wid>>1;
      f16x8 ka[4];
      #pragma unroll
      for(int ks=0;ks<4;++ks)ka[ks]=*(const LAS f16x8*)(Ks+(16*sA+fr)*RS1+32*ks+8*fq);
      const f32x4 cf4=*(const LAS f32x4*)(vec+16*sA+4*fq);
      #pragma unroll
      for(int t2=0;t2<2;++t2){ const int tt=2*(wid&1)+t2; f32x4 acc={0.f,0.f,0.f,0.f};
        #pragma unroll
        for(int ks=0;ks<4;++ks){ const f16x8 qb=*(const LAS f16x8*)(Qs+(16*tt+fr)*RS1+32*ks+8*fq); acc=MF16(ka[ks],qb,acc); }
        const int t=16*tt+fr; const float rf=vec[64+t]; float p[4],rsum=0.f;
        #pragma unroll
        for(int r=0;r<4;++r){ const int sidx=16*sA+4*fq+r; p[r]=(sidx<=t)?acc[r]*__expf(rf+cf4[r]):0.f; rsum+=p[r]; }
        u32x2 w; w.x=pk2h(p[0],p[1]); w.y=pk2h(p[2],p[3]); *(LAS u32x2*)(Ps+t*RS2+16*sA+4*fq)=w;
        rsum=xsum<16>(rsum); rsum=xsum<32>(rsum);
        if(fq==0)vec[384+64*sA+t]=rsum; } }
    f32x4 accN[4];
    { f16x8 ca[4];
      #pragma unroll
      for(int ks=0;ks<4;++ks)ca[ks]=*(const LAS f16x8*)(Cs+(16*wid+fr)*RS1+32*ks+8*fq);
      #pragma unroll
      for(int tt=0;tt<4;++tt){ accN[tt]=(f32x4){0.f,0.f,0.f,0.f};
        #pragma unroll
        for(int ks=0;ks<4;++ks){ const f16x8 qb=*(const LAS f16x8*)(Qs+(16*tt+fr)*RS1+32*ks+8*fq); accN[tt]=MF16(ca[ks],qb,accN[tt]); } } }
    f16x8 vfa[2];
    #pragma unroll
    for(int ks=0;ks<2;++ks){ const LAS f16*ap=Vs+trb+32*ks*RS1+16*wid; vfa[ks]=cat8(trd(ap),trd(ap+4*RS1)); }
    ML_BAR();
    float inv[4];
    #pragma unroll
    for(int tt=0;tt<4;++tt){ const int t=16*tt+fr; const float wi=vec[128+t]; const float den=(vec[384+t]+vec[448+t])+(vec[512+t]+vec[576+t])+wi*vec[320+t]; inv[tt]=frcp(fmaxf(fabsf(den),vec[192+t]));
      accN[tt]*=wi; }
    #pragma unroll
    for(int tt=0;tt<4;++tt)
      #pragma unroll
      for(int ks=0;ks<2;++ks){ const f16x8 pb=*(const LAS f16x8*)(Ps+(16*tt+fr)*RS2+32*ks+8*fq); accN[tt]=MF16(vfa[ks],pb,accN[tt]); }
    #pragma unroll
    for(int tt=0;tt<4;++tt){ accN[tt]*=inv[tt]; float q2=(accN[tt][0]*accN[tt][0]+accN[tt][1]*accN[tt][1])+(accN[tt][2]*accN[tt][2]+accN[tt][3]*accN[tt][3]);
      q2=xsum<16>(q2); q2=xsum<32>(q2); if(fq==0)vec[640+64*wid+16*tt+fr]=q2; }
    ML_BAR();
    #pragma unroll
    for(int tt=0;tt<4;++tt){ const int t=16*tt+fr; float tot=0.f;
      #pragma unroll
      for(int w=0;w<8;++w)tot+=vec[640+64*w+t];
      const float rs=1.f/sqrtf(tot*(1.f/128.f)+EPS);
      float o[4];
      #pragma unroll
      for(int r=0;r<4;++r)o[r]=accN[tt][r]*rs*gn[r]*frcp(1.f+__expf(-(float)om[tt][r]));
      u32x2 w; w.x=pk2h(o[0],o[1]); w.y=pk2h(o[2],o[3]); *(u32x2*)(outp+(rowbase+t0+t)*DM)=w; }
    if(sc<4*c+3){ const float sprev=vec[1280];
      #pragma unroll
      for(int et=0;et<8;++et)accC[et]*=sprev;
      #pragma unroll
      for(int ks=0;ks<2;++ks){ const LAS f16*ap=Ks+trb+32*ks*RS1+16*wid; const f16x8 kfa=cat8(trd(ap),trd(ap+4*RS1)) * *(const LAS f16x8*)(wph+32*ks+8*fq);
        #pragma unroll
        for(int et=0;et<8;++et){ const LAS f16*bp=Vs+trb+32*ks*RS1+16*et; const f16x8 vfb=cat8(trd(bp),trd(bp+4*RS1)); accC[et]=MF16(kfa,vfb,accC[et]); } }
      #pragma unroll
      for(int et=0;et<8;++et){ u32x2 w; w.x=pk2h(accC[et][0],accC[et][1]); w.y=pk2h(accC[et][2],accC[et][3]); *(LAS u32x2*)(Cs+(16*et+fr)*RS1+16*wid+4*fq)=w; }
      const int d=tid>>2,sg=tid&3; float sn=0.f;
      #pragma unroll
      for(int j=0;j<16;++j)sn+=(float)Ks[(16*sg+j)*RS1+d]*vec[256+16*sg+j];
      sn=xsum<1>(sn); sn=xsum<2>(sn);
      if(sg==0)vec[1152+d]=sprev*vec[1152+d]+sn; }
    ML_BAR();
  }
  #undef LOAD_RAW
}
__device__ __forceinline__ void publish(unsigned*cnt,const bool leader){
  asm volatile("s_waitcnt vmcnt(0)":::"memory"); __syncthreads();
  if(leader) __hip_atomic_fetch_add(cnt,1u,__ATOMIC_RELAXED,__HIP_MEMORY_SCOPE_AGENT);
}
__device__ __forceinline__ void await(unsigned*cnt,const unsigned want,const bool leader){
  if(leader){ unsigned sp=0; while(__hip_atomic_load(cnt,__ATOMIC_RELAXED,__HIP_MEMORY_SCOPE_AGENT)<want){ __builtin_amdgcn_s_sleep(8); if(++sp>(1u<<22))break; }
    __builtin_amdgcn_fence(__ATOMIC_ACQUIRE,"agent"); asm volatile("s_waitcnt vmcnt(0)":::"memory"); }
  __syncthreads();
}
#undef ML_BAR
#undef MF16
}

struct Args { const void* in[22]; float* out; unsigned char* ws; };
struct Frame {
    LAS unsigned char* lds; int tid, lane, wave, vcu, G, w0; float* out; unsigned char* ws;
    __device__ __forceinline__ void fresh() { const int t = tid_of(w0); tid = t; lane = t & 63; wave = w0; }
    template <class Tp> __device__ __forceinline__ const Tp* in(int k) const { const LAS unsigned* p = (const LAS unsigned*)(lds + ARGS_OFF) + 2 * k;
        const unsigned lo = __builtin_amdgcn_readfirstlane(p[0]), hi = __builtin_amdgcn_readfirstlane(p[1]); return (const Tp*)(((unsigned long long)hi << 32) | lo); }
    __device__ __forceinline__ const float* x() const { return in<float>(0); }
    __device__ __forceinline__ const float* c() const { return in<float>(1); }
    __device__ __forceinline__ const int* positions() const { return in<int>(2); }
    __device__ __forceinline__ const float* w_ada() const { return in<float>(3); }
    __device__ __forceinline__ const float* b_ada() const { return in<float>(4); }
    __device__ __forceinline__ const float* norm1_g() const { return in<float>(5); }
    __device__ __forceinline__ const float* w_in() const { return in<float>(6); }
    __device__ __forceinline__ const float* b_gate() const { return in<float>(7); }
    __device__ __forceinline__ const float* conv_w() const { return in<float>(8); }
    __device__ __forceinline__ const float* conv_b() const { return in<float>(9); }
    __device__ __forceinline__ const float* attn_g() const { return in<float>(10); }
    __device__ __forceinline__ const float* mlstm_g() const { return in<float>(11); }
    __device__ __forceinline__ const float* w_out() const { return in<float>(12); }
    __device__ __forceinline__ const float* norm2_g() const { return in<float>(13); }
    __device__ __forceinline__ const float* w_rg() const { return in<float>(14); }
    __device__ __forceinline__ const float* b_rg() const { return in<float>(15); }
    __device__ __forceinline__ const float* w_re() const { return in<float>(16); }
    __device__ __forceinline__ const float* b_re() const { return in<float>(17); }
    __device__ __forceinline__ const float* w1() const { return in<float>(18); }
    __device__ __forceinline__ const float* w3() const { return in<float>(19); }
    __device__ __forceinline__ const float* w2() const { return in<float>(20); }
    __device__ __forceinline__ const float* normf_g() const { return in<float>(21); }
};

struct TItem { const GAS float* W; unsigned char* WT; int K, ldw, k0, n0; bool f8; };
__device__ __forceinline__ bool p0_item(const Frame& F, int it, TItem& t) {
    constexpr int I_IN = 16 * 7, I_OUT = 16 * 2, I_E13 = 16, I_E2 = 8 * 2;
    constexpr int NITEMS = I_IN + I_OUT + NEXP * (2 * I_E13 + I_E2);
    if (it >= NITEMS) return false;
    int r = it, nnb; t.f8 = false;
    if (r < I_IN) { t.W = (const GAS float*)F.w_in(); t.WT = F.ws + WS_WIN; t.K = 1024; t.ldw = NPROJ_SRC; nnb = 7; }
    else if ((r -= I_IN) < I_OUT) { t.W = (const GAS float*)F.w_out(); t.WT = F.ws + WS_WOUT; t.K = 1024; t.ldw = 1024; nnb = 2; }
    else { r -= I_OUT; const int per = 2 * I_E13 + I_E2, e = r / per; r -= e * per;
        t.f8 = MOE8; const size_t eb = MOE8 ? 1 : 2;
        if (r < I_E13) { t.W = (const GAS float*)F.w1() + (size_t)e * 1024 * 512; t.WT = F.ws + WS_W1 + (size_t)e * 512 * 1024 * eb; t.K = 1024; t.ldw = 512; nnb = 1; }
        else if ((r -= I_E13) < I_E13) { t.W = (const GAS float*)F.w3() + (size_t)e * 1024 * 512; t.WT = F.ws + WS_W3 + (size_t)e * 512 * 1024 * eb; t.K = 1024; t.ldw = 512; nnb = 1; }
        else { r -= I_E13; t.W = (const GAS float*)F.w2() + (size_t)e * 512 * 1024; t.WT = F.ws + WS_W2 + (size_t)e * 1024 * 512 * eb; t.K = 512; t.ldw = 1024; nnb = 2; } }
    t.k0 = 64 * (r / nnb); t.n0 = 512 * (r % nnb);
    return true;
}
__device__ __forceinline__ void p0_load(const TItem& t, f32x4 (&v)[16], int wave, int lane) {
    const GAS float* p = t.W + (size_t)(t.k0 + 8 * wave) * t.ldw + t.n0 + 4 * lane;
#pragma unroll
    for (int r = 0; r < 8; ++r) { v[2 * r] = *(const GAS f32x4*)(p + (size_t)r * t.ldw); v[2 * r + 1] = *(const GAS f32x4*)(p + (size_t)r * t.ldw + 256); }
}
__device__ __forceinline__ void p0_park(const TItem& t, const f32x4 (&v)[16], LAS f16* Ts, int wave, int lane) {
    const float sc = t.f8 ? W8SCALE : 1.f;
#pragma unroll
    for (int r = 0; r < 8; ++r)
#pragma unroll
        for (int j = 0; j < 2; ++j) { const f32x4 x = v[2 * r + j] * sc; LAS unsigned* q = (LAS unsigned*)(Ts + (8 * wave + r) * 514 + 4 * lane + 256 * j); q[0] = pk2h(x[0], x[1]); q[1] = pk2h(x[2], x[3]); }
}
__device__ __forceinline__ void p0_emit(const TItem& t, const LAS f16* Ts, int tid) {
    const int kc = tid & 7;
#pragma unroll
    for (int jj = 0; jj < 8; ++jj) { const int n = (tid >> 3) + 64 * jj; const LAS f16* q = Ts + (8 * kc) * 514 + n;
        if (t.f8) { const float o8[8] = {(float)q[0], (float)q[514], (float)q[2 * 514], (float)q[3 * 514], (float)q[4 * 514], (float)q[5 * 514], (float)q[6 * 514], (float)q[7 * 514]};
            *(GAS u32x2*)(t.WT + (size_t)(t.n0 + n) * t.K + t.k0 + 8 * kc) = pk8_fp8(o8); }
        else { const f16x8 o = {q[0], q[514], q[2 * 514], q[3 * 514], q[4 * 514], q[5 * 514], q[6 * 514], q[7 * 514]};
            *(GAS f16x8*)((f16*)t.WT + (size_t)(t.n0 + n) * t.K + t.k0 + 8 * kc) = o; } }
}

__device__ __forceinline__ void p0_prologue(Frame F) {
    F.fresh();
    LAS float* sc = (LAS float*)F.lds; LAS float* part = (LAS float*)(F.lds + 32768);
    float* mod = (float*)(F.ws + WS_MOD);
    if ((int)blockIdx.x < 192) {
        { const GAS float* cg = (const GAS float*)F.c(); float cv[16];
#pragma unroll
          for (int u = 0; u < 16; ++u) cv[u] = cg[F.tid + NTHR * u];
#pragma unroll
          for (int u = 0; u < 16; ++u) sc[F.tid + NTHR * u] = cv[u] / (1.f + __expf(-cv[u])); }
        __syncthreads();
        for (int jb = blockIdx.x; jb < 192; jb += F.G) {
            const int jj = F.tid & 31, kc = F.tid >> 5, j0 = jb * 32;
            float a[8];
#pragma unroll
            for (int b = 0; b < 8; ++b) a[b] = 0.f;
            const GAS float* wad = (const GAS float*)F.w_ada() + (size_t)(kc * 64) * 6144 + j0 + jj;
#pragma unroll 1
            for (int k16 = 0; k16 < 64; k16 += 16) { float w[16];
#pragma unroll
                for (int u = 0; u < 16; ++u) w[u] = wad[(size_t)(k16 + u) * 6144];
#pragma unroll
                for (int u = 0; u < 16; ++u) { const int k = kc * 64 + k16 + u;
#pragma unroll
                    for (int b = 0; b < 8; ++b) a[b] += sc[b * 1024 + k] * w[u]; } }
#pragma unroll
            for (int b = 0; b < 8; ++b) part[(kc * 8 + b) * 32 + jj] = a[b];
            __syncthreads();
            if (F.tid < 256) { const int b = F.tid >> 5; float s = ((const GAS float*)F.b_ada())[j0 + jj];
                for (int k2 = 0; k2 < 16; ++k2) s += part[(k2 * 8 + b) * 32 + jj];
                mod[(size_t)b * 6144 + j0 + jj] = s; }
            __syncthreads();
        }
    }
    __syncthreads();
    const int gw = F.vcu * NWAVES + F.wave, NGW = F.G * NWAVES;
    { f16* wg = (f16*)(F.ws + WS_WGT); f16* wr = (f16*)(F.ws + WS_WRT); const GAS float* w_in = (const GAS float*)F.w_in(); const GAS float* w_rg = (const GAS float*)F.w_rg(); const GAS float* w_re = (const GAS float*)F.w_re();
      for (int i = gw * 64 + F.lane; i < 64 * 1024; i += NGW * 64) { const int n = i >> 10, k = i & 1023;
          if (n < 16) wg[n * 1024 + k] = (f16)(n < 8 ? w_in[(size_t)k * NPROJ_SRC + NPROJ + n] : 0.f);
          else { const int m = n - 16; wr[m * 1024 + k] = (f16)(m < 4 ? w_rg[k * 4 + m] : m < 36 ? w_re[k * 32 + (m - 4)] : 0.f); } } }
}


__device__ __forceinline__ void p1_weights(Frame F) {
    F.fresh();
    LAS f16* Ts = (LAS f16*)F.lds;
    TItem cur, nxt; f32x4 va[16], vb[16];
    bool have = p0_item(F, F.vcu, cur);
    if (have) p0_load(cur, va, F.wave, F.lane);
    for (int it = F.vcu; have; it += 2 * F.G) {
        const bool hn = p0_item(F, it + F.G, nxt);
        if (hn) p0_load(nxt, vb, F.wave, F.lane);
        p0_park(cur, va, Ts, F.wave, F.lane); __syncthreads(); p0_emit(cur, Ts, F.tid); __syncthreads();
        if (!hn) break;
        have = p0_item(F, it + 2 * F.G, cur);
        if (have) p0_load(cur, va, F.wave, F.lane);
        p0_park(nxt, vb, Ts, F.wave, F.lane); __syncthreads(); p0_emit(nxt, Ts, F.tid); __syncthreads();
    }
}

template <int NCT, bool SRC16, bool OUT8 = false>
__device__ __forceinline__ void modproj_tile(const void* xsrc_, const int row0, const LAS float* scl, const LAS float* sft, const f16* WT, f16* hout, f32x4 (&acc)[NCT], const int lane, const float* ssb = nullptr) {
    const int fr = lane & 15, fq = lane >> 4;
    const float* xp = (const float*)xsrc_ + (size_t)(row0 + fr) * DM + 8 * fq;
    const f16* xh = (const f16*)xsrc_ + (size_t)(row0 + fr) * 2048 + 8 * fq;
    float ss = 0.f;
    if (ssb) { const f32x4* sp = (const f32x4*)(ssb + (size_t)(row0 + fr) * 16); const f32x4 p0 = sp[0], p1 = sp[1], p2 = sp[2], p3 = sp[3];
        ss = ((p0[0] + p0[1]) + (p0[2] + p0[3])) + ((p1[0] + p1[1]) + (p1[2] + p1[3])) + ((p2[0] + p2[1]) + (p2[2] + p2[3])) + ((p3[0] + p3[1]) + (p3[2] + p3[3])); }
    else {
#pragma unroll 16
    for (int ks = 0; ks < 32; ++ks) {
        f32x4 a, c;
        if (SRC16) { const f16x8 t = *(const f16x8*)(xh + 32 * ks); a = (f32x4){(float)t[0], (float)t[1], (float)t[2], (float)t[3]}; c = (f32x4){(float)t[4], (float)t[5], (float)t[6], (float)t[7]}; }
        else { a = *(const f32x4*)(xp + 32 * ks); c = *(const f32x4*)(xp + 32 * ks + 4); }
        ss += (a[0] * a[0] + a[1] * a[1]) + (a[2] * a[2] + a[3] * a[3]) + (c[0] * c[0] + c[1] * c[1]) + (c[2] * c[2] + c[3] * c[3]); }
    ss = xsum<16>(ss); ss = xsum<32>(ss); }
    const float rstd = 1.f / sqrtf(ss * (1.f / DM) + EPS);
#pragma unroll
    for (int ct = 0; ct < NCT; ++ct) acc[ct] = (f32x4){0.f, 0.f, 0.f, 0.f};
    f16* hp = hout + (size_t)(row0 + fr) * DM + 8 * fq;
    const f16* wp = WT + (size_t)fr * DM + 8 * fq;
    constexpr int PF = 8;
    f32x4 ba[PF], bc[PF]; f16x8 bh[PF];
#define MP_LOAD(slot, ks) do { if (SRC16) bh[slot] = *(const f16x8*)(xh + 32 * (ks)); else { ba[slot] = *(const f32x4*)(xp + 32 * (ks)); bc[slot] = *(const f32x4*)(xp + 32 * (ks) + 4); } } while (0)
#pragma unroll
    for (int u = 0; u < PF; ++u) MP_LOAD(u, u);
#pragma unroll 1
    for (int k8 = 0; k8 < 32; k8 += PF) {
        f16x8 bf[PF][NCT];
#pragma unroll
        for (int u = 0; u < PF; ++u)
#pragma unroll
            for (int ct = 0; ct < NCT; ++ct) bf[u][ct] = *(const f16x8*)(wp + (size_t)ct * 16 * DM + 32 * (k8 + u));
#pragma unroll
        for (int u = 0; u < PF; ++u) { const int ks = k8 + u, k0 = 32 * ks + 8 * fq;
            f32x4 a, c;
            if (SRC16) { const f16x8 t = bh[u]; a = (f32x4){(float)t[0], (float)t[1], (float)t[2], (float)t[3]}; c = (f32x4){(float)t[4], (float)t[5], (float)t[6], (float)t[7]}; }
            else { a = ba[u]; c = bc[u]; }
            if (k8 + PF < 32) MP_LOAD(u, ks + PF);
            const f32x4 s0 = *(const LAS f32x4*)(scl + k0), s1 = *(const LAS f32x4*)(scl + k0 + 4), h0 = *(const LAS f32x4*)(sft + k0), h1 = *(const LAS f32x4*)(sft + k0 + 4);
            const f32x4 y0 = a * rstd * s0 + h0, y1 = c * rstd * s1 + h1;
            const f16x8 af = {(f16)y0[0], (f16)y0[1], (f16)y0[2], (f16)y0[3], (f16)y1[0], (f16)y1[1], (f16)y1[2], (f16)y1[3]};
            if (OUT8) { const float o8[8] = {y0[0], y0[1], y0[2], y0[3], y1[0], y1[1], y1[2], y1[3]}; *(u32x2*)((unsigned char*)hout + (size_t)(row0 + fr) * DM + 8 * fq + 32 * ks) = pk8_fp8(o8); }
            else *(f16x8*)(hp + 32 * ks) = af;
#pragma unroll
            for (int ct = 0; ct < NCT; ++ct) acc[ct] = __builtin_amdgcn_mfma_f32_16x16x32_f16(af, bf[u][ct], acc[ct], 0, 0, 0);
        }
    }
#undef MP_LOAD
}
__device__ __forceinline__ void stage_mod(LAS float* dst, const float* g, const float* sh, const float* sc, int tid) {
    for (int i = tid; i < 256; i += NTHR) { const f32x4 gv = *(const f32x4*)(g + 4 * i), sv = *(const f32x4*)(sc + 4 * i), hv = *(const f32x4*)(sh + 4 * i);
        *(LAS f32x4*)(dst + 4 * i) = gv * (sv + 1.f); *(LAS f32x4*)(dst + 1024 + 4 * i) = hv; }
}

__device__ __forceinline__ void p1_rows(Frame F) {
    F.fresh();
    const float* mod = (const float*)(F.ws + WS_MOD);
    f16* hbuf = (f16*)(F.ws + WS_A); float* gates = (float*)(F.ws + WS_GATES);
    float* cosT = (float*)(F.ws + WS_COS); float* sinT = (float*)(F.ws + WS_SIN);
    const float* x = F.x(); const float* g1n = F.norm1_g(); const float* bg = F.b_gate(); const int* pos = F.positions();
    const f16* WT = (const f16*)(F.ws + WS_WGT);
    const int lane = F.lane, w = F.wave, fr = lane & 15, fq = lane >> 4;
    constexpr int RSX = 1032;
    LAS f16* Xs = (LAS f16*)F.lds; LAS float* part = (LAS float*)(F.lds + 66048); LAS float* rsv = part + 1024; LAS float* smod = (LAS float*)(F.lds + 73728);
    int sb = -1;
    const int NT32 = T / 32;
    f32x4 rx[4][4];
#define P1_LOAD(t) do { _Pragma("unroll") for (int r = 0; r < 4; ++r) { const GAS f32x4* xr = (const GAS f32x4*)(x + (size_t)((t) * 32 + 4 * w + r) * DM) + lane; \
        _Pragma("unroll") for (int j = 0; j < 4; ++j) rx[r][j] = xr[64 * j]; } } while (0)
    int tile = F.vcu;
    if (tile < NT32) P1_LOAD(tile);
    for (; tile < NT32; tile += F.G) {
        const int row0 = tile * 32, b = row0 / SEQ;
        if (b != sb) { __syncthreads(); stage_mod(smod, g1n, mod + (size_t)b * 6144, mod + (size_t)b * 6144 + 1024, F.tid); sb = b; }
#pragma unroll
        for (int r = 0; r < 4; ++r) { float ss = 0.f;
#pragma unroll
            for (int j = 0; j < 4; ++j) { const f32x4 v = rx[r][j]; ss += (v.x * v.x + v.y * v.y) + (v.z * v.z + v.w * v.w);
                u32x2 pk; pk.x = pk2h(v.x, v.y); pk.y = pk2h(v.z, v.w); *(LAS u32x2*)(Xs + (4 * w + r) * RSX + 4 * lane + 256 * j) = pk; }
            ss = wave_sum(ss);
            if (lane == 0) rsv[4 * w + r] = 1.f / sqrtf(ss * (1.f / DM) + EPS); }
        __syncthreads();
        if (tile + F.G < NT32) P1_LOAD(tile + F.G);
        { const int rt = w >> 2, kq = w & 3, row = 16 * rt + fr; const float rs = rsv[row];
          f32x4 acc = {0.f, 0.f, 0.f, 0.f};
          f16* hp = hbuf + (size_t)(row0 + row) * DM + 8 * fq;
#pragma unroll
          for (int u = 0; u < 8; ++u) { const int ks = 8 * kq + u, k0 = 32 * ks + 8 * fq;
              const f16x8 xv = *(const LAS f16x8*)(Xs + row * RSX + k0);
              const f32x4 s0 = *(const LAS f32x4*)(smod + k0), s1 = *(const LAS f32x4*)(smod + k0 + 4), h0 = *(const LAS f32x4*)(smod + 1024 + k0), h1 = *(const LAS f32x4*)(smod + 1024 + k0 + 4);
              const f32x4 a = {(float)xv[0], (float)xv[1], (float)xv[2], (float)xv[3]}, c = {(float)xv[4], (float)xv[5], (float)xv[6], (float)xv[7]};
              const f32x4 y0 = a * rs * s0 + h0, y1 = c * rs * s1 + h1;
              const f16x8 af = {(f16)y0[0], (f16)y0[1], (f16)y0[2], (f16)y0[3], (f16)y1[0], (f16)y1[1], (f16)y1[2], (f16)y1[3]};
              *(f16x8*)(hp + 32 * ks) = af;
              const f16x8 bf = *(const f16x8*)(WT + (size_t)fr * DM + 32 * ks + 8 * fq);
              acc = __builtin_amdgcn_mfma_f32_16x16x32_f16(af, bf, acc, 0, 0, 0); }
          if (fr < 8) {
#pragma unroll
              for (int r = 0; r < 4; ++r) part[(w * 16 + 4 * fq + r) * 8 + fr] = acc[r]; } }
        __syncthreads();
        if (F.tid < 256) { const int r = F.tid >> 3, q = F.tid & 7, rt = r >> 4, rr = r & 15;
            float g = bg[q];
#pragma unroll
            for (int kq = 0; kq < 4; ++kq) g += part[((4 * rt + kq) * 16 + rr) * 8 + q];
            gates[(size_t)(row0 + r) * 8 + q] = g; }
#pragma unroll
        for (int i = 0; i < 2; ++i) { const int idx = F.tid + NTHR * i, r = idx >> 5, f = idx & 31;
            const float invf = exp2f(-(float)f * (13.287712379549449f / 32.f)); const float ang = (float)pos[row0 + r] * invf;
            cosT[(size_t)(row0 + r) * 32 + f] = cosf(ang); sinT[(size_t)(row0 + r) * 32 + f] = sinf(ang); }
        __syncthreads();
    }
#undef P1_LOAD
}

#if defined(PROBE_K) && PROBE_K == 33
#define ML_REP 2
#else
#define ML_REP 1
#endif
#if defined(PROBE_K) && PROBE_K == 34
#define AT_REP 2
#else
#define AT_REP 1
#endif
constexpr int CW_Q = 12288;
constexpr int CW_DEPA = 16384, CW_DEPB = 20480, CW_DEPC = 49152;
constexpr int CW_ASEL = 57344, CW_APART = 58368, CW_ACNT = 62464;
constexpr size_t WS_ALIST = 77 * MiB;
constexpr size_t WS_ALSE = 45 * MiB;
static_assert(MOE8, "the attention side buffers use the gaps the fp8 expert images leave in the weight map");
constexpr int ATAB_OFF = 131072;
constexpr int QSPLIT = 8;
constexpr int P3_GB = 260;
__device__ __forceinline__ void p3_mixers(Frame F) {
    F.fresh();
    const int q = blockIdx.x & 7;
    int tk = 0;
    if (F.tid == 0) tk = (int)__hip_atomic_fetch_add((unsigned*)(F.ws + WS_CTL) + CW_Q + 64 * q, 1u, RLX_AGENT);
    bool have_tab = false; int Nx = 0;
    bool own_ready = false;
    unsigned* pend = nullptr;
#define P3_FLUSH() do { if (pend != nullptr) { mlstm::publish(pend, F.tid == 0); pend = nullptr; } } while (0)
    for (;;) {
        F.fresh();
        unsigned char* wsl = F.ws; asm volatile("" : "+s"(wsl));
        LAS unsigned char* ldl = F.lds; asm volatile("" : "+s"(ldl));
        float* outl = F.out; asm volatile("" : "+s"(outl));
        const f16* proj = (const f16*)(wsl + WS_PROJ); const float* ksum = (const float*)(wsl + WS_CTL + CTL_KMEAN); f16* mix = (f16*)(wsl + WS_A);
        unsigned* ctl = (unsigned*)(wsl + WS_CTL);
        LAS int* slot = (LAS int*)(ldl + TAB_OFF + 512);
        LAS int* at = (LAS int*)(ldl + ATAB_OFF);
        int* alist = (int*)(wsl + WS_ALIST); f16* part = (f16*)outl; float* lseb = (float*)(wsl + WS_ALSE);
        float* mls = (float*)(wsl + WS_MLS);
        const mlstm::Glob G{(f16*)(wsl + WS_CLOC), (f16*)(wsl + WS_CPREV), mls, mls + 65536, mls + 131072, mls + 131584, mls + 132096,
                            (f16*)(wsl + WS_QKC), mls + 132608, mls + 132608 + 131072, (float*)(wsl + WS_GPM), mls + 132608 + 262144, mls + 132608 + 262144 + 2048};
        if (F.tid == 0) *slot = tk;
        __syncthreads();
        const int it = *slot;
        __syncthreads();
        if (it >= P3_GB && !have_tab) {
            P3_FLUSH();
            mlstm::await(ctl + CW_ASEL + 64 * q, 64u, F.tid == 0);
            if (F.tid < 120) { const int h = F.tid / 15, n = F.tid % 15; at[128 + F.tid] = (int)__hip_atomic_load(ctl + CW_ACNT + (8 * q + h) * 16 + n, RLX_AGENT); }
            __syncthreads();
            if (F.tid == 0) { int p = 0;
#pragma unroll 1
                for (int k = 0; k < 120; ++k) { at[k] = p; p += (at[128 + k] + 1023) >> 10; } at[120] = p; }
            __syncthreads();
            Nx = at[120]; have_tab = true;
        }
        if (have_tab && it >= P3_GB + Nx + 128) { P3_FLUSH(); break; }
#if defined(PROBE_K) && PROBE_K >= 50
        if (F.tid == 0) { LAS unsigned long long* st_ = (LAS unsigned long long*)(ldl + TAB_OFF + 768); const unsigned long long t_ = __builtin_amdgcn_s_memrealtime();
            if (it >= 196 && st_[2] == 0ull) st_[2] = t_;
            if (it >= P3_GB && st_[3] == 0ull) st_[3] = t_;
            if (have_tab && it >= P3_GB + Nx + 64 && st_[4] == 0ull) st_[4] = t_; }
#endif
        if (F.tid == 0) tk = (int)__hip_atomic_fetch_add(ctl + CW_Q + 64 * q, 1u, RLX_AGENT);
        if (it < 64) { const int h = it >> 3, qb = QSPLIT + (it & 7);
            moba::sel_list(q, h, qb, proj + C_QA, ksum, alist, ctl + CW_ACNT, (char*)ldl, F.w0, pend);
            pend = ctl + CW_ASEL + 64 * q; }
        else if (it < 128) { const int j = it - 64;
            P3_FLUSH();
            mlstm::prep(q, j, G, proj, (const float*)(wsl + WS_GATES), F.conv_w(), F.conv_b(), F.w0);
            mlstm::publish(ctl + CW_DEPC + 64 * (q * 16 + (j >> 2)), F.tid == 0); }
        else if (it < 192) { const int j = it - 128, hm = j >> 4, c = j & 15;
            P3_FLUSH();
            mlstm::await(ctl + CW_DEPC + 64 * (q * 16 + c), 4u, F.tid == 0);
            for (int rep = 0; rep < ML_REP; ++rep) mlstm::contrib(q, hm, c, G, proj, ldl, F.w0);
            mlstm::publish(ctl + CW_DEPA + 64 * (q * 4 + hm), F.tid == 0); }
        else if (it < 196) { const int seq = q * 4 + (it - 192);
            P3_FLUSH();
            mlstm::await(ctl + CW_DEPA + 64 * seq, 16u, F.tid == 0);
            for (int rep = 0; rep < ML_REP; ++rep) mlstm::scan(seq, G, F.w0);
            mlstm::publish(ctl + CW_DEPB + 64 * seq, F.tid == 0); }
        else if (it < 260) { const int j = it - 196, qb = QSPLIT - 1 - (j >> 3), h = j & 7;
            P3_FLUSH();
            mobad::sel_unit(q, h, qb, proj + C_QA, ksum, (char*)ldl, F.w0);
            mobad::attn_unit<8>(q, h, qb, proj + C_QA, proj + C_KA, proj + C_VA, mix, ksum, F.attn_g(), (char*)ldl, F.w0); }
        else if (it < P3_GB + Nx) { const int g = it - P3_GB;
            if (F.tid < 120 && at[F.tid] <= g && g < at[F.tid + 1]) at[124] = F.tid;
            __syncthreads();
            const int k = at[124], h = k / 15, n = k % 15, r0 = (g - at[k]) * 1024, cnt = at[128 + k], r1 = cnt < r0 + 1024 ? cnt : r0 + 1024;
            moba::attn_pass<8, 1>(q, h, n, r0, r1, 0, alist, proj + C_QA, proj + C_KA, proj + C_VA, mix, part, lseb, F.attn_g(), (char*)ldl, F.w0, pend);
            pend = ctl + CW_APART + 64 * (8 * q + h); }
        else if (it < P3_GB + Nx + 64) { const int j = it - (P3_GB + Nx), hm = j >> 4, c = j & 15;
            P3_FLUSH();
            mlstm::await(ctl + CW_DEPB + 64 * (q * 4 + hm), 1u, F.tid == 0);
            for (int rep = 0; rep < ML_REP; ++rep) mlstm::unit(q, hm, c, G, proj, F.mlstm_g(), mix, ldl, F.w0); }
        else { const int j = it - (P3_GB + Nx + 64), qb = 15 - (j >> 3), h = j & 7, npk = 3;
            P3_FLUSH();
            if (!own_ready) {
                if (F.tid < 8) { const unsigned want = (unsigned)(at[15 * F.tid + 15] - at[15 * F.tid]); unsigned sp = 0;
                    while (__hip_atomic_load(ctl + CW_APART + 64 * (8 * q + F.tid), RLX_AGENT) < want) { __builtin_amdgcn_s_sleep(8); if (++sp > (1u << 22)) break; } }
                if (F.tid < 64) { __builtin_amdgcn_fence(__ATOMIC_ACQUIRE, "agent"); asm volatile("s_waitcnt vmcnt(0)" ::: "memory"); }
                __syncthreads(); own_ready = true; }
            moba::attn_pass<8, 0>(q, h, qb, 0, 0, npk, alist, proj + C_QA, proj + C_KA, proj + C_VA, mix, part, lseb, F.attn_g(), (char*)ldl, F.w0, nullptr); }
    }
}

__device__ __forceinline__ void p5_route(Frame F) {
    F.fresh();
    const int gw = F.vcu * NWAVES + F.wave, NGW = F.G * NWAVES;
    const float* mod = (const float*)(F.ws + WS_MOD);
    f16* h2 = (f16*)(F.ws + WS_H2); int* list = (int*)(F.ws + WS_LIST); int* pos2 = (int*)(F.ws + WS_POS);
    unsigned* cnt = (unsigned*)(F.ws + WS_CTL) + CW_CNT;
    LAS int* hist = (LAS int*)F.lds; LAS int* rec = (LAS int*)(F.lds + 1024);
    LAS float* lgs = (LAS float*)(F.lds + 16384) + F.wave * 16 * 49;
    const float* g2n = F.norm2_g(); const float* brg = F.b_rg(); const float* bre = F.b_re();
    const int fr = F.lane & 15, fq = F.lane >> 4;
    if (F.tid < 64) hist[F.tid] = 0;
    __syncthreads();
    int nloc = 0;
    LAS float* smod = (LAS float*)(F.lds + 65536); int sb = -1;
    for (int tile0 = F.vcu * NWAVES; tile0 < T / 16; tile0 += NGW) {
        const int tile = tile0 + F.wave, row0 = tile * 16, b = (tile0 * 16) / SEQ;
        if (b != sb) { __syncthreads(); stage_mod(smod, g2n, mod + (size_t)b * 6144 + 3072, mod + (size_t)b * 6144 + 4096, F.tid); __syncthreads(); sb = b; }
        f32x4 acc[3];
        modproj_tile<3, true, MOE8>(F.out, row0, smod, smod + 1024, (const f16*)(F.ws + WS_WRT), h2, acc, F.lane, (const float*)(F.ws + WS_MLS));
#pragma unroll
        for (int ct = 0; ct < 3; ++ct)
#pragma unroll
            for (int r = 0; r < 4; ++r) lgs[(4 * fq + r) * 49 + 16 * ct + fr] = acc[ct][r];
        LDS_WAIT(); asm volatile("" ::: "memory");
        if (F.lane < 16) {
            const int row = row0 + F.lane; const LAS float* lg = lgs + F.lane * 49;
            float gl[4];
#pragma unroll
            for (int q = 0; q < 4; ++q) gl[q] = lg[q] + brg[q];
            int gi = 0; float gm = gl[0];
#pragma unroll
            for (int q = 1; q < 4; ++q) if (gl[q] > gm) { gm = gl[q]; gi = q; }
            float gsum = 0.f;
#pragma unroll
            for (int q = 0; q < 4; ++q) gsum += __expf(gl[q] - gm);
            const float pg = 1.f / gsum;
            float el[8];
#pragma unroll
            for (int q = 0; q < 8; ++q) el[q] = lg[4 + 8 * gi + q] + bre[gi * 8 + q];
            int i1 = 0; float m1 = el[0];
#pragma unroll
            for (int q = 1; q < 8; ++q) if (el[q] > m1) { m1 = el[q]; i1 = q; }
            int i2 = -1; float m2 = -INFINITY;
#pragma unroll
            for (int q = 0; q < 8; ++q) if (q != i1 && el[q] > m2) { m2 = el[q]; i2 = q; }
            const float rr = __expf(m2 - m1), w1 = pg / (1.f + rr), w2 = pg * rr / (1.f + rr);
#pragma unroll
            for (int k = 0; k < 2; ++k) { const int e = gi * 8 + (k == 0 ? i1 : i2); const float w = k == 0 ? w1 : w2;
                const int rank = (int)__hip_atomic_fetch_add((LAS unsigned*)hist + e, 1u, __ATOMIC_RELAXED, __HIP_MEMORY_SCOPE_WORKGROUP);
                LAS int* rp = rec + (F.wave * 64 + 32 * nloc + 2 * F.lane + k) * 4; rp[0] = row; rp[1] = e; rp[2] = rank; rp[3] = __float_as_int(w); }
        }
        ++nloc;
        LDS_WAIT(); asm volatile("" ::: "memory");
    }
    __syncthreads();
    if (F.tid < 32) hist[32 + F.tid] = (int)atomicAdd(cnt + 64 * F.tid, (unsigned)hist[F.tid]);
    __syncthreads();
    for (int i = F.lane; i < 32 * nloc; i += 64) { const LAS int* rp = rec + (F.wave * 64 + i) * 4; const int row = rp[0], e = rp[1], slot = hist[32 + e] + rp[2];
        list[2 * ((size_t)e * LISTCAP + slot)] = row; list[2 * ((size_t)e * LISTCAP + slot) + 1] = rp[3];
        pos2[2 * row + (i & 1)] = e * LISTCAP + slot; }
}

__device__ __forceinline__ void moe_tables(Frame F) {
    F.fresh();
    LAS int* tab = (LAS int*)(F.lds + TAB_OFF);
    const unsigned* cnt = (const unsigned*)(F.ws + WS_CTL) + CW_CNT;
    __syncthreads();
    if (F.tid < 32) tab[80 + F.tid] = (int)__hip_atomic_load(cnt + 64 * F.tid, RLX_AGENT);
    __syncthreads();
    if (F.tid == 0) { int up = 0, rp = 0;
        for (int e = 0; e < 32; ++e) { const int c = tab[80 + e]; tab[e] = up; tab[40 + e] = rp; up += ((c + 255) >> 8) * 4; rp += c; }
        tab[32] = up; tab[72] = rp; }
    __syncthreads();
}

struct P8Row { unsigned ya[4], yb[4]; f16x4 xh[4]; };
__device__ __forceinline__ void p8_load(P8Row& R, const unsigned char* Y, const f16* x1h, const LAS int* tab, int row, int p0, int p1, int lane) {
    const size_t y0 = (size_t)(tab[40 + (p0 >> 15)] + (p0 & 32767)) * DM, y1 = (size_t)(tab[40 + (p1 >> 15)] + (p1 & 32767)) * DM;
#pragma unroll
    for (int j = 0; j < 4; ++j) { const int k0 = 4 * lane + 256 * j; R.ya[j] = *(const unsigned*)(Y + y0 + k0); R.yb[j] = *(const unsigned*)(Y + y1 + k0); R.xh[j] = *(const f16x4*)(x1h + (size_t)row * 2048 + k0); }
}
__device__ __forceinline__ void p8_row(const P8Row& R, float* out, const float* g2, const float* gf, int row, int lane) {
    f32x4 v[4]; float ss = 0.f;
#pragma unroll
    for (int j = 0; j < 4; ++j) { const int k0 = 4 * lane + 256 * j; const f32x4 g = *(const f32x4*)(g2 + k0);
        const auto a01 = __builtin_amdgcn_cvt_pk_f32_fp8((int)R.ya[j], false), a23 = __builtin_amdgcn_cvt_pk_f32_fp8((int)R.ya[j], true), b01 = __builtin_amdgcn_cvt_pk_f32_fp8((int)R.yb[j], false), b23 = __builtin_amdgcn_cvt_pk_f32_fp8((int)R.yb[j], true);
        f32x4 sv; sv.x = a01[0] + b01[0]; sv.y = a01[1] + b01[1]; sv.z = a23[0] + b23[0]; sv.w = a23[1] + b23[1];
        v[j] = (f32x4){(float)R.xh[j][0], (float)R.xh[j][1], (float)R.xh[j][2], (float)R.xh[j][3]} + g * sv; ss += (v[j].x * v[j].x + v[j].y * v[j].y) + (v[j].z * v[j].z + v[j].w * v[j].w); }
    const float rstd = 1.f / sqrtf(wave_sum(ss) * (1.f / DM) + EPS);
    GAS f32x4* xr = (GAS f32x4*)(out + (size_t)row * DM) + lane;
#pragma unroll
    for (int j = 0; j < 4; ++j) { const int k0 = 4 * lane + 256 * j; xr[64 * j] = v[j] * rstd * *(const f32x4*)(gf + k0); }
}
__device__ __forceinline__ void p8_final(Frame F) {
    F.fresh();
    const int gw = F.vcu * NWAVES + F.wave, NGW = F.G * NWAVES;
    const float* mod = (const float*)(F.ws + WS_MOD); const unsigned char* Y = (const unsigned char*)(F.ws + WS_Y); const int* pos2 = (const int*)(F.ws + WS_POS);
    const LAS int* tab = (const LAS int*)(F.lds + TAB_OFF);
    const float* gf = F.normf_g(); const f16* x1h = (const f16*)F.out;
    const int RPW = (T + NGW - 1) / NGW, r0 = gw * RPW, r1 = min(T, r0 + RPW);
    if (r0 >= r1) return;
    P8Row A, B;
    int pa0 = pos2[2 * r0], pa1 = pos2[2 * r0 + 1], pb0 = 0, pb1 = 0;
    if (r0 + 1 < r1) { pb0 = pos2[2 * r0 + 2]; pb1 = pos2[2 * r0 + 3]; }
    p8_load(A, Y, x1h, tab, r0, pa0, pa1, F.lane);
    for (int row = r0; row < r1; row += 2) {
        const bool hb = row + 1 < r1;
        if (hb) p8_load(B, Y, x1h, tab, row + 1, pb0, pb1, F.lane);
        if (row + 2 < r1) { pa0 = pos2[2 * row + 4]; pa1 = pos2[2 * row + 5]; }
        p8_row(A, F.out, mod + (size_t)(row / SEQ) * 6144 + 5120, gf, row, F.lane);
        if (!hb) break;
        if (row + 2 < r1) p8_load(A, Y, x1h, tab, row + 2, pa0, pa1, F.lane);
        if (row + 3 < r1) { pb0 = pos2[2 * row + 6]; pb1 = pos2[2 * row + 7]; }
        p8_row(B, F.out, mod + (size_t)((row + 1) / SEQ) * 6144 + 5120, gf, row + 1, F.lane);
    }
}

#ifdef PROBE_K
#define PROBE_PH ((PROBE_K == 33 || PROBE_K == 34 || (PROBE_K >= 50 && PROBE_K <= 53)) ? 3 : (PROBE_K == 40) ? 100 : (PROBE_K == 41) ? 101 : PROBE_K)
#define PSTAMP(k) do { if ((k) == PROBE_PH || (k) == PROBE_PH + 1) { const unsigned long long t_ = __builtin_amdgcn_s_memrealtime(); if (F.tid == 0) ((LAS unsigned long long*)(F.lds + TAB_OFF + 768))[(k) - PROBE_PH] = t_; } } while (0)
#else
#define PSTAMP(k) do {} while (0)
#endif
__global__ void __launch_bounds__(NTHR, 2) fwd_kernel(Args args) {
    extern __shared__ __attribute__((aligned(16))) unsigned char lds_raw[];
    Frame F;
    F.lds = (LAS unsigned char*)lds_raw;
    F.w0 = __builtin_amdgcn_readfirstlane((int)threadIdx.x >> 6); F.fresh();
    F.G = gridDim.x; { const int bx = blockIdx.x; F.vcu = (F.G % 8 == 0) ? (bx % 8) * (F.G / 8) + bx / 8 : bx; }
    F.out = args.out; F.ws = args.ws;
    for (int u = F.tid; u < (LDS_BYTES - LDSCTL_OFF) / 4; u += NTHR) ((LAS unsigned*)(F.lds + LDSCTL_OFF))[u] = 0u;
    __syncthreads();
    if (F.tid < 44) ((LAS unsigned*)(F.lds + ARGS_OFF))[F.tid] = ((const __attribute__((address_space(4))) unsigned*)__builtin_amdgcn_kernarg_segment_ptr())[F.tid];
    __syncthreads();
    unsigned* ctl = (unsigned*)(F.ws + WS_CTL);
    XcdBarrier bar = xcd_barrier_post(ctl + CW_BAR, (volatile LAS unsigned*)(F.lds + MISC_OFF) + 8, F.tid == 0);

    PSTAMP(0);
    PSTAMP(100);
    p0_prologue(F);
    __syncthreads();
    PSTAMP(101);
    p1_weights(F);
    PSTAMP(102);
    xcd_barrier(bar, F.w0);
    PSTAMP(1);
    p1_rows(F);
    xcd_barrier(bar, F.w0);
    PSTAMP(2);
    { pg8::DenseSched S; S.init(T, NPROJ, 1024, F.G, (int)blockIdx.x, true);
      pg8::EpiProj E{(f16*)(F.ws + WS_PROJ), (const float*)(F.ws + WS_COS), (const float*)(F.ws + WS_SIN), (float*)(F.ws + WS_CTL + CTL_KMEAN)};
      pg8::gemm_phase<true, false>(F.lds, (const char*)(F.ws + WS_A), (const char*)(F.ws + WS_WIN), 1024, S, E, F.w0); }
    xcd_barrier(bar, F.w0);
    PSTAMP(3);
    p3_mixers(F);
    xcd_barrier(bar, F.w0);
    PSTAMP(4);
    { pg8::DenseSched S; S.init(T, DM, 1024, F.G, (int)blockIdx.x, false);
      pg8::EpiOut E{F.x(), (const float*)(F.ws + WS_MOD), (f16*)F.out, (float*)(F.ws + WS_MLS)};
      pg8::gemm_phase<false, false>(F.lds, (const char*)(F.ws + WS_A), (const char*)(F.ws + WS_WOUT), 1024, S, E, F.w0); }
    xcd_barrier(bar, F.w0);
    PSTAMP(5);
    p5_route(F);
    xcd_barrier(bar, F.w0);
    PSTAMP(6);
    moe_tables(F);
    { pg8::MoeSched S{(const LAS int*)(F.lds + TAB_OFF), F.G, F.vcu, 1024, true, (const int*)(F.ws + WS_LIST), (unsigned*)(F.ws + WS_CTL) + CW_MT};
      pg8::EpiMoe1 E{(unsigned char*)(F.ws + WS_HID)};
      pg8::gemm_phase<false, MOE8>(F.lds, (const char*)(F.ws + WS_H2), (const char*)(F.ws + WS_W1), 1024, S, E, F.w0); }
    PSTAMP(7);
    { pg8::MoeSched S{(const LAS int*)(F.lds + TAB_OFF), F.G, F.G - 1 - F.vcu, 512, false, (const int*)(F.ws + WS_LIST), (unsigned*)(F.ws + WS_CTL) + CW_MT};
      pg8::EpiMoe2 E{(unsigned char*)(F.ws + WS_Y), (const int*)(F.ws + WS_LIST)};
      pg8::gemm_phase<false, MOE8>(F.lds, (const char*)(F.ws + WS_HID), (const char*)(F.ws + WS_W2), 512, S, E, F.w0); }
    xcd_barrier(bar, F.w0);
    PSTAMP(8);
    p8_final(F);
#ifdef PROBE_K
    __syncthreads(); PSTAMP(9); __syncthreads();
    if (blockIdx.x == 0) { unsigned long long tp0 = ((LAS unsigned long long*)(F.lds + TAB_OFF + 768))[0], tp1 = ((LAS unsigned long long*)(F.lds + TAB_OFF + 768))[1];
#if PROBE_K >= 50
        { const LAS unsigned long long* st_ = (const LAS unsigned long long*)(F.lds + TAB_OFF + 768);
          const unsigned long long a_ = PROBE_K == 50 ? st_[0] : st_[PROBE_K - 49], b_ = PROBE_K == 53 ? st_[1] : st_[PROBE_K - 48]; tp0 = a_; tp1 = b_; }
#endif
 const unsigned long long te = __builtin_amdgcn_s_memrealtime(); while (__builtin_amdgcn_s_memrealtime() - te < 8ull * (tp1 - tp0)) __builtin_amdgcn_s_sleep(20); }
#endif
}

extern "C" void kernel_launch(void* const* d_in, const int* in_sizes, int n_in, void* d_out, int out_size, void* d_ws, size_t ws_size, hipStream_t stream) {
    static int grid = 0;
    if (grid == 0) {
        if (n_in != 22 || out_size != T * DM || ws_size < WS_END) { fprintf(stderr, "kernel_launch: unexpected problem (n_in %d, out %d, ws %zu)\n", n_in, out_size, ws_size); grid = -1; return; }
        int dev = 0, cus = 0, per_cu = 0;
        if (hipGetDevice(&dev) != hipSuccess || hipDeviceGetAttribute(&cus, hipDeviceAttributeMultiprocessorCount, dev) != hipSuccess) { grid = -1; return; }
        if (hipFuncSetAttribute((const void*)fwd_kernel, hipFuncAttributeMaxDynamicSharedMemorySize, LDS_BYTES) != hipSuccess) { fprintf(stderr, "kernel_launch: hipFuncSetAttribute failed\n"); grid = -1; return; }
        if (hipOccupancyMaxActiveBlocksPerMultiprocessor(&per_cu, (const void*)fwd_kernel, NTHR, LDS_BYTES) != hipSuccess || per_cu < 1) fprintf(stderr, "kernel_launch: occupancy query says %d\n", per_cu);
        (void)hipGetLastError();
        grid = cus;
    }
    if (grid < 0) return;
    (void)hipMemsetAsync((char*)d_ws + WS_CTL, 0, CTL_ZERO_BYTES, stream);
    Args a{};
    for (int i = 0; i < 22; ++i) a.in[i] = d_in[i];
    a.out = (float*)d_out; a.ws = (unsigned char*)d_ws;
    hipLaunchKernelGGL(fwd_kernel, dim3(grid), dim3(NTHR), LDS_BYTES, stream, a);
}
```

```cpp
#include <hip/hip_runtime.h>
#include <cstdio>
#include <cstdint>
#include <cmath>

#define LAS __attribute__((address_space(3)))
#define GAS __attribute__((address_space(1)))
typedef _Float16 f16;
typedef _Float16 f16x8 __attribute__((ext_vector_type(8)));
typedef _Float16 f16x4 __attribute__((ext_vector_type(4)));
typedef _Float16 f16x2 __attribute__((ext_vector_type(2)));
typedef float f32x4 __attribute__((ext_vector_type(4)));
typedef float f32x2 __attribute__((ext_vector_type(2)));
typedef unsigned u32x4 __attribute__((ext_vector_type(4)));
typedef unsigned u32x2 __attribute__((ext_vector_type(2)));

constexpr int NB = 8, SEQ = 4096, DM = 1024, T = NB * SEQ;
constexpr int NPROJ = 3584, NPROJ_SRC = 3592;
constexpr int C_QA = 0, C_KA = 512, C_VA = 1024, C_QM = 1536, C_KM = 2048, C_VM = 2560, C_OM = 3072;
constexpr int NEXP = 32, DEXP = 512, LISTCAP = 32768;
constexpr float EPS = 1e-6f;
constexpr float C2 = 0.125f * 1.4426950408889634f;
constexpr int NWAVES = 8, NTHR = 512;

constexpr size_t MiB = 1u << 20;
constexpr size_t WS_CTL = 0, CTL_ZERO_BYTES = 1 * MiB;
constexpr int CW_BAR = 4096;
constexpr int CW_MT = 28672;
constexpr int CW_CNT = 8192;
constexpr size_t CTL_KMEAN = 256 * 1024;
constexpr size_t WS_WGT = 1 * MiB + 256 * 1024, WS_WRT = 1 * MiB + 320 * 1024;
constexpr size_t WS_MOD = 1 * MiB, WS_GATES = 2 * MiB, WS_POS = 3 * MiB, WS_COS = 4 * MiB, WS_SIN = 8 * MiB, WS_LIST = 12 * MiB;
constexpr size_t WS_WIN = 20 * MiB, WS_WOUT = 27 * MiB, WS_W1 = 29 * MiB, WS_W3 = 61 * MiB, WS_W2 = 93 * MiB;
constexpr size_t WS_A = 126 * MiB;
constexpr size_t WS_PROJ = 190 * MiB;
constexpr size_t WS_H2 = 190 * MiB;
constexpr size_t WS_HID = 254 * MiB;
constexpr size_t WS_Y = 320 * MiB;
constexpr size_t WS_MLS = 414 * MiB;
constexpr size_t WS_GPM = 512 * 1024;
constexpr size_t WS_CLOC = 416 * MiB;
constexpr size_t WS_CPREV = 432 * MiB;
constexpr size_t WS_QKC = 448 * MiB;
constexpr size_t WS_END = 512 * MiB;

constexpr int RING_BYTES = 133120;
constexpr int LDSCTL_OFF = RING_BYTES, MISC_OFF = LDSCTL_OFF + 320, TAB_OFF = LDSCTL_OFF + 1024;
constexpr int ARGS_OFF = LDSCTL_OFF + 2048;
constexpr int LDS_BYTES = 147456;

#define RLX_AGENT __ATOMIC_RELAXED, __HIP_MEMORY_SCOPE_AGENT
#define LDS_WAIT() asm volatile("s_waitcnt lgkmcnt(0)" ::: "memory")
__device__ __forceinline__ unsigned pk2h(float a, float b) { f16x2 v = {(f16)a, (f16)b}; return __builtin_bit_cast(unsigned, v); }
template <int M> __device__ __forceinline__ float xsum(float v) {
    const int iv = __builtin_bit_cast(int, v);
    if constexpr (M == 1) return v + __builtin_bit_cast(float, __builtin_amdgcn_mov_dpp(iv, 0xB1, 0xF, 0xF, true));
    else if constexpr (M == 2) return v + __builtin_bit_cast(float, __builtin_amdgcn_mov_dpp(iv, 0x4E, 0xF, 0xF, true));
    else if constexpr (M == 32) { const auto r = __builtin_amdgcn_permlane32_swap((unsigned)iv, (unsigned)iv, false, false); return __uint_as_float(r[0]) + __uint_as_float(r[1]); }
    else return v + __builtin_bit_cast(float, __builtin_amdgcn_ds_swizzle(iv, (M << 10) | 0x1F));
}
__device__ __forceinline__ float wave_sum(float v) { v = xsum<1>(v); v = xsum<2>(v); v = xsum<4>(v); v = xsum<8>(v); v = xsum<16>(v); return xsum<32>(v); }
typedef int i32x8 __attribute__((ext_vector_type(8)));
typedef int i32x4 __attribute__((ext_vector_type(4)));
__device__ __forceinline__ u32x2 pk8_fp8(const float (&o)[8]) {
    float c[8];
#pragma unroll
    for (int j = 0; j < 8; ++j) c[j] = fminf(fmaxf(o[j], -448.f), 448.f);
    int lo = __builtin_amdgcn_cvt_pk_fp8_f32(c[0], c[1], 0, false); lo = __builtin_amdgcn_cvt_pk_fp8_f32(c[2], c[3], lo, true);
    int hi = __builtin_amdgcn_cvt_pk_fp8_f32(c[4], c[5], 0, false); hi = __builtin_amdgcn_cvt_pk_fp8_f32(c[6], c[7], hi, true);
    return (u32x2){(unsigned)lo, (unsigned)hi};
}
#ifndef MOE_FP8
#define MOE_FP8 1
#endif
constexpr bool MOE8 = MOE_FP8 != 0;
constexpr float W8SCALE = MOE8 ? 16.f : 1.f;
__device__ __forceinline__ float sigmoidf_(float x) { return 1.f / (1.f + __expf(-x)); }

__device__ __forceinline__ int tid_of(int w0) { unsigned z = 0u; asm volatile("" : "+v"(z));
    return w0 * 64 + (int)__builtin_amdgcn_mbcnt_hi(~0u, __builtin_amdgcn_mbcnt_lo(~0u, z)); }
__device__ __forceinline__ void st16_wt(void* base_uniform, unsigned byte_off, u32x4 v) {
    const __amdgpu_buffer_rsrc_t r = __builtin_amdgcn_make_buffer_rsrc(base_uniform, (short)0, 0x7fffffff, 0x00020000);
    __builtin_amdgcn_raw_buffer_store_b128(v, r, (int)byte_off, 0, 16);
}
__device__ __forceinline__ void st4_wt(float* p, float v) { __hip_atomic_store((unsigned*)p, __float_as_uint(v), __ATOMIC_RELAXED, __HIP_MEMORY_SCOPE_AGENT); }
#define XB_TMO      128
#define XB_XCNT(j)  (256  + 64 * (j))
#define XB_XSUB(j)  (1280 + 64 * (j))
#define XB_XGEN(j)  (2304 + 64 * (j))
#define XB_TOP      3328
#define XB_TOPGEN   3392
#define XCD_BAR_WORDS 3456
#define XB_SPIN_CAP (1u << 22)
__device__ __forceinline__ unsigned xb_ld(unsigned* p)              { return __hip_atomic_load(p, __ATOMIC_RELAXED, __HIP_MEMORY_SCOPE_AGENT); }
__device__ __forceinline__ unsigned xb_add(unsigned* p, unsigned v) { return __hip_atomic_fetch_add(p, v, __ATOMIC_RELAXED, __HIP_MEMORY_SCOPE_AGENT); }
__device__ __forceinline__ unsigned xb_xcc_id() { return (unsigned)__builtin_amdgcn_s_getreg((3 << 11) | 20) & 0xFu; }
#define XB_SPIN(cond, bar) do { unsigned _sp = 0; while (cond) { __builtin_amdgcn_s_sleep(1); \
    if ((++_sp & 255u) == 0u) { if (xb_ld(&(bar)[XB_TMO])) break; if (_sp > XB_SPIN_CAP) { atomicAdd(&(bar)[XB_TMO], 1u); break; } } } } while (0)
struct XcdBarrier { unsigned* bar; unsigned x; volatile LAS unsigned* st; };
__device__ __forceinline__ XcdBarrier xcd_barrier_post(unsigned* bar, volatile LAS unsigned* st, const bool leader) {
    XcdBarrier b; b.bar = bar; b.x = xb_xcc_id(); b.st = st;
    if (leader) (void)xb_add(&bar[XB_XCNT(b.x)], 1u);
    return b;
}
__device__ __forceinline__ void xcd_barrier_complete(unsigned* bar, unsigned x, unsigned& nloc, unsigned& nx) {
    const unsigned G = gridDim.x * gridDim.y * gridDim.z;
    unsigned sum, cnt, mine, sp = 0u;
    for (;;) {
        sum = 0u; cnt = 0u; mine = 0u;
#pragma unroll
        for (unsigned j = 0; j < 16; ++j) { const unsigned c = xb_ld(&bar[XB_XCNT(j)]); sum += c; cnt += (c > 0u) ? 1u : 0u; mine = (j == x) ? c : mine; }
        if (sum == G) break;
        __builtin_amdgcn_s_sleep(1);
        if ((++sp & 255u) == 0u) { if (xb_ld(&bar[XB_TMO])) break; if (sp > XB_SPIN_CAP) { atomicAdd(&bar[XB_TMO], 1u); break; } }
    }
    nloc = mine > 0u ? mine : 1u; nx = cnt > 0u ? cnt : 1u;
}
__device__ __forceinline__ void xcd_barrier(const XcdBarrier& b, const int w0) {
    asm volatile("s_waitcnt vmcnt(0)" ::: "memory");
    __syncthreads();
    if (tid_of(w0) == 0) {
        unsigned* bar = b.bar;
        __builtin_amdgcn_s_waitcnt(0);
        unsigned nloc = b.st[0], nx = b.st[1];
        if (nloc == 0u) { xcd_barrier_complete(bar, b.x, nloc, nx); b.st[0] = nloc; b.st[1] = nx; }
        const unsigned old = xb_add(&bar[XB_XSUB(b.x)], 1u);
        const unsigned gen = old / nloc;
        if (old + 1u == (gen + 1u) * nloc) {
            __builtin_amdgcn_fence(__ATOMIC_RELEASE, "agent");
            asm volatile("s_waitcnt vmcnt(0)" ::: "memory");
            const unsigned og = xb_add(&bar[XB_TOP], 1u);
            const unsigned tg = og / nx;
            if (og + 1u == (tg + 1u) * nx) xb_add(&bar[XB_TOPGEN], 1u);
            else XB_SPIN(xb_ld(&bar[XB_TOPGEN]) == tg, bar);
            __builtin_amdgcn_fence(__ATOMIC_ACQUIRE, "agent");
            xb_add(&bar[XB_XGEN(b.x)], 1u);
            asm volatile("s_waitcnt vmcnt(0)" ::: "memory");
        } else {
            XB_SPIN(xb_ld(&bar[XB_XGEN(b.x)]) == gen, bar);
            __builtin_amdgcn_fence(__ATOMIC_ACQUIRE, "agent");
            asm volatile("s_waitcnt vmcnt(0)" ::: "memory");
        }
    }
    __syncthreads();
}

namespace pg8 {
constexpr int BM = 256, BK = 64, HALF = 128, HTB = HALF * BK * 2, STAGE_BYTES = 8 * HTB;
__host__ __device__ __forceinline__ int lds_byte(int r, int c) { const int st = (r >> 4) * 2 + (c >> 5), rr = r & 15, cc = c & 31, ob = rr * 64 + cc * 2; return st * 1024 + (ob ^ (((ob >> 9) & 1) << 5)); }
__host__ __device__ __forceinline__ void stage_rc(int b, int& R, int& C) { const int st = b / 1024, sb = b % 1024, swz = sb ^ (((sb >> 9) & 1) << 5); R = (st >> 1) * 16 + swz / 64; C = (st & 1) * 32 + (swz % 64) / 2; }
__host__ __device__ __forceinline__ int perm32(int rho) { const int n = rho >> 4, i = rho & 15; return 8 * (i >> 2) + 4 * n + (i & 3); }

struct Unit { size_t b0, b1; int pm, pn, e, row0, rows, gt; };

template <bool ROPE, bool FP8, class Epi, class Sched>
__device__ __forceinline__ void gemm_phase(LAS unsigned char* lds, const char* Abase, const char* Bbase, const int K, const Sched& S, const Epi& E, const int w0) {
    const int tid = tid_of(w0);
    const int wid = w0, lane = tid & 63, wr = wid >> 2, wc = wid & 3, fr = lane & 15, fq = lane >> 4;
    const int Kb = FP8 ? K : 2 * K;
    int nt = Kb / 128; asm volatile("" : "+s"(nt));
    int R[2], C[2]; unsigned voffB[2];
#pragma unroll
    for (int i = 0; i < 2; ++i) { stage_rc(tid * 16 + i * 8192, R[i], C[i]);
        const int Rb = ROPE ? (64 * (R[i] >> 5) + perm32(R[i] & 31)) : ((R[i] & ~31) + perm32(R[i] & 31));
        voffB[i] = (unsigned)(Rb * Kb + C[i] * 2); }
    const size_t kstep = (size_t)(BK * 2);
    const unsigned ldsw = (unsigned)wid * 1024u;
    const int aoff = FP8 ? lds_byte(wr * 64 + fr, fq * 16) : lds_byte(wr * 64 + fr, fq * 8), boff = FP8 ? lds_byte(wc * 32 + fr, fq * 16) : lds_byte(wc * 32 + fr, fq * 8);
#define PG8_SA(b, h) (((b) * 2 + (h)) * HTB)
#define PG8_SB(b, h) ((4 + (b) * 2 + (h)) * HTB)
#define PG8_STG(bufoff, gbase, voff) do { _Pragma("unroll") for (int _i = 0; _i < 2; ++_i) \
        __builtin_amdgcn_global_load_lds((const unsigned*)((const char*)(gbase) + (voff)[_i]), (LAS unsigned*)(lds + (bufoff) + ldsw + _i * 8192), 16, 0, 0); } while (0)
#define PG8_LDA(dst, b, h) do { _Pragma("unroll") for (int m = 0; m < 4; ++m) { dst[m].lo = *(const LAS i32x4*)(lds + PG8_SA(b, h) + aoff + m * 2048); dst[m].hi = *(const LAS i32x4*)(lds + PG8_SA(b, h) + aoff + m * 2048 + (FP8 ? 16 : 1024)); } } while (0)
#define PG8_LDB(dst, b, h) do { _Pragma("unroll") for (int n = 0; n < 2; ++n) { dst[n].lo = *(const LAS i32x4*)(lds + PG8_SB(b, h) + boff + n * 2048); dst[n].hi = *(const LAS i32x4*)(lds + PG8_SB(b, h) + boff + n * 2048 + (FP8 ? 16 : 1024)); } } while (0)
#define PG8_MMA(ai, bj, At, Bt) do { __builtin_amdgcn_s_setprio(1); _Pragma("unroll") for (int m = 0; m < 4; ++m) _Pragma("unroll") for (int n = 0; n < 2; ++n) { \
        if constexpr (FP8) acc[ai][bj][m][n] = __builtin_amdgcn_mfma_scale_f32_16x16x128_f8f6f4(Bt[n], At[m], acc[ai][bj][m][n], 0, 0, 0, 0x7f7f7f7f, 0, 0x7f7f7f7f); \
        else { const i32x4 bl_ = Bt[n].lo, bh_ = Bt[n].hi, al_ = At[m].lo, ah_ = At[m].hi;        \
               acc[ai][bj][m][n] = __builtin_amdgcn_mfma_f32_16x16x32_f16(__builtin_bit_cast(f16x8, bl_), __builtin_bit_cast(f16x8, al_), acc[ai][bj][m][n], 0, 0, 0); \
               acc[ai][bj][m][n] = __builtin_amdgcn_mfma_f32_16x16x32_f16(__builtin_bit_cast(f16x8, bh_), __builtin_bit_cast(f16x8, ah_), acc[ai][bj][m][n], 0, 0, 0); } } \
        if constexpr (FP8) { _Pragma("unroll") for (int m = 0; m < 4; ++m) _Pragma("unroll") for (int n = 0; n < 2; ++n) asm volatile("" : "+v"(acc[ai][bj][m][n])); }     \
        __builtin_amdgcn_s_setprio(0); } while (0)
#define PG8_WAIT_V(n) asm volatile("s_waitcnt vmcnt(" #n ")" ::: "memory")
#define PG8_WAIT_L(n) asm volatile("s_waitcnt lgkmcnt(" #n ")" ::: "memory")
#define PG8_BAR __builtin_amdgcn_s_barrier()
#define PG8_SCHED __builtin_amdgcn_sched_barrier(0)
#define PG8_PIN do { if constexpr (FP8) __builtin_amdgcn_sched_barrier(0); } while (0)
    Unit cur, nxt; int ui = 0;
    if (!S.next(0, cur)) return;
    f32x4 acc[2][2][4][2];
#pragma unroll
    for (int a = 0; a < 2; ++a)
#pragma unroll
        for (int b = 0; b < 2; ++b)
#pragma unroll
            for (int m = 0; m < 4; ++m)
#pragma unroll
                for (int n = 0; n < 2; ++n) acc[a][b][m][n] = (f32x4){0.f, 0.f, 0.f, 0.f};
    i32x8 At[4], B0[2], B1[2];
    unsigned cvA[2][2], nvA[2][2];
    S.a_ready(cur, wid);
    S.avoff(cur, cvA, R, C);
    const char* cB0 = Bbase + cur.b0; const char* cB1 = Bbase + cur.b1;
    PG8_STG(PG8_SB(0, 0), cB0, voffB); PG8_STG(PG8_SB(0, 1), cB1, voffB); PG8_STG(PG8_SA(0, 0), Abase, cvA[0]); PG8_STG(PG8_SA(0, 1), Abase, cvA[1]);
    if (wr == 1) PG8_BAR;
    PG8_WAIT_V(2); PG8_BAR;
    PG8_STG(PG8_SB(1, 0), cB0 + kstep, voffB); PG8_STG(PG8_SA(1, 0), Abase + kstep, cvA[0]); PG8_STG(PG8_SB(1, 1), cB1 + kstep, voffB);
    PG8_WAIT_V(6); PG8_BAR;
    for (;;) {
        const bool has_next = S.next(ui + 1, nxt);
        if (has_next) S.avoff(nxt, nvA, R, C);
        else {
#pragma unroll
            for (int h = 0; h < 2; ++h)
#pragma unroll
                for (int i = 0; i < 2; ++i) nvA[h][i] = cvA[h][i];
        }
        const char* nB0 = has_next ? Bbase + nxt.b0 : cB0; const char* nB1 = has_next ? Bbase + nxt.b1 : cB1;
        for (int t = 0; t < nt; t += 2) {
            const bool last = (t == nt - 2);
            if (last && has_next) S.a_ready(nxt, wid);
            const char* a1 = Abase + (size_t)(t + 1) * kstep;
            const size_t k2 = last ? (size_t)0 : (size_t)(t + 2) * kstep;
            const char* a2 = Abase + k2; const char* a3 = a2 + kstep;
            const char* b20 = (last ? nB0 : cB0) + k2; const char* b21 = (last ? nB1 : cB1) + k2;
            const char* b30 = b20 + kstep; const char* b31 = b21 + kstep;
            unsigned vA2[2][2];
#pragma unroll
            for (int h = 0; h < 2; ++h)
#pragma unroll
                for (int i = 0; i < 2; ++i) vA2[h][i] = last ? nvA[h][i] : cvA[h][i];
            PG8_LDB(B0, 0, 0); PG8_LDB(B1, 0, 1); PG8_SCHED; PG8_LDA(At, 0, 0); PG8_STG(PG8_SA(1, 1), a1, cvA[1]);
            PG8_WAIT_V(8); PG8_WAIT_L(0); PG8_BAR; PG8_PIN; PG8_MMA(0, 0, At, B0); PG8_MMA(0, 1, At, B1); PG8_PIN; PG8_BAR; PG8_SCHED;
            PG8_LDA(At, 0, 1); PG8_STG(PG8_SB(0, 0), b20, voffB); PG8_STG(PG8_SB(0, 1), b21, voffB); PG8_STG(PG8_SA(0, 0), a2, vA2[0]);
            PG8_WAIT_V(8); PG8_WAIT_L(0); PG8_BAR; PG8_PIN; PG8_MMA(1, 0, At, B0); PG8_MMA(1, 1, At, B1); PG8_PIN; PG8_BAR; PG8_SCHED;
            PG8_LDB(B0, 1, 0); PG8_LDB(B1, 1, 1); PG8_SCHED; PG8_LDA(At, 1, 0); PG8_STG(PG8_SA(0, 1), a2, vA2[1]);
            PG8_WAIT_V(8); PG8_WAIT_L(0); PG8_BAR; PG8_PIN; PG8_MMA(0, 0, At, B0); PG8_MMA(0, 1, At, B1); PG8_PIN; PG8_BAR; PG8_SCHED;
            PG8_LDA(At, 1, 1); PG8_STG(PG8_SB(1, 0), b30, voffB); PG8_STG(PG8_SB(1, 1), b31, voffB); PG8_STG(PG8_SA(1, 0), a3, vA2[0]);
            PG8_WAIT_V(8); PG8_WAIT_L(0); PG8_BAR; PG8_PIN; PG8_MMA(1, 0, At, B0); PG8_MMA(1, 1, At, B1); PG8_PIN; PG8_BAR; PG8_SCHED;
        }
        if (wr == 0) PG8_BAR;
        E(acc, cur, wr, wc, fr, fq); S.done(cur, lane);
        if (!has_next) break;
#pragma unroll
        for (int a = 0; a < 2; ++a)
#pragma unroll
            for (int b = 0; b < 2; ++b)
#pragma unroll
                for (int m = 0; m < 4; ++m)
#pragma unroll
                    for (int n = 0; n < 2; ++n) acc[a][b][m][n] = (f32x4){0.f, 0.f, 0.f, 0.f};
        cur = nxt; cB0 = nB0; cB1 = nB1; ++ui;
#pragma unroll
        for (int h = 0; h < 2; ++h)
#pragma unroll
            for (int i = 0; i < 2; ++i) cvA[h][i] = nvA[h][i];
        if (wr == 1) PG8_BAR;
    }
    PG8_WAIT_V(0);
    PG8_BAR;
#undef PG8_SA
#undef PG8_SB
#undef PG8_STG
#undef PG8_LDA
#undef PG8_LDB
#undef PG8_MMA
#undef PG8_WAIT_V
#undef PG8_WAIT_L
#undef PG8_BAR
#undef PG8_SCHED
#undef PG8_PIN
}

struct DenseSched {
    int nM, nN, nwg, G, c, K; bool rope;
    __device__ __forceinline__ void init(int M, int N, int K_, int G_, int c_, bool rope_) { nM = M / BM; nN = N / BM; nwg = nM * nN; G = G_; c = c_; K = K_; rope = rope_; }
    __device__ __forceinline__ bool next(int i, Unit& u) const {
        const long L = (long)i * G + c; if (L >= nwg) return false;
        int wgid = (int)L; { const int q = nwg / 8, r = nwg % 8, xcd = wgid % 8, off = wgid / 8; wgid = (xcd < r ? xcd * (q + 1) : r * (q + 1) + (xcd - r) * q) + off; }
        const int WGM = 8, nig = WGM * nN, gid = wgid / nig, fm = gid * WGM, gsz = (nM - fm) < WGM ? (nM - fm) : WGM;
        u.pm = fm + ((wgid % nig) % gsz); u.pn = (wgid % nig) / gsz; u.e = 0; u.row0 = u.pm * BM; u.rows = BM;
        u.b0 = (size_t)(u.pn * BM) * K * 2; u.b1 = u.b0 + (size_t)(rope ? 32 : 128) * K * 2;
        return true;
    }
    __device__ __forceinline__ void avoff(const Unit& u, unsigned (&vo)[2][2], const int (&R)[2], const int (&C)[2]) const {
#pragma unroll
        for (int h = 0; h < 2; ++h)
#pragma unroll
            for (int i = 0; i < 2; ++i) vo[h][i] = (unsigned)((u.row0 + 128 * h + R[i]) * K + C[i]) * 2u;
    }
    __device__ __forceinline__ void a_ready(const Unit&, int) const {}
    __device__ __forceinline__ void done(const Unit&, int) const {}
};
struct MoeSched {
    const LAS int* tab; int G, cv, K; bool gather; const int* list; unsigned* mtc;
    __device__ __forceinline__ bool next(int i, Unit& u) const {
        const int L = i * G + cv; if (L >= tab[32]) return false;
        int e = 0;
#pragma unroll 1
        for (int k = 1; k < 32; ++k) if (tab[k] <= L) e = k;
        const int local = L - tab[e]; u.e = e; u.pm = local >> 2; u.pn = local & 3; u.gt = (tab[e] >> 2) + u.pm;
        const int cnt = tab[80 + e]; u.rows = min(256, cnt - u.pm * 256); u.row0 = tab[40 + e] + u.pm * 256;
        constexpr size_t EB = MOE8 ? 1 : 2;
        if (gather) { u.b0 = ((size_t)e * 512 + 128 * u.pn) * 1024 * EB; u.b1 = u.b0 + (WS_W3 - WS_W1); }
        else        { u.b0 = ((size_t)e * 1024 + 256 * u.pn) * 512 * EB; u.b1 = u.b0 + (size_t)128 * 512 * EB; }
        return true;
    }
    __device__ __forceinline__ void avoff(const Unit& u, unsigned (&vo)[2][2], const int (&R)[2], const int (&C)[2]) const {
#pragma unroll
        for (int h = 0; h < 2; ++h)
#pragma unroll
            for (int i = 0; i < 2; ++i) {
                if (gather) { int r = 128 * h + R[i]; r = r < u.rows ? r : u.rows - 1; const int tok = list[2 * ((size_t)u.e * LISTCAP + u.pm * 256 + r)];
                    vo[h][i] = MOE8 ? (unsigned)(tok * 1024 + C[i] * 2) : (unsigned)(tok * 1024 + C[i]) * 2u; }
                else vo[h][i] = MOE8 ? (unsigned)((u.row0 + 128 * h + R[i]) * 512 + C[i] * 2) : (unsigned)((u.row0 + 128 * h + R[i]) * 512 + C[i]) * 2u;
            }
    }
    __device__ __forceinline__ void a_ready(const Unit& u, int wid) const {
        if (gather) return;
        if (wid == 0) { unsigned sp = 0;
            while ((unsigned)__builtin_amdgcn_readfirstlane(__hip_atomic_load(mtc + 64 * u.gt, __ATOMIC_RELAXED, __HIP_MEMORY_SCOPE_AGENT)) < 32u) { __builtin_amdgcn_s_sleep(2); if (++sp > (1u << 22)) break; }
            __builtin_amdgcn_fence(__ATOMIC_ACQUIRE, "agent");
            asm volatile("s_waitcnt vmcnt(0)" ::: "memory"); }
        asm volatile("" ::: "memory"); __builtin_amdgcn_s_barrier(); asm volatile("" ::: "memory");
    }
    __device__ __forceinline__ void done(const Unit& u, int lane) const {
        if (!gather) return;
        asm volatile("s_waitcnt vmcnt(0)" ::: "memory");
        if (lane == 0) __hip_atomic_fetch_add(mtc + 64 * u.gt, 1u, __ATOMIC_RELAXED, __HIP_MEMORY_SCOPE_AGENT);
    }
};

struct EpiProj {
    f16* proj; const float* cosT; const float* sinT; float* ksum;
    __device__ __forceinline__ void operator()(const f32x4 (&acc)[2][2][4][2], const Unit& u, int wr, int wc, int fr, int fq) const {
        const int tile = u.pn, row0 = u.row0 + wr * 64 + fr, col0 = tile * 256 + 64 * wc + 8 * fq;
        if (tile < 4) {
            const float sc = tile < 2 ? C2 : 1.f;
            float ks[2][8];
#pragma unroll
            for (int bj = 0; bj < 2; ++bj)
#pragma unroll
                for (int j = 0; j < 8; ++j) ks[bj][j] = 0.f;
#pragma unroll
            for (int ai = 0; ai < 2; ++ai)
#pragma unroll
                for (int m = 0; m < 4; ++m) {
                    const int row = row0 + ai * HALF + m * 16;
                    const f32x4 c0 = *(const f32x4*)(cosT + (size_t)row * 32 + 8 * fq), c1 = *(const f32x4*)(cosT + (size_t)row * 32 + 8 * fq + 4);
                    const f32x4 s0 = *(const f32x4*)(sinT + (size_t)row * 32 + 8 * fq), s1 = *(const f32x4*)(sinT + (size_t)row * 32 + 8 * fq + 4);
                    const f32x4 a0 = acc[ai][0][m][0], a1 = acc[ai][0][m][1], b0 = acc[ai][1][m][0], b1 = acc[ai][1][m][1];
                    const f32x4 o10 = (a0 * c0 - b0 * s0) * sc, o11 = (a1 * c1 - b1 * s1) * sc;
                    const f32x4 o20 = (b0 * c0 + a0 * s0) * sc, o21 = (b1 * c1 + a1 * s1) * sc;
                    u32x4 w1, w2;
                    w1.x = pk2h(o10[0], o10[1]); w1.y = pk2h(o10[2], o10[3]); w1.z = pk2h(o11[0], o11[1]); w1.w = pk2h(o11[2], o11[3]);
                    w2.x = pk2h(o20[0], o20[1]); w2.y = pk2h(o20[2], o20[3]); w2.z = pk2h(o21[0], o21[1]); w2.w = pk2h(o21[2], o21[3]);
                    f16* rp = proj + (size_t)row * NPROJ + col0;
                    *(u32x4*)rp = w1; *(u32x4*)(rp + 32) = w2;
                    if (tile >= 2) {
#pragma unroll
                        for (int j = 0; j < 4; ++j) { ks[0][j] += o10[j]; ks[0][4 + j] += o11[j]; ks[1][j] += o20[j]; ks[1][4 + j] += o21[j]; }
                    }
                }
            if (tile >= 2) {
                const int b = u.pm >> 4, blk = u.pm & 15, head = (tile - 2) * 4 + wc;
                float* kp = ksum + ((size_t)((b * 8 + head) * 16 + blk)) * 64 + 8 * fq;
#pragma unroll
                for (int bj = 0; bj < 2; ++bj)
#pragma unroll
                    for (int j = 0; j < 8; ++j) { float v = ks[bj][j]; v = xsum<1>(v); v = xsum<2>(v); v = xsum<4>(v); v = xsum<8>(v);
                        if (fr == 0) atomicAdd(kp + 32 * bj + j, v); }
            }
        } else {
#pragma unroll
            for (int ai = 0; ai < 2; ++ai)
#pragma unroll
                for (int m = 0; m < 4; ++m) {
                    f16* rp = proj + (size_t)(row0 + ai * HALF + m * 16) * NPROJ + col0;
#pragma unroll
                    for (int bj = 0; bj < 2; ++bj) { const f32x4 v0 = acc[ai][bj][m][0], v1 = acc[ai][bj][m][1]; u32x4 w;
                        w.x = pk2h(v0[0], v0[1]); w.y = pk2h(v0[2], v0[3]); w.z = pk2h(v1[0], v1[1]); w.w = pk2h(v1[2], v1[3]);
                        *(u32x4*)(rp + 32 * bj) = w; }
                }
        }
    }
};
struct EpiOut {
    const float* x; const float* mod; f16* x1; float* ssb;
    __device__ __forceinline__ void operator()(const f32x4 (&acc)[2][2][4][2], const Unit& u, int wr, int wc, int fr, int fq) const {
        const int row0 = u.row0 + wr * 64 + fr, col0 = u.pn * BM + wc * 32 + 8 * fq, b = u.row0 / SEQ;
        const float* g1 = mod + (size_t)b * 6144 + 2048;
        float sq[2][4] = {{0.f, 0.f, 0.f, 0.f}, {0.f, 0.f, 0.f, 0.f}};
#pragma unroll
        for (int bj = 0; bj < 2; ++bj) {
            const f32x4 g0 = *(const f32x4*)(g1 + col0 + bj * HALF), gg1 = *(const f32x4*)(g1 + col0 + bj * HALF + 4);
#pragma unroll
            for (int ai = 0; ai < 2; ++ai)
#pragma unroll
                for (int m = 0; m < 4; ++m) { const int row = row0 + ai * HALF + m * 16; const size_t off = (size_t)row * DM + col0 + bj * HALF;
                    const f32x4 x0 = *(const GAS f32x4*)(x + off), xx1 = *(const GAS f32x4*)(x + off + 4);
                    const f32x4 v0 = x0 + g0 * acc[ai][bj][m][0], v1 = xx1 + gg1 * acc[ai][bj][m][1];
                    u32x4 w; w.x = pk2h(v0[0], v0[1]); w.y = pk2h(v0[2], v0[3]); w.z = pk2h(v1[0], v1[1]); w.w = pk2h(v1[2], v1[3]);
                    *(u32x4*)(x1 + (size_t)row * 2048 + col0 + bj * HALF) = w;
                    sq[ai][m] += (v0[0] * v0[0] + v0[1] * v0[1]) + (v0[2] * v0[2] + v0[3] * v0[3]) + (v1[0] * v1[0] + v1[1] * v1[1]) + (v1[2] * v1[2] + v1[3] * v1[3]); }
        }
#pragma unroll
        for (int ai = 0; ai < 2; ++ai)
#pragma unroll
            for (int m = 0; m < 4; ++m) { float q = sq[ai][m]; q = xsum<16>(q); q = xsum<32>(q);
                if (fq == 0) ssb[(size_t)(row0 + ai * HALF + m * 16) * 16 + u.pn * 4 + wc] = q; }
    }
};
struct EpiMoe1 {
    unsigned char* H;
    __device__ __forceinline__ void operator()(const f32x4 (&acc)[2][2][4][2], const Unit& u, int wr, int wc, int fr, int fq) const {
        const int r0 = wr * 64 + fr, col0 = u.pn * 128 + wc * 32 + 8 * fq;
        const __amdgpu_buffer_rsrc_t rs = __builtin_amdgcn_make_buffer_rsrc(H, (short)0, 0x7fffffff, 0x00020000);
#pragma unroll
        for (int ai = 0; ai < 2; ++ai)
#pragma unroll
            for (int m = 0; m < 4; ++m) { const int r = r0 + ai * HALF + m * 16;
                float o[8];
#pragma unroll
                for (int n = 0; n < 2; ++n)
#pragma unroll
                    for (int j = 0; j < 4; ++j) { const float a = acc[ai][0][m][n][j] * (1.f / W8SCALE), bb = acc[ai][1][m][n][j] * (1.f / W8SCALE); o[4 * n + j] = a * __builtin_amdgcn_rcpf(1.f + __expf(-a)) * bb; }
                if (r < u.rows) {
                    if constexpr (MOE8) __builtin_amdgcn_raw_buffer_store_b64(pk8_fp8(o), rs, (int)((u.row0 + r) * DEXP + col0), 0, 16);
                    else { u32x4 w; w.x = pk2h(o[0], o[1]); w.y = pk2h(o[2], o[3]); w.z = pk2h(o[4], o[5]); w.w = pk2h(o[6], o[7]); __builtin_amdgcn_raw_buffer_store_b128(w, rs, (int)(((u.row0 + r) * DEXP + col0) * 2), 0, 16); } } }
    }
};
struct EpiMoe2 {
    unsigned char* Y; const int* list;
    __device__ __forceinline__ void operator()(const f32x4 (&acc)[2][2][4][2], const Unit& u, int wr, int wc, int fr, int fq) const {
        const int r0 = wr * 64 + fr, col0 = u.pn * BM + wc * 32 + 8 * fq;
#pragma unroll
        for (int ai = 0; ai < 2; ++ai)
#pragma unroll
            for (int m = 0; m < 4; ++m) { const int r = r0 + ai * HALF + m * 16;
                if (r < u.rows) {
                    const float w = __int_as_float(list[2 * ((size_t)u.e * LISTCAP + u.pm * 256 + r) + 1]) * (1.f / W8SCALE);
#pragma unroll
                    for (int bj = 0; bj < 2; ++bj) { const f32x4 v0 = acc[ai][bj][m][0] * w, v1 = acc[ai][bj][m][1] * w;
                        const float o8[8] = {v0[0], v0[1], v0[2], v0[3], v1[0], v1[1], v1[2], v1[3]};
                        *(u32x2*)(Y + (size_t)(u.row0 + r) * DM + col0 + bj * HALF) = pk8_fp8(o8); }
                } }
    }
};
}


namespace moba {
using s16x8=__attribute__((ext_vector_type(8)))short;
using s16x4=__attribute__((ext_vector_type(4)))short;
using f32x16=__attribute__((ext_vector_type(16)))float;
constexpr int D=64, PITCH=NPROJ, OPITCH=DM;
constexpr int NW=8,QBLK=32,QB=QBLK*NW,KVBLK=64;
__device__ __forceinline__ int crow(int r,int hi){return (r&3)+8*(r>>2)+4*hi;}
#define SBAR() __builtin_amdgcn_sched_barrier(0)
#define MF32(a,b,c) __builtin_amdgcn_mfma_f32_32x32x16_f16(__builtin_bit_cast(f16x8,(a)),__builtin_bit_cast(f16x8,(b)),(c),0,0,0)
__device__ __forceinline__ void cmask(f32x16&p0,f32x16&p1,int jb,int qrel,int hi){
  const float NEG=-INFINITY; int kb=64*jb+4*hi;
  #pragma unroll
  for(int r=0;r<16;++r){int kv=kb+(r&3)+8*(r>>2); if(kv>qrel)p0[r]=NEG; if(kv+32>qrel)p1[r]=NEG;}
}
constexpr int NSLOT=4, SLOTB=8192;
constexpr int LDS_K=0, LDS_V=NSLOT*SLOTB, LDS_WS=2*NSLOT*SLOTB, LDS_OST=LDS_WS+NW*64*4, LDS_SEL=LDS_OST+NW*4096, LDS_KS=LDS_SEL+1024, LDS_BYTES_A=LDS_KS+4096;
__device__ __forceinline__ void glds16(const void*gsrc,unsigned lds_dst){unsigned keep;
  asm volatile("s_mov_b32 %0, m0\n\ts_mov_b32 m0, %2\n\ts_nop 0\n\tglobal_load_lds_dwordx4 %1, off\n\ts_mov_b32 m0, %0":"=&s"(keep):"v"(gsrc),"s"(lds_dst):"memory");}
__device__ __forceinline__ float max3f(float a,float b,float c){float r;asm("v_max3_f32 %0, %1, %2, %3":"=v"(r):"v"(a),"v"(b),"v"(c));return r;}
__device__ __forceinline__ float max2f(float a,float b){float r;asm("v_max_f32_e32 %0, %1, %2":"=v"(r):"v"(a),"v"(b));return r;}
__device__ __forceinline__ float fadd_s(float a,float b){float r;asm("v_add_f32_e32 %0, %1, %2":"=v"(r):"v"(a),"v"(b));return r;}
__device__ __forceinline__ float fsub_s(float a,float b){float r;asm("v_sub_f32_e32 %0, %1, %2":"=v"(r):"v"(a),"v"(b));return r;}
__device__ __forceinline__ unsigned cvtpk_s(float lo,float hi){return __builtin_bit_cast(unsigned,__builtin_amdgcn_cvt_pkrtz(lo,hi));}
#define WAIT_BAR(N) asm volatile("s_waitcnt vmcnt(" #N ") lgkmcnt(0)\n\ts_barrier":::"memory")
typedef __attribute__((address_space(3))) const char* lds_cptr;
__device__ __forceinline__ void qkt(f32x16&p0,f32x16&p1,lds_cptr kb,const s16x8*qr,const f32x16&negm){
  #pragma unroll
  for(int d0=0;d0<4;++d0){
    const s16x8 b0=*(const __attribute__((address_space(3))) s16x8*)(kb+d0*2048);
    const s16x8 b1=*(const __attribute__((address_space(3))) s16x8*)(kb+d0*2048+512);
    if(d0==0){p0=MF32(b0,qr[0],negm);p1=MF32(b1,qr[0],negm);}
    else{p0=MF32(b0,qr[d0],p0);p1=MF32(b1,qr[d0],p1);}}
}
typedef short v4i16_t __attribute__((ext_vector_type(4)));
__device__ __forceinline__ void kload8(s16x8*kf,lds_cptr kp){
  kf[0]=*(const __attribute__((address_space(3))) s16x8*)(kp);      kf[1]=*(const __attribute__((address_space(3))) s16x8*)(kp+512);
  kf[2]=*(const __attribute__((address_space(3))) s16x8*)(kp+2048); kf[3]=*(const __attribute__((address_space(3))) s16x8*)(kp+2560);
  kf[4]=*(const __attribute__((address_space(3))) s16x8*)(kp+4096); kf[5]=*(const __attribute__((address_space(3))) s16x8*)(kp+4608);
  kf[6]=*(const __attribute__((address_space(3))) s16x8*)(kp+6144); kf[7]=*(const __attribute__((address_space(3))) s16x8*)(kp+6656);
}
__device__ __forceinline__ void kload2(s16x8*kf,lds_cptr kp,int j){ kf[2*j]=*(const __attribute__((address_space(3))) s16x8*)(kp+j*2048); kf[2*j+1]=*(const __attribute__((address_space(3))) s16x8*)(kp+j*2048+512); }
__device__ __forceinline__ s16x4 vtr(lds_cptr p){ return __builtin_bit_cast(s16x4,__builtin_amdgcn_ds_read_tr16_b64_v4i16((__attribute__((address_space(3))) v4i16_t*)p)); }
__device__ __forceinline__ float rowmax(const f32x16&p0,const f32x16&p1){
  float a=max3f(p0[0],p0[1],p1[0]),b=max3f(p0[2],p0[3],p1[1]);a=max3f(a,p1[2],p1[3]);
  #pragma unroll
  for(int r=4;r<16;r+=4){a=max3f(a,p0[r],p0[r+1]);b=max3f(b,p0[r+2],p0[r+3]);a=max3f(a,p1[r],p1[r+1]);b=max3f(b,p1[r+2],p1[r+3]);}
  const float m=max2f(a,b);
  auto rr=__builtin_amdgcn_permlane32_swap(__float_as_uint(m),__float_as_uint(m),false,false);
  return max2f(__uint_as_float(rr[0]),__uint_as_float(rr[1]));
}
__device__ __forceinline__ void pv(f32x16*o,int vb,s16x8 pa0,s16x8 pa1,s16x8 pa2,s16x8 pa3){
  #pragma unroll
  for(int d0=0;d0<2;++d0){s16x4 lo[4],hi[4];
    #pragma unroll
    for(int ks=0;ks<4;++ks){
      asm volatile("ds_read_b64_tr_b16 %0,%1 offset:%c2":"=&v"(lo[ks]):"v"(vb),"i"(d0*4096+ks*1024):"memory");
      asm volatile("ds_read_b64_tr_b16 %0,%1 offset:%c2":"=&v"(hi[ks]):"v"(vb),"i"(d0*4096+ks*1024+512):"memory");}
    asm volatile("s_waitcnt lgkmcnt(0)":::"memory");SBAR();
    #define PK(k) (s16x8){lo[k][0],lo[k][1],lo[k][2],lo[k][3],hi[k][0],hi[k][1],hi[k][2],hi[k][3]}
    o[d0]=MF32(pa0,PK(0),o[d0]);
    o[d0]=MF32(pa1,PK(1),o[d0]);
    o[d0]=MF32(pa2,PK(2),o[d0]);
    o[d0]=MF32(pa3,PK(3),o[d0]);
    #undef PK
  }
}
__device__ __forceinline__ void sel_list(int b,int h,int qb,const f16*Q,const float*ksum,int*alist,unsigned*acnt,char*shm,const int w0,unsigned*pend){
  const int tid=tid_of(w0);
  const int row=tid>>1, half=tid&1, bh=b*8+h;
  unsigned sel=0u;
  LAS unsigned*hist=(LAS unsigned*)(shm+LDS_SEL);
  {
    float*ks=(float*)(shm+LDS_KS);
    if(tid<256)*(f32x4*)(ks+4*tid)=*(const f32x4*)(ksum+(size_t)(bh*16)*64+4*tid);
    if(tid<32)hist[tid]=0u;
    float qf[32];
    { const f16x8*qp=(const f16x8*)(Q+((long)b*SEQ+qb*QB+row)*PITCH+h*D+32*half);
      #pragma unroll
      for(int i=0;i<4;++i){ const f16x8 t=qp[i];
        #pragma unroll
        for(int j=0;j<8;++j)qf[8*i+j]=(float)t[j]; } }
    asm volatile("s_waitcnt lgkmcnt(0)\n\ts_barrier":::"memory");
    float g[15];
    const float*kp=ks+32*half;
    #pragma unroll
    for(int n=0;n<15;++n){ float s=0.f;
      if(n<qb){
        #pragma unroll
        for(int i=0;i<8;++i){ const f32x4 k4=*(const f32x4*)(kp+n*64+4*i); s+=qf[4*i]*k4[0]+qf[4*i+1]*k4[1]+qf[4*i+2]*k4[2]+qf[4*i+3]*k4[3]; }
        s = xsum<1>(s); }
      g[n]=(n<qb)?s:-INFINITY; }
    #pragma unroll
    for(int r=0;r<3;++r){ float best=-INFINITY; int bi=-1;
      #pragma unroll
      for(int n=0;n<15;++n){ const bool ok=!((sel>>n)&1u)&&g[n]>best; best=ok?g[n]:best; bi=ok?n:bi; }
      if(bi>=0)sel|=1u<<bi; } }
  int n0=-1,n1=-1,n2=-1; unsigned r0=0u,r1=0u,r2=0u;
  if(half==0){ unsigned s_=sel;
    if(s_){ n0=__builtin_ctz(s_); s_&=s_-1u; r0=__hip_atomic_fetch_add(hist+n0,1u,__ATOMIC_RELAXED,__HIP_MEMORY_SCOPE_WORKGROUP); }
    if(s_){ n1=__builtin_ctz(s_); s_&=s_-1u; r1=__hip_atomic_fetch_add(hist+n1,1u,__ATOMIC_RELAXED,__HIP_MEMORY_SCOPE_WORKGROUP); }
    if(s_){ n2=__builtin_ctz(s_);            r2=__hip_atomic_fetch_add(hist+n2,1u,__ATOMIC_RELAXED,__HIP_MEMORY_SCOPE_WORKGROUP); } }
  asm volatile("s_waitcnt vmcnt(0) lgkmcnt(0)\n\ts_barrier":::"memory");
  if(pend!=nullptr&&tid==0)__hip_atomic_fetch_add(pend,1u,__ATOMIC_RELAXED,__HIP_MEMORY_SCOPE_AGENT);
  if(tid<qb)hist[16+tid]=__hip_atomic_fetch_add(acnt+bh*16+tid,hist[tid],__ATOMIC_RELAXED,__HIP_MEMORY_SCOPE_AGENT);
  asm volatile("s_waitcnt vmcnt(0) lgkmcnt(0)\n\ts_barrier":::"memory");
  if(half==0){ const unsigned rv=(unsigned)(qb*QB+row);
    if(n0>=0)__hip_atomic_store((unsigned*)alist+(size_t)(bh*16+n0)*4096+hist[16+n0]+r0,rv,           __ATOMIC_RELAXED,__HIP_MEMORY_SCOPE_AGENT);
    if(n1>=0)__hip_atomic_store((unsigned*)alist+(size_t)(bh*16+n1)*4096+hist[16+n1]+r1,rv|(1u<<12),__ATOMIC_RELAXED,__HIP_MEMORY_SCOPE_AGENT);
    if(n2>=0)__hip_atomic_store((unsigned*)alist+(size_t)(bh*16+n2)*4096+hist[16+n2]+r2,rv|(2u<<12),__ATOMIC_RELAXED,__HIP_MEMORY_SCOPE_AGENT); }
}
template<int THRL,int MODE> __device__ __forceinline__ void attn_pass(int b,int h,int kb,int r0,int r1,int npk,const int*alist,const f16*Q,const f16*__restrict__ K,const f16*__restrict__ V,f16*O,f16*part,float*lseb,const float*gain,char*shm,const int w0,unsigned*pend){
  __builtin_assume((unsigned)w0<8u);
  const int tid=tid_of(w0),lane=tid&63,r32=lane&31,hi=lane>>5; const int wid=w0;
  const long rowbase=(long)b*SEQ; const int q0=kb*QB;
  const unsigned lds0=(unsigned)(uintptr_t)shm;
  float*wsf=(float*)(shm+LDS_WS)+wid*64;
  int*entl=(int*)(shm+LDS_KS)+wid*128;
  const int ngrp=(MODE==1)?((r1-r0+31)>>5):8;
  {
    const f16*kptr=K+rowbase*PITCH+h*D+(long)lane*PITCH+wid*8+(long)(4*kb)*KVBLK*PITCH;
    const f16*vptr=V+rowbase*PITCH+h*D+(long)(16*(wid&3)+(lane>>2))*PITCH+(wid>>2)*32+(lane&3)*8+(long)(4*kb)*KVBLK*PITCH;
    const unsigned kdst=lds0+LDS_K+wid*1024, vdst=lds0+LDS_V+wid*1024;
    #pragma unroll
    for(int t=0;t<4;++t){ glds16(kptr,(unsigned)__builtin_amdgcn_readfirstlane(kdst+t*SLOTB)); glds16(vptr,(unsigned)__builtin_amdgcn_readfirstlane(vdst+t*SLOTB)); kptr+=(long)KVBLK*PITCH; vptr+=(long)KVBLK*PITCH; } }
  if(MODE==1){
    #pragma unroll
    for(int gi=0;gi<4;++gi){ if(hi==0){ int idx=r0+32*(wid+8*gi)+r32; const bool ok=idx<r1; idx=ok?idx:r0;
        int e=alist[(size_t)((b*8+h)*16+kb)*4096+idx]&0x3fff; if(!ok)e|=(int)0x80000000; entl[gi*32+r32]=e; } }
    asm volatile("s_waitcnt lgkmcnt(0)":::"memory"); }
  const int vb0=(int)(lds0+LDS_V)+((lane>>4)&1)*32+(lane&3)*8+(4*hi+((lane&15)>>2))*64;
  s16x8 kf[8];
  const lds_cptr shm3=(lds_cptr)shm; const lds_cptr kp0=shm3+LDS_K+hi*1024+r32*16; const lds_cptr vp0=shm3+LDS_V+((lane>>4)&1)*32+(lane&3)*8+(4*hi+((lane&15)>>2))*64;
  s16x8 qr[4];
  #define LOADQ(gi_) do{ const f16*Qrow_; \
    if(MODE==1){ const int e_=entl[(gi_)*32+r32]; Qrow_=Q+(rowbase+(e_&4095))*PITCH+h*D; } else Qrow_=Q+(rowbase+q0+wid*QBLK+r32)*PITCH+h*D; \
    _Pragma("unroll") for(int d0=0;d0<4;++d0)qr[d0]=*reinterpret_cast<const s16x8*>(&Qrow_[d0*16+hi*8]); }while(0)
  int g=wid, gi=0;
  if(g<ngrp)LOADQ(0);
  asm volatile("s_waitcnt vmcnt(0)\n\ts_barrier":::"memory");
  if(pend!=nullptr&&tid==0)__hip_atomic_fetch_add(pend,1u,__ATOMIC_RELAXED,__HIP_MEMORY_SCOPE_AGENT);
  const int qrel=wid*QBLK+r32;
  #define CMASK(P0,P1,t) do{ if(MODE==0)cmask(P0,P1,(t),qrel,hi); }while(0)
  for(;g<ngrp;g+=8,++gi){
  float mhat=0.f,l_reg=0.f;f32x16 o[2];o[0]=f32x16{};o[1]=f32x16{};f32x16 negm=f32x16{};asm volatile("":"+v"(negm));
  bool resc=false;
  #define START(P0,P1) do{ const float rm=rowmax(P0,P1); resc=false; \
    { const float dl=rm; mhat=fadd_s(mhat,dl); \
      _Pragma("unroll") for(int r=0;r<16;++r){P0[r]=fsub_s(P0[r],dl);P1[r]=fsub_s(P1[r],dl);} \
      _Pragma("unroll") for(int r=0;r<16;++r)negm[r]=-mhat; asm volatile("":"+v"(negm)); } \
    _Pragma("unroll") for(int r=0;r<16;++r)P0[r]=__builtin_amdgcn_exp2f(P0[r]); }while(0)
  #define RESC() do{ if(resc){ asm volatile("s_waitcnt lgkmcnt(0)":::"memory"); \
      _Pragma("unroll") for(int d_=0;d_<2;++d_) _Pragma("unroll") for(int r=0;r<16;++r)o[d_][r]*=wsf[crow(r,hi)]; } }while(0)
  f32x16 pA0,pA1,pB0,pB1;
  int sl_prev=0,sl_cur=0,sl_next=SLOTB;
  #define ROT() do{sl_prev=sl_cur;sl_cur=sl_next;sl_next=(sl_next==(NSLOT-1)*SLOTB)?0:sl_next+SLOTB;}while(0)
  qkt(pA0,pA1,kp0,qr,negm);asm volatile("s_nop 15\n\ts_nop 7":"+v"(pA0),"+v"(pA1));CMASK(pA0,pA1,0);
  START(pA0,pA1);
  _Pragma("unroll") for(int r=0;r<16;++r)pA1[r]=__builtin_amdgcn_exp2f(pA1[r]);
  ROT();
  kload8(kf,kp0+sl_cur);
  s16x4 vlo[8],vhi[8]; u32x4 pw0,pw1,pw2,pw3;
  #define PKW(P,B) cvtpk_s(P[B],P[B+1])
  #define PAF(k) __builtin_bit_cast(s16x8,pw##k)
  #define VFR(i) (s16x8){vlo[i][0],vlo[i][1],vlo[i][2],vlo[i][3],vhi[i][0],vhi[i][1],vhi[i][2],vhi[i][3]}
  #define PIN(x) asm volatile("":"+v"(x))
  #define MX3(a,b,c) __builtin_fmaxf(__builtin_fmaxf((a),(b)),(c))
  #define GAPA(MF,A0,A1,A2,A3,W0,W1,PW) do{ MF; sacc+=A0; sacc+=A1; sacc+=A2; sacc+=A3; PIN(sacc); W0; W1; PIN(PW); SBAR(); }while(0)
  #define EX(v) __builtin_amdgcn_exp2f(v)
  #define GAPB(MF,X,B) do{ MF; X[B]=EX(X[B]); X[B+1]=EX(X[B+1]); X[B+2]=EX(X[B+2]); X[B+3]=EX(X[B+3]); PIN(X); SBAR(); }while(0)
  #define VRD(i) do{ vlo[i]=vtr(vp_+(((i)>>2)*4096+((i)&3)*1024)); vhi[i]=vtr(vp_+(((i)>>2)*4096+((i)&3)*1024+512)); }while(0)
  #define KRD(G,j) do{ if(G){ kload2(kf,kp0+sl_next,j); SBAR(); } }while(0)
  #define STEP(C0,C1,P0,P1,t,GL) do{ SBAR(); \
    const lds_cptr vp_=vp0+sl_prev; \
    VRD(0); SBAR(); float sacc=(P0[0]+P0[1]); \
    GAPA(C0=MF32(kf[0],qr[0],negm), P0[2],P0[3],P0[4],P0[5],     pw0[0]=PKW(P0,0), pw0[1]=PKW(P0,2), pw0); \
    VRD(4); SBAR(); GAPA(C1=MF32(kf[1],qr[0],negm), P0[6],P0[7],P0[8],P0[9],     pw0[2]=PKW(P0,4), pw0[3]=PKW(P0,6), pw0); \
    VRD(1); SBAR(); GAPA(C0=MF32(kf[2],qr[1],C0),   P0[10],P0[11],P0[12],P0[13], pw1[0]=PKW(P0,8), pw1[1]=PKW(P0,10), pw1); \
    VRD(5); SBAR(); GAPA(C1=MF32(kf[3],qr[1],C1),   P0[14],P0[15],P1[0],P1[1],   pw1[2]=PKW(P0,12),pw1[3]=PKW(P0,14), pw1); \
    VRD(2); SBAR(); GAPA(C0=MF32(kf[4],qr[2],C0),   P1[2],P1[3],P1[4],P1[5],     pw2[0]=PKW(P1,0), pw2[1]=PKW(P1,2), pw2); \
    VRD(6); SBAR(); GAPA(C1=MF32(kf[5],qr[2],C1),   P1[6],P1[7],P1[8],P1[9],     pw2[2]=PKW(P1,4), pw2[3]=PKW(P1,6), pw2); \
    VRD(3); SBAR(); GAPA(C0=MF32(kf[6],qr[3],C0),   P1[10],P1[11],P1[12],P1[13], pw3[0]=PKW(P1,8), pw3[1]=PKW(P1,10), pw3); \
    VRD(7); SBAR(); GAPA(C1=MF32(kf[7],qr[3],C1),   P1[14],P1[15],0.f,0.f,       pw3[2]=PKW(P1,12),pw3[3]=PKW(P1,14), pw3); \
    l_reg+=sacc; \
    CMASK(C0,C1,t); \
    { float a=MX3(C0[0],C0[1],C1[0]),b=MX3(C0[2],C0[3],C1[1]); a=MX3(a,C1[2],C1[3]); \
      _Pragma("unroll") for(int r=4;r<16;r+=4){a=MX3(a,C0[r],C0[r+1]);b=MX3(b,C0[r+2],C0[r+3]);a=MX3(a,C1[r],C1[r+1]);b=MX3(b,C1[r+2],C1[r+3]);} \
      float rm=__builtin_fmaxf(a,b); { auto rr=__builtin_amdgcn_permlane32_swap(__float_as_uint(rm),__float_as_uint(rm),false,false); rm=__builtin_fmaxf(__uint_as_float(rr[0]),__uint_as_float(rr[1])); } \
      resc=false; \
      if(__builtin_expect(__any(rm>(float)THRL),0)){ const float dl=__builtin_fmaxf(rm,0.f); mhat+=dl; \
        _Pragma("unroll") for(int r=0;r<16;++r){C0[r]-=dl;C1[r]-=dl;} \
        { const float nv_=-mhat; _Pragma("unroll") for(int r=0;r<16;++r)negm[r]=nv_; } asm volatile("":"+v"(negm)); \
        const float f=__builtin_amdgcn_exp2f(-dl); l_reg*=f; if(hi==0)wsf[r32]=f; resc=true; } } \
    SBAR(); \
    GAPB(o[0]=MF32(PAF(0),VFR(0),o[0]), C0,0); \
    GAPB(o[1]=MF32(PAF(0),VFR(4),o[1]), C0,4); \
    KRD(GL,0); GAPB(o[0]=MF32(PAF(1),VFR(1),o[0]), C0,8); \
    KRD(GL,1); GAPB(o[1]=MF32(PAF(1),VFR(5),o[1]), C0,12); \
    KRD(GL,2); GAPB(o[0]=MF32(PAF(2),VFR(2),o[0]), C1,0); \
    KRD(GL,3); GAPB(o[1]=MF32(PAF(2),VFR(6),o[1]), C1,4); \
    GAPB(o[0]=MF32(PAF(3),VFR(3),o[0]), C1,8); \
    GAPB(o[1]=MF32(PAF(3),VFR(7),o[1]), C1,12); \
    }while(0)
  STEP(pB0,pB1,pA0,pA1,1,true);   RESC(); ROT();
  STEP(pA0,pA1,pB0,pB1,2,true);   RESC(); ROT();
  STEP(pB0,pB1,pA0,pA1,3,false);  RESC();
  { float sacc=pB0[0]+pB0[1]; _Pragma("unroll") for(int r=2;r<16;++r)sacc+=pB0[r]; _Pragma("unroll") for(int r=0;r<16;++r)sacc+=pB1[r]; l_reg+=sacc;
    pw0=(u32x4){PKW(pB0,0),PKW(pB0,2),PKW(pB0,4),PKW(pB0,6)};pw1=(u32x4){PKW(pB0,8),PKW(pB0,10),PKW(pB0,12),PKW(pB0,14)};pw2=(u32x4){PKW(pB1,0),PKW(pB1,2),PKW(pB1,4),PKW(pB1,6)};pw3=(u32x4){PKW(pB1,8),PKW(pB1,10),PKW(pB1,12),PKW(pB1,14)};
    SBAR(); pv(o,vb0+sl_cur,PAF(0),PAF(1),PAF(2),PAF(3)); }
  #undef PKW
  #undef PAF
  #undef VFR
  #undef PIN
  #undef MX3
  #undef GAPA
  #undef GAPB
  #undef EX
  #undef VRD
  #undef KRD
  #undef STEP
  if(MODE==1&&g+8<ngrp)LOADQ(gi+1);
  unsigned zz_=0u; asm volatile("":"+v"(zz_)); const int lane_e=(lane+(int)zz_)&63, r32e=lane_e&31, hie=lane_e>>5;
  {auto rr=__builtin_amdgcn_permlane32_swap(__float_as_uint(l_reg),__float_as_uint(l_reg),false,false);l_reg=__uint_as_float(rr[0])+__uint_as_float(rr[1]);}
  const float lse_=mhat+__builtin_amdgcn_logf(l_reg);
  if(hie==0){ wsf[32+r32e]=__builtin_amdgcn_rcpf(l_reg); wsf[r32e]=lse_; }
  u32x4 pj[2][2][3]; float lj[2][2][3];
  const unsigned prow0=(unsigned)(rowbase+q0+wid*QBLK)+(unsigned)(lane_e>>3);
  if(MODE==0){
    #pragma unroll
    for(int hf=0;hf<2;++hf)
      #pragma unroll
      for(int i=0;i<2;++i)
        #pragma unroll
        for(int j=0;j<3;++j){ const unsigned rg=(prow0+hf*16+i*8)*8u+(unsigned)h; pj[hf][i][j]=*(const u32x4*)(part+(size_t)(rg*3u+j)*64+(lane_e&7)*8); lj[hf][i][j]=lseb[rg*4u+j]; } }
  asm volatile("s_waitcnt lgkmcnt(0)":::"memory");
  float rli[16];
  #pragma unroll
  for(int r=0;r<16;++r)rli[r]=wsf[32+crow(r,hie)];
  f16*Ow=O+(rowbase+q0+wid*QBLK)*OPITCH+h*D;
  { float*stg=(float*)(shm+LDS_OST)+wid*1024;
    #pragma unroll
    for(int half=0;half<2;++half){
      #pragma unroll
      for(int r=0;r<16;++r){ const int orow=crow(r,hie);
        if((orow>>4)==half){
          #pragma unroll
          for(int d0=0;d0<2;++d0)stg[(orow&15)*64+d0*32+r32e]=o[d0][r]*rli[r]; } }
      asm volatile("s_waitcnt lgkmcnt(0)":::"memory");
      #pragma unroll
      for(int i=0;i<2;++i){ const int row=i*8+(lane_e>>3),ch=lane_e&7; f32x4 v0=*(const f32x4*)(stg+row*64+ch*8),v1=*(const f32x4*)(stg+row*64+ch*8+4);
        if(MODE==1){ const int e=entl[gi*32+half*16+row];
          if(e>=0){ const unsigned rg=((unsigned)rowbase+(unsigned)(e&4095))*8u+(unsigned)h, sj=(unsigned)(e>>12)&3u;
            u32x4 w; w.x=pk2h(v0[0],v0[1]); w.y=pk2h(v0[2],v0[3]); w.z=pk2h(v1[0],v1[1]); w.w=pk2h(v1[2],v1[3]);
            st16_wt(part,(rg*3u+sj)*128u+(unsigned)ch*16u,w);
            if(ch==0)st4_wt(lseb+rg*4u+sj,wsf[half*16+row]); } }
        else{
          { const float lo=wsf[half*16+row];
            float M=lo;
            #pragma unroll
            for(int j=0;j<3;++j)M=__builtin_fmaxf(M,lj[half][i][j]);
            const float w0_=__builtin_amdgcn_exp2f(lo-M); float den=w0_; v0*=w0_; v1*=w0_;
            #pragma unroll
            for(int j=0;j<3;++j){ const float wj=__builtin_amdgcn_exp2f(lj[half][i][j]-M); den+=wj;
              const f16x8 pv_=__builtin_bit_cast(f16x8,pj[half][i][j]);
              v0[0]+=wj*(float)pv_[0]; v0[1]+=wj*(float)pv_[1]; v0[2]+=wj*(float)pv_[2]; v0[3]+=wj*(float)pv_[3];
              v1[0]+=wj*(float)pv_[4]; v1[1]+=wj*(float)pv_[5]; v1[2]+=wj*(float)pv_[6]; v1[3]+=wj*(float)pv_[7]; }
            const float rd=1.f/den; v0*=rd; v1*=rd; }
          float ss=(v0[0]*v0[0]+v0[1]*v0[1])+(v0[2]*v0[2]+v0[3]*v0[3])+(v1[0]*v1[0]+v1[1]*v1[1])+(v1[2]*v1[2]+v1[3]*v1[3]);
          ss = xsum<1>(ss); ss = xsum<2>(ss); ss = xsum<4>(ss);
          const float rs=1.f/sqrtf(ss*(1.f/64.f)+EPS);
          const f32x4 g0=*(const f32x4*)(gain+h*D+ch*8),g1=*(const f32x4*)(gain+h*D+ch*8+4);
          u32x4 w; w.x=pk2h(v0[0]*rs*g0[0],v0[1]*rs*g0[1]); w.y=pk2h(v0[2]*rs*g0[2],v0[3]*rs*g0[3]); w.z=pk2h(v1[0]*rs*g1[0],v1[1]*rs*g1[1]); w.w=pk2h(v1[2]*rs*g1[2],v1[3]*rs*g1[3]);
          *(u32x4*)(Ow+(long)(half*16+row)*OPITCH+ch*8)=w; } }
      asm volatile("s_waitcnt lgkmcnt(0)":::"memory"); } }
  #undef START
  #undef RESC
  #undef ROT
  }
  asm volatile("s_waitcnt lgkmcnt(0)\n\ts_barrier":::"memory");
  #undef LOADQ
  #undef CMASK
}
#undef SBAR
#undef WAIT_BAR
#undef MF32
}


namespace mobad {
using s16x8=__attribute__((ext_vector_type(8)))short;
using s16x4=__attribute__((ext_vector_type(4)))short;
using f32x16=__attribute__((ext_vector_type(16)))float;
constexpr int D=64, PITCH=NPROJ, OPITCH=DM;
constexpr int NW=8,QBLK=32,QB=QBLK*NW,KVBLK=64;
__device__ __forceinline__ int crow(int r,int hi){return (r&3)+8*(r>>2)+4*hi;}
#define SBAR() __builtin_amdgcn_sched_barrier(0)
#define MF32(a,b,c) __builtin_amdgcn_mfma_f32_32x32x16_f16(__builtin_bit_cast(f16x8,(a)),__builtin_bit_cast(f16x8,(b)),(c),0,0,0)
__device__ __forceinline__ void cmask(f32x16&p0,f32x16&p1,int jb,int qrel,int hi){
  const float NEG=-INFINITY; int kb=64*jb+4*hi;
  #pragma unroll
  for(int r=0;r<16;++r){int kv=kb+(r&3)+8*(r>>2); if(kv>qrel)p0[r]=NEG; if(kv+32>qrel)p1[r]=NEG;}
}
constexpr int NSLOT=3, SLOTB=8192;
constexpr int LDS_K=0, LDS_V=NSLOT*SLOTB, LDS_WS=2*NSLOT*SLOTB, LDS_OST=LDS_WS+NW*64*4, LDS_SEL=LDS_OST+NW*4096, LDS_KS=LDS_SEL+1024, LDS_BYTES_A=LDS_KS+4096;
__device__ __forceinline__ void glds16(const void*gsrc,unsigned lds_dst){unsigned keep;
  asm volatile("s_mov_b32 %0, m0\n\ts_mov_b32 m0, %2\n\ts_nop 0\n\tglobal_load_lds_dwordx4 %1, off\n\ts_mov_b32 m0, %0":"=&s"(keep):"v"(gsrc),"s"(lds_dst):"memory");}
__device__ __forceinline__ float max3f(float a,float b,float c){float r;asm("v_max3_f32 %0, %1, %2, %3":"=v"(r):"v"(a),"v"(b),"v"(c));return r;}
__device__ __forceinline__ float max2f(float a,float b){float r;asm("v_max_f32_e32 %0, %1, %2":"=v"(r):"v"(a),"v"(b));return r;}
__device__ __forceinline__ float fadd_s(float a,float b){float r;asm("v_add_f32_e32 %0, %1, %2":"=v"(r):"v"(a),"v"(b));return r;}
__device__ __forceinline__ float fsub_s(float a,float b){float r;asm("v_sub_f32_e32 %0, %1, %2":"=v"(r):"v"(a),"v"(b));return r;}
__device__ __forceinline__ unsigned cvtpk_s(float lo,float hi){return __builtin_bit_cast(unsigned,__builtin_amdgcn_cvt_pkrtz(lo,hi));}
#define WAIT_BAR(N) asm volatile("s_waitcnt vmcnt(" #N ") lgkmcnt(0)\n\ts_barrier":::"memory")
__device__ __forceinline__ void qkt(f32x16&p0,f32x16&p1,const char*Kslot,const s16x8*qr,const f32x16&negm,int r32,int hi){
  const char*kb=Kslot+hi*1024+r32*16;
  #pragma unroll
  for(int d0=0;d0<4;++d0){
    const s16x8 b0=*reinterpret_cast<const s16x8*>(kb+d0*2048);
    const s16x8 b1=*reinterpret_cast<const s16x8*>(kb+d0*2048+512);
    if(d0==0){p0=MF32(b0,qr[0],negm);p1=MF32(b1,qr[0],negm);}
    else{p0=MF32(b0,qr[d0],p0);p1=MF32(b1,qr[d0],p1);}}
}
typedef __attribute__((address_space(3))) const char* lds_cptr;
typedef short v4i16_t __attribute__((ext_vector_type(4)));
__device__ __forceinline__ void kload8(s16x8*kf,lds_cptr kp){
  kf[0]=*(const __attribute__((address_space(3))) s16x8*)(kp);      kf[1]=*(const __attribute__((address_space(3))) s16x8*)(kp+512);
  kf[2]=*(const __attribute__((address_space(3))) s16x8*)(kp+2048); kf[3]=*(const __attribute__((address_space(3))) s16x8*)(kp+2560);
  kf[4]=*(const __attribute__((address_space(3))) s16x8*)(kp+4096); kf[5]=*(const __attribute__((address_space(3))) s16x8*)(kp+4608);
  kf[6]=*(const __attribute__((address_space(3))) s16x8*)(kp+6144); kf[7]=*(const __attribute__((address_space(3))) s16x8*)(kp+6656);
}
__device__ __forceinline__ void kload2(s16x8*kf,lds_cptr kp,int j){ kf[2*j]=*(const __attribute__((address_space(3))) s16x8*)(kp+j*2048); kf[2*j+1]=*(const __attribute__((address_space(3))) s16x8*)(kp+j*2048+512); }
__device__ __forceinline__ s16x4 vtr(lds_cptr p){ return __builtin_bit_cast(s16x4,__builtin_amdgcn_ds_read_tr16_b64_v4i16((__attribute__((address_space(3))) v4i16_t*)p)); }
__device__ __forceinline__ float rowmax(const f32x16&p0,const f32x16&p1){
  float a=max3f(p0[0],p0[1],p1[0]),b=max3f(p0[2],p0[3],p1[1]);a=max3f(a,p1[2],p1[3]);
  #pragma unroll
  for(int r=4;r<16;r+=4){a=max3f(a,p0[r],p0[r+1]);b=max3f(b,p0[r+2],p0[r+3]);a=max3f(a,p1[r],p1[r+1]);b=max3f(b,p1[r+2],p1[r+3]);}
  const float m=max2f(a,b);
  auto rr=__builtin_amdgcn_permlane32_swap(__float_as_uint(m),__float_as_uint(m),false,false);
  return max2f(__uint_as_float(rr[0]),__uint_as_float(rr[1]));
}
__device__ __forceinline__ void pv(f32x16*o,int vb,s16x8 pa0,s16x8 pa1,s16x8 pa2,s16x8 pa3){
  #pragma unroll
  for(int d0=0;d0<2;++d0){s16x4 lo[4],hi[4];
    #pragma unroll
    for(int ks=0;ks<4;++ks){
      asm volatile("ds_read_b64_tr_b16 %0,%1 offset:%c2":"=&v"(lo[ks]):"v"(vb),"i"(d0*4096+ks*1024):"memory");
      asm volatile("ds_read_b64_tr_b16 %0,%1 offset:%c2":"=&v"(hi[ks]):"v"(vb),"i"(d0*4096+ks*1024+512):"memory");}
    asm volatile("s_waitcnt lgkmcnt(0)":::"memory");SBAR();
    #define PK(k) (s16x8){lo[k][0],lo[k][1],lo[k][2],lo[k][3],hi[k][0],hi[k][1],hi[k][2],hi[k][3]}
    o[d0]=MF32(pa0,PK(0),o[d0]);
    o[d0]=MF32(pa1,PK(1),o[d0]);
    o[d0]=MF32(pa2,PK(2),o[d0]);
    o[d0]=MF32(pa3,PK(3),o[d0]);
    #undef PK
  }
}
__device__ __forceinline__ void sel_unit(int b,int h,int qb,const f16*Q,const float*ksum,char*shm,const int w0){
  const int tid=tid_of(w0);
  const int row=tid>>1, half=tid&1;
  unsigned sel=0u;
  if(qb>0){
    float*ks=(float*)(shm+LDS_KS);
    if(tid<256)*(f32x4*)(ks+4*tid)=*(const f32x4*)(ksum+(size_t)((b*8+h)*16)*64+4*tid);
    float qf[32];
    { const f16x8*qp=(const f16x8*)(Q+((long)b*SEQ+qb*QB+row)*PITCH+h*D+32*half);
      #pragma unroll
      for(int i=0;i<4;++i){ const f16x8 t=qp[i];
        #pragma unroll
        for(int j=0;j<8;++j)qf[8*i+j]=(float)t[j]; } }
    asm volatile("s_waitcnt lgkmcnt(0)\n\ts_barrier":::"memory");
    float g[15];
    const float*kp=ks+32*half;
    #pragma unroll
    for(int n=0;n<15;++n){ float s=0.f;
      if(n<qb){
        #pragma unroll
        for(int i=0;i<8;++i){ const f32x4 k4=*(const f32x4*)(kp+n*64+4*i); s+=qf[4*i]*k4[0]+qf[4*i+1]*k4[1]+qf[4*i+2]*k4[2]+qf[4*i+3]*k4[3]; }
        s = xsum<1>(s); }
      g[n]=(n<qb)?s:-INFINITY; }
    #pragma unroll
    for(int r=0;r<3;++r){ float best=-INFINITY; int bi=-1;
      #pragma unroll
      for(int n=0;n<15;++n){ const bool ok=!((sel>>n)&1u)&&g[n]>best; best=ok?g[n]:best; bi=ok?n:bi; }
      if(bi>=0)sel|=1u<<bi; } }
  if(half==0)((unsigned*)(shm+LDS_SEL))[row]=sel;
  asm volatile("s_waitcnt lgkmcnt(0)\n\ts_barrier":::"memory");
}
constexpr float NEGBIG=-1.0e30f;
template<int THRL> __device__ __forceinline__ void attn_unit(int b,int h,int qb,const f16*Q,const f16*__restrict__ K,const f16*__restrict__ V,f16*O,const float*ksum,const float*gain,char*shm,const int w0){
  const int tid=tid_of(w0),lane=tid&63,r32=lane&31,hi=lane>>5; const int wid=w0;
  const long rowbase=(long)b*SEQ; const int q0=qb*QB;
  const f16*Qw=Q+(rowbase+q0+wid*QBLK)*PITCH+h*D;
  const f16*Kh=K+rowbase*PITCH+h*D,*Vh=V+rowbase*PITCH+h*D;
  const unsigned lds0=(unsigned)(uintptr_t)shm;
  float*wsf=(float*)(shm+LDS_WS)+wid*64;
  const f16*kptr=Kh+(long)lane*PITCH+wid*8+(long)(4*qb)*KVBLK*PITCH;
  const f16*vptr=Vh+(long)(16*(wid&3)+(lane>>2))*PITCH+(wid>>2)*32+(lane&3)*8+(long)(4*qb)*KVBLK*PITCH;
  const unsigned kdst=lds0+LDS_K+wid*1024, vdst=lds0+LDS_V+wid*1024;
  const long tstep_=(long)KVBLK*PITCH, twrap_=-(long)(4*qb+3)*KVBLK*PITCH;
  #define DMA_K(t,slot) do{ glds16(kptr,(unsigned)__builtin_amdgcn_readfirstlane(kdst+(slot))); kptr+=(((t)==3)?twrap_:tstep_); }while(0)
  #define DMA_V(t,slot) do{ glds16(vptr,(unsigned)__builtin_amdgcn_readfirstlane(vdst+(slot))); vptr+=(((t)==3)?twrap_:tstep_); }while(0)
  const int vb0=(int)(lds0+LDS_V)+((lane>>4)&1)*32+(lane&3)*8+(4*hi+((lane&15)>>2))*64;
  const char*Kbase=shm+LDS_K; s16x8 kf[8];
  const lds_cptr shm3=(lds_cptr)shm; const lds_cptr kp0=shm3+LDS_K+hi*1024+r32*16; const lds_cptr vp0=shm3+LDS_V+((lane>>4)&1)*32+(lane&3)*8+(4*hi+((lane&15)>>2))*64;
  const int NT=4*qb+4;
  DMA_K(0,0);DMA_V(0,0);DMA_K(1,SLOTB);
  s16x8 qr[4];
  #pragma unroll
  for(int d0=0;d0<4;++d0)qr[d0]=*reinterpret_cast<const s16x8*>(&Qw[(long)r32*PITCH+d0*16+hi*8]);
  const unsigned sel=((const unsigned*)(shm+LDS_SEL))[wid*QBLK+r32];
  bool msk=false;
  float mhat=0.f,l_reg=0.f;f32x16 o[2];o[0]=f32x16{};o[1]=f32x16{};f32x16 negm=f32x16{};asm volatile("":"+v"(negm));
  const int qrel=wid*QBLK+r32;
  #define CMASK(P0,P1,t) do{ if((t)<4)cmask(P0,P1,(t),qrel,hi); }while(0)
  #define SELM(t) do{ if((t)>=4&&(((t)&3)==0)){ msk=!((sel>>(((t)-4)>>2))&1u); const float nv_=msk?NEGBIG:-mhat; _Pragma("unroll") for(int r=0;r<16;++r)negm[r]=nv_; asm volatile("":"+v"(negm)); } }while(0)
  bool resc=false;
  #define START(P0,P1) do{ const float rm=rowmax(P0,P1); resc=false; \
    { const float dl=rm; mhat=fadd_s(mhat,dl); \
      _Pragma("unroll") for(int r=0;r<16;++r){P0[r]=fsub_s(P0[r],dl);P1[r]=fsub_s(P1[r],dl);} \
      _Pragma("unroll") for(int r=0;r<16;++r)negm[r]=-mhat; asm volatile("":"+v"(negm)); } \
    _Pragma("unroll") for(int r=0;r<16;++r)P0[r]=__builtin_amdgcn_exp2f(P0[r]); }while(0)
  #define RESC() do{ if(resc){ asm volatile("s_waitcnt lgkmcnt(0)":::"memory"); \
      _Pragma("unroll") for(int d_=0;d_<2;++d_) _Pragma("unroll") for(int r=0;r<16;++r)o[d_][r]*=wsf[crow(r,hi)]; } }while(0)
  f32x16 pA0,pA1,pB0,pB1;
  int sl_prev=0,sl_cur=0,sl_next=SLOTB;
  #define ROT() do{sl_prev=sl_cur;sl_cur=sl_next;sl_next=(sl_next==(NSLOT-1)*SLOTB)?0:sl_next+SLOTB;}while(0)
  DMA_K(2,2*SLOTB);
  WAIT_BAR(3);
  qkt(pA0,pA1,Kbase,qr,negm,r32,hi);asm volatile("s_nop 15\n\ts_nop 7":"+v"(pA0),"+v"(pA1));CMASK(pA0,pA1,0);
  START(pA0,pA1);
  _Pragma("unroll") for(int r=0;r<16;++r)pA1[r]=__builtin_amdgcn_exp2f(pA1[r]);
  WAIT_BAR(0);
  DMA_K(3,0);DMA_V(1,SLOTB);
  ROT();
  kload8(kf,kp0+sl_cur);
  WAIT_BAR(2);
  s16x4 vlo[8],vhi[8]; u32x4 pw0,pw1,pw2,pw3;
  #define PKW(P,B) cvtpk_s(P[B],P[B+1])
  #define PAF(k) __builtin_bit_cast(s16x8,pw##k)
  #define VFR(i) (s16x8){vlo[i][0],vlo[i][1],vlo[i][2],vlo[i][3],vhi[i][0],vhi[i][1],vhi[i][2],vhi[i][3]}
  #define PIN(x) asm volatile("":"+v"(x))
  #define MX3(a,b,c) __builtin_fmaxf(__builtin_fmaxf((a),(b)),(c))
  #define GAPA(MF,A0,A1,A2,A3,W0,W1,PW) do{ MF; sacc+=A0; sacc+=A1; sacc+=A2; sacc+=A3; PIN(sacc); W0; W1; PIN(PW); SBAR(); }while(0)
  #define EX(v) __builtin_amdgcn_exp2f(v)
  #define GAPB(MF,X,B) do{ MF; X[B]=EX(X[B]); X[B+1]=EX(X[B+1]); X[B+2]=EX(X[B+2]); X[B+3]=EX(X[B+3]); PIN(X); SBAR(); }while(0)
  #define VRD(i) do{ vlo[i]=vtr(vp_+(((i)>>2)*4096+((i)&3)*1024)); vhi[i]=vtr(vp_+(((i)>>2)*4096+((i)&3)*1024+512)); }while(0)
  #define KRD(G,j) do{ if(G){ kload2(kf,kp0+sl_next,j); SBAR(); } }while(0)
  #define STEP(C0,C1,P0,P1,t,GK,GV,GL) do{ SELM(t); SBAR(); \
    const lds_cptr vp_=vp0+sl_prev; \
    VRD(0); SBAR(); float sacc=(P0[0]+P0[1]); \
    GAPA(C0=MF32(kf[0],qr[0],negm), P0[2],P0[3],P0[4],P0[5],     pw0[0]=PKW(P0,0), pw0[1]=PKW(P0,2), pw0); \
    VRD(4); SBAR(); GAPA(C1=MF32(kf[1],qr[0],negm), P0[6],P0[7],P0[8],P0[9],     pw0[2]=PKW(P0,4), pw0[3]=PKW(P0,6), pw0); \
    VRD(1); SBAR(); GAPA(C0=MF32(kf[2],qr[1],C0),   P0[10],P0[11],P0[12],P0[13], pw1[0]=PKW(P0,8), pw1[1]=PKW(P0,10), pw1); \
    VRD(5); SBAR(); GAPA(C1=MF32(kf[3],qr[1],C1),   P0[14],P0[15],P1[0],P1[1],   pw1[2]=PKW(P0,12),pw1[3]=PKW(P0,14), pw1); \
    VRD(2); SBAR(); GAPA(C0=MF32(kf[4],qr[2],C0),   P1[2],P1[3],P1[4],P1[5],     pw2[0]=PKW(P1,0), pw2[1]=PKW(P1,2), pw2); \
    VRD(6); SBAR(); GAPA(C1=MF32(kf[5],qr[2],C1),   P1[6],P1[7],P1[8],P1[9],     pw2[2]=PKW(P1,4), pw2[3]=PKW(P1,6), pw2); \
    VRD(3); SBAR(); GAPA(C0=MF32(kf[6],qr[3],C0),   P1[10],P1[11],P1[12],P1[13], pw3[0]=PKW(P1,8), pw3[1]=PKW(P1,10), pw3); \
    VRD(7); SBAR(); GAPA(C1=MF32(kf[7],qr[3],C1),   P1[14],P1[15],0.f,0.f,       pw3[2]=PKW(P1,12),pw3[3]=PKW(P1,14), pw3); \
    l_reg+=sacc; \
    if(GK){DMA_K((t)+3,sl_cur);} if(GV){DMA_V((t)+1,sl_next);} \
    CMASK(C0,C1,t); \
    { float a=MX3(C0[0],C0[1],C1[0]),b=MX3(C0[2],C0[3],C1[1]); a=MX3(a,C1[2],C1[3]); \
      _Pragma("unroll") for(int r=4;r<16;r+=4){a=MX3(a,C0[r],C0[r+1]);b=MX3(b,C0[r+2],C0[r+3]);a=MX3(a,C1[r],C1[r+1]);b=MX3(b,C1[r+2],C1[r+3]);} \
      float rm=__builtin_fmaxf(a,b); { auto rr=__builtin_amdgcn_permlane32_swap(__float_as_uint(rm),__float_as_uint(rm),false,false); rm=__builtin_fmaxf(__uint_as_float(rr[0]),__uint_as_float(rr[1])); } \
      resc=false; \
      if(__builtin_expect(__any(rm>(float)THRL),0)){ const float dl=__builtin_fmaxf(rm,0.f); mhat+=dl; \
        _Pragma("unroll") for(int r=0;r<16;++r){C0[r]-=dl;C1[r]-=dl;} \
        { const float nv_=msk?NEGBIG:-mhat; _Pragma("unroll") for(int r=0;r<16;++r)negm[r]=nv_; } asm volatile("":"+v"(negm)); \
        const float f=__builtin_amdgcn_exp2f(-dl); l_reg*=f; if(hi==0)wsf[r32]=f; resc=true; } } \
    SBAR(); \
    GAPB(o[0]=MF32(PAF(0),VFR(0),o[0]), C0,0); \
    GAPB(o[1]=MF32(PAF(0),VFR(4),o[1]), C0,4); \
    KRD(GL,0); GAPB(o[0]=MF32(PAF(1),VFR(1),o[0]), C0,8); \
    KRD(GL,1); GAPB(o[1]=MF32(PAF(1),VFR(5),o[1]), C0,12); \
    KRD(GL,2); GAPB(o[0]=MF32(PAF(2),VFR(2),o[0]), C1,0); \
    KRD(GL,3); GAPB(o[1]=MF32(PAF(2),VFR(6),o[1]), C1,4); \
    GAPB(o[0]=MF32(PAF(3),VFR(3),o[0]), C1,8); \
    GAPB(o[1]=MF32(PAF(3),VFR(7),o[1]), C1,12); \
    }while(0)
  int t=1;
  for(;t+5<NT;t+=2){
    STEP(pB0,pB1,pA0,pA1,t,true,true,true);     WAIT_BAR(2); RESC(); ROT();
    STEP(pA0,pA1,pB0,pB1,t+1,true,true,true);   WAIT_BAR(2); RESC(); ROT();
  }
  #define ENDW(tt) do{ if((tt)+3<NT){WAIT_BAR(2);} else if((tt)+2<NT){WAIT_BAR(1);} else {WAIT_BAR(0);} }while(0)
  for(;t+1<NT;t+=2){
    STEP(pB0,pB1,pA0,pA1,t,(t+3<NT),(t+1<NT),(t+1<NT));       ENDW(t);   RESC(); ROT();
    STEP(pA0,pA1,pB0,pB1,t+1,(t+4<NT),(t+2<NT),(t+2<NT));     ENDW(t+1); RESC(); ROT();
  }
  STEP(pB0,pB1,pA0,pA1,NT-1,false,false,false); RESC();
  { float sacc=pB0[0]+pB0[1]; _Pragma("unroll") for(int r=2;r<16;++r)sacc+=pB0[r]; _Pragma("unroll") for(int r=0;r<16;++r)sacc+=pB1[r]; l_reg+=sacc;
    pw0=(u32x4){PKW(pB0,0),PKW(pB0,2),PKW(pB0,4),PKW(pB0,6)};pw1=(u32x4){PKW(pB0,8),PKW(pB0,10),PKW(pB0,12),PKW(pB0,14)};pw2=(u32x4){PKW(pB1,0),PKW(pB1,2),PKW(pB1,4),PKW(pB1,6)};pw3=(u32x4){PKW(pB1,8),PKW(pB1,10),PKW(pB1,12),PKW(pB1,14)};
    SBAR(); pv(o,vb0+sl_cur,PAF(0),PAF(1),PAF(2),PAF(3)); }
  #undef PKW
  #undef PAF
  #undef VFR
  #undef PIN
  #undef MX3
  #undef GAPA
  #undef GAPB
  #undef EX
  #undef VRD
  #undef KRD
  #undef STEP
  #undef ENDW
  {auto rr=__builtin_amdgcn_permlane32_swap(__float_as_uint(l_reg),__float_as_uint(l_reg),false,false);l_reg=__uint_as_float(rr[0])+__uint_as_float(rr[1]);}
  if(hi==0)wsf[32+r32]=l_reg;asm volatile("s_waitcnt lgkmcnt(0)":::"memory");
  float rli[16];
  #pragma unroll
  for(int r=0;r<16;++r)rli[r]=__builtin_amdgcn_rcpf(wsf[32+crow(r,hi)]);
  f16*Ow=O+(rowbase+q0+wid*QBLK)*OPITCH+h*D;
  { float*stg=(float*)(shm+LDS_OST)+wid*1024;
    #pragma unroll
    for(int half=0;half<2;++half){
      #pragma unroll
      for(int r=0;r<16;++r){ const int orow=crow(r,hi);
        if((orow>>4)==half){
          #pragma unroll
          for(int d0=0;d0<2;++d0)stg[(orow&15)*64+d0*32+r32]=o[d0][r]*rli[r]; } }
      asm volatile("s_waitcnt lgkmcnt(0)":::"memory");
      #pragma unroll
      for(int i=0;i<2;++i){ const int row=i*8+(lane>>3),ch=lane&7; const f32x4 v0=*(const f32x4*)(stg+row*64+ch*8),v1=*(const f32x4*)(stg+row*64+ch*8+4);
        float ss=(v0[0]*v0[0]+v0[1]*v0[1])+(v0[2]*v0[2]+v0[3]*v0[3])+(v1[0]*v1[0]+v1[1]*v1[1])+(v1[2]*v1[2]+v1[3]*v1[3]);
        ss = xsum<1>(ss); ss = xsum<2>(ss); ss = xsum<4>(ss);
        const float rs=1.f/sqrtf(ss*(1.f/64.f)+EPS);
        const f32x4 g0=*(const f32x4*)(gain+h*D+ch*8),g1=*(const f32x4*)(gain+h*D+ch*8+4);
        u32x4 w; w.x=pk2h(v0[0]*rs*g0[0],v0[1]*rs*g0[1]); w.y=pk2h(v0[2]*rs*g0[2],v0[3]*rs*g0[3]); w.z=pk2h(v1[0]*rs*g1[0],v1[1]*rs*g1[1]); w.w=pk2h(v1[2]*rs*g1[2],v1[3]*rs*g1[3]);
        *(u32x4*)(Ow+(long)(half*16+row)*OPITCH+ch*8)=w; }
      asm volatile("s_waitcnt lgkmcnt(0)":::"memory"); } }
  asm volatile("s_waitcnt lgkmcnt(0)\n\ts_barrier":::"memory");
  #undef DMA_K
  #undef DMA_V
  #undef CMASK
  #undef SELM
  #undef START
  #undef RESC
  #undef ROT
}
#undef SBAR
#undef WAIT_BAR
#undef MF32
}


namespace mlstm {
constexpr int L=64, DH=128, NCH=16;
constexpr int RS1=136, RS2=72;
#define ML_BAR() asm volatile("s_waitcnt lgkmcnt(0)\n\ts_barrier" ::: "memory")
#define MF16(a,b,c) __builtin_amdgcn_mfma_f32_16x16x32_f16((a),(b),(c),0,0,0)
typedef short v4i16_t __attribute__((ext_vector_type(4)));
__device__ __forceinline__ f16x4 trd(const LAS f16* p){ return __builtin_bit_cast(f16x4,__builtin_amdgcn_ds_read_tr16_b64_v4i16((LAS v4i16_t*)p)); }
__device__ __forceinline__ f16x8 cat8(f16x4 a,f16x4 c){ return (f16x8){a[0],a[1],a[2],a[3],c[0],c[1],c[2],c[3]}; }
__device__ __forceinline__ float frcp(float x){ return __builtin_amdgcn_rcpf(x); }
struct Glob { f16* cloc; f16* cprev; float* nloc; float* nprev; float* sa; float* smloc; float* smprev;
              f16* qkc;
              float* gcolf; float* gcum; float* gpm;
              float* sca; float* scpm; };

__device__ __forceinline__ void prep(int b,int sc,const Glob G,const f16*proj,const float*gates,const float*conv_w,const float*conv_b,const int w0){
  const int tid=tid_of(w0),lane=tid&63,wid=w0;
  const int cg=tid&127,tq=tid>>7; const long rowbase=(long)b*SEQ; const int t0=sc*L+16*tq;
  const f16*src=proj+C_QM+8*cg;
  f16x8 raw[19];
  #pragma unroll
  for(int i=0;i<19;++i){ const int t_=t0-3+i; raw[i]=(t_>=0)?*(const f16x8*)(src+(rowbase+t_)*NPROJ):(f16x8){0,0,0,0,0,0,0,0}; }
  float cw[4][8],cb[8];
  #pragma unroll
  for(int tp=0;tp<4;++tp){ const f32x4 a=*(const f32x4*)(conv_w+tp*1024+8*cg),c=*(const f32x4*)(conv_w+tp*1024+8*cg+4);
    cw[tp][0]=a[0];cw[tp][1]=a[1];cw[tp][2]=a[2];cw[tp][3]=a[3];cw[tp][4]=c[0];cw[tp][5]=c[1];cw[tp][6]=c[2];cw[tp][7]=c[3]; }
  { const f32x4 a=*(const f32x4*)(conv_b+8*cg),c=*(const f32x4*)(conv_b+8*cg+4); cb[0]=a[0];cb[1]=a[1];cb[2]=a[2];cb[3]=a[3];cb[4]=c[0];cb[5]=c[1];cb[6]=c[2];cb[7]=c[3]; }
  const float ksc=(cg>=64)?0.08838834764831845f:1.f;
  const unsigned dsto=(unsigned)(((rowbase+t0)*1024+8*cg)*2);
  #pragma unroll
  for(int i=0;i<16;++i){ float o[8];
    #pragma unroll
    for(int j=0;j<8;++j){ float v=cb[j];
      #pragma unroll
      for(int tp=0;tp<4;++tp)v+=cw[tp][j]*(float)raw[i+tp][j];
      o[j]=v*frcp(1.f+__expf(-v))*ksc; }
    u32x4 w; w.x=pk2h(o[0],o[1]); w.y=pk2h(o[2],o[3]); w.z=pk2h(o[4],o[5]); w.w=pk2h(o[6],o[7]);
    st16_wt(G.qkc,dsto+(unsigned)i*2048u,w); }
  if(wid<4){ const int hm=wid; const long row=rowbase+sc*L+lane;
    const float ig=gates[row*8+hm],fg=gates[row*8+4+hm];
    const float logf=fminf(fg,0.f)-log1pf(__expf(-fabsf(fg)));
    float cum=logf;
    #pragma unroll
    for(int o=1;o<64;o<<=1){ const float tmp=__builtin_bit_cast(float,__builtin_amdgcn_ds_bpermute((lane-o)<<2,__builtin_bit_cast(int,cum))); if(lane>=o)cum+=tmp; }
    const float colf=ig-cum; float pm=colf;
    #pragma unroll
    for(int o=1;o<64;o<<=1){ const float tmp=__builtin_bit_cast(float,__builtin_amdgcn_ds_bpermute((lane-o)<<2,__builtin_bit_cast(int,pm))); if(lane>=o)pm=fmaxf(pm,tmp); }
    const size_t gi=(size_t)(b*4+hm)*SEQ+sc*L+lane;
    st4_wt(G.gcolf+gi,colf); st4_wt(G.gcum+gi,cum); st4_wt(G.gpm+gi,pm);
    if(lane==63){ st4_wt(G.sca+(b*4+hm)*64+sc,cum); st4_wt(G.scpm+(b*4+hm)*64+sc,pm); } }
}

__device__ __forceinline__ void contrib(int b,int hm,int c,const Glob G,const f16*proj,LAS unsigned char*lds,const int w0){
  constexpr int KS0=0,VS0=34816,CS=69632,VEC=104448;
  const int tid=tid_of(w0),lane=tid&63,wid=w0,fr=lane&15,fq=lane>>4;
  LAS f16*Cs=(LAS f16*)(lds+CS); LAS float*vec=(LAS float*)(lds+VEC); LAS f16*wph=(LAS f16*)(vec+128);
  const int seq=b*4+hm,item=seq*NCH+c; const long rowbase=(long)b*SEQ; const int tc=256*c;
  const int eg=tid&15,sq=tid>>4;
  const f16*kp=G.qkc+512+hm*DH+8*eg; const f16*vp=proj+C_VM+hm*DH+8*eg;
  const int trb=(8*fq+(fr>>2))*RS1+4*(fr&3);
  float aj[4],pj[4],off[4];
  #pragma unroll
  for(int j=0;j<4;++j){ aj[j]=G.sca[seq*64+4*c+j]; pj[j]=G.scpm[seq*64+4*c+j]; }
  off[0]=0.f; off[1]=aj[0]; off[2]=aj[0]+aj[1]; off[3]=off[2]+aj[2];
  const float a256=off[3]+aj[3];
  const float mloc=a256+fmaxf(fmaxf(pj[0]-off[0],pj[1]-off[1]),fmaxf(pj[2]-off[2],pj[3]-off[3]));
  f32x4 accC[8];
  #pragma unroll
  for(int i=0;i<8;++i)accC[i]=(f32x4){0.f,0.f,0.f,0.f};
  float nacc=0.f;
  f16x8 rk[2],rv[2]; float rcolf=0.f;
  #define LOADP(j) do{ const long r0_=rowbase+tc+64*(j)+2*sq; \
    rk[0]=*(const f16x8*)(kp+r0_*1024); rk[1]=*(const f16x8*)(kp+(r0_+1)*1024); rv[0]=*(const f16x8*)(vp+r0_*NPROJ); rv[1]=*(const f16x8*)(vp+(r0_+1)*NPROJ); \
    if(wid==0) rcolf=G.gcolf[(size_t)seq*SEQ+tc+64*(j)+lane]; }while(0)
  LOADP(0);
  #pragma unroll
  for(int j=0;j<4;++j){ const int buf=j&1;
    LAS f16*Ks=(LAS f16*)(lds+KS0+buf*17408); LAS f16*Vs=(LAS f16*)(lds+VS0+buf*17408);
    *(LAS f16x8*)(Ks+(2*sq)*RS1+8*eg)=rk[0]; *(LAS f16x8*)(Ks+(2*sq+1)*RS1+8*eg)=rk[1];
    *(LAS f16x8*)(Vs+(2*sq)*RS1+8*eg)=rv[0]; *(LAS f16x8*)(Vs+(2*sq+1)*RS1+8*eg)=rv[1];
    if(wid==0){ const float wpv=__expf(a256+(rcolf-off[j])-mloc); vec[64*buf+lane]=wpv; wph[64*buf+lane]=(f16)wpv; }
    ML_BAR();
    if(j<3) LOADP(j+1);
    #pragma unroll
    for(int ks=0;ks<2;++ks){ const LAS f16*ap=Ks+trb+32*ks*RS1+16*wid; const f16x8 kfa=cat8(trd(ap),trd(ap+4*RS1)) * *(const LAS f16x8*)(wph+64*buf+32*ks+8*fq);
      #pragma unroll
      for(int et=0;et<8;++et){ const LAS f16*bp=Vs+trb+32*ks*RS1+16*et; const f16x8 vfb=cat8(trd(bp),trd(bp+4*RS1)); accC[et]=MF16(kfa,vfb,accC[et]); } }
    { const int d=tid>>2,sg=tid&3; float sn=0.f;
      #pragma unroll
      for(int i=0;i<16;++i)sn+=(float)Ks[(16*sg+i)*RS1+d]*vec[64*buf+16*sg+i];
      sn=xsum<1>(sn); sn=xsum<2>(sn); nacc+=sn; } }
  #undef LOADP
  #pragma unroll
  for(int et=0;et<8;++et){ u32x2 w; w.x=pk2h(accC[et][0],accC[et][1]); w.y=pk2h(accC[et][2],accC[et][3]); *(LAS u32x2*)(Cs+(16*et+fr)*RS1+16*wid+4*fq)=w; }
  ML_BAR();
  { f16*dst=G.cloc+(size_t)item*DH*DH;
    #pragma unroll
    for(int i=0;i<4;++i){ const int idx=tid+NTHR*i, e=idx>>4, ch=idx&15; st16_wt(dst,(unsigned)((e*DH+8*ch)*2),*(const LAS u32x4*)(Cs+e*RS1+8*ch)); }
    if((tid&3)==0)st4_wt(G.nloc+(size_t)item*DH+(tid>>2),nacc);
    if(tid==0){ st4_wt(G.sa+item,a256); st4_wt(G.smloc+item,mloc); } }
  ML_BAR();
}

__device__ __forceinline__ void scan(int seq,const Glob G,const int w0){
  const int tid=tid_of(w0); const int e=tid>>2,d0=32*(tid&3);
  float C[32];
  #pragma unroll
  for(int j=0;j<32;++j)C[j]=0.f;
  float nv=0.f,mst=0.f;
  u32x4 in4[4],nx4[4]; float a,ml,nl,an=0.f,mln=0.f,nln=0.f;
  { const int item=seq*NCH; const u32x4*src=(const u32x4*)(G.cloc+(size_t)item*DH*DH+e*DH+d0);
    #pragma unroll
    for(int i=0;i<4;++i)in4[i]=src[i];
    a=G.sa[item]; ml=G.smloc[item]; nl=(tid<DH)?G.nloc[(size_t)item*DH+tid]:0.f; }
  #pragma unroll 1
  for(int c=0;c<NCH;++c){ const int item=seq*NCH+c;
    if(c+1<NCH){ const u32x4*src=(const u32x4*)(G.cloc+(size_t)(item+1)*DH*DH+e*DH+d0);
      #pragma unroll
      for(int i=0;i<4;++i)nx4[i]=src[i];
      an=G.sa[item+1]; mln=G.smloc[item+1]; nln=(tid<DH)?G.nloc[(size_t)(item+1)*DH+tid]:0.f; }
    f16*dstb=G.cprev+(size_t)item*DH*DH; const unsigned dsto=(unsigned)((e*DH+d0)*2);
    #pragma unroll
    for(int i=0;i<4;++i){ u32x4 o; o.x=pk2h(C[8*i],C[8*i+1]); o.y=pk2h(C[8*i+2],C[8*i+3]); o.z=pk2h(C[8*i+4],C[8*i+5]); o.w=pk2h(C[8*i+6],C[8*i+7]); st16_wt(dstb,dsto+16u*i,o); }
    if(tid<DH)st4_wt(G.nprev+(size_t)item*DH+tid,nv);
    if(tid==0)st4_wt(G.smprev+item,mst);
    const float mn=fmaxf(a+mst,ml),sp=__expf(a+mst-mn),sl=__expf(ml-mn);
    #pragma unroll
    for(int i=0;i<4;++i){ const f16x8 h8=__builtin_bit_cast(f16x8,in4[i]);
      #pragma unroll
      for(int j=0;j<8;++j)C[8*i+j]=sp*C[8*i+j]+sl*(float)h8[j]; }
    nv=sp*nv+sl*nl; mst=mn;
    #pragma unroll
    for(int i=0;i<4;++i)in4[i]=nx4[i];
    a=an; ml=mln; nl=nln; }
}

__device__ __forceinline__ void unit(int b,int hm,int c,const Glob G,const f16*proj,const float*gain,f16*mix,LAS unsigned char*lds,const int w0){
  constexpr int QS=0, KS=17408, VS=34816, CS=52224, PS=87040, VEC=96256;
  const int tid=tid_of(w0),lane=tid&63,wid=w0,fr=lane&15,fq=lane>>4;
  LAS f16*Qs=(LAS f16*)(lds+QS); LAS f16*Ks=(LAS f16*)(lds+KS); LAS f16*Vs=(LAS f16*)(lds+VS); LAS f16*Cs=(LAS f16*)(lds+CS); LAS f16*Ps=(LAS f16*)(lds+PS);
  LAS float*vec=(LAS float*)(lds+VEC); LAS f16*wph=(LAS f16*)(vec+1288);
  const int seq=b*4+hm,item=seq*NCH+c; const long rowbase=(long)b*SEQ;
  const int eg=tid&15,sq=tid>>4;
  const f16*qp=G.qkc+hm*DH+8*eg; const f16*kp=qp+512; const f16*vp=proj+C_VM+hm*DH+8*eg;
  const f32x4 gn=*(const f32x4*)(gain+hm*DH+16*wid+4*fq);
  const f16*omp=proj+C_OM+hm*DH+16*wid+4*fq; f16*outp=mix+512+hm*DH+16*wid+4*fq;
  const int trb=(8*fq+(fr>>2))*RS1+4*(fr&3);
  { const f16*src=G.cprev+(size_t)item*DH*DH;
    #pragma unroll
    for(int i=0;i<4;++i){ const int idx=tid+NTHR*i, e=idx>>4, ch=idx&15; *(LAS u32x4*)(Cs+e*RS1+8*ch)=*(const u32x4*)(src+e*DH+8*ch); }
    if(tid<DH)vec[1152+tid]=G.nprev[(size_t)item*DH+tid]; }
  float mprev=G.smprev[item];
  f16x8 rq[2],rk[2],rv[2]; f16x4 omn[4]; float rcolf=0.f,rcum=0.f,rpm=0.f,ra=0.f,rpx=0.f;
  #define LOAD_RAW(sc) do{ const long r0_=rowbase+(sc)*L+2*sq; \
    rq[0]=*(const f16x8*)(qp+r0_*1024); rq[1]=*(const f16x8*)(qp+(r0_+1)*1024); rk[0]=*(const f16x8*)(kp+r0_*1024); rk[1]=*(const f16x8*)(kp+(r0_+1)*1024); \
    rv[0]=*(const f16x8*)(vp+r0_*NPROJ); rv[1]=*(const f16x8*)(vp+(r0_+1)*NPROJ); \
    _Pragma("unroll") for(int tt=0;tt<4;++tt) omn[tt]=*(const f16x4*)(omp+(rowbase+(sc)*L+16*tt+fr)*NPROJ); \
    if(wid==0){ const size_t gi_=(size_t)seq*SEQ+(sc)*L+lane; rcolf=G.gcolf[gi_]; rcum=G.gcum[gi_]; rpm=G.gpm[gi_]; ra=G.sca[seq*64+(sc)]; rpx=G.scpm[seq*64+(sc)]; } }while(0)
  LOAD_RAW(4*c);
  ML_BAR();
  f32x4 accC[8];
  #pragma unroll
  for(int et=0;et<8;++et){ const f16x4 t4=*(const LAS f16x4*)(Cs+(16*et+fr)*RS1+16*wid+4*fq); accC[et]=(f32x4){(float)t4[0],(float)t4[1],(float)t4[2],(float)t4[3]}; }
  #pragma unroll 1
  for(int sc=4*c;sc<4*c+4;++sc){
    const int t0=sc*L;
    *(LAS f16x8*)(Qs+(2*sq)*RS1+8*eg)=rq[0]; *(LAS f16x8*)(Qs+(2*sq+1)*RS1+8*eg)=rq[1];
    *(LAS f16x8*)(Ks+(2*sq)*RS1+8*eg)=rk[0]; *(LAS f16x8*)(Ks+(2*sq+1)*RS1+8*eg)=rk[1];
    *(LAS f16x8*)(Vs+(2*sq)*RS1+8*eg)=rv[0]; *(LAS f16x8*)(Vs+(2*sq+1)*RS1+8*eg)=rv[1];
    f16x4 om[4];
    #pragma unroll
    for(int tt=0;tt<4;++tt)om[tt]=omn[tt];
    if(wid==0){
      const float mx=fmaxf(mprev,rpm);
      const float mloc=ra+rpx, mnew=fmaxf(ra+mprev,mloc), sprev=__expf(ra+mprev-mnew), wpv=__expf(ra+rcolf-mnew);
      vec[lane]=rcolf; vec[64+lane]=-mx; vec[128+lane]=__expf(mprev-mx); vec[192+lane]=__expf(-(rcum+mx)); vec[256+lane]=wpv; wph[lane]=(f16)wpv;
      if(lane==0)vec[1280]=sprev;
      mprev=mnew; }
    ML_BAR();
    if(sc<4*c+3) LOAD_RAW(sc+1);
    { const int t=tid>>3,dg=tid&7; float sv=0.f;
      const f16x8 q0=*(const LAS f16x8*)(Qs+t*RS1+16*dg),q1=*(const LAS f16x8*)(Qs+t*RS1+16*dg+8);
      #pragma unroll
      for(int j=0;j<8;++j){ sv+=(float)q0[j]*vec[1152+16*dg+j]+(float)q1[j]*vec[1152+16*dg+8+j]; }
      sv=xsum<1>(sv); sv=xsum<2>(sv); sv=xsum<4>(sv);
      if(dg==0)vec[320+t]=sv; }
    { const int sA=wid>>1;
      f16x8 ka[4];
      #pragma unroll
      for(int ks=0;ks<4;++ks)ka[ks]=*(const LAS f16x8*)(Ks+(16*sA+fr)*RS1+32*ks+8*fq);
      const f32x4 cf4=*(const LAS f32x4*)(vec+16*sA+4*fq);
      #pragma unroll
      for(int t2=0;t2<2;++t2){ const int tt=2*(wid&1)+t2; f32x4 acc={0.f,0.f,0.f,0.f};
        #pragma unroll
        for(int ks=0;ks<4;++ks){ const f16x8 qb=*(const LAS f16x8*)(Qs+(16*tt+fr)*RS1+32*ks+8*fq); acc=MF16(ka[ks],qb,acc); }
        const int t=16*tt+fr; const float rf=vec[64+t]; float p[4],rsum=0.f;
        #pragma unroll
        for(int r=0;r<4;++r){ const int sidx=16*sA+4*fq+r; p[r]=(sidx<=t)?acc[r]*__expf(rf+cf4[r]):0.f; rsum+=p[r]; }
        u32x2 w; w.x=pk2h(p[0],p[1]); w.y=pk2h(p[2],p[3]); *(LAS u32x2*)(Ps+t*RS2+16*sA+4*fq)=w;
        rsum=xsum<16>(rsum); rsum=xsum<32>(rsum);
        if(fq==0)vec[384+64*sA+t]=rsum; } }
    f32x4 accN[4];
    { f16x8 ca[4];
      #pragma unroll
      for(int ks=0;ks<4;++ks)ca[ks]=*(const LAS f16x8*)(Cs+(16*wid+fr)*RS1+32*ks+8*fq);
      #pragma unroll
      for(int tt=0;tt<4;++tt){ accN[tt]=(f32x4){0.f,0.f,0.f,0.f};
        #pragma unroll
        for(int ks=0;ks<4;++ks){ const f16x8 qb=*(const LAS f16x8*)(Qs+(16*tt+fr)*RS1+32*ks+8*fq); accN[tt]=MF16(ca[ks],qb,accN[tt]); } } }
    f16x8 vfa[2];
    #pragma unroll
    for(int ks=0;ks<2;++ks){ const LAS f16*ap=Vs+trb+32*ks*RS1+16*wid; vfa[ks]=cat8(trd(ap),trd(ap+4*RS1)); }
    ML_BAR();
    float inv[4];
    #pragma unroll
    for(int tt=0;tt<4;++tt){ const int t=16*tt+fr; const float wi=vec[128+t]; const float den=(vec[384+t]+vec[448+t])+(vec[512+t]+vec[576+t])+wi*vec[320+t]; inv[tt]=frcp(fmaxf(fabsf(den),vec[192+t]));
      accN[tt]*=wi; }
    #pragma unroll
    for(int tt=0;tt<4;++tt)
      #pragma unroll
      for(int ks=0;ks<2;++ks){ const f16x8 pb=*(const LAS f16x8*)(Ps+(16*tt+fr)*RS2+32*ks+8*fq); accN[tt]=MF16(vfa[ks],pb,accN[tt]); }
    #pragma unroll
    for(int tt=0;tt<4;++tt){ accN[tt]*=inv[tt]; float q2=(accN[tt][0]*accN[tt][0]+accN[tt][1]*accN[tt][1])+(accN[tt][2]*accN[tt][2]+accN[tt][3]*accN[tt][3]);
      q2=xsum<16>(q2); q2=xsum<32>(q2); if(fq==0)vec[640+64*wid+16*tt+fr]=q2; }
    ML_BAR();
    #pragma unroll
    for(int tt=0;tt<4;++tt){ const int t=16*tt+fr; float tot=0.f;
      #pragma unroll
      for(int w=0;w<8;++w)tot+=vec[640+64*w+t];
      const float rs=1.f/sqrtf(tot*(1.f/128.f)+EPS);
      float o[4];
      #pragma unroll
      for(int r=0;r<4;++r)o[r]=accN[tt][r]*rs*gn[r]*frcp(1.f+__expf(-(float)om[tt][r]));
      u32x2 w; w.x=pk2h(o[0],o[1]); w.y=pk2h(o[2],o[3]); *(u32x2*)(outp+(rowbase+t0+t)*DM)=w; }
    if(sc<4*c+3){ const float sprev=vec[1280];
      #pragma unroll
      for(int et=0;et<8;++et)accC[et]*=sprev;
      #pragma unroll
      for(int ks=0;ks<2;++ks){ const LAS f16*ap=Ks+trb+32*ks*RS1+16*wid; const f16x8 kfa=cat8(trd(ap),trd(ap+4*RS1)) * *(const LAS f16x8*)(wph+32*ks+8*fq);
        #pragma unroll
        for(int et=0;et<8;++et){ const LAS f16*bp=Vs+trb+32*ks*RS1+16*et; const f16x8 vfb=cat8(trd(bp),trd(bp+4*RS1)); accC[et]=MF16(kfa,vfb,accC[et]); } }
      #pragma unroll
      for(int et=0;et<8;++et){ u32x2 w; w.x=pk2h(accC[et][0],accC[et][1]); w.y=pk2h(accC[et][2],accC[et][3]); *(LAS u32x2*)(Cs+(16*et+fr)*RS1+16*wid+4*fq)=w; }
      const int d=tid>>2,sg=tid&3; float sn=0.f;
      #pragma unroll
      for(int j=0;j<16;++j)sn+=(float)Ks[(16*sg+j)*RS1+d]*vec[256+16*sg+j];
      sn=xsum<1>(sn); sn=xsum<2>(sn);
      if(sg==0)vec[1152+d]=sprev*vec[1152+d]+sn; }
    ML_BAR();
  }
  #undef LOAD_RAW
}
__device__ __forceinline__ void publish(unsigned*cnt,const bool leader){
  asm volatile("s_waitcnt vmcnt(0)":::"memory"); __syncthreads();
  if(leader) __hip_atomic_fetch_add(cnt,1u,__ATOMIC_RELAXED,__HIP_MEMORY_SCOPE_AGENT);
}
__device__ __forceinline__ void await(unsigned*cnt,const unsigned want,const bool leader){
  if(leader){ unsigned sp=0; while(__hip_atomic_load(cnt,__ATOMIC_RELAXED,__HIP_MEMORY_SCOPE_AGENT)<want){ __builtin_amdgcn_s_sleep(8); if(++sp>(1u<<22))break; }
    __builtin_amdgcn_fence(__ATOMIC_ACQUIRE,"agent"); asm volatile("s_waitcnt vmcnt(0)":::"memory"); }
  __syncthreads();
}
#undef ML_BAR
#undef MF16
}

struct Args { const void* in[22]; float* out; unsigned char* ws; };
struct Frame {
    LAS unsigned char* lds; int tid, lane, wave, vcu, G, w0; float* out; unsigned char* ws;
    __device__ __forceinline__ void fresh() { const int t = tid_of(w0); tid = t; lane = t & 63; wave = w0; }
    template <class Tp> __device__ __forceinline__ const Tp* in(int k) const { const LAS unsigned* p = (const LAS unsigned*)(lds + ARGS_OFF) + 2 * k;
        const unsigned lo = __builtin_amdgcn_readfirstlane(p[0]), hi = __builtin_amdgcn_readfirstlane(p[1]); return (const Tp*)(((unsigned long long)hi << 32) | lo); }
    __device__ __forceinline__ const float* x() const { return in<float>(0); }
    __device__ __forceinline__ const float* c() const { return in<float>(1); }
    __device__ __forceinline__ const int* positions() const { return in<int>(2); }
    __device__ __forceinline__ const float* w_ada() const { return in<float>(3); }
    __device__ __forceinline__ const float* b_ada() const { return in<float>(4); }
    __device__ __forceinline__ const float* norm1_g() const { return in<float>(5); }
    __device__ __forceinline__ const float* w_in() const { return in<float>(6); }
    __device__ __forceinline__ const float* b_gate() const { return in<float>(7); }
    __device__ __forceinline__ const float* conv_w() const { return in<float>(8); }
    __device__ __forceinline__ const float* conv_b() const { return in<float>(9); }
    __device__ __forceinline__ const float* attn_g() const { return in<float>(10); }
    __device__ __forceinline__ const float* mlstm_g() const { return in<float>(11); }
    __device__ __forceinline__ const float* w_out() const { return in<float>(12); }
    __device__ __forceinline__ const float* norm2_g() const { return in<float>(13); }
    __device__ __forceinline__ const float* w_rg() const { return in<float>(14); }
    __device__ __forceinline__ const float* b_rg() const { return in<float>(15); }
    __device__ __forceinline__ const float* w_re() const { return in<float>(16); }
    __device__ __forceinline__ const float* b_re() const { return in<float>(17); }
    __device__ __forceinline__ const float* w1() const { return in<float>(18); }
    __device__ __forceinline__ const float* w3() const { return in<float>(19); }
    __device__ __forceinline__ const float* w2() const { return in<float>(20); }
    __device__ __forceinline__ const float* normf_g() const { return in<float>(21); }
};

struct TItem { const GAS float* W; unsigned char* WT; int K, ldw, k0, n0; bool f8; };
__device__ __forceinline__ bool p0_item(const Frame& F, int it, TItem& t) {
    constexpr int I_IN = 16 * 7, I_OUT = 16 * 2, I_E13 = 16, I_E2 = 8 * 2;
    constexpr int NITEMS = I_IN + I_OUT + NEXP * (2 * I_E13 + I_E2);
    if (it >= NITEMS) return false;
    int r = it, nnb; t.f8 = false;
    if (r < I_IN) { t.W = (const GAS float*)F.w_in(); t.WT = F.ws + WS_WIN; t.K = 1024; t.ldw = NPROJ_SRC; nnb = 7; }
    else if ((r -= I_IN) < I_OUT) { t.W = (const GAS float*)F.w_out(); t.WT = F.ws + WS_WOUT; t.K = 1024; t.ldw = 1024; nnb = 2; }
    else { r -= I_OUT; const int per = 2 * I_E13 + I_E2, e = r / per; r -= e * per;
        t.f8 = MOE8; const size_t eb = MOE8 ? 1 : 2;
        if (r < I_E13) { t.W = (const GAS float*)F.w1() + (size_t)e * 1024 * 512; t.WT = F.ws + WS_W1 + (size_t)e * 512 * 1024 * eb; t.K = 1024; t.ldw = 512; nnb = 1; }
        else if ((r -= I_E13) < I_E13) { t.W = (const GAS float*)F.w3() + (size_t)e * 1024 * 512; t.WT = F.ws + WS_W3 + (size_t)e * 512 * 1024 * eb; t.K = 1024; t.ldw = 512; nnb = 1; }
        else { r -= I_E13; t.W = (const GAS float*)F.w2() + (size_t)e * 512 * 1024; t.WT = F.ws + WS_W2 + (size_t)e * 1024 * 512 * eb; t.K = 512; t.ldw = 1024; nnb = 2; } }
    t.k0 = 64 * (r / nnb); t.n0 = 512 * (r % nnb);
    return true;
}
__device__ __forceinline__ void p0_load(const TItem& t, f32x4 (&v)[16], int wave, int lane) {
    const GAS float* p = t.W + (size_t)(t.k0 + 8 * wave) * t.ldw + t.n0 + 4 * lane;
#pragma unroll
    for (int r = 0; r < 8; ++r) { v[2 * r] = *(const GAS f32x4*)(p + (size_t)r * t.ldw); v[2 * r + 1] = *(const GAS f32x4*)(p + (size_t)r * t.ldw + 256); }
}
__device__ __forceinline__ void p0_park(const TItem& t, const f32x4 (&v)[16], LAS f16* Ts, int wave, int lane) {
    const float sc = t.f8 ? W8SCALE : 1.f;
#pragma unroll
    for (int r = 0; r < 8; ++r)
#pragma unroll
        for (int j = 0; j < 2; ++j) { const f32x4 x = v[2 * r + j] * sc; LAS unsigned* q = (LAS unsigned*)(Ts + (8 * wave + r) * 514 + 4 * lane + 256 * j); q[0] = pk2h(x[0], x[1]); q[1] = pk2h(x[2], x[3]); }
}
__device__ __forceinline__ void p0_emit(const TItem& t, const LAS f16* Ts, int tid) {
    const int kc = tid & 7;
#pragma unroll
    for (int jj = 0; jj < 8; ++jj) { const int n = (tid >> 3) + 64 * jj; const LAS f16* q = Ts + (8 * kc) * 514 + n;
        if (t.f8) { const float o8[8] = {(float)q[0], (float)q[514], (float)q[2 * 514], (float)q[3 * 514], (float)q[4 * 514], (float)q[5 * 514], (float)q[6 * 514], (float)q[7 * 514]};
            *(GAS u32x2*)(t.WT + (size_t)(t.n0 + n) * t.K + t.k0 + 8 * kc) = pk8_fp8(o8); }
        else { const f16x8 o = {q[0], q[514], q[2 * 514], q[3 * 514], q[4 * 514], q[5 * 514], q[6 * 514], q[7 * 514]};
            *(GAS f16x8*)((f16*)t.WT + (size_t)(t.n0 + n) * t.K + t.k0 + 8 * kc) = o; } }
}

__device__ __forceinline__ void p0_prologue(Frame F) {
    F.fresh();
    LAS float* sc = (LAS float*)F.lds; LAS float* part = (LAS float*)(F.lds + 32768);
    float* mod = (float*)(F.ws + WS_MOD);
    if ((int)blockIdx.x < 192) {
        { const GAS float* cg = (const GAS float*)F.c(); float cv[16];
#pragma unroll
          for (int u = 0; u < 16; ++u) cv[u] = cg[F.tid + NTHR * u];
#pragma unroll
          for (int u = 0; u < 16; ++u) sc[F.tid + NTHR * u] = cv[u] / (1.f + __expf(-cv[u])); }
        __syncthreads();
        for (int jb = blockIdx.x; jb < 192; jb += F.G) {
            const int jj = F.tid & 31, kc = F.tid >> 5, j0 = jb * 32;
            float a[8];
#pragma unroll
            for (int b = 0; b < 8; ++b) a[b] = 0.f;
            const GAS float* wad = (const GAS float*)F.w_ada() + (size_t)(kc * 64) * 6144 + j0 + jj;
#pragma unroll 1
            for (int k16 = 0; k16 < 64; k16 += 16) { float w[16];
#pragma unroll
                for (int u = 0; u < 16; ++u) w[u] = wad[(size_t)(k16 + u) * 6144];
#pragma unroll
                for (int u = 0; u < 16; ++u) { const int k = kc * 64 + k16 + u;
#pragma unroll
                    for (int b = 0; b < 8; ++b) a[b] += sc[b * 1024 + k] * w[u]; } }
#pragma unroll
            for (int b = 0; b < 8; ++b) part[(kc * 8 + b) * 32 + jj] = a[b];
            __syncthreads();
            if (F.tid < 256) { const int b = F.tid >> 5; float s = ((const GAS float*)F.b_ada())[j0 + jj];
                for (int k2 = 0; k2 < 16; ++k2) s += part[(k2 * 8 + b) * 32 + jj];
                mod[(size_t)b * 6144 + j0 + jj] = s; }
            __syncthreads();
        }
    }
    __syncthreads();
    const int gw = F.vcu * NWAVES + F.wave, NGW = F.G * NWAVES;
    { f16* wg = (f16*)(F.ws + WS_WGT); f16* wr = (f16*)(F.ws + WS_WRT); const GAS float* w_in = (const GAS float*)F.w_in(); const GAS float* w_rg = (const GAS float*)F.w_rg(); const GAS float* w_re = (const GAS float*)F.w_re();
      for (int i = gw * 64 + F.lane; i < 64 * 1024; i += NGW * 64) { const int n = i >> 10, k = i & 1023;
          if (n < 16) wg[n * 1024 + k] = (f16)(n < 8 ? w_in[(size_t)k * NPROJ_SRC + NPROJ + n] : 0.f);
          else { const int m = n - 16; wr[m * 1024 + k] = (f16)(m < 4 ? w_rg[k * 4 + m] : m < 36 ? w_re[k * 32 + (m - 4)] : 0.f); } } }
}


constexpr int P0_NPROJ_ITEMS = 16 * 7 + 16 * 2;
__device__ __forceinline__ void p1_weights(Frame F) {
    F.fresh();
    LAS f16* Ts = (LAS f16*)F.lds;
    TItem cur, nxt; f32x4 va[16], vb[16];
    bool have = F.vcu < P0_NPROJ_ITEMS && p0_item(F, F.vcu, cur);
    if (have) p0_load(cur, va, F.wave, F.lane);
    for (int it = F.vcu; have; it += 2 * F.G) {
        const bool hn = it + F.G < P0_NPROJ_ITEMS && p0_item(F, it + F.G, nxt);
        if (hn) p0_load(nxt, vb, F.wave, F.lane);
        p0_park(cur, va, Ts, F.wave, F.lane); __syncthreads(); p0_emit(cur, Ts, F.tid); __syncthreads();
        if (!hn) break;
        have = it + 2 * F.G < P0_NPROJ_ITEMS && p0_item(F, it + 2 * F.G, cur);
        if (have) p0_load(cur, va, F.wave, F.lane);
        p0_park(nxt, vb, Ts, F.wave, F.lane); __syncthreads(); p0_emit(nxt, Ts, F.tid); __syncthreads();
    }
}

template <int NCT, bool SRC16, bool OUT8 = false>
__device__ __forceinline__ void modproj_tile(const void* xsrc_, const int row0, const LAS float* scl, const LAS float* sft, const f16* WT, f16* hout, f32x4 (&acc)[NCT], const int lane, const float* ssb = nullptr) {
    const int fr = lane & 15, fq = lane >> 4;
    const float* xp = (const float*)xsrc_ + (size_t)(row0 + fr) * DM + 8 * fq;
    const f16* xh = (const f16*)xsrc_ + (size_t)(row0 + fr) * 2048 + 8 * fq;
    float ss = 0.f;
    if (ssb) { const f32x4* sp = (const f32x4*)(ssb + (size_t)(row0 + fr) * 16); const f32x4 p0 = sp[0], p1 = sp[1], p2 = sp[2], p3 = sp[3];
        ss = ((p0[0] + p0[1]) + (p0[2] + p0[3])) + ((p1[0] + p1[1]) + (p1[2] + p1[3])) + ((p2[0] + p2[1]) + (p2[2] + p2[3])) + ((p3[0] + p3[1]) + (p3[2] + p3[3])); }
    else {
#pragma unroll 16
    for (int ks = 0; ks < 32; ++ks) {
        f32x4 a, c;
        if (SRC16) { const f16x8 t = *(const f16x8*)(xh + 32 * ks); a = (f32x4){(float)t[0], (float)t[1], (float)t[2], (float)t[3]}; c = (f32x4){(float)t[4], (float)t[5], (float)t[6], (float)t[7]}; }
        else { a = *(const f32x4*)(xp + 32 * ks); c = *(const f32x4*)(xp + 32 * ks + 4); }
        ss += (a[0] * a[0] + a[1] * a[1]) + (a[2] * a[2] + a[3] * a[3]) + (c[0] * c[0] + c[1] * c[1]) + (c[2] * c[2] + c[3] * c[3]); }
    ss = xsum<16>(ss); ss = xsum<32>(ss); }
    const float rstd = 1.f / sqrtf(ss * (1.f / DM) + EPS);
#pragma unroll
    for (int ct = 0; ct < NCT; ++ct) acc[ct] = (f32x4){0.f, 0.f, 0.f, 0.f};
    f16* hp = hout + (size_t)(row0 + fr) * DM + 8 * fq;
    const f16* wp = WT + (size_t)fr * DM + 8 * fq;
    constexpr int PF = 8;
    f32x4 ba[PF], bc[PF]; f16x8 bh[PF];
#define MP_LOAD(slot, ks) do { if (SRC16) bh[slot] = *(const f16x8*)(xh + 32 * (ks)); else { ba[slot] = *(const f32x4*)(xp + 32 * (ks)); bc[slot] = *(const f32x4*)(xp + 32 * (ks) + 4); } } while (0)
#pragma unroll
    for (int u = 0; u < PF; ++u) MP_LOAD(u, u);
#pragma unroll 1
    for (int k8 = 0; k8 < 32; k8 += PF) {
        f16x8 bf[PF][NCT];
#pragma unroll
        for (int u = 0; u < PF; ++u)
#pragma unroll
            for (int ct = 0; ct < NCT; ++ct) bf[u][ct] = *(const f16x8*)(wp + (size_t)ct * 16 * DM + 32 * (k8 + u));
#pragma unroll
        for (int u = 0; u < PF; ++u) { const int ks = k8 + u, k0 = 32 * ks + 8 * fq;
            f32x4 a, c;
            if (SRC16) { const f16x8 t = bh[u]; a = (f32x4){(float)t[0], (float)t[1], (float)t[2], (float)t[3]}; c = (f32x4){(float)t[4], (float)t[5], (float)t[6], (float)t[7]}; }
            else { a = ba[u]; c = bc[u]; }
            if (k8 + PF < 32) MP_LOAD(u, ks + PF);
            const f32x4 s0 = *(const LAS f32x4*)(scl + k0), s1 = *(const LAS f32x4*)(scl + k0 + 4), h0 = *(const LAS f32x4*)(sft + k0), h1 = *(const LAS f32x4*)(sft + k0 + 4);
            const f32x4 y0 = a * rstd * s0 + h0, y1 = c * rstd * s1 + h1;
            const f16x8 af = {(f16)y0[0], (f16)y0[1], (f16)y0[2], (f16)y0[3], (f16)y1[0], (f16)y1[1], (f16)y1[2], (f16)y1[3]};
            if (OUT8) { const float o8[8] = {y0[0], y0[1], y0[2], y0[3], y1[0], y1[1], y1[2], y1[3]}; *(u32x2*)((unsigned char*)hout + (size_t)(row0 + fr) * DM + 8 * fq + 32 * ks) = pk8_fp8(o8); }
            else *(f16x8*)(hp + 32 * ks) = af;
#pragma unroll
            for (int ct = 0; ct < NCT; ++ct) acc[ct] = __builtin_amdgcn_mfma_f32_16x16x32_f16(af, bf[u][ct], acc[ct], 0, 0, 0);
        }
    }
#undef MP_LOAD
}
__device__ __forceinline__ void stage_mod(LAS float* dst, const float* g, const float* sh, const float* sc, int tid) {
    for (int i = tid; i < 256; i += NTHR) { const f32x4 gv = *(const f32x4*)(g + 4 * i), sv = *(const f32x4*)(sc + 4 * i), hv = *(const f32x4*)(sh + 4 * i);
        *(LAS f32x4*)(dst + 4 * i) = gv * (sv + 1.f); *(LAS f32x4*)(dst + 1024 + 4 * i) = hv; }
}

__device__ __forceinline__ void p1_rows(Frame F) {
    F.fresh();
    const float* mod = (const float*)(F.ws + WS_MOD);
    f16* hbuf = (f16*)(F.ws + WS_A); float* gates = (float*)(F.ws + WS_GATES);
    float* cosT = (float*)(F.ws + WS_COS); float* sinT = (float*)(F.ws + WS_SIN);
    const float* x = F.x(); const float* g1n = F.norm1_g(); const float* bg = F.b_gate(); const int* pos = F.positions();
    const f16* WT = (const f16*)(F.ws + WS_WGT);
    const int lane = F.lane, w = F.wave, fr = lane & 15, fq = lane >> 4;
    constexpr int RSX = 1032;
    LAS f16* Xs = (LAS f16*)F.lds; LAS float* part = (LAS float*)(F.lds + 66048); LAS float* rsv = part + 1024; LAS float* smod = (LAS float*)(F.lds + 73728);
    int sb = -1;
    const int NT32 = T / 32;
    f32x4 rx[4][4];
#define P1_LOAD(t) do { _Pragma("unroll") for (int r = 0; r < 4; ++r) { const GAS f32x4* xr = (const GAS f32x4*)(x + (size_t)((t) * 32 + 4 * w + r) * DM) + lane; \
        _Pragma("unroll") for (int j = 0; j < 4; ++j) rx[r][j] = xr[64 * j]; } } while (0)
    int tile = F.vcu;
    if (tile < NT32) P1_LOAD(tile);
    for (; tile < NT32; tile += F.G) {
        const int row0 = tile * 32, b = row0 / SEQ;
        if (b != sb) { __syncthreads(); stage_mod(smod, g1n, mod + (size_t)b * 6144, mod + (size_t)b * 6144 + 1024, F.tid); sb = b; }
#pragma unroll
        for (int r = 0; r < 4; ++r) { float ss = 0.f;
#pragma unroll
            for (int j = 0; j < 4; ++j) { const f32x4 v = rx[r][j]; ss += (v.x * v.x + v.y * v.y) + (v.z * v.z + v.w * v.w);
                u32x2 pk; pk.x = pk2h(v.x, v.y); pk.y = pk2h(v.z, v.w); *(LAS u32x2*)(Xs + (4 * w + r) * RSX + 4 * lane + 256 * j) = pk; }
            ss = wave_sum(ss);
            if (lane == 0) rsv[4 * w + r] = 1.f / sqrtf(ss * (1.f / DM) + EPS); }
        __syncthreads();
        if (tile + F.G < NT32) P1_LOAD(tile + F.G);
        { const int rt = w >> 2, kq = w & 3, row = 16 * rt + fr; const float rs = rsv[row];
          f32x4 acc = {0.f, 0.f, 0.f, 0.f};
          f16* hp = hbuf + (size_t)(row0 + row) * DM + 8 * fq;
#pragma unroll
          for (int u = 0; u < 8; ++u) { const int ks = 8 * kq + u, k0 = 32 * ks + 8 * fq;
              const f16x8 xv = *(const LAS f16x8*)(Xs + row * RSX + k0);
              const f32x4 s0 = *(const LAS f32x4*)(smod + k0), s1 = *(const LAS f32x4*)(smod + k0 + 4), h0 = *(const LAS f32x4*)(smod + 1024 + k0), h1 = *(const LAS f32x4*)(smod + 1024 + k0 + 4);
              const f32x4 a = {(float)xv[0], (float)xv[1], (float)xv[2], (float)xv[3]}, c = {(float)xv[4], (float)xv[5], (float)xv[6], (float)xv[7]};
              const f32x4 y0 = a * rs * s0 + h0, y1 = c * rs * s1 + h1;
              const f16x8 af = {(f16)y0[0], (f16)y0[1], (f16)y0[2], (f16)y0[3], (f16)y1[0], (f16)y1[1], (f16)y1[2], (f16)y1[3]};
              *(f16x8*)(hp + 32 * ks) = af;
              const f16x8 bf = *(const f16x8*)(WT + (size_t)fr * DM + 32 * ks + 8 * fq);
              acc = __builtin_amdgcn_mfma_f32_16x16x32_f16(af, bf, acc, 0, 0, 0); }
          if (fr < 8) {
#pragma unroll
              for (int r = 0; r < 4; ++r) part[(w * 16 + 4 * fq + r) * 8 + fr] = acc[r]; } }
        __syncthreads();
        if (F.tid < 256) { const int r = F.tid >> 3, q = F.tid & 7, rt = r >> 4, rr = r & 15;
            float g = bg[q];
#pragma unroll
            for (int kq = 0; kq < 4; ++kq) g += part[((4 * rt + kq) * 16 + rr) * 8 + q];
            gates[(size_t)(row0 + r) * 8 + q] = g; }
#pragma unroll
        for (int i = 0; i < 2; ++i) { const int idx = F.tid + NTHR * i, r = idx >> 5, f = idx & 31;
            const float invf = exp2f(-(float)f * (13.287712379549449f / 32.f)); const float ang = (float)pos[row0 + r] * invf;
            cosT[(size_t)(row0 + r) * 32 + f] = cosf(ang); sinT[(size_t)(row0 + r) * 32 + f] = sinf(ang); }
        __syncthreads();
    }
#undef P1_LOAD
}

#if defined(PROBE_K) && PROBE_K == 33
#define ML_REP 2
#else
#define ML_REP 1
#endif
#if defined(PROBE_K) && PROBE_K == 34
#define AT_REP 2
#else
#define AT_REP 1
#endif
constexpr int CW_Q = 12288;
constexpr int CW_DEPA = 16384, CW_DEPB = 20480, CW_DEPC = 49152;
constexpr int CW_ASEL = 57344, CW_APART = 58368, CW_ACNT = 62464;
constexpr size_t WS_ALIST = 77 * MiB;
constexpr size_t WS_ALSE = 45 * MiB;
static_assert(MOE8, "the attention side buffers use the gaps the fp8 expert images leave in the weight map");
constexpr int ATAB_OFF = 131072;
constexpr int QSPLIT = 8;
constexpr int P3_GB = 260;
__device__ __forceinline__ void p3_mixers(Frame F) {
    F.fresh();
    const int q = blockIdx.x & 7;
    int tk = 0;
    if (F.tid == 0) tk = (int)__hip_atomic_fetch_add((unsigned*)(F.ws + WS_CTL) + CW_Q + 64 * q, 1u, RLX_AGENT);
    bool have_tab = false; int Nx = 0;
    bool own_ready = false;
    unsigned* pend = nullptr;
#define P3_FLUSH() do { if (pend != nullptr) { mlstm::publish(pend, F.tid == 0); pend = nullptr; } } while (0)
    for (;;) {
        F.fresh();
        unsigned char* wsl = F.ws; asm volatile("" : "+s"(wsl));
        LAS unsigned char* ldl = F.lds; asm volatile("" : "+s"(ldl));
        float* outl = F.out; asm volatile("" : "+s"(outl));
        const f16* proj = (const f16*)(wsl + WS_PROJ); const float* ksum = (const float*)(wsl + WS_CTL + CTL_KMEAN); f16* mix = (f16*)(wsl + WS_A);
        unsigned* ctl = (unsigned*)(wsl + WS_CTL);
        LAS int* slot = (LAS int*)(ldl + TAB_OFF + 512);
        LAS int* at = (LAS int*)(ldl + ATAB_OFF);
        int* alist = (int*)(wsl + WS_ALIST); f16* part = (f16*)outl; float* lseb = (float*)(wsl + WS_ALSE);
        float* mls = (float*)(wsl + WS_MLS);
        const mlstm::Glob G{(f16*)(wsl + WS_CLOC), (f16*)(wsl + WS_CPREV), mls, mls + 65536, mls + 131072, mls + 131584, mls + 132096,
                            (f16*)(wsl + WS_QKC), mls + 132608, mls + 132608 + 131072, (float*)(wsl + WS_GPM), mls + 132608 + 262144, mls + 132608 + 262144 + 2048};
        if (F.tid == 0) *slot = tk;
        __syncthreads();
        const int it = *slot;
        __syncthreads();
        if (it >= P3_GB && !have_tab) {
            P3_FLUSH();
            mlstm::await(ctl + CW_ASEL + 64 * q, 64u, F.tid == 0);
            if (F.tid < 120) { const int h = F.tid / 15, n = F.tid % 15; at[128 + F.tid] = (int)__hip_atomic_load(ctl + CW_ACNT + (8 * q + h) * 16 + n, RLX_AGENT); }
            __syncthreads();
            if (F.tid == 0) { int p = 0;
#pragma unroll 1
                for (int k = 0; k < 120; ++k) { at[k] = p; p += (at[128 + k] + 1023) >> 10; } at[120] = p; }
            __syncthreads();
            Nx = at[120]; have_tab = true;
        }
        if (have_tab && it >= P3_GB + Nx + 128) { P3_FLUSH(); break; }
#if defined(PROBE_K) && PROBE_K >= 50
        if (F.tid == 0) { LAS unsigned long long* st_ = (LAS unsigned long long*)(ldl + TAB_OFF + 768); const unsigned long long t_ = __builtin_amdgcn_s_memrealtime();
            if (it >= 196 && st_[2] == 0ull) st_[2] = t_;
            if (it >= P3_GB && st_[3] == 0ull) st_[3] = t_;
            if (have_tab && it >= P3_GB + Nx + 64 && st_[4] == 0ull) st_[4] = t_; }
#endif
        if (F.tid == 0) tk = (int)__hip_atomic_fetch_add(ctl + CW_Q + 64 * q, 1u, RLX_AGENT);
        if (it < 64) { const int h = it >> 3, qb = QSPLIT + (it & 7);
            moba::sel_list(q, h, qb, proj + C_QA, ksum, alist, ctl + CW_ACNT, (char*)ldl, F.w0, pend);
            pend = ctl + CW_ASEL + 64 * q; }
        else if (it < 128) { const int j = it - 64;
            P3_FLUSH();
            mlstm::prep(q, j, G, proj, (const float*)(wsl + WS_GATES), F.conv_w(), F.conv_b(), F.w0);
            mlstm::publish(ctl + CW_DEPC + 64 * (q * 16 + (j >> 2)), F.tid == 0); }
        else if (it < 192) { const int j = it - 128, hm = j >> 4, c = j & 15;
            P3_FLUSH();
            mlstm::await(ctl + CW_DEPC + 64 * (q * 16 + c), 4u, F.tid == 0);
            for (int rep = 0; rep < ML_REP; ++rep) mlstm::contrib(q, hm, c, G, proj, ldl, F.w0);
            mlstm::publish(ctl + CW_DEPA + 64 * (q * 4 + hm), F.tid == 0); }
        else if (it < 196) { const int seq = q * 4 + (it - 192);
            P3_FLUSH();
            mlstm::await(ctl + CW_DEPA + 64 * seq, 16u, F.tid == 0);
            for (int rep = 0; rep < ML_REP; ++rep) mlstm::scan(seq, G, F.w0);
            mlstm::publish(ctl + CW_DEPB + 64 * seq, F.tid == 0); }
        else if (it < 260) { const int j = it - 196, qb = QSPLIT - 1 - (j >> 3), h = j & 7;
            P3_FLUSH();
            mobad::sel_unit(q, h, qb, proj + C_QA, ksum, (char*)ldl, F.w0);
            mobad::attn_unit<8>(q, h, qb, proj + C_QA, proj + C_KA, proj + C_VA, mix, ksum, F.attn_g(), (char*)ldl, F.w0); }
        else if (it < P3_GB + Nx) { const int g = it - P3_GB;
            if (F.tid < 120 && at[F.tid] <= g && g < at[F.tid + 1]) at[124] = F.tid;
            __syncthreads();
            const int k = at[124], h = k / 15, n = k % 15, r0 = (g - at[k]) * 1024, cnt = at[128 + k], r1 = cnt < r0 + 1024 ? cnt : r0 + 1024;
            moba::attn_pass<8, 1>(q, h, n, r0, r1, 0, alist, proj + C_QA, proj + C_KA, proj + C_VA, mix, part, lseb, F.attn_g(), (char*)ldl, F.w0, pend);
            pend = ctl + CW_APART + 64 * (8 * q + h); }
        else if (it < P3_GB + Nx + 64) { const int j = it - (P3_GB + Nx), hm = j >> 4, c = j & 15;
            P3_FLUSH();
            mlstm::await(ctl + CW_DEPB + 64 * (q * 4 + hm), 1u, F.tid == 0);
            for (int rep = 0; rep < ML_REP; ++rep) mlstm::unit(q, hm, c, G, proj, F.mlstm_g(), mix, ldl, F.w0); }
        else { const int j = it - (P3_GB + Nx + 64), qb = 15 - (j >> 3), h = j & 7, npk = 3;
            P3_FLUSH();
            if (!own_ready) {
                if (F.tid < 8) { const unsigned want = (unsigned)(at[15 * F.tid + 15] - at[15 * F.tid]); unsigned sp = 0;
                    while (__hip_atomic_load(ctl + CW_APART + 64 * (8 * q + F.tid), RLX_AGENT) < want) { __builtin_amdgcn_s_sleep(8); if (++sp > (1u << 22)) break; } }
                if (F.tid < 64) { __builtin_amdgcn_fence(__ATOMIC_ACQUIRE, "agent"); asm volatile("s_waitcnt vmcnt(0)" ::: "memory"); }
                __syncthreads(); own_ready = true; }
            moba::attn_pass<8, 0>(q, h, qb, 0, 0, npk, alist, proj + C_QA, proj + C_KA, proj + C_VA, mix, part, lseb, F.attn_g(), (char*)ldl, F.w0, nullptr); }
    }
}

__device__ __forceinline__ void p3_weights(Frame F) {
    F.fresh();
    unsigned* cq = (unsigned*)(F.ws + WS_CTL) + CW_Q + 64 * 8;
    LAS int* slot = (LAS int*)(F.lds + TAB_OFF + 512);
    LAS f16* Ts = (LAS f16*)F.lds;
    int tk = 0;
    if (F.tid == 0) tk = (int)__hip_atomic_fetch_add(cq, 1u, RLX_AGENT);
    for (;;) {
        if (F.tid == 0) *slot = tk;
        __syncthreads();
        const int it = *slot;
        __syncthreads();
        if (it >= 768) break;
        if (F.tid == 0) tk = (int)__hip_atomic_fetch_add(cq, 1u, RLX_AGENT);
        const int i0 = P0_NPROJ_ITEMS + 2 * it;
        TItem ca, cb; f32x4 va[16], vb[16];
        p0_item(F, i0, ca); p0_item(F, i0 + 1, cb);
        p0_load(ca, va, F.wave, F.lane); p0_load(cb, vb, F.wave, F.lane);
        p0_park(ca, va, Ts, F.wave, F.lane); __syncthreads(); p0_emit(ca, Ts, F.tid); __syncthreads();
        p0_park(cb, vb, Ts, F.wave, F.lane); __syncthreads(); p0_emit(cb, Ts, F.tid); __syncthreads();
    }
}

__device__ __forceinline__ void p5_route(Frame F) {
    F.fresh();
    const int gw = F.vcu * NWAVES + F.wave, NGW = F.G * NWAVES;
    const float* mod = (const float*)(F.ws + WS_MOD);
    f16* h2 = (f16*)(F.ws + WS_H2); int* list = (int*)(F.ws + WS_LIST); int* pos2 = (int*)(F.ws + WS_POS);
    unsigned* cnt = (unsigned*)(F.ws + WS_CTL) + CW_CNT;
    LAS int* hist = (LAS int*)F.lds; LAS int* rec = (LAS int*)(F.lds + 1024);
    LAS float* lgs = (LAS float*)(F.lds + 16384) + F.wave * 16 * 49;
    const float* g2n = F.norm2_g(); const float* brg = F.b_rg(); const float* bre = F.b_re();
    const int fr = F.lane & 15, fq = F.lane >> 4;
    if (F.tid < 64) hist[F.tid] = 0;
    __syncthreads();
    int nloc = 0;
    LAS float* smod = (LAS float*)(F.lds + 65536); int sb = -1;
    for (int tile0 = F.vcu * NWAVES; tile0 < T / 16; tile0 += NGW) {
        const int tile = tile0 + F.wave, row0 = tile * 16, b = (tile0 * 16) / SEQ;
        if (b != sb) { __syncthreads(); stage_mod(smod, g2n, mod + (size_t)b * 6144 + 3072, mod + (size_t)b * 6144 + 4096, F.tid); __syncthreads(); sb = b; }
        f32x4 acc[3];
        modproj_tile<3, true, MOE8>(F.out, row0, smod, smod + 1024, (const f16*)(F.ws + WS_WRT), h2, acc, F.lane, (const float*)(F.ws + WS_MLS));
#pragma unroll
        for (int ct = 0; ct < 3; ++ct)
#pragma unroll
            for (int r = 0; r < 4; ++r) lgs[(4 * fq + r) * 49 + 16 * ct + fr] = acc[ct][r];
        LDS_WAIT(); asm volatile("" ::: "memory");
        if (F.lane < 16) {
            const int row = row0 + F.lane; const LAS float* lg = lgs + F.lane * 49;
            float gl[4];
#pragma unroll
            for (int q = 0; q < 4; ++q) gl[q] = lg[q] + brg[q];
            int gi = 0; float gm = gl[0];
#pragma unroll
            for (int q = 1; q < 4; ++q) if (gl[q] > gm) { gm = gl[q]; gi = q; }
            float gsum = 0.f;
#pragma unroll
            for (int q = 0; q < 4; ++q) gsum += __expf(gl[q] - gm);
            const float pg = 1.f / gsum;
            float el[8];
#pragma unroll
            for (int q = 0; q < 8; ++q) el[q] = lg[4 + 8 * gi + q] + bre[gi * 8 + q];
            int i1 = 0; float m1 = el[0];
#pragma unroll
            for (int q = 1; q < 8; ++q) if (el[q] > m1) { m1 = el[q]; i1 = q; }
            int i2 = -1; float m2 = -INFINITY;
#pragma unroll
            for (int q = 0; q < 8; ++q) if (q != i1 && el[q] > m2) { m2 = el[q]; i2 = q; }
            const float rr = __expf(m2 - m1), w1 = pg / (1.f + rr), w2 = pg * rr / (1.f + rr);
#pragma unroll
            for (int k = 0; k < 2; ++k) { const int e = gi * 8 + (k == 0 ? i1 : i2); const float w = k == 0 ? w1 : w2;
                const int rank = (int)__hip_atomic_fetch_add((LAS unsigned*)hist + e, 1u, __ATOMIC_RELAXED, __HIP_MEMORY_SCOPE_WORKGROUP);
                LAS int* rp = rec + (F.wave * 64 + 32 * nloc + 2 * F.lane + k) * 4; rp[0] = row; rp[1] = e; rp[2] = rank; rp[3] = __float_as_int(w); }
        }
        ++nloc;
        LDS_WAIT(); asm volatile("" ::: "memory");
    }
    __syncthreads();
    if (F.tid < 32) hist[32 + F.tid] = (int)atomicAdd(cnt + 64 * F.tid, (unsigned)hist[F.tid]);
    __syncthreads();
    for (int i = F.lane; i < 32 * nloc; i += 64) { const LAS int* rp = rec + (F.wave * 64 + i) * 4; const int row = rp[0], e = rp[1], slot = hist[32 + e] + rp[2];
        list[2 * ((size_t)e * LISTCAP + slot)] = row; list[2 * ((size_t)e * LISTCAP + slot) + 1] = rp[3];
        pos2[2 * row + (i & 1)] = e * LISTCAP + slot; }
}

__device__ __forceinline__ void moe_tables(Frame F) {
    F.fresh();
    LAS int* tab = (LAS int*)(F.lds + TAB_OFF);
    const unsigned* cnt = (const unsigned*)(F.ws + WS_CTL) + CW_CNT;
    __syncthreads();
    if (F.tid < 32) tab[80 + F.tid] = (int)__hip_atomic_load(cnt + 64 * F.tid, RLX_AGENT);
    __syncthreads();
    if (F.tid == 0) { int up = 0, rp = 0;
        for (int e = 0; e < 32; ++e) { const int c = tab[80 + e]; tab[e] = up; tab[40 + e] = rp; up += ((c + 255) >> 8) * 4; rp += c; }
        tab[32] = up; tab[72] = rp; }
    __syncthreads();
}

struct P8Row { unsigned ya[4], yb[4]; f16x4 xh[4]; };
__device__ __forceinline__ void p8_load(P8Row& R, const unsigned char* Y, const f16* x1h, const LAS int* tab, int row, int p0, int p1, int lane) {
    const size_t y0 = (size_t)(tab[40 + (p0 >> 15)] + (p0 & 32767)) * DM, y1 = (size_t)(tab[40 + (p1 >> 15)] + (p1 & 32767)) * DM;
#pragma unroll
    for (int j = 0; j < 4; ++j) { const int k0 = 4 * lane + 256 * j; R.ya[j] = *(const unsigned*)(Y + y0 + k0); R.yb[j] = *(const unsigned*)(Y + y1 + k0); R.xh[j] = *(const f16x4*)(x1h + (size_t)row * 2048 + k0); }
}
__device__ __forceinline__ void p8_row(const P8Row& R, float* out, const float* g2, const float* gf, int row, int lane) {
    f32x4 v[4]; float ss = 0.f;
#pragma unroll
    for (int j = 0; j < 4; ++j) { const int k0 = 4 * lane + 256 * j; const f32x4 g = *(const f32x4*)(g2 + k0);
        const auto a01 = __builtin_amdgcn_cvt_pk_f32_fp8((int)R.ya[j], false), a23 = __builtin_amdgcn_cvt_pk_f32_fp8((int)R.ya[j], true), b01 = __builtin_amdgcn_cvt_pk_f32_fp8((int)R.yb[j], false), b23 = __builtin_amdgcn_cvt_pk_f32_fp8((int)R.yb[j], true);
        f32x4 sv; sv.x = a01[0] + b01[0]; sv.y = a01[1] + b01[1]; sv.z = a23[0] + b23[0]; sv.w = a23[1] + b23[1];
        v[j] = (f32x4){(float)R.xh[j][0], (float)R.xh[j][1], (float)R.xh[j][2], (float)R.xh[j][3]} + g * sv; ss += (v[j].x * v[j].x + v[j].y * v[j].y) + (v[j].z * v[j].z + v[j].w * v[j].w); }
    const float rstd = 1.f / sqrtf(wave_sum(ss) * (1.f / DM) + EPS);
    GAS f32x4* xr = (GAS f32x4*)(out + (size_t)row * DM) + lane;
#pragma unroll
    for (int j = 0; j < 4; ++j) { const int k0 = 4 * lane + 256 * j; xr[64 * j] = v[j] * rstd * *(const f32x4*)(gf + k0); }
}
__device__ __forceinline__ void p8_final(Frame F) {
    F.fresh();
    const int gw = F.vcu * NWAVES + F.wave, NGW = F.G * NWAVES;
    const float* mod = (const float*)(F.ws + WS_MOD); const unsigned char* Y = (const unsigned char*)(F.ws + WS_Y); const int* pos2 = (const int*)(F.ws + WS_POS);
    const LAS int* tab = (const LAS int*)(F.lds + TAB_OFF);
    const float* gf = F.normf_g(); const f16* x1h = (const f16*)F.out;
    const int RPW = (T + NGW - 1) / NGW, r0 = gw * RPW, r1 = min(T, r0 + RPW);
    if (r0 >= r1) return;
    P8Row A, B;
    int pa0 = pos2[2 * r0], pa1 = pos2[2 * r0 + 1], pb0 = 0, pb1 = 0;
    if (r0 + 1 < r1) { pb0 = pos2[2 * r0 + 2]; pb1 = pos2[2 * r0 + 3]; }
    p8_load(A, Y, x1h, tab, r0, pa0, pa1, F.lane);
    for (int row = r0; row < r1; row += 2) {
        const bool hb = row + 1 < r1;
        if (hb) p8_load(B, Y, x1h, tab, row + 1, pb0, pb1, F.lane);
        if (row + 2 < r1) { pa0 = pos2[2 * row + 4]; pa1 = pos2[2 * row + 5]; }
        p8_row(A, F.out, mod + (size_t)(row / SEQ) * 6144 + 5120, gf, row, F.lane);
        if (!hb) break;
        if (row + 2 < r1) p8_load(A, Y, x1h, tab, row + 2, pa0, pa1, F.lane);
        if (row + 3 < r1) { pb0 = pos2[2 * row + 6]; pb1 = pos2[2 * row + 7]; }
        p8_row(B, F.out, mod + (size_t)((row + 1) / SEQ) * 6144 + 5120, gf, row + 1, F.lane);
    }
}

#ifdef PROBE_K
#define PROBE_PH ((PROBE_K == 33 || PROBE_K == 34 || (PROBE_K >= 50 && PROBE_K <= 53)) ? 3 : (PROBE_K == 40) ? 100 : (PROBE_K == 41) ? 101 : PROBE_K)
#define PSTAMP(k) do { if ((k) == PROBE_PH || (k) == PROBE_PH + 1) { const unsigned long long t_ = __builtin_amdgcn_s_memrealtime(); if (F.tid == 0) ((LAS unsigned long long*)(F.lds + TAB_OFF + 768))[(k) - PROBE_PH] = t_; } } while (0)
#else
#define PSTAMP(k) do {} while (0)
#endif
__global__ void __launch_bounds__(NTHR, 2) fwd_kernel(Args args) {
    extern __shared__ __attribute__((aligned(16))) unsigned char lds_raw[];
    Frame F;
    F.lds = (LAS unsigned char*)lds_raw;
    F.w0 = __builtin_amdgcn_readfirstlane((int)threadIdx.x >> 6); F.fresh();
    F.G = gridDim.x; { const int bx = blockIdx.x; F.vcu = (F.G % 8 == 0) ? (bx % 8) * (F.G / 8) + bx / 8 : bx; }
    F.out = args.out; F.ws = args.ws;
    for (int u = F.tid; u < (LDS_BYTES - LDSCTL_OFF) / 4; u += NTHR) ((LAS unsigned*)(F.lds + LDSCTL_OFF))[u] = 0u;
    __syncthreads();
    if (F.tid < 44) ((LAS unsigned*)(F.lds + ARGS_OFF))[F.tid] = ((const __attribute__((address_space(4))) unsigned*)__builtin_amdgcn_kernarg_segment_ptr())[F.tid];
    __syncthreads();
    unsigned* ctl = (unsigned*)(F.ws + WS_CTL);
    XcdBarrier bar = xcd_barrier_post(ctl + CW_BAR, (volatile LAS unsigned*)(F.lds + MISC_OFF) + 8, F.tid == 0);

    PSTAMP(0);
    PSTAMP(100);
    p0_prologue(F);
    __syncthreads();
    PSTAMP(101);
    p1_weights(F);
    PSTAMP(102);
    xcd_barrier(bar, F.w0);
    PSTAMP(1);
    p1_rows(F);
    xcd_barrier(bar, F.w0);
    PSTAMP(2);
    { pg8::DenseSched S; S.init(T, NPROJ, 1024, F.G, (int)blockIdx.x, true);
      pg8::EpiProj E{(f16*)(F.ws + WS_PROJ), (const float*)(F.ws + WS_COS), (const float*)(F.ws + WS_SIN), (float*)(F.ws + WS_CTL + CTL_KMEAN)};
      pg8::gemm_phase<true, false>(F.lds, (const char*)(F.ws + WS_A), (const char*)(F.ws + WS_WIN), 1024, S, E, F.w0); }
    xcd_barrier(bar, F.w0);
    PSTAMP(3);
    p3_mixers(F);
    p3_weights(F);
    xcd_barrier(bar, F.w0);
    PSTAMP(4);
    { pg8::DenseSched S; S.init(T, DM, 1024, F.G, (int)blockIdx.x, false);
      pg8::EpiOut E{F.x(), (const float*)(F.ws + WS_MOD), (f16*)F.out, (float*)(F.ws + WS_MLS)};
      pg8::gemm_phase<false, false>(F.lds, (const char*)(F.ws + WS_A), (const char*)(F.ws + WS_WOUT), 1024, S, E, F.w0); }
    xcd_barrier(bar, F.w0);
    PSTAMP(5);
    p5_route(F);
    xcd_barrier(bar, F.w0);
    PSTAMP(6);
    moe_tables(F);
    { pg8::MoeSched S{(const LAS int*)(F.lds + TAB_OFF), F.G, F.vcu, 1024, true, (const int*)(F.ws + WS_LIST), (unsigned*)(F.ws + WS_CTL) + CW_MT};
      pg8::EpiMoe1 E{(unsigned char*)(F.ws + WS_HID)};
      pg8::gemm_phase<false, MOE8>(F.lds, (const char*)(F.ws + WS_H2), (const char*)(F.ws + WS_W1), 1024, S, E, F.w0); }
    PSTAMP(7);
    { pg8::MoeSched S{(const LAS int*)(F.lds + TAB_OFF), F.G, F.G - 1 - F.vcu, 512, false, (const int*)(F.ws + WS_LIST), (unsigned*)(F.ws + WS_CTL) + CW_MT};
      pg8::EpiMoe2 E{(unsigned char*)(F.ws + WS_Y), (const int*)(F.ws + WS_LIST)};
      pg8::gemm_phase<false, MOE8>(F.lds, (const char*)(F.ws + WS_HID), (const char*)(F.ws + WS_W2), 512, S, E, F.w0); }
    xcd_barrier(bar, F.w0);
    PSTAMP(8);
    p8_final(F);
#ifdef PROBE_K
    __syncthreads(); PSTAMP(9); __syncthreads();
    if (blockIdx.x == 0) { unsigned long long tp0 = ((LAS unsigned long long*)(F.lds + TAB_OFF + 768))[0], tp1 = ((LAS unsigned long long*)(F.lds + TAB_OFF + 768))[1];
#if PROBE_K >= 50
        { const LAS unsigned long long* st_ = (const LAS unsigned long long*)(F.lds + TAB_OFF + 768);
          const unsigned long long a_ = PROBE_K == 50 ? st_[0] : st_[PROBE_K - 49], b_ = PROBE_K == 53 ? st_[1] : st_[PROBE_K - 48]; tp0 = a_; tp1 = b_; }
#endif
 const unsigned long long te = __builtin_amdgcn_s_memrealtime(); while (__builtin_amdgcn_s_memrealtime() - te < 8ull * (tp1 - tp0)) __builtin_amdgcn_s_sleep(20); }
#endif
}

extern "C" void kernel_launch(void* const* d_in, const int* in_sizes, int n_in, void* d_out, int out_size, void* d_ws, size_t ws_size, hipStream_t stream) {
    static int grid = 0;
    if (grid == 0) {
        if (n_in != 22 || out_size != T * DM || ws_size < WS_END) { fprintf(stderr, "kernel_launch: unexpected problem (n_in %d, out %d, ws %zu)\n", n_in, out_size, ws_size); grid = -1; return; }
        int dev = 0, cus = 0, per_cu = 0;
        if (hipGetDevice(&dev) != hipSuccess || hipDeviceGetAttribute(&cus, hipDeviceAttributeMultiprocessorCount, dev) != hipSuccess) { grid = -1; return; }
        if (hipFuncSetAttribute((const void*)fwd_kernel, hipFuncAttributeMaxDynamicSharedMemorySize, LDS_BYTES) != hipSuccess) { fprintf(stderr, "kernel_launch: hipFuncSetAttribute failed\n"); grid = -1; return; }
        if (hipOccupancyMaxActiveBlocksPerMultiprocessor(&per_cu, (const void*)fwd_kernel, NTHR, LDS_BYTES) != hipSuccess || per_cu < 1) fprintf(stderr, "kernel_launch: occupancy query says %d\n", per_cu);
        (void)hipGetLastError();
        grid = cus;
    }
    if (grid < 0) return;
    (void)hipMemsetAsync((char*)d_ws + WS_CTL, 0, CTL_ZERO_BYTES, stream);
    Args a{};
    for (int i = 0; i < 22; ++i) a.in[i] = d_in[i];
    a.out = (float*)d_out; a.ws = (unsigned char*)d_ws;
    hipLaunchKernelGGL(fwd_kernel, dim3(grid), dim3(NTHR), LDS_BYTES, stream, a);
}
```

```cpp
#include <hip/hip_runtime.h>
#include <cstdio>
#include <cstdint>
#include <cmath>

#define LAS __attribute__((address_space(3)))
#define GAS __attribute__((address_space(1)))
typedef _Float16 f16;
typedef _Float16 f16x8 __attribute__((ext_vector_type(8)));
typedef _Float16 f16x4 __attribute__((ext_vector_type(4)));
typedef _Float16 f16x2 __attribute__((ext_vector_type(2)));
typedef float f32x4 __attribute__((ext_vector_type(4)));
typedef float f32x2 __attribute__((ext_vector_type(2)));
typedef unsigned u32x4 __attribute__((ext_vector_type(4)));
typedef unsigned u32x2 __attribute__((ext_vector_type(2)));

constexpr int NB = 8, SEQ = 4096, DM = 1024, T = NB * SEQ;
constexpr int NPROJ = 3584, NPROJ_SRC = 3592;
constexpr int C_QA = 0, C_KA = 512, C_VA = 1024, C_QM = 1536, C_KM = 2048, C_VM = 2560, C_OM = 3072;
constexpr int NEXP = 32, DEXP = 512, LISTCAP = 32768;
constexpr float EPS = 1e-6f;
constexpr float C2 = 0.125f * 1.4426950408889634f;
constexpr int NWAVES = 8, NTHR = 512;

constexpr size_t MiB = 1u << 20;
constexpr size_t WS_CTL = 0, CTL_ZERO_BYTES = 1 * MiB;
constexpr int CW_BAR = 4096;
constexpr int CW_MT = 28672;
constexpr int CW_CNT = 8192;
constexpr size_t CTL_KMEAN = 256 * 1024;
constexpr size_t WS_WGT = 1 * MiB + 256 * 1024, WS_WRT = 1 * MiB + 320 * 1024;
constexpr size_t WS_MOD = 1 * MiB, WS_GATES = 2 * MiB, WS_POS = 3 * MiB, WS_COS = 4 * MiB, WS_SIN = 8 * MiB, WS_LIST = 12 * MiB;
constexpr size_t WS_WIN = 20 * MiB, WS_WOUT = 27 * MiB, WS_W1 = 29 * MiB, WS_W3 = 61 * MiB, WS_W2 = 93 * MiB;
constexpr size_t WS_A = 126 * MiB;
constexpr size_t WS_PROJ = 190 * MiB;
constexpr size_t WS_H2 = 190 * MiB;
constexpr size_t WS_HID = 254 * MiB;
constexpr size_t WS_Y = 320 * MiB;
constexpr size_t WS_MLS = 414 * MiB;
constexpr size_t WS_GPM = 512 * 1024;
constexpr size_t WS_CLOC = 416 * MiB;
constexpr size_t WS_CPREV = 432 * MiB;
constexpr size_t WS_QKC = 448 * MiB;
constexpr size_t WS_X1 = 448 * MiB;
constexpr int X1P = 1024;
constexpr size_t WS_END = 512 * MiB;

constexpr int RING_BYTES = 133120;
constexpr int LDSCTL_OFF = RING_BYTES, MISC_OFF = LDSCTL_OFF + 320, TAB_OFF = LDSCTL_OFF + 1024;
constexpr int ARGS_OFF = LDSCTL_OFF + 2048;
constexpr int LDS_BYTES = 147456;

#define RLX_AGENT __ATOMIC_RELAXED, __HIP_MEMORY_SCOPE_AGENT
#define LDS_WAIT() asm volatile("s_waitcnt lgkmcnt(0)" ::: "memory")
__device__ __forceinline__ unsigned pk2h(float a, float b) { f16x2 v = {(f16)a, (f16)b}; return __builtin_bit_cast(unsigned, v); }
template <int M> __device__ __forceinline__ float xsum(float v) {
    const int iv = __builtin_bit_cast(int, v);
    if constexpr (M == 1) return v + __builtin_bit_cast(float, __builtin_amdgcn_mov_dpp(iv, 0xB1, 0xF, 0xF, true));
    else if constexpr (M == 2) return v + __builtin_bit_cast(float, __builtin_amdgcn_mov_dpp(iv, 0x4E, 0xF, 0xF, true));
    else if constexpr (M == 32) { const auto r = __builtin_amdgcn_permlane32_swap((unsigned)iv, (unsigned)iv, false, false); return __uint_as_float(r[0]) + __uint_as_float(r[1]); }
    else return v + __builtin_bit_cast(float, __builtin_amdgcn_ds_swizzle(iv, (M << 10) | 0x1F));
}
__device__ __forceinline__ float wave_sum(float v) { v = xsum<1>(v); v = xsum<2>(v); v = xsum<4>(v); v = xsum<8>(v); v = xsum<16>(v); return xsum<32>(v); }
typedef int i32x8 __attribute__((ext_vector_type(8)));
typedef int i32x4 __attribute__((ext_vector_type(4)));
__device__ __forceinline__ u32x2 pk8_fp8(const float (&o)[8]) {
    float c[8];
#pragma unroll
    for (int j = 0; j < 8; ++j) c[j] = fminf(fmaxf(o[j], -448.f), 448.f);
    int lo = __builtin_amdgcn_cvt_pk_fp8_f32(c[0], c[1], 0, false); lo = __builtin_amdgcn_cvt_pk_fp8_f32(c[2], c[3], lo, true);
    int hi = __builtin_amdgcn_cvt_pk_fp8_f32(c[4], c[5], 0, false); hi = __builtin_amdgcn_cvt_pk_fp8_f32(c[6], c[7], hi, true);
    return (u32x2){(unsigned)lo, (unsigned)hi};
}
#ifndef MOE_FP8
#define MOE_FP8 1
#endif
constexpr bool MOE8 = MOE_FP8 != 0;
constexpr float W8SCALE = MOE8 ? 16.f : 1.f;
__device__ __forceinline__ float sigmoidf_(float x) { return 1.f / (1.f + __expf(-x)); }

__device__ __forceinline__ int tid_of(int w0) { unsigned z = 0u; asm volatile("" : "+v"(z));
    return w0 * 64 + (int)__builtin_amdgcn_mbcnt_hi(~0u, __builtin_amdgcn_mbcnt_lo(~0u, z)); }
__device__ __forceinline__ void st16_wt(void* base_uniform, unsigned byte_off, u32x4 v) {
    const __amdgpu_buffer_rsrc_t r = __builtin_amdgcn_make_buffer_rsrc(base_uniform, (short)0, 0x7fffffff, 0x00020000);
    __builtin_amdgcn_raw_buffer_store_b128(v, r, (int)byte_off, 0, 16);
}
__device__ __forceinline__ void st4_wt(float* p, float v) { __hip_atomic_store((unsigned*)p, __float_as_uint(v), __ATOMIC_RELAXED, __HIP_MEMORY_SCOPE_AGENT); }
#define XB_TMO      128
#define XB_XCNT(j)  (256  + 64 * (j))
#define XB_XSUB(j)  (1280 + 64 * (j))
#define XB_XGEN(j)  (2304 + 64 * (j))
#define XB_TOP      3328
#define XB_TOPGEN   3392
#define XCD_BAR_WORDS 3456
#define XB_SPIN_CAP (1u << 22)
__device__ __forceinline__ unsigned xb_ld(unsigned* p)              { return __hip_atomic_load(p, __ATOMIC_RELAXED, __HIP_MEMORY_SCOPE_AGENT); }
__device__ __forceinline__ unsigned xb_add(unsigned* p, unsigned v) { return __hip_atomic_fetch_add(p, v, __ATOMIC_RELAXED, __HIP_MEMORY_SCOPE_AGENT); }
__device__ __forceinline__ unsigned xb_xcc_id() { return (unsigned)__builtin_amdgcn_s_getreg((3 << 11) | 20) & 0xFu; }
#define XB_SPIN(cond, bar) do { unsigned _sp = 0; while (cond) { __builtin_amdgcn_s_sleep(1); \
    if ((++_sp & 255u) == 0u) { if (xb_ld(&(bar)[XB_TMO])) break; if (_sp > XB_SPIN_CAP) { atomicAdd(&(bar)[XB_TMO], 1u); break; } } } } while (0)
struct XcdBarrier { unsigned* bar; unsigned x; volatile LAS unsigned* st; };
__device__ __forceinline__ XcdBarrier xcd_barrier_post(unsigned* bar, volatile LAS unsigned* st, const bool leader) {
    XcdBarrier b; b.bar = bar; b.x = xb_xcc_id(); b.st = st;
    if (leader) (void)xb_add(&bar[XB_XCNT(b.x)], 1u);
    return b;
}
__device__ __forceinline__ void xcd_barrier_complete(unsigned* bar, unsigned x, unsigned& nloc, unsigned& nx) {
    const unsigned G = gridDim.x * gridDim.y * gridDim.z;
    unsigned sum, cnt, mine, sp = 0u;
    for (;;) {
        sum = 0u; cnt = 0u; mine = 0u;
#pragma unroll
        for (unsigned j = 0; j < 16; ++j) { const unsigned c = xb_ld(&bar[XB_XCNT(j)]); sum += c; cnt += (c > 0u) ? 1u : 0u; mine = (j == x) ? c : mine; }
        if (sum == G) break;
        __builtin_amdgcn_s_sleep(1);
        if ((++sp & 255u) == 0u) { if (xb_ld(&bar[XB_TMO])) break; if (sp > XB_SPIN_CAP) { atomicAdd(&bar[XB_TMO], 1u); break; } }
    }
    nloc = mine > 0u ? mine : 1u; nx = cnt > 0u ? cnt : 1u;
}
__device__ __forceinline__ void xcd_barrier(const XcdBarrier& b, const int w0) {
    asm volatile("s_waitcnt vmcnt(0)" ::: "memory");
    __syncthreads();
    if (tid_of(w0) == 0) {
        unsigned* bar = b.bar;
        __builtin_amdgcn_s_waitcnt(0);
        unsigned nloc = b.st[0], nx = b.st[1];
        if (nloc == 0u) { xcd_barrier_complete(bar, b.x, nloc, nx); b.st[0] = nloc; b.st[1] = nx; }
        const unsigned old = xb_add(&bar[XB_XSUB(b.x)], 1u);
        const unsigned gen = old / nloc;
        if (old + 1u == (gen + 1u) * nloc) {
            __builtin_amdgcn_fence(__ATOMIC_RELEASE, "agent");
            asm volatile("s_waitcnt vmcnt(0)" ::: "memory");
            const unsigned og = xb_add(&bar[XB_TOP], 1u);
            const unsigned tg = og / nx;
            if (og + 1u == (tg + 1u) * nx) xb_add(&bar[XB_TOPGEN], 1u);
            else XB_SPIN(xb_ld(&bar[XB_TOPGEN]) == tg, bar);
            __builtin_amdgcn_fence(__ATOMIC_ACQUIRE, "agent");
            xb_add(&bar[XB_XGEN(b.x)], 1u);
            asm volatile("s_waitcnt vmcnt(0)" ::: "memory");
        } else {
            XB_SPIN(xb_ld(&bar[XB_XGEN(b.x)]) == gen, bar);
            __builtin_amdgcn_fence(__ATOMIC_ACQUIRE, "agent");
            asm volatile("s_waitcnt vmcnt(0)" ::: "memory");
        }
    }
    __syncthreads();
}

namespace pg8 {
constexpr int BM = 256, BK = 64, HALF = 128, HTB = HALF * BK * 2, STAGE_BYTES = 8 * HTB;
__host__ __device__ __forceinline__ int lds_byte(int r, int c) { const int st = (r >> 4) * 2 + (c >> 5), rr = r & 15, cc = c & 31, ob = rr * 64 + cc * 2; return st * 1024 + (ob ^ (((ob >> 9) & 1) << 5)); }
__host__ __device__ __forceinline__ void stage_rc(int b, int& R, int& C) { const int st = b / 1024, sb = b % 1024, swz = sb ^ (((sb >> 9) & 1) << 5); R = (st >> 1) * 16 + swz / 64; C = (st & 1) * 32 + (swz % 64) / 2; }
__host__ __device__ __forceinline__ int perm32(int rho) { const int n = rho >> 4, i = rho & 15; return 8 * (i >> 2) + 4 * n + (i & 3); }

struct Unit { size_t b0, b1; int pm, pn, e, row0, rows, gt; };

template <bool ROPE, bool FP8, class Epi, class Sched>
__device__ __forceinline__ void gemm_phase(LAS unsigned char* lds, const char* Abase, const char* Bbase, const int K, const Sched& S, const Epi& E, const int w0) {
    const int tid = tid_of(w0);
    const int wid = w0, lane = tid & 63, wr = wid >> 2, wc = wid & 3, fr = lane & 15, fq = lane >> 4;
    const int Kb = FP8 ? K : 2 * K;
    int nt = Kb / 128; asm volatile("" : "+s"(nt));
    int R[2], C[2]; unsigned voffB[2];
#pragma unroll
    for (int i = 0; i < 2; ++i) { stage_rc(tid * 16 + i * 8192, R[i], C[i]);
        const int Rb = ROPE ? (64 * (R[i] >> 5) + perm32(R[i] & 31)) : ((R[i] & ~31) + perm32(R[i] & 31));
        voffB[i] = (unsigned)(Rb * Kb + C[i] * 2); }
    const size_t kstep = (size_t)(BK * 2);
    const unsigned ldsw = (unsigned)wid * 1024u;
    const int aoff = FP8 ? lds_byte(wr * 64 + fr, fq * 16) : lds_byte(wr * 64 + fr, fq * 8), boff = FP8 ? lds_byte(wc * 32 + fr, fq * 16) : lds_byte(wc * 32 + fr, fq * 8);
#define PG8_SA(b, h) (((b) * 2 + (h)) * HTB)
#define PG8_SB(b, h) ((4 + (b) * 2 + (h)) * HTB)
#define PG8_STG(bufoff, gbase, voff) do { _Pragma("unroll") for (int _i = 0; _i < 2; ++_i) \
        __builtin_amdgcn_global_load_lds((const unsigned*)((const char*)(gbase) + (voff)[_i]), (LAS unsigned*)(lds + (bufoff) + ldsw + _i * 8192), 16, 0, 0); } while (0)
#define PG8_LDA(dst, b, h) do { _Pragma("unroll") for (int m = 0; m < 4; ++m) { dst[m].lo = *(const LAS i32x4*)(lds + PG8_SA(b, h) + aoff + m * 2048); dst[m].hi = *(const LAS i32x4*)(lds + PG8_SA(b, h) + aoff + m * 2048 + (FP8 ? 16 : 1024)); } } while (0)
#define PG8_LDB(dst, b, h) do { _Pragma("unroll") for (int n = 0; n < 2; ++n) { dst[n].lo = *(const LAS i32x4*)(lds + PG8_SB(b, h) + boff + n * 2048); dst[n].hi = *(const LAS i32x4*)(lds + PG8_SB(b, h) + boff + n * 2048 + (FP8 ? 16 : 1024)); } } while (0)
#define PG8_MMA(ai, bj, At, Bt) do { __builtin_amdgcn_s_setprio(1); _Pragma("unroll") for (int m = 0; m < 4; ++m) _Pragma("unroll") for (int n = 0; n < 2; ++n) { \
        if constexpr (FP8) acc[ai][bj][m][n] = __builtin_amdgcn_mfma_scale_f32_16x16x128_f8f6f4(Bt[n], At[m], acc[ai][bj][m][n], 0, 0, 0, 0x7f7f7f7f, 0, 0x7f7f7f7f); \
        else { const i32x4 bl_ = Bt[n].lo, bh_ = Bt[n].hi, al_ = At[m].lo, ah_ = At[m].hi;        \
               acc[ai][bj][m][n] = __builtin_amdgcn_mfma_f32_16x16x32_f16(__builtin_bit_cast(f16x8, bl_), __builtin_bit_cast(f16x8, al_), acc[ai][bj][m][n], 0, 0, 0); \
               acc[ai][bj][m][n] = __builtin_amdgcn_mfma_f32_16x16x32_f16(__builtin_bit_cast(f16x8, bh_), __builtin_bit_cast(f16x8, ah_), acc[ai][bj][m][n], 0, 0, 0); } } \
        if constexpr (FP8) { _Pragma("unroll") for (int m = 0; m < 4; ++m) _Pragma("unroll") for (int n = 0; n < 2; ++n) asm volatile("" : "+v"(acc[ai][bj][m][n])); }     \
        __builtin_amdgcn_s_setprio(0); } while (0)
#define PG8_WAIT_V(n) asm volatile("s_waitcnt vmcnt(" #n ")" ::: "memory")
#define PG8_WAIT_L(n) asm volatile("s_waitcnt lgkmcnt(" #n ")" ::: "memory")
#define PG8_BAR __builtin_amdgcn_s_barrier()
#define PG8_SCHED __builtin_amdgcn_sched_barrier(0)
#define PG8_PIN do { if constexpr (FP8) __builtin_amdgcn_sched_barrier(0); } while (0)
    Unit cur, nxt; int ui = 0;
    if (!S.next(0, cur)) return;
    f32x4 acc[2][2][4][2];
#pragma unroll
    for (int a = 0; a < 2; ++a)
#pragma unroll
        for (int b = 0; b < 2; ++b)
#pragma unroll
            for (int m = 0; m < 4; ++m)
#pragma unroll
                for (int n = 0; n < 2; ++n) acc[a][b][m][n] = (f32x4){0.f, 0.f, 0.f, 0.f};
    i32x8 At[4], B0[2], B1[2];
    unsigned cvA[2][2], nvA[2][2];
    S.a_ready(cur, wid, false);
    S.avoff(cur, cvA, R, C);
    const char* cB0 = Bbase + cur.b0; const char* cB1 = Bbase + cur.b1;
    PG8_STG(PG8_SB(0, 0), cB0, voffB); PG8_STG(PG8_SB(0, 1), cB1, voffB); PG8_STG(PG8_SA(0, 0), Abase, cvA[0]); PG8_STG(PG8_SA(0, 1), Abase, cvA[1]);
    if (wr == 1) PG8_BAR;
    PG8_WAIT_V(2); PG8_BAR;
    PG8_STG(PG8_SB(1, 0), cB0 + kstep, voffB); PG8_STG(PG8_SA(1, 0), Abase + kstep, cvA[0]); PG8_STG(PG8_SB(1, 1), cB1 + kstep, voffB);
    PG8_WAIT_V(6); PG8_BAR;
    int pgt = -1;
    for (;;) {
        const bool has_next = S.next(ui + 1, nxt);
        if (has_next) S.avoff(nxt, nvA, R, C);
        else {
#pragma unroll
            for (int h = 0; h < 2; ++h)
#pragma unroll
                for (int i = 0; i < 2; ++i) nvA[h][i] = cvA[h][i];
        }
        const char* nB0 = has_next ? Bbase + nxt.b0 : cB0; const char* nB1 = has_next ? Bbase + nxt.b1 : cB1;
        if (pgt >= 0) { S.done_gt(pgt, lane); pgt = -1; }
        const bool pre = has_next ? S.a_pre(nxt, wid) : false;
        for (int t = 0; t < nt; t += 2) {
            const bool last = (t == nt - 2);
            if (last && has_next) S.a_ready(nxt, wid, pre);
            const char* a1 = Abase + (size_t)(t + 1) * kstep;
            const size_t k2 = last ? (size_t)0 : (size_t)(t + 2) * kstep;
            const char* a2 = Abase + k2; const char* a3 = a2 + kstep;
            const char* b20 = (last ? nB0 : cB0) + k2; const char* b21 = (last ? nB1 : cB1) + k2;
            const char* b30 = b20 + kstep; const char* b31 = b21 + kstep;
            unsigned vA2[2][2];
#pragma unroll
            for (int h = 0; h < 2; ++h)
#pragma unroll
                for (int i = 0; i < 2; ++i) vA2[h][i] = last ? nvA[h][i] : cvA[h][i];
            PG8_LDB(B0, 0, 0); PG8_LDB(B1, 0, 1); PG8_SCHED; PG8_LDA(At, 0, 0); PG8_STG(PG8_SA(1, 1), a1, cvA[1]);
            PG8_WAIT_V(8); PG8_WAIT_L(0); PG8_BAR; PG8_PIN; PG8_MMA(0, 0, At, B0); PG8_MMA(0, 1, At, B1); PG8_PIN; PG8_BAR; PG8_SCHED;
            PG8_LDA(At, 0, 1); PG8_STG(PG8_SB(0, 0), b20, voffB); PG8_STG(PG8_SB(0, 1), b21, voffB); PG8_STG(PG8_SA(0, 0), a2, vA2[0]);
            PG8_WAIT_V(8); PG8_WAIT_L(0); PG8_BAR; PG8_PIN; PG8_MMA(1, 0, At, B0); PG8_MMA(1, 1, At, B1); PG8_PIN; PG8_BAR; PG8_SCHED;
            PG8_LDB(B0, 1, 0); PG8_LDB(B1, 1, 1); PG8_SCHED; PG8_LDA(At, 1, 0); PG8_STG(PG8_SA(0, 1), a2, vA2[1]);
            PG8_WAIT_V(8); PG8_WAIT_L(0); PG8_BAR; PG8_PIN; PG8_MMA(0, 0, At, B0); PG8_MMA(0, 1, At, B1); PG8_PIN; PG8_BAR; PG8_SCHED;
            PG8_LDA(At, 1, 1); PG8_STG(PG8_SB(1, 0), b30, voffB); PG8_STG(PG8_SB(1, 1), b31, voffB); PG8_STG(PG8_SA(1, 0), a3, vA2[0]);
            PG8_WAIT_V(8); PG8_WAIT_L(0); PG8_BAR; PG8_PIN; PG8_MMA(1, 0, At, B0); PG8_MMA(1, 1, At, B1); PG8_PIN; PG8_BAR; PG8_SCHED;
        }
        if (wr == 0) PG8_BAR;
        E(acc, cur, wr, wc, fr, fq); pgt = cur.gt;
        if (!has_next) { S.done_gt(pgt, lane); break; }
#pragma unroll
        for (int a = 0; a < 2; ++a)
#pragma unroll
            for (int b = 0; b < 2; ++b)
#pragma unroll
                for (int m = 0; m < 4; ++m)
#pragma unroll
                    for (int n = 0; n < 2; ++n) acc[a][b][m][n] = (f32x4){0.f, 0.f, 0.f, 0.f};
        cur = nxt; cB0 = nB0; cB1 = nB1; ++ui;
#pragma unroll
        for (int h = 0; h < 2; ++h)
#pragma unroll
            for (int i = 0; i < 2; ++i) cvA[h][i] = nvA[h][i];
        if (wr == 1) PG8_BAR;
    }
    PG8_WAIT_V(0);
    PG8_BAR;
#undef PG8_SA
#undef PG8_SB
#undef PG8_STG
#undef PG8_LDA
#undef PG8_LDB
#undef PG8_MMA
#undef PG8_WAIT_V
#undef PG8_WAIT_L
#undef PG8_BAR
#undef PG8_SCHED
#undef PG8_PIN
}

struct DenseSched {
    int nM, nN, nwg, G, c, K; bool rope;
    __device__ __forceinline__ void init(int M, int N, int K_, int G_, int c_, bool rope_) { nM = M / BM; nN = N / BM; nwg = nM * nN; G = G_; c = c_; K = K_; rope = rope_; }
    __device__ __forceinline__ bool next(int i, Unit& u) const {
        const long L = (long)i * G + c; if (L >= nwg) return false;
        int wgid = (int)L; { const int q = nwg / 8, r = nwg % 8, xcd = wgid % 8, off = wgid / 8; wgid = (xcd < r ? xcd * (q + 1) : r * (q + 1) + (xcd - r) * q) + off; }
        const int WGM = 8, nig = WGM * nN, gid = wgid / nig, fm = gid * WGM, gsz = (nM - fm) < WGM ? (nM - fm) : WGM;
        u.pm = fm + ((wgid % nig) % gsz); u.pn = (wgid % nig) / gsz; u.e = 0; u.row0 = u.pm * BM; u.rows = BM;
        u.b0 = (size_t)(u.pn * BM) * K * 2; u.b1 = u.b0 + (size_t)(rope ? 32 : 128) * K * 2;
        return true;
    }
    __device__ __forceinline__ void avoff(const Unit& u, unsigned (&vo)[2][2], const int (&R)[2], const int (&C)[2]) const {
#pragma unroll
        for (int h = 0; h < 2; ++h)
#pragma unroll
            for (int i = 0; i < 2; ++i) vo[h][i] = (unsigned)((u.row0 + 128 * h + R[i]) * K + C[i]) * 2u;
    }
    __device__ __forceinline__ bool a_pre(const Unit&, int) const { return false; }
    __device__ __forceinline__ void a_ready(const Unit&, int, bool) const {}
    __device__ __forceinline__ void done(const Unit&, int) const {}
    __device__ __forceinline__ void done_gt(int, int) const {}
};
struct MoeSched {
    const LAS int* tab; int G, cv, K; bool gather; const int* list; unsigned* mtc;
    __device__ __forceinline__ bool next(int i, Unit& u) const {
        const int L = i * G + cv; if (L >= tab[32]) return false;
        unsigned z_ = 0u; asm volatile("" : "+v"(z_));
        const int ln_ = (int)__builtin_amdgcn_mbcnt_hi(~0u, __builtin_amdgcn_mbcnt_lo(~0u, z_));
        const int tv_ = tab[ln_ & 31];
        const int e = __builtin_popcountll(__builtin_amdgcn_ballot_w64(ln_ < 32 && tv_ <= L)) - 1;
        const int local = L - tab[e]; u.e = e; u.pm = local >> 2; u.pn = local & 3; u.gt = (tab[e] >> 2) + u.pm;
        const int cnt = tab[80 + e]; u.rows = min(256, cnt - u.pm * 256); u.row0 = tab[40 + e] + u.pm * 256;
        constexpr size_t EB = MOE8 ? 1 : 2;
        if (gather) { u.b0 = ((size_t)e * 512 + 128 * u.pn) * 1024 * EB; u.b1 = u.b0 + (WS_W3 - WS_W1); }
        else        { u.b0 = ((size_t)e * 1024 + 256 * u.pn) * 512 * EB; u.b1 = u.b0 + (size_t)128 * 512 * EB; }
        return true;
    }
    __device__ __forceinline__ void avoff(const Unit& u, unsigned (&vo)[2][2], const int (&R)[2], const int (&C)[2]) const {
#pragma unroll
        for (int h = 0; h < 2; ++h)
#pragma unroll
            for (int i = 0; i < 2; ++i) {
                if (gather) { int r = 128 * h + R[i]; r = r < u.rows ? r : u.rows - 1; const int tok = list[2 * ((size_t)u.e * LISTCAP + u.pm * 256 + r)];
                    vo[h][i] = MOE8 ? (unsigned)(tok * 1024 + C[i] * 2) : (unsigned)(tok * 1024 + C[i]) * 2u; }
                else vo[h][i] = MOE8 ? (unsigned)((u.row0 + 128 * h + R[i]) * 512 + C[i] * 2) : (unsigned)((u.row0 + 128 * h + R[i]) * 512 + C[i]) * 2u;
            }
    }
    __device__ __forceinline__ bool a_pre(const Unit& u, int wid) const {
        if (gather || wid != 0) return false;
        const bool ok = (unsigned)__builtin_amdgcn_readfirstlane(__hip_atomic_load(mtc + 64 * u.gt, __ATOMIC_RELAXED, __HIP_MEMORY_SCOPE_AGENT)) >= 32u;
        if (ok) __builtin_amdgcn_fence(__ATOMIC_ACQUIRE, "agent");
        return ok;
    }
    __device__ __forceinline__ void a_ready(const Unit& u, int wid, bool pre) const {
        if (gather) return;
        if (wid == 0 && !pre) { unsigned sp = 0;
            while ((unsigned)__builtin_amdgcn_readfirstlane(__hip_atomic_load(mtc + 64 * u.gt, __ATOMIC_RELAXED, __HIP_MEMORY_SCOPE_AGENT)) < 32u) { __builtin_amdgcn_s_sleep(2); if (++sp > (1u << 22)) break; }
            __builtin_amdgcn_fence(__ATOMIC_ACQUIRE, "agent");
            asm volatile("s_waitcnt vmcnt(0)" ::: "memory"); }
        asm volatile("" ::: "memory"); __builtin_amdgcn_s_barrier(); asm volatile("" ::: "memory");
    }
    __device__ __forceinline__ void done_gt(int gt, int lane) const {
        if (!gather) return;
        asm volatile("s_waitcnt vmcnt(0)" ::: "memory");
        if (lane == 0) __hip_atomic_fetch_add(mtc + 64 * gt, 1u, __ATOMIC_RELAXED, __HIP_MEMORY_SCOPE_AGENT);
    }
    __device__ __forceinline__ void done(const Unit& u, int lane) const {
        if (!gather) return;
        asm volatile("s_waitcnt vmcnt(0)" ::: "memory");
        if (lane == 0) __hip_atomic_fetch_add(mtc + 64 * u.gt, 1u, __ATOMIC_RELAXED, __HIP_MEMORY_SCOPE_AGENT);
    }
};

struct EpiProj {
    f16* proj; const float* cosT; const float* sinT; float* ksum;
    __device__ __forceinline__ void operator()(const f32x4 (&acc)[2][2][4][2], const Unit& u, int wr, int wc, int fr, int fq) const {
        const int tile = u.pn, row0 = u.row0 + wr * 64 + fr, col0 = tile * 256 + 64 * wc + 8 * fq;
        if (tile < 4) {
            const float sc = tile < 2 ? C2 : 1.f;
            float ks[2][8];
#pragma unroll
            for (int bj = 0; bj < 2; ++bj)
#pragma unroll
                for (int j = 0; j < 8; ++j) ks[bj][j] = 0.f;
#pragma unroll
            for (int ai = 0; ai < 2; ++ai)
#pragma unroll
                for (int m = 0; m < 4; ++m) {
                    const int row = row0 + ai * HALF + m * 16;
                    const f32x4 c0 = *(const f32x4*)(cosT + (size_t)row * 32 + 8 * fq), c1 = *(const f32x4*)(cosT + (size_t)row * 32 + 8 * fq + 4);
                    const f32x4 s0 = *(const f32x4*)(sinT + (size_t)row * 32 + 8 * fq), s1 = *(const f32x4*)(sinT + (size_t)row * 32 + 8 * fq + 4);
                    const f32x4 a0 = acc[ai][0][m][0], a1 = acc[ai][0][m][1], b0 = acc[ai][1][m][0], b1 = acc[ai][1][m][1];
                    const f32x4 o10 = (a0 * c0 - b0 * s0) * sc, o11 = (a1 * c1 - b1 * s1) * sc;
                    const f32x4 o20 = (b0 * c0 + a0 * s0) * sc, o21 = (b1 * c1 + a1 * s1) * sc;
                    u32x4 w1, w2;
                    w1.x = pk2h(o10[0], o10[1]); w1.y = pk2h(o10[2], o10[3]); w1.z = pk2h(o11[0], o11[1]); w1.w = pk2h(o11[2], o11[3]);
                    w2.x = pk2h(o20[0], o20[1]); w2.y = pk2h(o20[2], o20[3]); w2.z = pk2h(o21[0], o21[1]); w2.w = pk2h(o21[2], o21[3]);
                    f16* rp = proj + (size_t)row * NPROJ + col0;
                    *(u32x4*)rp = w1; *(u32x4*)(rp + 32) = w2;
                    if (tile >= 2) {
#pragma unroll
                        for (int j = 0; j < 4; ++j) { ks[0][j] += o10[j]; ks[0][4 + j] += o11[j]; ks[1][j] += o20[j]; ks[1][4 + j] += o21[j]; }
                    }
                }
            if (tile >= 2) {
                const int b = u.pm >> 4, blk = u.pm & 15, head = (tile - 2) * 4 + wc;
                float* kp = ksum + ((size_t)((b * 8 + head) * 16 + blk)) * 64 + 8 * fq;
#pragma unroll
                for (int bj = 0; bj < 2; ++bj)
#pragma unroll
                    for (int j = 0; j < 8; ++j) { float v = ks[bj][j]; v = xsum<1>(v); v = xsum<2>(v); v = xsum<4>(v); v = xsum<8>(v);
                        if (fr == 0) atomicAdd(kp + 32 * bj + j, v); }
            }
        } else {
#pragma unroll
            for (int ai = 0; ai < 2; ++ai)
#pragma unroll
                for (int m = 0; m < 4; ++m) {
                    f16* rp = proj + (size_t)(row0 + ai * HALF + m * 16) * NPROJ + col0;
#pragma unroll
                    for (int bj = 0; bj < 2; ++bj) { const f32x4 v0 = acc[ai][bj][m][0], v1 = acc[ai][bj][m][1]; u32x4 w;
                        w.x = pk2h(v0[0], v0[1]); w.y = pk2h(v0[2], v0[3]); w.z = pk2h(v1[0], v1[1]); w.w = pk2h(v1[2], v1[3]);
                        *(u32x4*)(rp + 32 * bj) = w; }
                }
        }
    }
};
struct EpiOut {
    const float* x; const float* mod; f16* x1; float* ssb;
    __device__ __forceinline__ void operator()(const f32x4 (&acc)[2][2][4][2], const Unit& u, int wr, int wc, int fr, int fq) const {
        const int row0 = u.row0 + wr * 64 + fr, col0 = u.pn * BM + wc * 32 + 8 * fq, b = u.row0 / SEQ;
        const float* g1 = mod + (size_t)b * 6144 + 2048;
        float sq[2][4] = {{0.f, 0.f, 0.f, 0.f}, {0.f, 0.f, 0.f, 0.f}};
#pragma unroll
        for (int bj = 0; bj < 2; ++bj) {
            const f32x4 g0 = *(const f32x4*)(g1 + col0 + bj * HALF), gg1 = *(const f32x4*)(g1 + col0 + bj * HALF + 4);
#pragma unroll
            for (int ai = 0; ai < 2; ++ai)
#pragma unroll
                for (int m = 0; m < 4; ++m) { const int row = row0 + ai * HALF + m * 16; const size_t off = (size_t)row * DM + col0 + bj * HALF;
                    const f32x4 x0 = __builtin_nontemporal_load((const GAS f32x4*)(x + off)), xx1 = __builtin_nontemporal_load((const GAS f32x4*)(x + off + 4));
                    const f32x4 v0 = x0 + g0 * acc[ai][bj][m][0], v1 = xx1 + gg1 * acc[ai][bj][m][1];
                    u32x4 w; w.x = pk2h(v0[0], v0[1]); w.y = pk2h(v0[2], v0[3]); w.z = pk2h(v1[0], v1[1]); w.w = pk2h(v1[2], v1[3]);
                    *(u32x4*)(x1 + (size_t)row * X1P + col0 + bj * HALF) = w;
                    sq[ai][m] += (v0[0] * v0[0] + v0[1] * v0[1]) + (v0[2] * v0[2] + v0[3] * v0[3]) + (v1[0] * v1[0] + v1[1] * v1[1]) + (v1[2] * v1[2] + v1[3] * v1[3]); }
        }
#pragma unroll
        for (int ai = 0; ai < 2; ++ai)
#pragma unroll
            for (int m = 0; m < 4; ++m) { float q = sq[ai][m]; q = xsum<16>(q); q = xsum<32>(q);
                if (fq == 0) ssb[(size_t)(row0 + ai * HALF + m * 16) * 16 + u.pn * 4 + wc] = q; }
    }
};
struct EpiMoe1 {
    unsigned char* H;
    __device__ __forceinline__ void operator()(const f32x4 (&acc)[2][2][4][2], const Unit& u, int wr, int wc, int fr, int fq) const {
        const int r0 = wr * 64 + fr, col0 = u.pn * 128 + wc * 32 + 8 * fq;
        const __amdgpu_buffer_rsrc_t rs = __builtin_amdgcn_make_buffer_rsrc(H, (short)0, 0x7fffffff, 0x00020000);
#pragma unroll
        for (int ai = 0; ai < 2; ++ai)
#pragma unroll
            for (int m = 0; m < 4; ++m) { const int r = r0 + ai * HALF + m * 16;
                float o[8];
#pragma unroll
                for (int n = 0; n < 2; ++n)
#pragma unroll
                    for (int j = 0; j < 4; ++j) { const float a = acc[ai][0][m][n][j] * (1.f / W8SCALE), bb = acc[ai][1][m][n][j] * (1.f / W8SCALE); o[4 * n + j] = a * __builtin_amdgcn_rcpf(1.f + __expf(-a)) * bb; }
                if (r < u.rows) {
                    if constexpr (MOE8) __builtin_amdgcn_raw_buffer_store_b64(pk8_fp8(o), rs, (int)((u.row0 + r) * DEXP + col0), 0, 16);
                    else { u32x4 w; w.x = pk2h(o[0], o[1]); w.y = pk2h(o[2], o[3]); w.z = pk2h(o[4], o[5]); w.w = pk2h(o[6], o[7]); __builtin_amdgcn_raw_buffer_store_b128(w, rs, (int)(((u.row0 + r) * DEXP + col0) * 2), 0, 16); } } }
    }
};
struct EpiMoe2 {
    unsigned char* Y; const int* list;
    __device__ __forceinline__ void operator()(const f32x4 (&acc)[2][2][4][2], const Unit& u, int wr, int wc, int fr, int fq) const {
        const int r0 = wr * 64 + fr, col0 = u.pn * BM + wc * 32 + 8 * fq;
#pragma unroll
        for (int ai = 0; ai < 2; ++ai)
#pragma unroll
            for (int m = 0; m < 4; ++m) { const int r = r0 + ai * HALF + m * 16;
                if (r < u.rows) {
                    const float w = 1.f / W8SCALE;
#pragma unroll
                    for (int bj = 0; bj < 2; ++bj) { const f32x4 v0 = acc[ai][bj][m][0] * w, v1 = acc[ai][bj][m][1] * w;
                        const float o8[8] = {v0[0], v0[1], v0[2], v0[3], v1[0], v1[1], v1[2], v1[3]};
                        *(u32x2*)(Y + (size_t)(u.row0 + r) * DM + col0 + bj * HALF) = pk8_fp8(o8); }
                } }
    }
};
}


namespace moba {
using s16x8=__attribute__((ext_vector_type(8)))short;
using s16x4=__attribute__((ext_vector_type(4)))short;
using f32x16=__attribute__((ext_vector_type(16)))float;
constexpr int D=64, PITCH=NPROJ, OPITCH=DM;
constexpr int NW=8,QBLK=32,QB=QBLK*NW,KVBLK=64;
__device__ __forceinline__ int crow(int r,int hi){return (r&3)+8*(r>>2)+4*hi;}
#define SBAR() __builtin_amdgcn_sched_barrier(0)
#define MF32(a,b,c) __builtin_amdgcn_mfma_f32_32x32x16_f16(__builtin_bit_cast(f16x8,(a)),__builtin_bit_cast(f16x8,(b)),(c),0,0,0)
__device__ __forceinline__ void cmask(f32x16&p0,f32x16&p1,int jb,int qrel,int hi){
  const float NEG=-INFINITY; int d=qrel-(64*jb+4*hi); asm volatile("":"+v"(d));
  #pragma unroll
  for(int r=0;r<16;++r){ const int cr=(r&3)+8*(r>>2); if(cr>d)p0[r]=NEG; if(cr+32>d)p1[r]=NEG; }
}
constexpr int NSLOT=4, SLOTB=8192;
constexpr int LDS_K=0, LDS_V=NSLOT*SLOTB, LDS_WS=2*NSLOT*SLOTB, LDS_OST=LDS_WS+NW*64*4, LDS_SEL=LDS_OST+NW*4096, LDS_KS=LDS_SEL+1024, LDS_BYTES_A=LDS_KS+4096;
__device__ __forceinline__ void glds16(const void*gsrc,unsigned lds_dst){unsigned keep;
  asm volatile("s_mov_b32 %0, m0\n\ts_mov_b32 m0, %2\n\ts_nop 0\n\tglobal_load_lds_dwordx4 %1, off\n\ts_mov_b32 m0, %0":"=&s"(keep):"v"(gsrc),"s"(lds_dst):"memory");}
__device__ __forceinline__ float max3f(float a,float b,float c){float r;asm("v_max3_f32 %0, %1, %2, %3":"=v"(r):"v"(a),"v"(b),"v"(c));return r;}
__device__ __forceinline__ float max2f(float a,float b){float r;asm("v_max_f32_e32 %0, %1, %2":"=v"(r):"v"(a),"v"(b));return r;}
__device__ __forceinline__ float fadd_s(float a,float b){float r;asm("v_add_f32_e32 %0, %1, %2":"=v"(r):"v"(a),"v"(b));return r;}
__device__ __forceinline__ float fsub_s(float a,float b){float r;asm("v_sub_f32_e32 %0, %1, %2":"=v"(r):"v"(a),"v"(b));return r;}
__device__ __forceinline__ unsigned cvtpk_s(float lo,float hi){return __builtin_bit_cast(unsigned,__builtin_amdgcn_cvt_pkrtz(lo,hi));}
#define WAIT_BAR(N) asm volatile("s_waitcnt vmcnt(" #N ") lgkmcnt(0)\n\ts_barrier":::"memory")
typedef __attribute__((address_space(3))) const char* lds_cptr;
__device__ __forceinline__ void qkt(f32x16&p0,f32x16&p1,lds_cptr kb,const s16x8*qr,const f32x16&negm){
  #pragma unroll
  for(int d0=0;d0<4;++d0){
    const s16x8 b0=*(const __attribute__((address_space(3))) s16x8*)(kb+d0*2048);
    const s16x8 b1=*(const __attribute__((address_space(3))) s16x8*)(kb+d0*2048+512);
    if(d0==0){p0=MF32(b0,qr[0],negm);p1=MF32(b1,qr[0],negm);}
    else{p0=MF32(b0,qr[d0],p0);p1=MF32(b1,qr[d0],p1);}}
}
typedef short v4i16_t __attribute__((ext_vector_type(4)));
__device__ __forceinline__ void kload8(s16x8*kf,lds_cptr kp){
  kf[0]=*(const __attribute__((address_space(3))) s16x8*)(kp);      kf[1]=*(const __attribute__((address_space(3))) s16x8*)(kp+512);
  kf[2]=*(const __attribute__((address_space(3))) s16x8*)(kp+2048); kf[3]=*(const __attribute__((address_space(3))) s16x8*)(kp+2560);
  kf[4]=*(const __attribute__((address_space(3))) s16x8*)(kp+4096); kf[5]=*(const __attribute__((address_space(3))) s16x8*)(kp+4608);
  kf[6]=*(const __attribute__((address_space(3))) s16x8*)(kp+6144); kf[7]=*(const __attribute__((address_space(3))) s16x8*)(kp+6656);
}
__device__ __forceinline__ void kload2(s16x8*kf,lds_cptr kp,int j){ kf[2*j]=*(const __attribute__((address_space(3))) s16x8*)(kp+j*2048); kf[2*j+1]=*(const __attribute__((address_space(3))) s16x8*)(kp+j*2048+512); }
__device__ __forceinline__ s16x4 vtr(lds_cptr p){ return __builtin_bit_cast(s16x4,__builtin_amdgcn_ds_read_tr16_b64_v4i16((__attribute__((address_space(3))) v4i16_t*)p)); }
__device__ __forceinline__ float rowmax(const f32x16&p0,const f32x16&p1){
  float a=max3f(p0[0],p0[1],p1[0]),b=max3f(p0[2],p0[3],p1[1]);a=max3f(a,p1[2],p1[3]);
  #pragma unroll
  for(int r=4;r<16;r+=4){a=max3f(a,p0[r],p0[r+1]);b=max3f(b,p0[r+2],p0[r+3]);a=max3f(a,p1[r],p1[r+1]);b=max3f(b,p1[r+2],p1[r+3]);}
  const float m=max2f(a,b);
  auto rr=__builtin_amdgcn_permlane32_swap(__float_as_uint(m),__float_as_uint(m),false,false);
  return max2f(__uint_as_float(rr[0]),__uint_as_float(rr[1]));
}
__device__ __forceinline__ void pv(f32x16*o,int vb,s16x8 pa0,s16x8 pa1,s16x8 pa2,s16x8 pa3){
  #pragma unroll
  for(int d0=0;d0<2;++d0){s16x4 lo[4],hi[4];
    #pragma unroll
    for(int ks=0;ks<4;++ks){
      asm volatile("ds_read_b64_tr_b16 %0,%1 offset:%c2":"=&v"(lo[ks]):"v"(vb),"i"(d0*4096+ks*1024):"memory");
      asm volatile("ds_read_b64_tr_b16 %0,%1 offset:%c2":"=&v"(hi[ks]):"v"(vb),"i"(d0*4096+ks*1024+512):"memory");}
    asm volatile("s_waitcnt lgkmcnt(0)":::"memory");SBAR();
    #define PK(k) (s16x8){lo[k][0],lo[k][1],lo[k][2],lo[k][3],hi[k][0],hi[k][1],hi[k][2],hi[k][3]}
    o[d0]=MF32(pa0,PK(0),o[d0]);
    o[d0]=MF32(pa1,PK(1),o[d0]);
    o[d0]=MF32(pa2,PK(2),o[d0]);
    o[d0]=MF32(pa3,PK(3),o[d0]);
    #undef PK
  }
}
__device__ __forceinline__ void sel_list(int b,int h,int qb,const f16*Q,const float*ksum,int*alist,unsigned*acnt,char*shm,const int w0,unsigned*pend){
  const int tid=tid_of(w0);
  const int row=tid>>1, half=tid&1, bh=b*8+h;
  unsigned sel=0u;
  LAS unsigned*hist=(LAS unsigned*)(shm+LDS_SEL);
  {
    float*ks=(float*)(shm+LDS_KS);
    if(tid<256)*(f32x4*)(ks+4*tid)=*(const GAS f32x4*)((const GAS float*)ksum+(size_t)(bh*16)*64+4*tid);
    if(tid<32)hist[tid]=0u;
    float qf[32];
    { const GAS f16x8*qp=(const GAS f16x8*)((const GAS f16*)Q+((long)b*SEQ+qb*QB+row)*PITCH+h*D+32*half);
      #pragma unroll
      for(int i=0;i<4;++i){ const f16x8 t=qp[i];
        #pragma unroll
        for(int j=0;j<8;++j)qf[8*i+j]=(float)t[j]; } }
    asm volatile("s_waitcnt lgkmcnt(0)\n\ts_barrier":::"memory");
    float g[15];
    const float*kp=ks+32*half;
    #pragma unroll
    for(int n=0;n<15;++n){ float s=0.f;
      if(n<qb){
        #pragma unroll
        for(int i=0;i<8;++i){ const f32x4 k4=*(const f32x4*)(kp+n*64+4*i); s+=qf[4*i]*k4[0]+qf[4*i+1]*k4[1]+qf[4*i+2]*k4[2]+qf[4*i+3]*k4[3]; }
        s = xsum<1>(s); }
      g[n]=(n<qb)?s:-INFINITY; }
    #pragma unroll
    for(int r=0;r<3;++r){ float best=-INFINITY; int bi=-1;
      #pragma unroll
      for(int n=0;n<15;++n){ const bool ok=!((sel>>n)&1u)&&g[n]>best; best=ok?g[n]:best; bi=ok?n:bi; }
      if(bi>=0)sel|=1u<<bi; } }
  int n0=-1,n1=-1,n2=-1; unsigned r0=0u,r1=0u,r2=0u;
  if(half==0){ unsigned s_=sel;
    if(s_){ n0=__builtin_ctz(s_); s_&=s_-1u; r0=__hip_atomic_fetch_add(hist+n0,1u,__ATOMIC_RELAXED,__HIP_MEMORY_SCOPE_WORKGROUP); }
    if(s_){ n1=__builtin_ctz(s_); s_&=s_-1u; r1=__hip_atomic_fetch_add(hist+n1,1u,__ATOMIC_RELAXED,__HIP_MEMORY_SCOPE_WORKGROUP); }
    if(s_){ n2=__builtin_ctz(s_);            r2=__hip_atomic_fetch_add(hist+n2,1u,__ATOMIC_RELAXED,__HIP_MEMORY_SCOPE_WORKGROUP); } }
  asm volatile("s_waitcnt vmcnt(0) lgkmcnt(0)\n\ts_barrier":::"memory");
  if(pend!=nullptr&&tid==0)__hip_atomic_fetch_add(pend,1u,__ATOMIC_RELAXED,__HIP_MEMORY_SCOPE_AGENT);
  if(tid<qb)hist[16+tid]=__hip_atomic_fetch_add(acnt+bh*16+tid,hist[tid],__ATOMIC_RELAXED,__HIP_MEMORY_SCOPE_AGENT);
  asm volatile("s_waitcnt vmcnt(0) lgkmcnt(0)\n\ts_barrier":::"memory");
  if(half==0){ const unsigned rv=(unsigned)(qb*QB+row);
    if(n0>=0)__hip_atomic_store((unsigned*)alist+(size_t)(bh*16+n0)*4096+hist[16+n0]+r0,rv,           __ATOMIC_RELAXED,__HIP_MEMORY_SCOPE_AGENT);
    if(n1>=0)__hip_atomic_store((unsigned*)alist+(size_t)(bh*16+n1)*4096+hist[16+n1]+r1,rv|(1u<<12),__ATOMIC_RELAXED,__HIP_MEMORY_SCOPE_AGENT);
    if(n2>=0)__hip_atomic_store((unsigned*)alist+(size_t)(bh*16+n2)*4096+hist[16+n2]+r2,rv|(2u<<12),__ATOMIC_RELAXED,__HIP_MEMORY_SCOPE_AGENT); }
}
template<int THRL,int MODE> __device__ __forceinline__ void attn_pass(int b,int h,int kb,int r0,int r1,int npk,const int*alist,const f16*Q,const f16*__restrict__ K,const f16*__restrict__ V,f16*O,f16*part,float*lseb,const float*gain,char*shm,const int w0,unsigned*pend){
  __builtin_assume((unsigned)w0<8u);
  int wid_=w0; asm volatile("":"+s"(wid_)); __builtin_assume((unsigned)wid_<8u);
  const int tid=tid_of(wid_),lane=tid&63,r32=lane&31,hi=lane>>5; const int wid=wid_;
  const long rowbase=(long)b*SEQ; const int q0=kb*QB;
  const unsigned lds0=(unsigned)(uintptr_t)shm;
  float*wsf=(float*)(shm+LDS_WS)+wid*64;
  int*entl=(int*)(shm+LDS_KS)+wid*128;
  const int ngrp=(MODE==1)?((r1-r0+31)>>5):8;
  const int gw=(MODE==0)?((wid<4)?wid:11-wid):wid, tmax=(MODE==0)?(gw>>1):3;
  {
    const f16*kptr=K+rowbase*PITCH+h*D+(long)lane*PITCH+wid*8+(long)(4*kb)*KVBLK*PITCH;
    const f16*vptr=V+rowbase*PITCH+h*D+(long)(16*(wid&3)+(lane>>2))*PITCH+(wid>>2)*32+(lane&3)*8+(long)(4*kb)*KVBLK*PITCH;
    const unsigned kdst=lds0+LDS_K+wid*1024, vdst=lds0+LDS_V+wid*1024;
    #pragma unroll
    for(int t=0;t<4;++t){ glds16(kptr,(unsigned)__builtin_amdgcn_readfirstlane(kdst+t*SLOTB)); glds16(vptr,(unsigned)__builtin_amdgcn_readfirstlane(vdst+t*SLOTB)); kptr+=(long)KVBLK*PITCH; vptr+=(long)KVBLK*PITCH; } }
  if(MODE==1){
    #pragma unroll
    for(int gi=0;gi<4;++gi){ if(hi==0){ int idx=r0+32*(wid+8*gi)+r32; const bool ok=idx<r1; idx=ok?idx:r0;
        int e=((const GAS int*)alist)[(size_t)((b*8+h)*16+kb)*4096+idx]&0x3fff; if(!ok)e|=(int)0x80000000; entl[gi*32+r32]=e; } }
    asm volatile("s_waitcnt lgkmcnt(0)":::"memory"); }
  const int vb0=(int)(lds0+LDS_V)+((lane>>4)&1)*32+(lane&3)*8+(4*hi+((lane&15)>>2))*64;
  s16x8 kf[8];
  const lds_cptr shm3=(lds_cptr)shm; const lds_cptr kp0=shm3+LDS_K+hi*1024+r32*16; const lds_cptr vp0=shm3+LDS_V+((lane>>4)&1)*32+(lane&3)*8+(4*hi+((lane&15)>>2))*64;
  s16x8 qr[4];
  #define LOADQ(gi_) do{ const GAS f16*Qrow_;        \
    if(MODE==1){ const int e_=entl[(gi_)*32+r32]; Qrow_=(const GAS f16*)Q+(rowbase+(e_&4095))*PITCH+h*D; } else Qrow_=(const GAS f16*)Q+(rowbase+q0+gw*QBLK+r32)*PITCH+h*D; \
    _Pragma("unroll") for(int d0=0;d0<4;++d0)qr[d0]=*(const GAS s16x8*)(Qrow_+d0*16+hi*8); }while(0)
  int g=wid, gi=0;
  if(g<ngrp)LOADQ(0);
  asm volatile("s_waitcnt vmcnt(0)\n\ts_barrier":::"memory");
  if(pend!=nullptr&&tid==0)__hip_atomic_fetch_add(pend,1u,__ATOMIC_RELAXED,__HIP_MEMORY_SCOPE_AGENT);
  const int qrel=gw*QBLK+r32;
  #define CMASK(P0,P1,t) do{ if(MODE==0)cmask(P0,P1,(t),qrel,hi); }while(0)
  for(;g<ngrp;g+=8,++gi){
  float mhat=0.f,l_reg=0.f;f32x16 o[2];o[0]=f32x16{};o[1]=f32x16{};f32x16 negm=f32x16{};asm volatile("":"+v"(negm));
  bool resc=false;
  #define START(P0,P1) do{ const float rm=rowmax(P0,P1); resc=false; \
    { const float dl=rm; mhat=fadd_s(mhat,dl); \
      _Pragma("unroll") for(int r=0;r<16;++r){P0[r]=fsub_s(P0[r],dl);P1[r]=fsub_s(P1[r],dl);} \
      _Pragma("unroll") for(int r=0;r<16;++r)negm[r]=-mhat; asm volatile("":"+v"(negm)); } \
    _Pragma("unroll") for(int r=0;r<16;++r)P0[r]=__builtin_amdgcn_exp2f(P0[r]); }while(0)
  #define RESC() do{ if(resc){ asm volatile("s_waitcnt lgkmcnt(0)":::"memory"); \
      _Pragma("unroll") for(int d_=0;d_<2;++d_) _Pragma("unroll") for(int r=0;r<16;++r)o[d_][r]*=wsf[crow(r,hi)]; } }while(0)
  f32x16 pA0,pA1,pB0,pB1;
  qkt(pA0,pA1,kp0,qr,negm);asm volatile("s_nop 15\n\ts_nop 7":"+v"(pA0),"+v"(pA1));CMASK(pA0,pA1,0);
  START(pA0,pA1);
  _Pragma("unroll") for(int r=0;r<16;++r)pA1[r]=__builtin_amdgcn_exp2f(pA1[r]);
  kload8(kf,kp0+SLOTB);
  s16x4 vlo[8],vhi[8]; u32x4 pw0,pw1,pw2,pw3;
  #define PKW(P,B) cvtpk_s(P[B],P[B+1])
  #define PAF(k) __builtin_bit_cast(s16x8,pw##k)
  #define VFR(i) (s16x8){vlo[i][0],vlo[i][1],vlo[i][2],vlo[i][3],vhi[i][0],vhi[i][1],vhi[i][2],vhi[i][3]}
  #define PIN(x) asm volatile("":"+v"(x))
  #define MX3(a,b,c) __builtin_fmaxf(__builtin_fmaxf((a),(b)),(c))
  #define GAPA(MF,A0,A1,A2,A3,W0,W1,PW) do{ MF; sacc+=A0; sacc+=A1; sacc+=A2; sacc+=A3; PIN(sacc); W0; W1; PIN(PW); SBAR(); }while(0)
  #define EX(v) __builtin_amdgcn_exp2f(v)
  #define GAPB(MF,X,B) do{ MF; X[B]=EX(X[B]); X[B+1]=EX(X[B+1]); X[B+2]=EX(X[B+2]); X[B+3]=EX(X[B+3]); PIN(X); SBAR(); }while(0)
  #define VRD(i) do{ vlo[i]=vtr(vp_+(((i)>>2)*4096+((i)&3)*1024)); vhi[i]=vtr(vp_+(((i)>>2)*4096+((i)&3)*1024+512)); }while(0)
  #define KRD(G,j,t_) do{ if(G){ kload2(kf,kp0+((((t_)+1)&3)*SLOTB),j); SBAR(); } }while(0)
  #define STEP(C0,C1,P0,P1,t,GL) do{ SBAR(); \
    const lds_cptr vp_=vp0+(((t)-1)*SLOTB); \
    VRD(0); SBAR(); float sacc=(P0[0]+P0[1]); \
    GAPA(C0=MF32(kf[0],qr[0],negm), P0[2],P0[3],P0[4],P0[5],     pw0[0]=PKW(P0,0), pw0[1]=PKW(P0,2), pw0); \
    VRD(4); SBAR(); GAPA(C1=MF32(kf[1],qr[0],negm), P0[6],P0[7],P0[8],P0[9],     pw0[2]=PKW(P0,4), pw0[3]=PKW(P0,6), pw0); \
    VRD(1); SBAR(); GAPA(C0=MF32(kf[2],qr[1],C0),   P0[10],P0[11],P0[12],P0[13], pw1[0]=PKW(P0,8), pw1[1]=PKW(P0,10), pw1); \
    VRD(5); SBAR(); GAPA(C1=MF32(kf[3],qr[1],C1),   P0[14],P0[15],P1[0],P1[1],   pw1[2]=PKW(P0,12),pw1[3]=PKW(P0,14), pw1); \
    VRD(2); SBAR(); GAPA(C0=MF32(kf[4],qr[2],C0),   P1[2],P1[3],P1[4],P1[5],     pw2[0]=PKW(P1,0), pw2[1]=PKW(P1,2), pw2); \
    VRD(6); SBAR(); GAPA(C1=MF32(kf[5],qr[2],C1),   P1[6],P1[7],P1[8],P1[9],     pw2[2]=PKW(P1,4), pw2[3]=PKW(P1,6), pw2); \
    VRD(3); SBAR(); GAPA(C0=MF32(kf[6],qr[3],C0),   P1[10],P1[11],P1[12],P1[13], pw3[0]=PKW(P1,8), pw3[1]=PKW(P1,10), pw3); \
    VRD(7); SBAR(); GAPA(C1=MF32(kf[7],qr[3],C1),   P1[14],P1[15],0.f,0.f,       pw3[2]=PKW(P1,12),pw3[3]=PKW(P1,14), pw3); \
    l_reg+=sacc; \
    CMASK(C0,C1,t); \
    { float a=MX3(C0[0],C0[1],C1[0]),b=MX3(C0[2],C0[3],C1[1]); a=MX3(a,C1[2],C1[3]); \
      _Pragma("unroll") for(int r=4;r<16;r+=4){a=MX3(a,C0[r],C0[r+1]);b=MX3(b,C0[r+2],C0[r+3]);a=MX3(a,C1[r],C1[r+1]);b=MX3(b,C1[r+2],C1[r+3]);} \
      float rm=__builtin_fmaxf(a,b); { auto rr=__builtin_amdgcn_permlane32_swap(__float_as_uint(rm),__float_as_uint(rm),false,false); rm=__builtin_fmaxf(__uint_as_float(rr[0]),__uint_as_float(rr[1])); } \
      resc=false; \
      if(__builtin_expect(__any(rm>(float)THRL),0)){ const float dl=__builtin_fmaxf(rm,0.f); mhat+=dl; \
        _Pragma("unroll") for(int r=0;r<16;++r){C0[r]-=dl;C1[r]-=dl;} \
        { const float nv_=-mhat; _Pragma("unroll") for(int r=0;r<16;++r)negm[r]=nv_; } asm volatile("":"+v"(negm)); \
        const float f=__builtin_amdgcn_exp2f(-dl); l_reg*=f; if(hi==0)wsf[r32]=f; resc=true; } } \
    SBAR(); \
    GAPB(o[0]=MF32(PAF(0),VFR(0),o[0]), C0,0); \
    GAPB(o[1]=MF32(PAF(0),VFR(4),o[1]), C0,4); \
    KRD(GL,0,t); GAPB(o[0]=MF32(PAF(1),VFR(1),o[0]), C0,8); \
    KRD(GL,1,t); GAPB(o[1]=MF32(PAF(1),VFR(5),o[1]), C0,12); \
    KRD(GL,2,t); GAPB(o[0]=MF32(PAF(2),VFR(2),o[0]), C1,0); \
    KRD(GL,3,t); GAPB(o[1]=MF32(PAF(2),VFR(6),o[1]), C1,4); \
    GAPB(o[0]=MF32(PAF(3),VFR(3),o[0]), C1,8); \
    GAPB(o[1]=MF32(PAF(3),VFR(7),o[1]), C1,12); \
    }while(0)
  #define FIN(P0,P1,SLOT_) do{ float sacc=P0[0]+P0[1]; _Pragma("unroll") for(int r=2;r<16;++r)sacc+=P0[r]; _Pragma("unroll") for(int r=0;r<16;++r)sacc+=P1[r]; l_reg+=sacc; \
    pw0=(u32x4){PKW(P0,0),PKW(P0,2),PKW(P0,4),PKW(P0,6)};pw1=(u32x4){PKW(P0,8),PKW(P0,10),PKW(P0,12),PKW(P0,14)};pw2=(u32x4){PKW(P1,0),PKW(P1,2),PKW(P1,4),PKW(P1,6)};pw3=(u32x4){PKW(P1,8),PKW(P1,10),PKW(P1,12),PKW(P1,14)}; \
    SBAR(); pv(o,vb0+(SLOT_),PAF(0),PAF(1),PAF(2),PAF(3)); }while(0)
  if(tmax>=1){ STEP(pB0,pB1,pA0,pA1,1,true); RESC(); }
  if(tmax>=2){ STEP(pA0,pA1,pB0,pB1,2,true); RESC(); }
  if(tmax>=3){ STEP(pB0,pB1,pA0,pA1,3,false); RESC(); }
  if(tmax&1){ pA0=pB0; pA1=pB1; }
  FIN(pA0,pA1,tmax*SLOTB);
  #undef FIN
  #undef PKW
  #undef PAF
  #undef VFR
  #undef PIN
  #undef MX3
  #undef GAPA
  #undef GAPB
  #undef EX
  #undef VRD
  #undef KRD
  #undef STEP
  if(MODE==1&&g+8<ngrp)LOADQ(gi+1);
  unsigned zz_=0u; asm volatile("":"+v"(zz_)); const int lane_e=(lane+(int)zz_)&63, r32e=lane_e&31, hie=lane_e>>5;
  {auto rr=__builtin_amdgcn_permlane32_swap(__float_as_uint(l_reg),__float_as_uint(l_reg),false,false);l_reg=__uint_as_float(rr[0])+__uint_as_float(rr[1]);}
  const float lse_=mhat+__builtin_amdgcn_logf(l_reg);
  if(hie==0){ wsf[32+r32e]=__builtin_amdgcn_rcpf(l_reg); wsf[r32e]=lse_; }
  u32x4 pj[2][2][3]; float lj[2][2][3];
  const unsigned prow0=(unsigned)(rowbase+q0+gw*QBLK)+(unsigned)(lane_e>>3);
  if(MODE==0){
    #pragma unroll
    for(int hf=0;hf<2;++hf)
      #pragma unroll
      for(int i=0;i<2;++i)
        #pragma unroll
        for(int j=0;j<3;++j){ const unsigned rg=(prow0+hf*16+i*8)*8u+(unsigned)h; pj[hf][i][j]=*(const GAS u32x4*)((const GAS f16*)part+(size_t)(rg*3u+j)*64+(lane_e&7)*8); lj[hf][i][j]=((const GAS float*)lseb)[rg*4u+j]; } }
  asm volatile("s_waitcnt lgkmcnt(0)":::"memory");
  float rli[16];
  #pragma unroll
  for(int r=0;r<16;++r)rli[r]=wsf[32+crow(r,hie)];
  f16*Ow=O+(rowbase+q0+gw*QBLK)*OPITCH+h*D;
  { float*stg=(float*)(shm+LDS_OST)+wid*1024;
    #pragma unroll
    for(int half=0;half<2;++half){
      #pragma unroll
      for(int r=0;r<16;++r){ const int orow=crow(r,hie);
        if((orow>>4)==half){
          #pragma unroll
          for(int d0=0;d0<2;++d0)stg[(orow&15)*64+d0*32+r32e]=o[d0][r]*rli[r]; } }
      asm volatile("s_waitcnt lgkmcnt(0)":::"memory");
      #pragma unroll
      for(int i=0;i<2;++i){ const int row=i*8+(lane_e>>3),ch=lane_e&7; f32x4 v0=*(const f32x4*)(stg+row*64+ch*8),v1=*(const f32x4*)(stg+row*64+ch*8+4);
        if(MODE==1){ const int e=entl[gi*32+half*16+row];
          if(e>=0){ const unsigned rg=((unsigned)rowbase+(unsigned)(e&4095))*8u+(unsigned)h, sj=(unsigned)(e>>12)&3u;
            u32x4 w; w.x=pk2h(v0[0],v0[1]); w.y=pk2h(v0[2],v0[3]); w.z=pk2h(v1[0],v1[1]); w.w=pk2h(v1[2],v1[3]);
            st16_wt(part,(rg*3u+sj)*128u+(unsigned)ch*16u,w);
            if(ch==0)st4_wt(lseb+rg*4u+sj,wsf[half*16+row]); } }
        else{
          { const float lo=wsf[half*16+row];
            float M=lo;
            #pragma unroll
            for(int j=0;j<3;++j)M=__builtin_fmaxf(M,lj[half][i][j]);
            const float w0_=__builtin_amdgcn_exp2f(lo-M); float den=w0_; v0*=w0_; v1*=w0_;
            #pragma unroll
            for(int j=0;j<3;++j){ const float wj=__builtin_amdgcn_exp2f(lj[half][i][j]-M); den+=wj;
              const f16x8 pv_=__builtin_bit_cast(f16x8,pj[half][i][j]);
              v0[0]+=wj*(float)pv_[0]; v0[1]+=wj*(float)pv_[1]; v0[2]+=wj*(float)pv_[2]; v0[3]+=wj*(float)pv_[3];
              v1[0]+=wj*(float)pv_[4]; v1[1]+=wj*(float)pv_[5]; v1[2]+=wj*(float)pv_[6]; v1[3]+=wj*(float)pv_[7]; }
            const float rd=1.f/den; v0*=rd; v1*=rd; }
          float ss=(v0[0]*v0[0]+v0[1]*v0[1])+(v0[2]*v0[2]+v0[3]*v0[3])+(v1[0]*v1[0]+v1[1]*v1[1])+(v1[2]*v1[2]+v1[3]*v1[3]);
          ss = xsum<1>(ss); ss = xsum<2>(ss); ss = xsum<4>(ss);
          const float rs=1.f/sqrtf(ss*(1.f/64.f)+EPS);
          const f32x4 g0=*(const GAS f32x4*)((const GAS float*)gain+h*D+ch*8),g1=*(const GAS f32x4*)((const GAS float*)gain+h*D+ch*8+4);
          u32x4 w; w.x=pk2h(v0[0]*rs*g0[0],v0[1]*rs*g0[1]); w.y=pk2h(v0[2]*rs*g0[2],v0[3]*rs*g0[3]); w.z=pk2h(v1[0]*rs*g1[0],v1[1]*rs*g1[1]); w.w=pk2h(v1[2]*rs*g1[2],v1[3]*rs*g1[3]);
          *(GAS u32x4*)((GAS f16*)Ow+(long)(half*16+row)*OPITCH+ch*8)=w; } }
      asm volatile("s_waitcnt lgkmcnt(0)":::"memory"); } }
  #undef START
  #undef RESC
  }
  asm volatile("s_waitcnt lgkmcnt(0)\n\ts_barrier":::"memory");
  #undef LOADQ
  #undef CMASK
}
#undef SBAR
#undef WAIT_BAR
#undef MF32
}


namespace mobad {
using s16x8=__attribute__((ext_vector_type(8)))short;
using s16x4=__attribute__((ext_vector_type(4)))short;
using f32x16=__attribute__((ext_vector_type(16)))float;
constexpr int D=64, PITCH=NPROJ, OPITCH=DM;
constexpr int NW=8,QBLK=32,QB=QBLK*NW,KVBLK=64;
__device__ __forceinline__ int crow(int r,int hi){return (r&3)+8*(r>>2)+4*hi;}
#define SBAR() __builtin_amdgcn_sched_barrier(0)
#define MF32(a,b,c) __builtin_amdgcn_mfma_f32_32x32x16_f16(__builtin_bit_cast(f16x8,(a)),__builtin_bit_cast(f16x8,(b)),(c),0,0,0)
__device__ __forceinline__ void cmask(f32x16&p0,f32x16&p1,int jb,int qrel,int hi){
  const float NEG=-INFINITY; int kb=64*jb+4*hi;
  #pragma unroll
  for(int r=0;r<16;++r){int kv=kb+(r&3)+8*(r>>2); if(kv>qrel)p0[r]=NEG; if(kv+32>qrel)p1[r]=NEG;}
}
constexpr int NSLOT=3, SLOTB=8192;
constexpr int LDS_K=0, LDS_V=NSLOT*SLOTB, LDS_WS=2*NSLOT*SLOTB, LDS_OST=LDS_WS+NW*64*4, LDS_SEL=LDS_OST+NW*4096, LDS_KS=LDS_SEL+1024, LDS_BYTES_A=LDS_KS+4096;
__device__ __forceinline__ void glds16(const void*gsrc,unsigned lds_dst){unsigned keep;
  asm volatile("s_mov_b32 %0, m0\n\ts_mov_b32 m0, %2\n\ts_nop 0\n\tglobal_load_lds_dwordx4 %1, off\n\ts_mov_b32 m0, %0":"=&s"(keep):"v"(gsrc),"s"(lds_dst):"memory");}
__device__ __forceinline__ float max3f(float a,float b,float c){float r;asm("v_max3_f32 %0, %1, %2, %3":"=v"(r):"v"(a),"v"(b),"v"(c));return r;}
__device__ __forceinline__ float max2f(float a,float b){float r;asm("v_max_f32_e32 %0, %1, %2":"=v"(r):"v"(a),"v"(b));return r;}
__device__ __forceinline__ float fadd_s(float a,float b){float r;asm("v_add_f32_e32 %0, %1, %2":"=v"(r):"v"(a),"v"(b));return r;}
__device__ __forceinline__ float fsub_s(float a,float b){float r;asm("v_sub_f32_e32 %0, %1, %2":"=v"(r):"v"(a),"v"(b));return r;}
__device__ __forceinline__ unsigned cvtpk_s(float lo,float hi){return __builtin_bit_cast(unsigned,__builtin_amdgcn_cvt_pkrtz(lo,hi));}
#define WAIT_BAR(N) asm volatile("s_waitcnt vmcnt(" #N ") lgkmcnt(0)\n\ts_barrier":::"memory")
__device__ __forceinline__ void qkt(f32x16&p0,f32x16&p1,const char*Kslot,const s16x8*qr,const f32x16&negm,int r32,int hi){
  const char*kb=Kslot+hi*1024+r32*16;
  #pragma unroll
  for(int d0=0;d0<4;++d0){
    const s16x8 b0=*reinterpret_cast<const s16x8*>(kb+d0*2048);
    const s16x8 b1=*reinterpret_cast<const s16x8*>(kb+d0*2048+512);
    if(d0==0){p0=MF32(b0,qr[0],negm);p1=MF32(b1,qr[0],negm);}
    else{p0=MF32(b0,qr[d0],p0);p1=MF32(b1,qr[d0],p1);}}
}
typedef __attribute__((address_space(3))) const char* lds_cptr;
typedef short v4i16_t __attribute__((ext_vector_type(4)));
__device__ __forceinline__ void kload8(s16x8*kf,lds_cptr kp){
  kf[0]=*(const __attribute__((address_space(3))) s16x8*)(kp);      kf[1]=*(const __attribute__((address_space(3))) s16x8*)(kp+512);
  kf[2]=*(const __attribute__((address_space(3))) s16x8*)(kp+2048); kf[3]=*(const __attribute__((address_space(3))) s16x8*)(kp+2560);
  kf[4]=*(const __attribute__((address_space(3))) s16x8*)(kp+4096); kf[5]=*(const __attribute__((address_space(3))) s16x8*)(kp+4608);
  kf[6]=*(const __attribute__((address_space(3))) s16x8*)(kp+6144); kf[7]=*(const __attribute__((address_space(3))) s16x8*)(kp+6656);
}
__device__ __forceinline__ void kload2(s16x8*kf,lds_cptr kp,int j){ kf[2*j]=*(const __attribute__((address_space(3))) s16x8*)(kp+j*2048); kf[2*j+1]=*(const __attribute__((address_space(3))) s16x8*)(kp+j*2048+512); }
__device__ __forceinline__ s16x4 vtr(lds_cptr p){ return __builtin_bit_cast(s16x4,__builtin_amdgcn_ds_read_tr16_b64_v4i16((__attribute__((address_space(3))) v4i16_t*)p)); }
__device__ __forceinline__ float rowmax(const f32x16&p0,const f32x16&p1){
  float a=max3f(p0[0],p0[1],p1[0]),b=max3f(p0[2],p0[3],p1[1]);a=max3f(a,p1[2],p1[3]);
  #pragma unroll
  for(int r=4;r<16;r+=4){a=max3f(a,p0[r],p0[r+1]);b=max3f(b,p0[r+2],p0[r+3]);a=max3f(a,p1[r],p1[r+1]);b=max3f(b,p1[r+2],p1[r+3]);}
  const float m=max2f(a,b);
  auto rr=__builtin_amdgcn_permlane32_swap(__float_as_uint(m),__float_as_uint(m),false,false);
  return max2f(__uint_as_float(rr[0]),__uint_as_float(rr[1]));
}
__device__ __forceinline__ void pv(f32x16*o,int vb,s16x8 pa0,s16x8 pa1,s16x8 pa2,s16x8 pa3){
  #pragma unroll
  for(int d0=0;d0<2;++d0){s16x4 lo[4],hi[4];
    #pragma unroll
    for(int ks=0;ks<4;++ks){
      asm volatile("ds_read_b64_tr_b16 %0,%1 offset:%c2":"=&v"(lo[ks]):"v"(vb),"i"(d0*4096+ks*1024):"memory");
      asm volatile("ds_read_b64_tr_b16 %0,%1 offset:%c2":"=&v"(hi[ks]):"v"(vb),"i"(d0*4096+ks*1024+512):"memory");}
    asm volatile("s_waitcnt lgkmcnt(0)":::"memory");SBAR();
    #define PK(k) (s16x8){lo[k][0],lo[k][1],lo[k][2],lo[k][3],hi[k][0],hi[k][1],hi[k][2],hi[k][3]}
    o[d0]=MF32(pa0,PK(0),o[d0]);
    o[d0]=MF32(pa1,PK(1),o[d0]);
    o[d0]=MF32(pa2,PK(2),o[d0]);
    o[d0]=MF32(pa3,PK(3),o[d0]);
    #undef PK
  }
}
__device__ __forceinline__ void sel_unit(int b,int h,int qb,const f16*Q,const float*ksum,char*shm,const int w0){
  const int tid=tid_of(w0);
  const int row=tid>>1, half=tid&1;
  unsigned sel=0u;
  if(qb>0){
    float*ks=(float*)(shm+LDS_KS);
    if(tid<256)*(f32x4*)(ks+4*tid)=*(const f32x4*)(ksum+(size_t)((b*8+h)*16)*64+4*tid);
    float qf[32];
    { const f16x8*qp=(const f16x8*)(Q+((long)b*SEQ+qb*QB+row)*PITCH+h*D+32*half);
      #pragma unroll
      for(int i=0;i<4;++i){ const f16x8 t=qp[i];
        #pragma unroll
        for(int j=0;j<8;++j)qf[8*i+j]=(float)t[j]; } }
    asm volatile("s_waitcnt lgkmcnt(0)\n\ts_barrier":::"memory");
    float g[15];
    const float*kp=ks+32*half;
    #pragma unroll
    for(int n=0;n<15;++n){ float s=0.f;
      if(n<qb){
        #pragma unroll
        for(int i=0;i<8;++i){ const f32x4 k4=*(const f32x4*)(kp+n*64+4*i); s+=qf[4*i]*k4[0]+qf[4*i+1]*k4[1]+qf[4*i+2]*k4[2]+qf[4*i+3]*k4[3]; }
        s = xsum<1>(s); }
      g[n]=(n<qb)?s:-INFINITY; }
    #pragma unroll
    for(int r=0;r<3;++r){ float best=-INFINITY; int bi=-1;
      #pragma unroll
      for(int n=0;n<15;++n){ const bool ok=!((sel>>n)&1u)&&g[n]>best; best=ok?g[n]:best; bi=ok?n:bi; }
      if(bi>=0)sel|=1u<<bi; } }
  if(half==0)((unsigned*)(shm+LDS_SEL))[row]=sel;
  asm volatile("s_waitcnt lgkmcnt(0)\n\ts_barrier":::"memory");
}
constexpr float NEGBIG=-1.0e30f;
template<int THRL> __device__ __forceinline__ void attn_unit(int b,int h,int qb,const f16*Q,const f16*__restrict__ K,const f16*__restrict__ V,f16*O,const float*ksum,const float*gain,char*shm,const int w0){
  const int tid=tid_of(w0),lane=tid&63,r32=lane&31,hi=lane>>5; const int wid=w0;
  const long rowbase=(long)b*SEQ; const int q0=qb*QB;
  const f16*Qw=Q+(rowbase+q0+wid*QBLK)*PITCH+h*D;
  const f16*Kh=K+rowbase*PITCH+h*D,*Vh=V+rowbase*PITCH+h*D;
  const unsigned lds0=(unsigned)(uintptr_t)shm;
  float*wsf=(float*)(shm+LDS_WS)+wid*64;
  const f16*kptr=Kh+(long)lane*PITCH+wid*8+(long)(4*qb)*KVBLK*PITCH;
  const f16*vptr=Vh+(long)(16*(wid&3)+(lane>>2))*PITCH+(wid>>2)*32+(lane&3)*8+(long)(4*qb)*KVBLK*PITCH;
  const unsigned kdst=lds0+LDS_K+wid*1024, vdst=lds0+LDS_V+wid*1024;
  const long tstep_=(long)KVBLK*PITCH, twrap_=-(long)(4*qb+3)*KVBLK*PITCH;
  #define DMA_K(t,slot) do{ glds16(kptr,(unsigned)__builtin_amdgcn_readfirstlane(kdst+(slot))); kptr+=(((t)==3)?twrap_:tstep_); }while(0)
  #define DMA_V(t,slot) do{ glds16(vptr,(unsigned)__builtin_amdgcn_readfirstlane(vdst+(slot))); vptr+=(((t)==3)?twrap_:tstep_); }while(0)
  const int vb0=(int)(lds0+LDS_V)+((lane>>4)&1)*32+(lane&3)*8+(4*hi+((lane&15)>>2))*64;
  const char*Kbase=shm+LDS_K; s16x8 kf[8];
  const lds_cptr shm3=(lds_cptr)shm; const lds_cptr kp0=shm3+LDS_K+hi*1024+r32*16; const lds_cptr vp0=shm3+LDS_V+((lane>>4)&1)*32+(lane&3)*8+(4*hi+((lane&15)>>2))*64;
  const int NT=4*qb+4;
  DMA_K(0,0);DMA_V(0,0);DMA_K(1,SLOTB);
  s16x8 qr[4];
  #pragma unroll
  for(int d0=0;d0<4;++d0)qr[d0]=*reinterpret_cast<const s16x8*>(&Qw[(long)r32*PITCH+d0*16+hi*8]);
  const unsigned sel=((const unsigned*)(shm+LDS_SEL))[wid*QBLK+r32];
  bool msk=false;
  float mhat=0.f,l_reg=0.f;f32x16 o[2];o[0]=f32x16{};o[1]=f32x16{};f32x16 negm=f32x16{};asm volatile("":"+v"(negm));
  const int qrel=wid*QBLK+r32;
  #define CMASK(P0,P1,t) do{ if((t)<4)cmask(P0,P1,(t),qrel,hi); }while(0)
  #define SELM(t) do{ if((t)>=4&&(((t)&3)==0)){ msk=!((sel>>(((t)-4)>>2))&1u); const float nv_=msk?NEGBIG:-mhat; _Pragma("unroll") for(int r=0;r<16;++r)negm[r]=nv_; asm volatile("":"+v"(negm)); } }while(0)
  bool resc=false;
  #define START(P0,P1) do{ const float rm=rowmax(P0,P1); resc=false; \
    { const float dl=rm; mhat=fadd_s(mhat,dl); \
      _Pragma("unroll") for(int r=0;r<16;++r){P0[r]=fsub_s(P0[r],dl);P1[r]=fsub_s(P1[r],dl);} \
      _Pragma("unroll") for(int r=0;r<16;++r)negm[r]=-mhat; asm volatile("":"+v"(negm)); } \
    _Pragma("unroll") for(int r=0;r<16;++r)P0[r]=__builtin_amdgcn_exp2f(P0[r]); }while(0)
  #define RESC() do{ if(resc){ asm volatile("s_waitcnt lgkmcnt(0)":::"memory"); \
      _Pragma("unroll") for(int d_=0;d_<2;++d_) _Pragma("unroll") for(int r=0;r<16;++r)o[d_][r]*=wsf[crow(r,hi)]; } }while(0)
  f32x16 pA0,pA1,pB0,pB1;
  int sl_prev=0,sl_cur=0,sl_next=SLOTB;
  #define ROT() do{sl_prev=sl_cur;sl_cur=sl_next;sl_next=(sl_next==(NSLOT-1)*SLOTB)?0:sl_next+SLOTB;}while(0)
  DMA_K(2,2*SLOTB);
  WAIT_BAR(3);
  qkt(pA0,pA1,Kbase,qr,negm,r32,hi);asm volatile("s_nop 15\n\ts_nop 7":"+v"(pA0),"+v"(pA1));CMASK(pA0,pA1,0);
  START(pA0,pA1);
  _Pragma("unroll") for(int r=0;r<16;++r)pA1[r]=__builtin_amdgcn_exp2f(pA1[r]);
  WAIT_BAR(0);
  DMA_K(3,0);DMA_V(1,SLOTB);
  ROT();
  kload8(kf,kp0+sl_cur);
  WAIT_BAR(2);
  s16x4 vlo[8],vhi[8]; u32x4 pw0,pw1,pw2,pw3;
  #define PKW(P,B) cvtpk_s(P[B],P[B+1])
  #define PAF(k) __builtin_bit_cast(s16x8,pw##k)
  #define VFR(i) (s16x8){vlo[i][0],vlo[i][1],vlo[i][2],vlo[i][3],vhi[i][0],vhi[i][1],vhi[i][2],vhi[i][3]}
  #define PIN(x) asm volatile("":"+v"(x))
  #define MX3(a,b,c) __builtin_fmaxf(__builtin_fmaxf((a),(b)),(c))
  #define GAPA(MF,A0,A1,A2,A3,W0,W1,PW) do{ MF; sacc+=A0; sacc+=A1; sacc+=A2; sacc+=A3; PIN(sacc); W0; W1; PIN(PW); SBAR(); }while(0)
  #define EX(v) __builtin_amdgcn_exp2f(v)
  #define GAPB(MF,X,B) do{ MF; X[B]=EX(X[B]); X[B+1]=EX(X[B+1]); X[B+2]=EX(X[B+2]); X[B+3]=EX(X[B+3]); PIN(X); SBAR(); }while(0)
  #define VRD(i) do{ vlo[i]=vtr(vp_+(((i)>>2)*4096+((i)&3)*1024)); vhi[i]=vtr(vp_+(((i)>>2)*4096+((i)&3)*1024+512)); }while(0)
  #define KRD(G,j) do{ if(G){ kload2(kf,kp0+sl_next,j); SBAR(); } }while(0)
  #define STEP(C0,C1,P0,P1,t,GK,GV,GL) do{ SELM(t); SBAR(); \
    const lds_cptr vp_=vp0+sl_prev; \
    VRD(0); SBAR(); float sacc=(P0[0]+P0[1]); \
    GAPA(C0=MF32(kf[0],qr[0],negm), P0[2],P0[3],P0[4],P0[5],     pw0[0]=PKW(P0,0), pw0[1]=PKW(P0,2), pw0); \
    VRD(4); SBAR(); GAPA(C1=MF32(kf[1],qr[0],negm), P0[6],P0[7],P0[8],P0[9],     pw0[2]=PKW(P0,4), pw0[3]=PKW(P0,6), pw0); \
    VRD(1); SBAR(); GAPA(C0=MF32(kf[2],qr[1],C0),   P0[10],P0[11],P0[12],P0[13], pw1[0]=PKW(P0,8), pw1[1]=PKW(P0,10), pw1); \
    VRD(5); SBAR(); GAPA(C1=MF32(kf[3],qr[1],C1),   P0[14],P0[15],P1[0],P1[1],   pw1[2]=PKW(P0,12),pw1[3]=PKW(P0,14), pw1); \
    VRD(2); SBAR(); GAPA(C0=MF32(kf[4],qr[2],C0),   P1[2],P1[3],P1[4],P1[5],     pw2[0]=PKW(P1,0), pw2[1]=PKW(P1,2), pw2); \
    VRD(6); SBAR(); GAPA(C1=MF32(kf[5],qr[2],C1),   P1[6],P1[7],P1[8],P1[9],     pw2[2]=PKW(P1,4), pw2[3]=PKW(P1,6), pw2); \
    VRD(3); SBAR(); GAPA(C0=MF32(kf[6],qr[3],C0),   P1[10],P1[11],P1[12],P1[13], pw3[0]=PKW(P1,8), pw3[1]=PKW(P1,10), pw3); \
    VRD(7); SBAR(); GAPA(C1=MF32(kf[7],qr[3],C1),   P1[14],P1[15],0.f,0.f,       pw3[2]=PKW(P1,12),pw3[3]=PKW(P1,14), pw3); \
    l_reg+=sacc; \
    if(GK){DMA_K((t)+3,sl_cur);} if(GV){DMA_V((t)+1,sl_next);} \
    CMASK(C0,C1,t); \
    { float a=MX3(C0[0],C0[1],C1[0]),b=MX3(C0[2],C0[3],C1[1]); a=MX3(a,C1[2],C1[3]); \
      _Pragma("unroll") for(int r=4;r<16;r+=4){a=MX3(a,C0[r],C0[r+1]);b=MX3(b,C0[r+2],C0[r+3]);a=MX3(a,C1[r],C1[r+1]);b=MX3(b,C1[r+2],C1[r+3]);} \
      float rm=__builtin_fmaxf(a,b); { auto rr=__builtin_amdgcn_permlane32_swap(__float_as_uint(rm),__float_as_uint(rm),false,false); rm=__builtin_fmaxf(__uint_as_float(rr[0]),__uint_as_float(rr[1])); } \
      resc=false; \
      if(__builtin_expect(__any(rm>(float)THRL),0)){ const float dl=__builtin_fmaxf(rm,0.f); mhat+=dl; \
        _Pragma("unroll") for(int r=0;r<16;++r){C0[r]-=dl;C1[r]-=dl;} \
        { const float nv_=msk?NEGBIG:-mhat; _Pragma("unroll") for(int r=0;r<16;++r)negm[r]=nv_; } asm volatile("":"+v"(negm)); \
        const float f=__builtin_amdgcn_exp2f(-dl); l_reg*=f; if(hi==0)wsf[r32]=f; resc=true; } } \
    SBAR(); \
    GAPB(o[0]=MF32(PAF(0),VFR(0),o[0]), C0,0); \
    GAPB(o[1]=MF32(PAF(0),VFR(4),o[1]), C0,4); \
    KRD(GL,0); GAPB(o[0]=MF32(PAF(1),VFR(1),o[0]), C0,8); \
    KRD(GL,1); GAPB(o[1]=MF32(PAF(1),VFR(5),o[1]), C0,12); \
    KRD(GL,2); GAPB(o[0]=MF32(PAF(2),VFR(2),o[0]), C1,0); \
    KRD(GL,3); GAPB(o[1]=MF32(PAF(2),VFR(6),o[1]), C1,4); \
    GAPB(o[0]=MF32(PAF(3),VFR(3),o[0]), C1,8); \
    GAPB(o[1]=MF32(PAF(3),VFR(7),o[1]), C1,12); \
    }while(0)
  int t=1;
  for(;t+5<NT;t+=2){
    STEP(pB0,pB1,pA0,pA1,t,true,true,true);     WAIT_BAR(2); RESC(); ROT();
    STEP(pA0,pA1,pB0,pB1,t+1,true,true,true);   WAIT_BAR(2); RESC(); ROT();
  }
  #define ENDW(tt) do{ if((tt)+3<NT){WAIT_BAR(2);} else if((tt)+2<NT){WAIT_BAR(1);} else {WAIT_BAR(0);} }while(0)
  for(;t+1<NT;t+=2){
    STEP(pB0,pB1,pA0,pA1,t,(t+3<NT),(t+1<NT),(t+1<NT));       ENDW(t);   RESC(); ROT();
    STEP(pA0,pA1,pB0,pB1,t+1,(t+4<NT),(t+2<NT),(t+2<NT));     ENDW(t+1); RESC(); ROT();
  }
  STEP(pB0,pB1,pA0,pA1,NT-1,false,false,false); RESC();
  { float sacc=pB0[0]+pB0[1]; _Pragma("unroll") for(int r=2;r<16;++r)sacc+=pB0[r]; _Pragma("unroll") for(int r=0;r<16;++r)sacc+=pB1[r]; l_reg+=sacc;
    pw0=(u32x4){PKW(pB0,0),PKW(pB0,2),PKW(pB0,4),PKW(pB0,6)};pw1=(u32x4){PKW(pB0,8),PKW(pB0,10),PKW(pB0,12),PKW(pB0,14)};pw2=(u32x4){PKW(pB1,0),PKW(pB1,2),PKW(pB1,4),PKW(pB1,6)};pw3=(u32x4){PKW(pB1,8),PKW(pB1,10),PKW(pB1,12),PKW(pB1,14)};
    SBAR(); pv(o,vb0+sl_cur,PAF(0),PAF(1),PAF(2),PAF(3)); }
  #undef PKW
  #undef PAF
  #undef VFR
  #undef PIN
  #undef MX3
  #undef GAPA
  #undef GAPB
  #undef EX
  #undef VRD
  #undef KRD
  #undef STEP
  #undef ENDW
  {auto rr=__builtin_amdgcn_permlane32_swap(__float_as_uint(l_reg),__float_as_uint(l_reg),false,false);l_reg=__uint_as_float(rr[0])+__uint_as_float(rr[1]);}
  if(hi==0)wsf[32+r32]=l_reg;asm volatile("s_waitcnt lgkmcnt(0)":::"memory");
  float rli[16];
  #pragma unroll
  for(int r=0;r<16;++r)rli[r]=__builtin_amdgcn_rcpf(wsf[32+crow(r,hi)]);
  f16*Ow=O+(rowbase+q0+wid*QBLK)*OPITCH+h*D;
  { float*stg=(float*)(shm+LDS_OST)+wid*1024;
    #pragma unroll
    for(int half=0;half<2;++half){
      #pragma unroll
      for(int r=0;r<16;++r){ const int orow=crow(r,hi);
        if((orow>>4)==half){
          #pragma unroll
          for(int d0=0;d0<2;++d0)stg[(orow&15)*64+d0*32+r32]=o[d0][r]*rli[r]; } }
      asm volatile("s_waitcnt lgkmcnt(0)":::"memory");
      #pragma unroll
      for(int i=0;i<2;++i){ const int row=i*8+(lane>>3),ch=lane&7; const f32x4 v0=*(const f32x4*)(stg+row*64+ch*8),v1=*(const f32x4*)(stg+row*64+ch*8+4);
        float ss=(v0[0]*v0[0]+v0[1]*v0[1])+(v0[2]*v0[2]+v0[3]*v0[3])+(v1[0]*v1[0]+v1[1]*v1[1])+(v1[2]*v1[2]+v1[3]*v1[3]);
        ss = xsum<1>(ss); ss = xsum<2>(ss); ss = xsum<4>(ss);
        const float rs=1.f/sqrtf(ss*(1.f/64.f)+EPS);
        const f32x4 g0=*(const f32x4*)(gain+h*D+ch*8),g1=*(const f32x4*)(gain+h*D+ch*8+4);
        u32x4 w; w.x=pk2h(v0[0]*rs*g0[0],v0[1]*rs*g0[1]); w.y=pk2h(v0[2]*rs*g0[2],v0[3]*rs*g0[3]); w.z=pk2h(v1[0]*rs*g1[0],v1[1]*rs*g1[1]); w.w=pk2h(v1[2]*rs*g1[2],v1[3]*rs*g1[3]);
        *(u32x4*)(Ow+(long)(half*16+row)*OPITCH+ch*8)=w; }
      asm volatile("s_waitcnt lgkmcnt(0)":::"memory"); } }
  asm volatile("s_waitcnt lgkmcnt(0)\n\ts_barrier":::"memory");
  #undef DMA_K
  #undef DMA_V
  #undef CMASK
  #undef SELM
  #undef START
  #undef RESC
  #undef ROT
}
#undef SBAR
#undef WAIT_BAR
#undef MF32
}


namespace mlstm {
constexpr int L=64, DH=128, NCH=16;
constexpr int RS1=136, RS2=72;
#define ML_BAR() asm volatile("s_waitcnt lgkmcnt(0)\n\ts_barrier" ::: "memory")
#define MF16(a,b,c) __builtin_amdgcn_mfma_f32_16x16x32_f16((a),(b),(c),0,0,0)
typedef short v4i16_t __attribute__((ext_vector_type(4)));
__device__ __forceinline__ f16x4 trd(const LAS f16* p){ return __builtin_bit_cast(f16x4,__builtin_amdgcn_ds_read_tr16_b64_v4i16((LAS v4i16_t*)p)); }
__device__ __forceinline__ f16x8 cat8(f16x4 a,f16x4 c){ return (f16x8){a[0],a[1],a[2],a[3],c[0],c[1],c[2],c[3]}; }
__device__ __forceinline__ float frcp(float x){ return __builtin_amdgcn_rcpf(x); }
struct Glob { f16* cloc; f16* cprev; float* nloc; float* nprev; float* sa; float* smloc; float* smprev;
              f16* qkc;
              float* gcolf; float* gcum; float* gpm;
              float* sca; float* scpm; };

__device__ __forceinline__ void prep(int b,int sc,const Glob G,const f16*proj,const float*gates,const float*conv_w,const float*conv_b,const int w0,unsigned*pend){
  const int tid=tid_of(w0),lane=tid&63,wid=w0;
  const int cg=tid&127,tq=tid>>7; const long rowbase=(long)b*SEQ; const int t0=sc*L+16*tq;
  const GAS f16*src=(const GAS f16*)proj+C_QM+8*cg;
  f16x8 raw[19];
  #pragma unroll
  for(int i=0;i<19;++i){ const int t_=t0-3+i; raw[i]=(t_>=0)?*(const GAS f16x8*)(src+(rowbase+t_)*NPROJ):(f16x8){0,0,0,0,0,0,0,0}; }
  float cw[4][8],cb[8];
  #pragma unroll
  for(int tp=0;tp<4;++tp){ const f32x4 a=*(const GAS f32x4*)((const GAS float*)conv_w+tp*1024+8*cg),c=*(const GAS f32x4*)((const GAS float*)conv_w+tp*1024+8*cg+4);
    cw[tp][0]=a[0];cw[tp][1]=a[1];cw[tp][2]=a[2];cw[tp][3]=a[3];cw[tp][4]=c[0];cw[tp][5]=c[1];cw[tp][6]=c[2];cw[tp][7]=c[3]; }
  { const f32x4 a=*(const GAS f32x4*)((const GAS float*)conv_b+8*cg),c=*(const GAS f32x4*)((const GAS float*)conv_b+8*cg+4); cb[0]=a[0];cb[1]=a[1];cb[2]=a[2];cb[3]=a[3];cb[4]=c[0];cb[5]=c[1];cb[6]=c[2];cb[7]=c[3]; }
  if(pend!=nullptr){ asm volatile("s_waitcnt vmcnt(0)\n\ts_barrier":::"memory"); if(tid==0)__hip_atomic_fetch_add(pend,1u,__ATOMIC_RELAXED,__HIP_MEMORY_SCOPE_AGENT); }
  if(wid<4){ const int hm=wid; const long row=rowbase+sc*L+lane;
    const float ig=((const GAS float*)gates)[row*8+hm],fg=((const GAS float*)gates)[row*8+4+hm];
    const float logf=fminf(fg,0.f)-log1pf(__expf(-fabsf(fg)));
    float cum=logf;
    #pragma unroll
    for(int o=1;o<64;o<<=1){ const float tmp=__builtin_bit_cast(float,__builtin_amdgcn_ds_bpermute((lane-o)<<2,__builtin_bit_cast(int,cum))); if(lane>=o)cum+=tmp; }
    const float colf=ig-cum; float pm=colf;
    #pragma unroll
    for(int o=1;o<64;o<<=1){ const float tmp=__builtin_bit_cast(float,__builtin_amdgcn_ds_bpermute((lane-o)<<2,__builtin_bit_cast(int,pm))); if(lane>=o)pm=fmaxf(pm,tmp); }
    const size_t gi=(size_t)(b*4+hm)*SEQ+sc*L+lane;
    st4_wt(G.gcolf+gi,colf); st4_wt(G.gcum+gi,cum); st4_wt(G.gpm+gi,pm);
    if(lane==63){ st4_wt(G.sca+(b*4+hm)*64+sc,cum); st4_wt(G.scpm+(b*4+hm)*64+sc,pm); } }
  const float ksc=(cg>=64)?0.08838834764831845f:1.f;
  const unsigned dsto=(unsigned)(((rowbase+t0)*1024+8*cg)*2);
  #pragma unroll
  for(int i=0;i<16;++i){ float o[8];
    #pragma unroll
    for(int j=0;j<8;++j){ float v=cb[j];
      #pragma unroll
      for(int tp=0;tp<4;++tp)v+=cw[tp][j]*(float)raw[i+tp][j];
      o[j]=v*frcp(1.f+__expf(-v))*ksc; }
    u32x4 w; w.x=pk2h(o[0],o[1]); w.y=pk2h(o[2],o[3]); w.z=pk2h(o[4],o[5]); w.w=pk2h(o[6],o[7]);
    st16_wt(G.qkc,dsto+(unsigned)i*2048u,w); }
}

__device__ __forceinline__ void contrib(int b,int hm,int c,const Glob G,const f16*proj,LAS unsigned char*lds,const int w0,unsigned*pend){
  constexpr int KS0=0,VS0=34816,CS=69632,VEC=104448;
  const int tid=tid_of(w0),lane=tid&63,wid=w0,fr=lane&15,fq=lane>>4;
  LAS f16*Cs=(LAS f16*)(lds+CS); LAS float*vec=(LAS float*)(lds+VEC); LAS f16*wph=(LAS f16*)(vec+128);
  const int seq=b*4+hm,item=seq*NCH+c; const long rowbase=(long)b*SEQ; const int tc=256*c;
  const int eg=tid&15,sq=tid>>4;
  const GAS f16*kp=(const GAS f16*)G.qkc+512+hm*DH+8*eg; const GAS f16*vp=(const GAS f16*)proj+C_VM+hm*DH+8*eg;
  const int trb=(8*fq+(fr>>2))*RS1+4*(fr&3);
  float aj[4],pj[4],off[4];
  #pragma unroll
  for(int j=0;j<4;++j){ aj[j]=((const GAS float*)G.sca)[seq*64+4*c+j]; pj[j]=((const GAS float*)G.scpm)[seq*64+4*c+j]; }
  off[0]=0.f; off[1]=aj[0]; off[2]=aj[0]+aj[1]; off[3]=off[2]+aj[2];
  const float a256=off[3]+aj[3];
  const float mloc=a256+fmaxf(fmaxf(pj[0]-off[0],pj[1]-off[1]),fmaxf(pj[2]-off[2],pj[3]-off[3]));
  f32x4 accC[8];
  #pragma unroll
  for(int i=0;i<8;++i)accC[i]=(f32x4){0.f,0.f,0.f,0.f};
  float nacc=0.f;
  f16x8 rk[2],rv[2]; float rcolf=0.f;
  #define LOADP(j) do{ const long r0_=rowbase+tc+64*(j)+2*sq; \
    rk[0]=*(const GAS f16x8*)(kp+r0_*1024); rk[1]=*(const GAS f16x8*)(kp+(r0_+1)*1024); rv[0]=*(const GAS f16x8*)(vp+r0_*NPROJ); rv[1]=*(const GAS f16x8*)(vp+(r0_+1)*NPROJ); \
    if(wid==0) rcolf=((const GAS float*)G.gcolf)[(size_t)seq*SEQ+tc+64*(j)+lane]; }while(0)
  LOADP(0);
  #pragma unroll
  for(int j=0;j<4;++j){ const int buf=j&1;
    LAS f16*Ks=(LAS f16*)(lds+KS0+buf*17408); LAS f16*Vs=(LAS f16*)(lds+VS0+buf*17408);
    *(LAS f16x8*)(Ks+(2*sq)*RS1+8*eg)=rk[0]; *(LAS f16x8*)(Ks+(2*sq+1)*RS1+8*eg)=rk[1];
    *(LAS f16x8*)(Vs+(2*sq)*RS1+8*eg)=rv[0]; *(LAS f16x8*)(Vs+(2*sq+1)*RS1+8*eg)=rv[1];
    if(wid==0){ const float wpv=__expf(a256+(rcolf-off[j])-mloc); vec[64*buf+lane]=wpv; wph[64*buf+lane]=(f16)wpv; }
    if(j==0&&pend!=nullptr)asm volatile("s_waitcnt vmcnt(0)":::"memory");
    ML_BAR();
    if(j==0&&pend!=nullptr&&tid==0)__hip_atomic_fetch_add(pend,1u,__ATOMIC_RELAXED,__HIP_MEMORY_SCOPE_AGENT);
    if(j<3) LOADP(j+1);
    #pragma unroll
    for(int ks=0;ks<2;++ks){ const LAS f16*ap=Ks+trb+32*ks*RS1+16*wid; const f16x8 kfa=cat8(trd(ap),trd(ap+4*RS1)) * *(const LAS f16x8*)(wph+64*buf+32*ks+8*fq);
      #pragma unroll
      for(int et=0;et<8;++et){ const LAS f16*bp=Vs+trb+32*ks*RS1+16*et; const f16x8 vfb=cat8(trd(bp),trd(bp+4*RS1)); accC[et]=MF16(kfa,vfb,accC[et]); } }
    { const int d=tid>>2,sg=tid&3; float sn=0.f;
      #pragma unroll
      for(int i=0;i<16;++i)sn+=(float)Ks[(16*sg+i)*RS1+d]*vec[64*buf+16*sg+i];
      sn=xsum<1>(sn); sn=xsum<2>(sn); nacc+=sn; } }
  #undef LOADP
  #pragma unroll
  for(int et=0;et<8;++et){ u32x2 w; w.x=pk2h(accC[et][0],accC[et][1]); w.y=pk2h(accC[et][2],accC[et][3]); *(LAS u32x2*)(Cs+(16*et+fr)*RS1+16*wid+4*fq)=w; }
  ML_BAR();
  { f16*dst=G.cloc+(size_t)item*DH*DH;
    #pragma unroll
    for(int i=0;i<4;++i){ const int idx=tid+NTHR*i, e=idx>>4, ch=idx&15; st16_wt(dst,(unsigned)((e*DH+8*ch)*2),*(const LAS u32x4*)(Cs+e*RS1+8*ch)); }
    if((tid&3)==0)st4_wt(G.nloc+(size_t)item*DH+(tid>>2),nacc);
    if(tid==0){ st4_wt(G.sa+item,a256); st4_wt(G.smloc+item,mloc); } }
  ML_BAR();
}

__device__ __forceinline__ void scan(int seq,const Glob G,const int w0){
  const int tid=tid_of(w0); const int e=tid>>2,d0=32*(tid&3);
  float C[32];
  #pragma unroll
  for(int j=0;j<32;++j)C[j]=0.f;
  float nv=0.f,mst=0.f;
  u32x4 in4[4],nx4[4]; float a,ml,nl,an=0.f,mln=0.f,nln=0.f;
  { const int item=seq*NCH; const u32x4*src=(const u32x4*)(G.cloc+(size_t)item*DH*DH+e*DH+d0);
    #pragma unroll
    for(int i=0;i<4;++i)in4[i]=src[i];
    a=G.sa[item]; ml=G.smloc[item]; nl=(tid<DH)?G.nloc[(size_t)item*DH+tid]:0.f; }
  #pragma unroll 1
  for(int c=0;c<NCH;++c){ const int item=seq*NCH+c;
    if(c+1<NCH){ const u32x4*src=(const u32x4*)(G.cloc+(size_t)(item+1)*DH*DH+e*DH+d0);
      #pragma unroll
      for(int i=0;i<4;++i)nx4[i]=src[i];
      an=G.sa[item+1]; mln=G.smloc[item+1]; nln=(tid<DH)?G.nloc[(size_t)(item+1)*DH+tid]:0.f; }
    f16*dstb=G.cprev+(size_t)item*DH*DH; const unsigned dsto=(unsigned)((e*DH+d0)*2);
    #pragma unroll
    for(int i=0;i<4;++i){ u32x4 o; o.x=pk2h(C[8*i],C[8*i+1]); o.y=pk2h(C[8*i+2],C[8*i+3]); o.z=pk2h(C[8*i+4],C[8*i+5]); o.w=pk2h(C[8*i+6],C[8*i+7]); st16_wt(dstb,dsto+16u*i,o); }
    if(tid<DH)st4_wt(G.nprev+(size_t)item*DH+tid,nv);
    if(tid==0)st4_wt(G.smprev+item,mst);
    const float mn=fmaxf(a+mst,ml),sp=__expf(a+mst-mn),sl=__expf(ml-mn);
    #pragma unroll
    for(int i=0;i<4;++i){ const f16x8 h8=__builtin_bit_cast(f16x8,in4[i]);
      #pragma unroll
      for(int j=0;j<8;++j)C[8*i+j]=sp*C[8*i+j]+sl*(float)h8[j]; }
    nv=sp*nv+sl*nl; mst=mn;
    #pragma unroll
    for(int i=0;i<4;++i)in4[i]=nx4[i];
    a=an; ml=mln; nl=nln; }
}

__device__ __forceinline__ void unit(int b,int hm,int c,const Glob G,const f16*proj,const float*gain,f16*mix,LAS unsigned char*lds,const int w0){
  constexpr int QS=0, KS=17408, VS=34816, CS=52224, PS=87040, VEC=96256;
  const int tid=tid_of(w0),lane=tid&63,wid=w0,fr=lane&15,fq=lane>>4;
  LAS f16*Qs=(LAS f16*)(lds+QS); LAS f16*Ks=(LAS f16*)(lds+KS); LAS f16*Vs=(LAS f16*)(lds+VS); LAS f16*Cs=(LAS f16*)(lds+CS); LAS f16*Ps=(LAS f16*)(lds+PS);
  LAS float*vec=(LAS float*)(lds+VEC); LAS f16*wph=(LAS f16*)(vec+1288);
  const int seq=b*4+hm,item=seq*NCH+c; const long rowbase=(long)b*SEQ;
  const int eg=tid&15,sq=tid>>4;
  const GAS f16*qp=(const GAS f16*)G.qkc+hm*DH+8*eg; const GAS f16*kp=qp+512; const GAS f16*vp=(const GAS f16*)proj+C_VM+hm*DH+8*eg;
  const f32x4 gn=*(const GAS f32x4*)((const GAS float*)gain+hm*DH+16*wid+4*fq);
  const GAS f16*omp=(const GAS f16*)proj+C_OM+hm*DH+16*wid+4*fq; GAS f16*outp=(GAS f16*)mix+512+hm*DH+16*wid+4*fq;
  const int trb=(8*fq+(fr>>2))*RS1+4*(fr&3);
  { const GAS f16*src=(const GAS f16*)G.cprev+(size_t)item*DH*DH;
    #pragma unroll
    for(int i=0;i<4;++i){ const int idx=tid+NTHR*i, e=idx>>4, ch=idx&15; *(LAS u32x4*)(Cs+e*RS1+8*ch)=*(const GAS u32x4*)(src+e*DH+8*ch); }
    if(tid<DH)vec[1152+tid]=((const GAS float*)G.nprev)[(size_t)item*DH+tid]; }
  float mprev=((const GAS float*)G.smprev)[item];
  f16x8 rq[2],rk[2],rv[2]; f16x4 omn[4]; float rcolf=0.f,rcum=0.f,rpm=0.f,ra=0.f,rpx=0.f;
  #define LOAD_RAW(sc) do{ const long r0_=rowbase+(sc)*L+2*sq; \
    rq[0]=*(const GAS f16x8*)(qp+r0_*1024); rq[1]=*(const GAS f16x8*)(qp+(r0_+1)*1024); rk[0]=*(const GAS f16x8*)(kp+r0_*1024); rk[1]=*(const GAS f16x8*)(kp+(r0_+1)*1024); \
    rv[0]=*(const GAS f16x8*)(vp+r0_*NPROJ); rv[1]=*(const GAS f16x8*)(vp+(r0_+1)*NPROJ); \
    _Pragma("unroll") for(int tt=0;tt<4;++tt) omn[tt]=*(const GAS f16x4*)(omp+(rowbase+(sc)*L+16*tt+fr)*NPROJ); \
    if(wid==0){ const size_t gi_=(size_t)seq*SEQ+(sc)*L+lane; rcolf=((const GAS float*)G.gcolf)[gi_]; rcum=((const GAS float*)G.gcum)[gi_]; rpm=((const GAS float*)G.gpm)[gi_]; ra=((const GAS float*)G.sca)[seq*64+(sc)]; rpx=((const GAS float*)G.scpm)[seq*64+(sc)]; } }while(0)
  LOAD_RAW(4*c);
  ML_BAR();
  f32x4 accC[8];
  #pragma unroll
  for(int et=0;et<8;++et){ const f16x4 t4=*(const LAS f16x4*)(Cs+(16*et+fr)*RS1+16*wid+4*fq); accC[et]=(f32x4){(float)t4[0],(float)t4[1],(float)t4[2],(float)t4[3]}; }
  #pragma unroll 1
  for(int sc=4*c;sc<4*c+4;++sc){
    const int t0=sc*L;
    *(LAS f16x8*)(Qs+(2*sq)*RS1+8*eg)=rq[0]; *(LAS f16x8*)(Qs+(2*sq+1)*RS1+8*eg)=rq[1];
    *(LAS f16x8*)(Ks+(2*sq)*RS1+8*eg)=rk[0]; *(LAS f16x8*)(Ks+(2*sq+1)*RS1+8*eg)=rk[1];
    *(LAS f16x8*)(Vs+(2*sq)*RS1+8*eg)=rv[0]; *(LAS f16x8*)(Vs+(2*sq+1)*RS1+8*eg)=rv[1];
    f16x4 om[4];
    #pragma unroll
    for(int tt=0;tt<4;++tt)om[tt]=omn[tt];
    if(wid==0){
      const float mx=fmaxf(mprev,rpm);
      const float mloc=ra+rpx, mnew=fmaxf(ra+mprev,mloc), sprev=__expf(ra+mprev-mnew), wpv=__expf(ra+rcolf-mnew);
      vec[lane]=rcolf; vec[64+lane]=-mx; vec[128+lane]=__expf(mprev-mx); vec[192+lane]=__expf(-(rcum+mx)); vec[256+lane]=wpv; wph[lane]=(f16)wpv;
      if(lane==0)vec[1280]=sprev;
      mprev=mnew; }
    ML_BAR();
    if(sc<4*c+3) LOAD_RAW(sc+1);
    { const int t=tid>>3,dg=tid&7; float sv=0.f;
      const f16x8 q0=*(const LAS f16x8*)(Qs+t*RS1+16*dg),q1=*(const LAS f16x8*)(Qs+t*RS1+16*dg+8);
      #pragma unroll
      for(int j=0;j<8;++j){ sv+=(float)q0[j]*vec[1152+16*dg+j]+(float)q1[j]*vec[1152+16*dg+8+j]; }
      sv=xsum<1>(sv); sv=xsum<2>(sv); sv=xsum<4>(sv);
      if(dg==0)vec[320+t]=sv; }
    { const int sA=wid>>1;
      f16x8 ka[4];
      #pragma unroll
      for(int ks=0;ks<4;++ks)ka[ks]=*(const LAS f16x8*)(Ks+(16*sA+fr)*RS1+32*ks+8*fq);
      const f32x4 cf4=*(const LAS f32x4*)(vec+16*sA+4*fq);
      #pragma unroll
      for(int t2=0;t2<2;++t2){ const int tt=2*(wid&1)+t2; f32x4 acc={0.f,0.f,0.f,0.f};
        #pragma unroll
        for(int ks=0;ks<4;++ks){ const f16x8 qb=*(const LAS f16x8*)(Qs+(16*tt+fr)*RS1+32*ks+8*fq); acc=MF16(ka[ks],qb,acc); }
        const int t=16*tt+fr; const float rf=vec[64+t]; float p[4],rsum=0.f;
        #pragma unroll
        for(int r=0;r<4;++r){ const int sidx=16*sA+4*fq+r; p[r]=(sidx<=t)?acc[r]*__expf(rf+cf4[r]):0.f; rsum+=p[r]; }
        u32x2 w; w.x=pk2h(p[0],p[1]); w.y=pk2h(p[2],p[3]); *(LAS u32x2*)(Ps+t*RS2+16*sA+4*fq)=w;
        rsum=xsum<16>(rsum); rsum=xsum<32>(rsum);
        if(fq==0)vec[384+64*sA+t]=rsum; } }
    f32x4 accN[4];
    { f16x8 ca[4];
      #pragma unroll
      for(int ks=0;ks<4;++ks)ca[ks]=*(const LAS f16x8*)(Cs+(16*wid+fr)*RS1+32*ks+8*fq);
      #pragma unroll
      for(int tt=0;tt<4;++tt){ accN[tt]=(f32x4){0.f,0.f,0.f,0.f};
        #pragma unroll
        for(int ks=0;ks<4;++ks){ const f16x8 qb=*(const LAS f16x8*)(Qs+(16*tt+fr)*RS1+32*ks+8*fq); accN[tt]=MF16(ca[ks],qb,accN[tt]); } } }
    f16x8 vfa[2];
    #pragma unroll
    for(int ks=0;ks<2;++ks){ const LAS f16*ap=Vs+trb+32*ks*RS1+16*wid; vfa[ks]=cat8(trd(ap),trd(ap+4*RS1)); }
    ML_BAR();
    float inv[4];
    #pragma unroll
    for(int tt=0;tt<4;++tt){ const int t=16*tt+fr; const float wi=vec[128+t]; const float den=(vec[384+t]+vec[448+t])+(vec[512+t]+vec[576+t])+wi*vec[320+t]; inv[tt]=frcp(fmaxf(fabsf(den),vec[192+t]));
      accN[tt]*=wi; }
    #pragma unroll
    for(int tt=0;tt<4;++tt)
      #pragma unroll
      for(int ks=0;ks<2;++ks){ const f16x8 pb=*(const LAS f16x8*)(Ps+(16*tt+fr)*RS2+32*ks+8*fq); accN[tt]=MF16(vfa[ks],pb,accN[tt]); }
    #pragma unroll
    for(int tt=0;tt<4;++tt){ accN[tt]*=inv[tt]; float q2=(accN[tt][0]*accN[tt][0]+accN[tt][1]*accN[tt][1])+(accN[tt][2]*accN[tt][2]+accN[tt][3]*accN[tt][3]);
      q2=xsum<16>(q2); q2=xsum<32>(q2); if(fq==0)vec[640+64*wid+16*tt+fr]=q2; }
    ML_BAR();
    #pragma unroll
    for(int tt=0;tt<4;++tt){ const int t=16*tt+fr; float tot=0.f;
      #pragma unroll
      for(int w=0;w<8;++w)tot+=vec[640+64*w+t];
      const float rs=1.f/sqrtf(tot*(1.f/128.f)+EPS);
      float o[4];
      #pragma unroll
      for(int r=0;r<4;++r)o[r]=accN[tt][r]*rs*gn[r]*frcp(1.f+__expf(-(float)om[tt][r]));
      u32x2 w; w.x=pk2h(o[0],o[1]); w.y=pk2h(o[2],o[3]); *(GAS u32x2*)(outp+(rowbase+t0+t)*DM)=w; }
    if(sc<4*c+3){ const float sprev=vec[1280];
      #pragma unroll
      for(int et=0;et<8;++et)accC[et]*=sprev;
      #pragma unroll
      for(int ks=0;ks<2;++ks){ const LAS f16*ap=Ks+trb+32*ks*RS1+16*wid; const f16x8 kfa=cat8(trd(ap),trd(ap+4*RS1)) * *(const LAS f16x8*)(wph+32*ks+8*fq);
        #pragma unroll
        for(int et=0;et<8;++et){ const LAS f16*bp=Vs+trb+32*ks*RS1+16*et; const f16x8 vfb=cat8(trd(bp),trd(bp+4*RS1)); accC[et]=MF16(kfa,vfb,accC[et]); } }
      #pragma unroll
      for(int et=0;et<8;++et){ u32x2 w; w.x=pk2h(accC[et][0],accC[et][1]); w.y=pk2h(accC[et][2],accC[et][3]); *(LAS u32x2*)(Cs+(16*et+fr)*RS1+16*wid+4*fq)=w; }
      const int d=tid>>2,sg=tid&3; float sn=0.f;
      #pragma unroll
      for(int j=0;j<16;++j)sn+=(float)Ks[(16*sg+j)*RS1+d]*vec[256+16*sg+j];
      sn=xsum<1>(sn); sn=xsum<2>(sn);
      if(sg==0)vec[1152+d]=sprev*vec[1152+d]+sn; }
    ML_BAR();
  }
  #undef LOAD_RAW
}
__device__ __forceinline__ void publish(unsigned*cnt,const bool leader){
  asm volatile("s_waitcnt vmcnt(0)":::"memory"); __syncthreads();
  if(leader) __hip_atomic_fetch_add(cnt,1u,__ATOMIC_RELAXED,__HIP_MEMORY_SCOPE_AGENT);
}
__device__ __forceinline__ void await(unsigned*cnt,const unsigned want,const bool leader){
  if(leader){ unsigned sp=0; while(__hip_atomic_load(cnt,__ATOMIC_RELAXED,__HIP_MEMORY_SCOPE_AGENT)<want){ __builtin_amdgcn_s_sleep(8); if(++sp>(1u<<22))break; }
    __builtin_amdgcn_fence(__ATOMIC_ACQUIRE,"agent"); asm volatile("s_waitcnt vmcnt(0)":::"memory"); }
  __syncthreads();
}
#undef ML_BAR
#undef MF16
}

struct Args { const void* in[22]; float* out; unsigned char* ws; };
struct Frame {
    LAS unsigned char* lds; int tid, lane, wave, vcu, G, w0; float* out; unsigned char* ws;
    __device__ __forceinline__ void fresh() { const int t = tid_of(w0); tid = t; lane = t & 63; wave = w0; }
    template <class Tp> __device__ __forceinline__ const Tp* in(int k) const { const LAS unsigned* p = (const LAS unsigned*)(lds + ARGS_OFF) + 2 * k;
        const unsigned lo = __builtin_amdgcn_readfirstlane(p[0]), hi = __builtin_amdgcn_readfirstlane(p[1]); return (const Tp*)(((unsigned long long)hi << 32) | lo); }
    __device__ __forceinline__ const float* x() const { return in<float>(0); }
    __device__ __forceinline__ const float* c() const { return in<float>(1); }
    __device__ __forceinline__ const int* positions() const { return in<int>(2); }
    __device__ __forceinline__ const float* w_ada() const { return in<float>(3); }
    __device__ __forceinline__ const float* b_ada() const { return in<float>(4); }
    __device__ __forceinline__ const float* norm1_g() const { return in<float>(5); }
    __device__ __forceinline__ const float* w_in() const { return in<float>(6); }
    __device__ __forceinline__ const float* b_gate() const { return in<float>(7); }
    __device__ __forceinline__ const float* conv_w() const { return in<float>(8); }
    __device__ __forceinline__ const float* conv_b() const { return in<float>(9); }
    __device__ __forceinline__ const float* attn_g() const { return in<float>(10); }
    __device__ __forceinline__ const float* mlstm_g() const { return in<float>(11); }
    __device__ __forceinline__ const float* w_out() const { return in<float>(12); }
    __device__ __forceinline__ const float* norm2_g() const { return in<float>(13); }
    __device__ __forceinline__ const float* w_rg() const { return in<float>(14); }
    __device__ __forceinline__ const float* b_rg() const { return in<float>(15); }
    __device__ __forceinline__ const float* w_re() const { return in<float>(16); }
    __device__ __forceinline__ const float* b_re() const { return in<float>(17); }
    __device__ __forceinline__ const float* w1() const { return in<float>(18); }
    __device__ __forceinline__ const float* w3() const { return in<float>(19); }
    __device__ __forceinline__ const float* w2() const { return in<float>(20); }
    __device__ __forceinline__ const float* normf_g() const { return in<float>(21); }
};

struct TItem { const GAS float* W; unsigned char* WT; int K, ldw, k0, n0; bool f8; };
__device__ __forceinline__ bool p0_item(const Frame& F, int it, TItem& t) {
    constexpr int I_IN = 16 * 7, I_OUT = 16 * 2, I_E13 = 16, I_E2 = 8 * 2;
    constexpr int NITEMS = I_IN + I_OUT + NEXP * (2 * I_E13 + I_E2);
    if (it >= NITEMS) return false;
    int r = it, nnb; t.f8 = false;
    if (r < I_IN) { t.W = (const GAS float*)F.w_in(); t.WT = F.ws + WS_WIN; t.K = 1024; t.ldw = NPROJ_SRC; nnb = 7; }
    else if ((r -= I_IN) < I_OUT) { t.W = (const GAS float*)F.w_out(); t.WT = F.ws + WS_WOUT; t.K = 1024; t.ldw = 1024; nnb = 2; }
    else { r -= I_OUT; const int per = 2 * I_E13 + I_E2, e = r / per; r -= e * per;
        t.f8 = MOE8; const size_t eb = MOE8 ? 1 : 2;
        if (r < I_E13) { t.W = (const GAS float*)F.w1() + (size_t)e * 1024 * 512; t.WT = F.ws + WS_W1 + (size_t)e * 512 * 1024 * eb; t.K = 1024; t.ldw = 512; nnb = 1; }
        else if ((r -= I_E13) < I_E13) { t.W = (const GAS float*)F.w3() + (size_t)e * 1024 * 512; t.WT = F.ws + WS_W3 + (size_t)e * 512 * 1024 * eb; t.K = 1024; t.ldw = 512; nnb = 1; }
        else { r -= I_E13; t.W = (const GAS float*)F.w2() + (size_t)e * 512 * 1024; t.WT = F.ws + WS_W2 + (size_t)e * 1024 * 512 * eb; t.K = 512; t.ldw = 1024; nnb = 2; } }
    t.k0 = 64 * (r / nnb); t.n0 = 512 * (r % nnb);
    return true;
}
__device__ __forceinline__ void p0_load(const TItem& t, f32x4 (&v)[16], int wave, int lane) {
    const GAS float* p = t.W + (size_t)(t.k0 + 8 * wave) * t.ldw + t.n0 + 4 * lane;
#pragma unroll
    for (int r = 0; r < 8; ++r) { v[2 * r] = __builtin_nontemporal_load((const GAS f32x4*)(p + (size_t)r * t.ldw)); v[2 * r + 1] = __builtin_nontemporal_load((const GAS f32x4*)(p + (size_t)r * t.ldw + 256)); }
}
__device__ __forceinline__ void p0_park(const TItem& t, const f32x4 (&v)[16], LAS f16* Ts, int wave, int lane) {
    const float sc = t.f8 ? W8SCALE : 1.f;
#pragma unroll
    for (int r = 0; r < 8; ++r)
#pragma unroll
        for (int j = 0; j < 2; ++j) { const f32x4 x = v[2 * r + j] * sc; LAS unsigned* q = (LAS unsigned*)(Ts + (8 * wave + r) * 514 + 4 * lane + 256 * j); q[0] = pk2h(x[0], x[1]); q[1] = pk2h(x[2], x[3]); }
}
__device__ __forceinline__ void p0_emit(const TItem& t, const LAS f16* Ts, int tid) {
    const int kc = tid & 7;
#pragma unroll
    for (int jj = 0; jj < 8; ++jj) { const int n = (tid >> 3) + 64 * jj; const LAS f16* q = Ts + (8 * kc) * 514 + n;
        if (t.f8) { const float o8[8] = {(float)q[0], (float)q[514], (float)q[2 * 514], (float)q[3 * 514], (float)q[4 * 514], (float)q[5 * 514], (float)q[6 * 514], (float)q[7 * 514]};
            *(GAS u32x2*)(t.WT + (size_t)(t.n0 + n) * t.K + t.k0 + 8 * kc) = pk8_fp8(o8); }
        else { const f16x8 o = {q[0], q[514], q[2 * 514], q[3 * 514], q[4 * 514], q[5 * 514], q[6 * 514], q[7 * 514]};
            *(GAS f16x8*)((f16*)t.WT + (size_t)(t.n0 + n) * t.K + t.k0 + 8 * kc) = o; } }
}

__device__ __forceinline__ void p0_park8(const f32x4 (&v)[16], LAS unsigned char* T8, int wave, int lane) {
#pragma unroll
    for (int j = 0; j < 2; ++j)
#pragma unroll
        for (int c = 0; c < 4; ++c) { const int n = 4 * lane + c + 256 * j;
            const float o8[8] = {v[j][c] * W8SCALE, v[2 + j][c] * W8SCALE, v[4 + j][c] * W8SCALE, v[6 + j][c] * W8SCALE, v[8 + j][c] * W8SCALE, v[10 + j][c] * W8SCALE, v[12 + j][c] * W8SCALE, v[14 + j][c] * W8SCALE};
            *(LAS u32x2*)(T8 + n * 64 + (((wave >> 1) ^ (lane & 3)) * 16) + (wave & 1) * 8) = pk8_fp8(o8); }
}
__device__ __forceinline__ void p0_emit8(const TItem& t, const LAS unsigned char* T8, int tid) {
    const int pc = tid & 3;
#pragma unroll
    for (int i = 0; i < 4; ++i) { const int n = (tid >> 2) + 128 * i;
        const u32x4 w = *(const LAS u32x4*)(T8 + n * 64 + ((pc ^ ((n >> 2) & 3)) * 16));
        *(GAS u32x4*)(t.WT + (size_t)(t.n0 + n) * t.K + t.k0 + 16 * pc) = w; }
}

__device__ __forceinline__ void p0_park16(const f32x4 (&v)[16], LAS unsigned char* T16, int wave, int lane) {
#pragma unroll
    for (int j = 0; j < 2; ++j)
#pragma unroll
        for (int c = 0; c < 4; ++c) { const int n = 4 * lane + c + 256 * j;
            u32x4 w; w.x = pk2h(v[j][c], v[2 + j][c]); w.y = pk2h(v[4 + j][c], v[6 + j][c]); w.z = pk2h(v[8 + j][c], v[10 + j][c]); w.w = pk2h(v[12 + j][c], v[14 + j][c]);
            *(LAS u32x4*)(T16 + n * 128 + ((wave ^ (lane & 7)) * 16)) = w; }
}
__device__ __forceinline__ void p0_emit16(const TItem& t, const LAS unsigned char* T16, int tid) {
    const int pc = tid & 7;
#pragma unroll
    for (int i = 0; i < 8; ++i) { const int n = (tid >> 3) + 64 * i;
        const u32x4 w = *(const LAS u32x4*)(T16 + n * 128 + ((pc ^ ((n >> 2) & 7)) * 16));
        *(GAS u32x4*)(t.WT + ((size_t)(t.n0 + n) * t.K + t.k0 + 8 * pc) * 2) = w; }
}

__device__ __forceinline__ void p0_prologue(Frame F) {
    F.fresh();
    LAS float* sc = (LAS float*)F.lds; LAS float* part = (LAS float*)(F.lds + 32768);
    float* mod = (float*)(F.ws + WS_MOD);
    if ((int)blockIdx.x < 192) {
        { const GAS float* cg = (const GAS float*)F.c(); float cv[16];
#pragma unroll
          for (int u = 0; u < 16; ++u) cv[u] = cg[F.tid + NTHR * u];
#pragma unroll
          for (int u = 0; u < 16; ++u) sc[F.tid + NTHR * u] = cv[u] / (1.f + __expf(-cv[u])); }
        __syncthreads();
        for (int jb = blockIdx.x; jb < 192; jb += F.G) {
            const int jj = F.tid & 31, kc = F.tid >> 5, j0 = jb * 32;
            float a[8];
#pragma unroll
            for (int b = 0; b < 8; ++b) a[b] = 0.f;
            const GAS float* wad = (const GAS float*)F.w_ada() + (size_t)(kc * 64) * 6144 + j0 + jj;
            { float w[64];
#pragma unroll
                for (int u = 0; u < 64; ++u) w[u] = __builtin_nontemporal_load(wad + (size_t)u * 6144);
#pragma unroll
                for (int u = 0; u < 64; ++u) { const int k = kc * 64 + u;
#pragma unroll
                    for (int b = 0; b < 8; ++b) a[b] += sc[b * 1024 + k] * w[u]; } }
#pragma unroll
            for (int b = 0; b < 8; ++b) part[(kc * 8 + b) * 32 + jj] = a[b];
            __syncthreads();
            if (F.tid < 256) { const int b = F.tid >> 5; float s = ((const GAS float*)F.b_ada())[j0 + jj];
                for (int k2 = 0; k2 < 16; ++k2) s += part[(k2 * 8 + b) * 32 + jj];
                mod[(size_t)b * 6144 + j0 + jj] = s; }
            __syncthreads();
        }
    }
    __syncthreads();
    const int gw = F.vcu * NWAVES + F.wave, NGW = F.G * NWAVES;
    { f16* wg = (f16*)(F.ws + WS_WGT); f16* wr = (f16*)(F.ws + WS_WRT); const GAS float* w_in = (const GAS float*)F.w_in(); const GAS float* w_rg = (const GAS float*)F.w_rg(); const GAS float* w_re = (const GAS float*)F.w_re();
      for (int i = gw * 64 + F.lane; i < 64 * 1024; i += NGW * 64) { const int n = i >> 10, k = i & 1023;
          if (n < 16) wg[n * 1024 + k] = (f16)(n < 8 ? w_in[(size_t)k * NPROJ_SRC + NPROJ + n] : 0.f);
          else { const int m = n - 16; wr[m * 1024 + k] = (f16)(m < 4 ? w_rg[k * 4 + m] : m < 36 ? w_re[k * 32 + (m - 4)] : 0.f); } } }
}


constexpr int P0_NPROJ_ITEMS = 16 * 7 + 16 * 2;
__device__ __forceinline__ void p1_weights(Frame F) {
    F.fresh();
    LAS unsigned char* T16 = F.lds;
    if (F.vcu < P0_NPROJ_ITEMS) { TItem cur; f32x4 va[16];
        p0_item(F, F.vcu, cur); p0_load(cur, va, F.wave, F.lane);
        p0_park16(va, T16, F.wave, F.lane); __syncthreads(); p0_emit16(cur, T16, F.tid); __syncthreads(); }
}

constexpr int MP_WROWS = 37, MP_WRS = 1032;
template <int NCT, bool SRC16, bool OUT8 = false>
__device__ __forceinline__ void modproj_tile(const void* xsrc_, const int row0, const LAS float* scl, const LAS float* sft, const LAS f16* WTs, f16* hout, f32x4 (&acc)[NCT], const int lane, const float* ssb = nullptr) {
    const int fr = lane & 15, fq = lane >> 4;
    const GAS float* xp = (const GAS float*)xsrc_ + (size_t)(row0 + fr) * DM + 8 * fq;
    const GAS f16* xh = (const GAS f16*)xsrc_ + (size_t)(row0 + fr) * X1P + 8 * fq;
    float ss = 0.f;
    if (ssb) { const GAS f32x4* sp = (const GAS f32x4*)((const GAS float*)ssb + (size_t)(row0 + fr) * 16); const f32x4 p0 = sp[0], p1 = sp[1], p2 = sp[2], p3 = sp[3];
        ss = ((p0[0] + p0[1]) + (p0[2] + p0[3])) + ((p1[0] + p1[1]) + (p1[2] + p1[3])) + ((p2[0] + p2[1]) + (p2[2] + p2[3])) + ((p3[0] + p3[1]) + (p3[2] + p3[3])); }
    else {
#pragma unroll 16
    for (int ks = 0; ks < 32; ++ks) {
        f32x4 a, c;
        if (SRC16) { const f16x8 t = *(const GAS f16x8*)(xh + 32 * ks); a = (f32x4){(float)t[0], (float)t[1], (float)t[2], (float)t[3]}; c = (f32x4){(float)t[4], (float)t[5], (float)t[6], (float)t[7]}; }
        else { a = *(const GAS f32x4*)(xp + 32 * ks); c = *(const GAS f32x4*)(xp + 32 * ks + 4); }
        ss += (a[0] * a[0] + a[1] * a[1]) + (a[2] * a[2] + a[3] * a[3]) + (c[0] * c[0] + c[1] * c[1]) + (c[2] * c[2] + c[3] * c[3]); }
    ss = xsum<16>(ss); ss = xsum<32>(ss); }
    const float rstd = 1.f / sqrtf(ss * (1.f / DM) + EPS);
#pragma unroll
    for (int ct = 0; ct < NCT; ++ct) acc[ct] = (f32x4){0.f, 0.f, 0.f, 0.f};
    GAS f16* hp = (GAS f16*)hout + (size_t)(row0 + fr) * DM + 8 * fq;
    const LAS f16* wrow[NCT];
#pragma unroll
    for (int ct = 0; ct < NCT; ++ct) { const int r = 16 * ct + fr; wrow[ct] = WTs + (r < MP_WROWS - 1 ? r : MP_WROWS - 1) * MP_WRS + 8 * fq; }
    constexpr int PF = 8;
    f32x4 ba[PF], bc[PF]; f16x8 bh[PF];
#define MP_LOAD(slot, ks) do { if (SRC16) bh[slot] = *(const GAS f16x8*)(xh + 32 * (ks)); else { ba[slot] = *(const GAS f32x4*)(xp + 32 * (ks)); bc[slot] = *(const GAS f32x4*)(xp + 32 * (ks) + 4); } } while (0)
#pragma unroll
    for (int u = 0; u < PF; ++u) MP_LOAD(u, u);
#pragma unroll 1
    for (int k8 = 0; k8 < 32; k8 += PF) {
#pragma unroll
        for (int u = 0; u < PF; ++u) { const int ks = k8 + u, k0 = 32 * ks + 8 * fq;
            f32x4 a, c;
            if (SRC16) { const f16x8 t = bh[u]; a = (f32x4){(float)t[0], (float)t[1], (float)t[2], (float)t[3]}; c = (f32x4){(float)t[4], (float)t[5], (float)t[6], (float)t[7]}; }
            else { a = ba[u]; c = bc[u]; }
            if (k8 + PF < 32) MP_LOAD(u, ks + PF);
            const f32x4 s0 = *(const LAS f32x4*)(scl + k0), s1 = *(const LAS f32x4*)(scl + k0 + 4), h0 = *(const LAS f32x4*)(sft + k0), h1 = *(const LAS f32x4*)(sft + k0 + 4);
            const f32x4 y0 = a * rstd * s0 + h0, y1 = c * rstd * s1 + h1;
            const f16x8 af = {(f16)y0[0], (f16)y0[1], (f16)y0[2], (f16)y0[3], (f16)y1[0], (f16)y1[1], (f16)y1[2], (f16)y1[3]};
            if (OUT8) { const float o8[8] = {y0[0], y0[1], y0[2], y0[3], y1[0], y1[1], y1[2], y1[3]}; *(GAS u32x2*)((GAS unsigned char*)hout + (size_t)(row0 + fr) * DM + 8 * fq + 32 * ks) = pk8_fp8(o8); }
            else *(GAS f16x8*)(hp + 32 * ks) = af;
#pragma unroll
            for (int ct = 0; ct < NCT; ++ct) acc[ct] = __builtin_amdgcn_mfma_f32_16x16x32_f16(af, *(const LAS f16x8*)(wrow[ct] + 32 * ks), acc[ct], 0, 0, 0);
        }
    }
#undef MP_LOAD
}
__device__ __forceinline__ void stage_mod(LAS float* dst, const float* g, const float* sh, const float* sc, int tid) {
    for (int i = tid; i < 256; i += NTHR) { const f32x4 gv = *(const f32x4*)(g + 4 * i), sv = *(const f32x4*)(sc + 4 * i), hv = *(const f32x4*)(sh + 4 * i);
        *(LAS f32x4*)(dst + 4 * i) = gv * (sv + 1.f); *(LAS f32x4*)(dst + 1024 + 4 * i) = hv; }
}

__device__ __forceinline__ void p1_rows(Frame F) {
    F.fresh();
    const float* mod = (const float*)(F.ws + WS_MOD);
    f16* hbuf = (f16*)(F.ws + WS_A); float* gates = (float*)(F.ws + WS_GATES);
    float* cosT = (float*)(F.ws + WS_COS); float* sinT = (float*)(F.ws + WS_SIN);
    const float* x = F.x(); const float* g1n = F.norm1_g(); const GAS float* bg = (const GAS float*)F.b_gate(); const GAS int* pos = (const GAS int*)F.positions();
    const GAS f16* WT = (const GAS f16*)(F.ws + WS_WGT);
    const int lane = F.lane, w = F.wave, fr = lane & 15, fq = lane >> 4;
    constexpr int RSX = 1032;
    LAS f16* Xs = (LAS f16*)F.lds; LAS float* part = (LAS float*)(F.lds + 66048); LAS float* rsv = part + 1024; LAS float* smod = (LAS float*)(F.lds + 73728);
    LAS f16* WTs = (LAS f16*)(F.lds + 81920);
    int sb = -1;
    const int NT32 = T / 32, tpb = (NT32 + F.G - 1) / F.G, tile0 = F.vcu * tpb, tile1 = (tile0 + tpb < NT32) ? tile0 + tpb : NT32;
#pragma unroll
    for (int i = 0; i < 4; ++i) { const int idx = F.tid + NTHR * i, row = idx >> 7, pc = idx & 127; *(LAS u32x4*)(WTs + row * RSX + 8 * pc) = *(const GAS u32x4*)(WT + (size_t)row * DM + 8 * pc); }
    const float gq = (F.tid < 256) ? bg[F.tid & 7] : 0.f;
    if (tile0 < NT32) { const int b = (tile0 * 32) / SEQ; stage_mod(smod, g1n, mod + (size_t)b * 6144, mod + (size_t)b * 6144 + 1024, F.tid); sb = b; }
    f32x4 rxA[4][4], rxB[4][4]; int pnA[2] = {0, 0}, pnB[2] = {0, 0};
#define P1_LOAD(rx, pn, t) do { _Pragma("unroll") for (int r = 0; r < 4; ++r) { const GAS f32x4* xr = (const GAS f32x4*)(x + (size_t)((t) * 32 + 4 * w + r) * DM) + lane; \
        _Pragma("unroll") for (int j = 0; j < 4; ++j) rx[r][j] = __builtin_nontemporal_load(xr + 64 * j); } \
        _Pragma("unroll") for (int i = 0; i < 2; ++i) pn[i] = pos[(t) * 32 + (F.tid >> 5) + 16 * i]; } while (0)
    auto body = [&](f32x4 (&rx)[4][4], int (&pn)[2], const int tile) __attribute__((always_inline)) {
        const int row0 = tile * 32, b = row0 / SEQ;
        if (b != sb) { __syncthreads(); stage_mod(smod, g1n, mod + (size_t)b * 6144, mod + (size_t)b * 6144 + 1024, F.tid); sb = b; }
#pragma unroll
        for (int r = 0; r < 4; ++r) { float ss = 0.f;
#pragma unroll
            for (int j = 0; j < 4; ++j) { const f32x4 v = rx[r][j]; ss += (v.x * v.x + v.y * v.y) + (v.z * v.z + v.w * v.w);
                u32x2 pk; pk.x = pk2h(v.x, v.y); pk.y = pk2h(v.z, v.w); *(LAS u32x2*)(Xs + (4 * w + r) * RSX + 4 * lane + 256 * j) = pk; }
            ss = wave_sum(ss);
            if (lane == 0) rsv[4 * w + r] = 1.f / sqrtf(ss * (1.f / DM) + EPS); }
        const int pv0 = pn[0], pv1 = pn[1];
        __syncthreads();
        if (tile + 2 < tile1) P1_LOAD(rx, pn, tile + 2);
        { const int rt = w >> 2, kq = w & 3, row = 16 * rt + fr; const float rs = rsv[row];
          f32x4 acc = {0.f, 0.f, 0.f, 0.f};
          f16* hp = hbuf + (size_t)(row0 + row) * DM + 8 * fq;
#pragma unroll
          for (int u = 0; u < 8; ++u) { const int ks = 8 * kq + u, k0 = 32 * ks + 8 * fq;
              const f16x8 xv = *(const LAS f16x8*)(Xs + row * RSX + k0);
              const f32x4 s0 = *(const LAS f32x4*)(smod + k0), s1 = *(const LAS f32x4*)(smod + k0 + 4), h0 = *(const LAS f32x4*)(smod + 1024 + k0), h1 = *(const LAS f32x4*)(smod + 1024 + k0 + 4);
              const f32x4 a = {(float)xv[0], (float)xv[1], (float)xv[2], (float)xv[3]}, c = {(float)xv[4], (float)xv[5], (float)xv[6], (float)xv[7]};
              const f32x4 y0 = a * rs * s0 + h0, y1 = c * rs * s1 + h1;
              const f16x8 af = {(f16)y0[0], (f16)y0[1], (f16)y0[2], (f16)y0[3], (f16)y1[0], (f16)y1[1], (f16)y1[2], (f16)y1[3]};
              *(f16x8*)(hp + 32 * ks) = af;
              const f16x8 bf = *(const LAS f16x8*)(WTs + fr * RSX + 32 * ks + 8 * fq);
              acc = __builtin_amdgcn_mfma_f32_16x16x32_f16(af, bf, acc, 0, 0, 0); }
          if (fr < 8) {
#pragma unroll
              for (int r = 0; r < 4; ++r) part[(w * 16 + 4 * fq + r) * 8 + fr] = acc[r]; } }
        __syncthreads();
        if (F.tid < 256) { const int r = F.tid >> 3, q = F.tid & 7, rt = r >> 4, rr = r & 15;
            float g = gq;
#pragma unroll
            for (int kq = 0; kq < 4; ++kq) g += part[((4 * rt + kq) * 16 + rr) * 8 + q];
            gates[(size_t)(row0 + r) * 8 + q] = g; }
#pragma unroll
        for (int i = 0; i < 2; ++i) { const int idx = F.tid + NTHR * i, r = idx >> 5, f = idx & 31;
            const float invf = exp2f(-(float)f * (13.287712379549449f / 32.f)); const float ang = (float)(i == 0 ? pv0 : pv1) * invf;
            cosT[(size_t)(row0 + r) * 32 + f] = cosf(ang); sinT[(size_t)(row0 + r) * 32 + f] = sinf(ang); }
        __syncthreads();
    };
    int tile = tile0;
    if (tile < tile1) P1_LOAD(rxA, pnA, tile);
    if (tile + 1 < tile1) P1_LOAD(rxB, pnB, tile + 1);
    for (; tile < tile1; tile += 2) { body(rxA, pnA, tile); if (tile + 1 < tile1) body(rxB, pnB, tile + 1); }
#undef P1_LOAD
}

#if defined(PROBE_K) && PROBE_K == 33
#define ML_REP 2
#else
#define ML_REP 1
#endif
#if defined(PROBE_K) && PROBE_K == 34
#define AT_REP 2
#else
#define AT_REP 1
#endif
constexpr int CW_Q = 12288;
constexpr int CW_DEPA = 16384, CW_DEPB = 20480, CW_DEPC = 49152;
constexpr int CW_ASEL = 57344, CW_APART = 58368, CW_ACNT = 62464;
constexpr size_t WS_ALIST = 77 * MiB;
constexpr size_t WS_ALSE = 45 * MiB;
static_assert(MOE8, "the attention side buffers use the gaps the fp8 expert images leave in the weight map");
constexpr int ATAB_OFF = 131072;
constexpr int QSPLIT = 8;
constexpr int P3_GB = 260;
__device__ __forceinline__ void p3_mixers(Frame F) {
    F.fresh();
    const int q = blockIdx.x & 7;
    int tk = 0;
    if (F.tid == 0) tk = (int)__hip_atomic_fetch_add((unsigned*)(F.ws + WS_CTL) + CW_Q + 64 * q, 1u, RLX_AGENT);
    bool have_tab = false; int Nx = 0;
    bool own_ready = false;
    bool pend_prep = false;
    unsigned* pend = nullptr;
#define P3_FLUSH() do { if (pend != nullptr) { mlstm::publish(pend, F.tid == 0); pend = nullptr; } pend_prep = false; } while (0)
    for (;;) {
        F.fresh();
        unsigned char* wsl = F.ws; asm volatile("" : "+s"(wsl));
        LAS unsigned char* ldl = F.lds; asm volatile("" : "+s"(ldl));
        float* outl = F.out; asm volatile("" : "+s"(outl));
        const f16* proj = (const f16*)(wsl + WS_PROJ); const float* ksum = (const float*)(wsl + WS_CTL + CTL_KMEAN); f16* mix = (f16*)(wsl + WS_A);
        unsigned* ctl = (unsigned*)(wsl + WS_CTL);
        LAS int* slot = (LAS int*)(ldl + TAB_OFF + 512);
        LAS int* at = (LAS int*)(ldl + ATAB_OFF);
        int* alist = (int*)(wsl + WS_ALIST); f16* part = (f16*)outl; float* lseb = (float*)(wsl + WS_ALSE);
        float* mls = (float*)(wsl + WS_MLS);
        const mlstm::Glob G{(f16*)(wsl + WS_CLOC), (f16*)(wsl + WS_CPREV), mls, mls + 65536, mls + 131072, mls + 131584, mls + 132096,
                            (f16*)(wsl + WS_QKC), mls + 132608, mls + 132608 + 131072, (float*)(wsl + WS_GPM), mls + 132608 + 262144, mls + 132608 + 262144 + 2048};
        if (F.tid == 0) *slot = tk;
        __syncthreads();
        const int it = *slot;
        __syncthreads();
        if (it >= P3_GB && !have_tab) {
            P3_FLUSH();
            mlstm::await(ctl + CW_ASEL + 64 * q, 64u, F.tid == 0);
            if (F.tid < 120) { const int h = F.tid / 15, n = F.tid % 15; at[128 + F.tid] = (int)__hip_atomic_load(ctl + CW_ACNT + (8 * q + h) * 16 + n, RLX_AGENT); }
            __syncthreads();
            if (F.tid < 64) {
                const int l = F.tid, v0 = (2 * l < 120) ? (at[128 + 2 * l] + 1023) >> 10 : 0, v1 = (2 * l + 1 < 120) ? (at[128 + 2 * l + 1] + 1023) >> 10 : 0;
                const int sm = v0 + v1; int inc = sm;
#pragma unroll
                for (int o = 1; o < 64; o <<= 1) { const int t_ = __builtin_amdgcn_ds_bpermute((l - o) << 2, inc); if (l >= o) inc += t_; }
                at[2 * l] = inc - sm; at[2 * l + 1] = inc - sm + v0; }
            __syncthreads();
            Nx = at[120]; have_tab = true;
        }
        if (have_tab && it >= P3_GB + Nx + 128) { P3_FLUSH(); break; }
#if defined(PROBE_K) && PROBE_K >= 50 && PROBE_K <= 53
        if (F.tid == 0) { LAS unsigned long long* st_ = (LAS unsigned long long*)(ldl + TAB_OFF + 768); const unsigned long long t_ = __builtin_amdgcn_s_memrealtime();
            if (it >= 196 && st_[2] == 0ull) st_[2] = t_;
            if (it >= P3_GB && st_[3] == 0ull) st_[3] = t_;
            if (have_tab && it >= P3_GB + Nx + 64 && st_[4] == 0ull) st_[4] = t_; }
#endif
        if (F.tid == 0) tk = (int)__hip_atomic_fetch_add(ctl + CW_Q + 64 * q, 1u, RLX_AGENT);
        if (it < 64) { const int h = it >> 3, qb = QSPLIT + (it & 7);
            moba::sel_list(q, h, qb, proj + C_QA, ksum, alist, ctl + CW_ACNT, (char*)ldl, F.w0, pend);
            pend = ctl + CW_ASEL + 64 * q; pend_prep = false; }
        else if (it < 128) { const int j = it - 64;
            mlstm::prep(q, j, G, proj, (const float*)(wsl + WS_GATES), F.conv_w(), F.conv_b(), F.w0, pend);
            pend = ctl + CW_DEPC + 64 * (q * 16 + (j >> 2)); pend_prep = true; }
        else if (it < 192) { const int j = it - 128, hm = j >> 4, c = j & 15;
            if (pend_prep) { P3_FLUSH(); pend_prep = false; }
            mlstm::await(ctl + CW_DEPC + 64 * (q * 16 + c), 4u, F.tid == 0);
            mlstm::contrib(q, hm, c, G, proj, ldl, F.w0, pend);
            pend = ctl + CW_DEPA + 64 * (q * 4 + hm); pend_prep = false; }
        else if (it < 196) { const int seq = q * 4 + (it - 192);
            P3_FLUSH();
            mlstm::await(ctl + CW_DEPA + 64 * seq, 16u, F.tid == 0);
            for (int rep = 0; rep < ML_REP; ++rep) mlstm::scan(seq, G, F.w0);
            mlstm::publish(ctl + CW_DEPB + 64 * seq, F.tid == 0); }
        else if (it < 260) { const int j = it - 196, qb = QSPLIT - 1 - (j >> 3), h = j & 7;
            P3_FLUSH();
            mobad::sel_unit(q, h, qb, proj + C_QA, ksum, (char*)ldl, F.w0);
            mobad::attn_unit<8>(q, h, qb, proj + C_QA, proj + C_KA, proj + C_VA, mix, ksum, F.attn_g(), (char*)ldl, F.w0); }
        else if (it < P3_GB + Nx) { const int g = it - P3_GB;
            if (F.tid < 120 && at[F.tid] <= g && g < at[F.tid + 1]) at[124] = F.tid;
            __syncthreads();
            const int k = at[124], h = k / 15, n = k % 15, r0 = (g - at[k]) * 1024, cnt = at[128 + k], r1 = cnt < r0 + 1024 ? cnt : r0 + 1024;
            moba::attn_pass<8, 1>(q, h, n, r0, r1, 0, alist, proj + C_QA, proj + C_KA, proj + C_VA, mix, part, lseb, F.attn_g(), (char*)ldl, F.w0, pend);
            pend = ctl + CW_APART + 64 * (8 * q + h); pend_prep = false; }
        else if (it < P3_GB + Nx + 64) { const int j = it - (P3_GB + Nx), hm = j >> 4, c = j & 15;
            P3_FLUSH();
            mlstm::await(ctl + CW_DEPB + 64 * (q * 4 + hm), 1u, F.tid == 0);
            for (int rep = 0; rep < ML_REP; ++rep) mlstm::unit(q, hm, c, G, proj, F.mlstm_g(), mix, ldl, F.w0); }
        else { const int j = it - (P3_GB + Nx + 64), qb = 15 - (j >> 3), h = j & 7, npk = 3;
            P3_FLUSH();
            if (!own_ready) {
                if (F.tid < 8) { const unsigned want = (unsigned)(at[15 * F.tid + 15] - at[15 * F.tid]); unsigned sp = 0;
                    while (__hip_atomic_load(ctl + CW_APART + 64 * (8 * q + F.tid), RLX_AGENT) < want) { __builtin_amdgcn_s_sleep(8); if (++sp > (1u << 22)) break; } }
                if (F.tid < 64) { __builtin_amdgcn_fence(__ATOMIC_ACQUIRE, "agent"); asm volatile("s_waitcnt vmcnt(0)" ::: "memory"); }
                __syncthreads(); own_ready = true; }
            moba::attn_pass<8, 0>(q, h, qb, 0, 0, npk, alist, proj + C_QA, proj + C_KA, proj + C_VA, mix, part, lseb, F.attn_g(), (char*)ldl, F.w0, nullptr); }
    }
}

__device__ __forceinline__ void p3_weights(Frame F) {
    F.fresh();
    unsigned* cq = (unsigned*)(F.ws + WS_CTL) + CW_Q + 64 * 8;
    LAS int* slot = (LAS int*)(F.lds + TAB_OFF + 512);
    LAS unsigned char* T8 = F.lds;
    int tk = 0;
    if (F.tid == 0) tk = (int)__hip_atomic_fetch_add(cq, 1u, RLX_AGENT);
    for (;;) {
        if (F.tid == 0) *slot = tk;
        __syncthreads();
        const int it = *slot;
        __syncthreads();
        if (it >= 768) break;
        if (F.tid == 0) tk = (int)__hip_atomic_fetch_add(cq, 1u, RLX_AGENT);
        const int i0 = P0_NPROJ_ITEMS + 2 * it;
        TItem ca, cb; f32x4 va[16], vb[16];
        p0_item(F, i0, ca); p0_item(F, i0 + 1, cb);
        p0_load(ca, va, F.wave, F.lane); p0_load(cb, vb, F.wave, F.lane);
        p0_park8(va, T8, F.wave, F.lane); p0_park8(vb, T8 + 32768, F.wave, F.lane); __syncthreads();
        p0_emit8(ca, T8, F.tid); p0_emit8(cb, T8 + 32768, F.tid); __syncthreads();
    }
}

#if defined(PROBE_K) && PROBE_K >= 60 && PROBE_K <= 63
#define P5STAMP(i) do { if (F.tid == 0) ((LAS unsigned long long*)(F.lds + TAB_OFF + 768))[i] = __builtin_amdgcn_s_memrealtime(); } while (0)
#else
#define P5STAMP(i) do {} while (0)
#endif
__device__ __forceinline__ void p5_route(Frame F) {
    F.fresh();
    const int gw = F.vcu * NWAVES + F.wave, NGW = F.G * NWAVES;
    const float* mod = (const float*)(F.ws + WS_MOD);
    f16* h2 = (f16*)(F.ws + WS_H2); int* list = (int*)(F.ws + WS_LIST); int* pos2 = (int*)(F.ws + WS_POS);
    unsigned* cnt = (unsigned*)(F.ws + WS_CTL) + CW_CNT;
    LAS int* hist = (LAS int*)F.lds; LAS int* rec = (LAS int*)(F.lds + 1024);
    LAS float* lgs = (LAS float*)(F.lds + 16384) + F.wave * 16 * 49;
    const float* g2n = F.norm2_g(); const float* brg = F.b_rg(); const float* bre = F.b_re();
    const int fr = F.lane & 15, fq = F.lane >> 4;
    if (F.tid < 64) hist[F.tid] = 0;
    __syncthreads();
    int nloc = 0;
    LAS float* smod = (LAS float*)(F.lds + 41472); int sb = -1;
    LAS f16* WTs = (LAS f16*)(F.lds + 49664);
    { const GAS f16* wsrc = (const GAS f16*)(F.ws + WS_WRT);
      for (int i = F.tid; i < MP_WROWS * 128; i += NTHR) { const int row = i >> 7, pc = i & 127;
          *(LAS u32x4*)(WTs + row * MP_WRS + 8 * pc) = row < MP_WROWS - 1 ? *(const GAS u32x4*)(wsrc + (size_t)row * DM + 8 * pc) : (u32x4){0u, 0u, 0u, 0u}; } }
    for (int tile0 = F.vcu * NWAVES; tile0 < T / 16; tile0 += NGW) {
        const int tile = tile0 + F.wave, row0 = tile * 16, b = (tile0 * 16) / SEQ;
        if (b != sb) { __syncthreads(); stage_mod(smod, g2n, mod + (size_t)b * 6144 + 3072, mod + (size_t)b * 6144 + 4096, F.tid); __syncthreads(); sb = b; }
        f32x4 acc[3];
        modproj_tile<3, true, MOE8>(F.ws + WS_X1, row0, smod, smod + 1024, WTs, h2, acc, F.lane, (const float*)(F.ws + WS_MLS));
        P5STAMP(2);
#pragma unroll
        for (int ct = 0; ct < 3; ++ct)
#pragma unroll
            for (int r = 0; r < 4; ++r) lgs[(4 * fq + r) * 49 + 16 * ct + fr] = acc[ct][r];
        LDS_WAIT(); asm volatile("" ::: "memory");
        if (F.lane < 16) {
            const int row = row0 + F.lane; const LAS float* lg = lgs + F.lane * 49;
            float gl[4];
#pragma unroll
            for (int q = 0; q < 4; ++q) gl[q] = lg[q] + brg[q];
            int gi = 0; float gm = gl[0];
#pragma unroll
            for (int q = 1; q < 4; ++q) if (gl[q] > gm) { gm = gl[q]; gi = q; }
            float gsum = 0.f;
#pragma unroll
            for (int q = 0; q < 4; ++q) gsum += __expf(gl[q] - gm);
            const float pg = 1.f / gsum;
            float el[8];
#pragma unroll
            for (int q = 0; q < 8; ++q) el[q] = lg[4 + 8 * gi + q] + bre[gi * 8 + q];
            int i1 = 0; float m1 = el[0];
#pragma unroll
            for (int q = 1; q < 8; ++q) if (el[q] > m1) { m1 = el[q]; i1 = q; }
            int i2 = -1; float m2 = -INFINITY;
#pragma unroll
            for (int q = 0; q < 8; ++q) if (q != i1 && el[q] > m2) { m2 = el[q]; i2 = q; }
            const float rr = __expf(m2 - m1), w1 = pg / (1.f + rr), w2 = pg * rr / (1.f + rr);
#pragma unroll
            for (int k = 0; k < 2; ++k) { const int e = gi * 8 + (k == 0 ? i1 : i2); const float w = k == 0 ? w1 : w2;
                const int rank = (int)__hip_atomic_fetch_add((LAS unsigned*)hist + e, 1u, __ATOMIC_RELAXED, __HIP_MEMORY_SCOPE_WORKGROUP);
                LAS int* rp = rec + (F.wave * 64 + 32 * nloc + 2 * F.lane + k) * 4; rp[0] = row; rp[1] = e; rp[2] = rank; rp[3] = __float_as_int(w); }
        }
        ++nloc;
        LDS_WAIT(); asm volatile("" ::: "memory");
    }
    __syncthreads();
    P5STAMP(3);
    if (F.tid < 32) hist[32 + F.tid] = (int)atomicAdd(cnt + 64 * F.tid, (unsigned)hist[F.tid]);
    __syncthreads();
    for (int i = F.lane; i < 32 * nloc; i += 64) { const LAS int* rp = rec + (F.wave * 64 + i) * 4; const int row = rp[0], e = rp[1], slot = hist[32 + e] + rp[2];
        list[2 * ((size_t)e * LISTCAP + slot)] = row; list[2 * ((size_t)e * LISTCAP + slot) + 1] = rp[3];
        pos2[2 * row + (i & 1)] = e * LISTCAP + slot; pos2[2 * T + 2 * row + (i & 1)] = rp[3]; }
    P5STAMP(4);
}

__device__ __forceinline__ void moe_tables(Frame F) {
    F.fresh();
    LAS int* tab = (LAS int*)(F.lds + TAB_OFF);
    const unsigned* cnt = (const unsigned*)(F.ws + WS_CTL) + CW_CNT;
    __syncthreads();
    if (F.tid < 32) tab[80 + F.tid] = (int)__hip_atomic_load(cnt + 64 * F.tid, RLX_AGENT);
    __syncthreads();
    if (F.tid < 64) {
        const int l = F.tid, c = l < 32 ? tab[80 + l] : 0, u = ((c + 255) >> 8) * 4;
        int iu = u, ir = c;
#pragma unroll
        for (int o = 1; o < 64; o <<= 1) { const int tu = __builtin_amdgcn_ds_bpermute((l - o) << 2, iu), tr = __builtin_amdgcn_ds_bpermute((l - o) << 2, ir); if (l >= o) { iu += tu; ir += tr; } }
        if (l <= 32) { tab[l] = iu - u; tab[40 + l] = ir - c; } }
    __syncthreads();
}

struct P8Row { unsigned ya[4], yb[4]; f16x4 xh[4]; };
__device__ __forceinline__ void p8_load(P8Row& R, const unsigned char* Y, const f16* x1h, const LAS int* tab, int row, int p0, int p1, int lane) {
    const size_t y0 = (size_t)(tab[40 + (p0 >> 15)] + (p0 & 32767)) * DM, y1 = (size_t)(tab[40 + (p1 >> 15)] + (p1 & 32767)) * DM;
#pragma unroll
    for (int j = 0; j < 4; ++j) { const int k0 = 4 * lane + 256 * j; R.ya[j] = *(const GAS unsigned*)(Y + y0 + k0); R.yb[j] = *(const GAS unsigned*)(Y + y1 + k0); R.xh[j] = *(const GAS f16x4*)((const GAS f16*)x1h + (size_t)row * X1P + k0); }
}
__device__ __forceinline__ void p8_row(const P8Row& R, float* out, const f32x4 (&g2v)[4], const f32x4 (&gfv)[4], int row, int lane, float w0, float w1) {
    f32x4 v[4]; float ss = 0.f;
#pragma unroll
    for (int j = 0; j < 4; ++j) { const f32x4 g = g2v[j];
        const auto a01 = __builtin_amdgcn_cvt_pk_f32_fp8((int)R.ya[j], false), a23 = __builtin_amdgcn_cvt_pk_f32_fp8((int)R.ya[j], true), b01 = __builtin_amdgcn_cvt_pk_f32_fp8((int)R.yb[j], false), b23 = __builtin_amdgcn_cvt_pk_f32_fp8((int)R.yb[j], true);
        f32x4 sv; sv.x = a01[0] * w0 + b01[0] * w1; sv.y = a01[1] * w0 + b01[1] * w1; sv.z = a23[0] * w0 + b23[0] * w1; sv.w = a23[1] * w0 + b23[1] * w1;
        v[j] = (f32x4){(float)R.xh[j][0], (float)R.xh[j][1], (float)R.xh[j][2], (float)R.xh[j][3]} + g * sv; ss += (v[j].x * v[j].x + v[j].y * v[j].y) + (v[j].z * v[j].z + v[j].w * v[j].w); }
    const float rstd = 1.f / sqrtf(wave_sum(ss) * (1.f / DM) + EPS);
    GAS f32x4* xr = (GAS f32x4*)(out + (size_t)row * DM) + lane;
#pragma unroll
    for (int j = 0; j < 4; ++j) xr[64 * j] = v[j] * rstd * gfv[j];
}
__device__ __forceinline__ void p8_final(Frame F) {
    F.fresh();
    const int gw = F.vcu * NWAVES + F.wave, NGW = F.G * NWAVES;
    const float* mod = (const float*)(F.ws + WS_MOD); const unsigned char* Y = (const unsigned char*)(F.ws + WS_Y); const int* pos2 = (const int*)(F.ws + WS_POS);
    const LAS int* tab = (const LAS int*)(F.lds + TAB_OFF);
    const float* gf = F.normf_g(); const f16* x1h = (const f16*)(F.ws + WS_X1);
    const int RPW = (T + NGW - 1) / NGW, r0 = gw * RPW, r1 = min(T, r0 + RPW);
    if (r0 >= r1) return;
    P8Row A, B, C, D;
    f32x4 gfv[4], g2v[4]; int gb = r0 / SEQ;
#pragma unroll
    for (int j = 0; j < 4; ++j) { const int k0 = 4 * F.lane + 256 * j; gfv[j] = *(const GAS f32x4*)((const GAS float*)gf + k0); g2v[j] = *(const GAS f32x4*)((const GAS float*)mod + (size_t)gb * 6144 + 5120 + k0); }
#define P8_G2(r_) do { if ((r_) / SEQ != gb) { gb = (r_) / SEQ; _Pragma("unroll") for (int j = 0; j < 4; ++j) g2v[j] = *(const GAS f32x4*)((const GAS float*)mod + (size_t)gb * 6144 + 5120 + 4 * F.lane + 256 * j); } } while (0)
    for (int c0 = r0; c0 < r1; c0 += 32) { const int c1 = (c0 + 32 < r1) ? c0 + 32 : r1;
        const int pp = (F.lane < 2 * (c1 - c0)) ? ((const GAS int*)pos2)[2 * c0 + F.lane] : 0;
        const int pw = (F.lane < 2 * (c1 - c0)) ? ((const GAS int*)pos2)[2 * T + 2 * c0 + F.lane] : 0;
#define P8_W(r_, k_) __int_as_float(__builtin_amdgcn_readlane(pw, 2 * ((r_) - c0) + (k_)))
#define P8_POS(r_, k_) __builtin_amdgcn_readlane(pp, 2 * ((r_) - c0) + (k_))
#define P8_LD(R_, r_) p8_load(R_, Y, x1h, tab, (r_), P8_POS((r_), 0), P8_POS((r_), 1), F.lane)
#define P8_RW(R_, r_) do { P8_G2(r_); p8_row(R_, F.out, g2v, gfv, (r_), F.lane, P8_W((r_), 0), P8_W((r_), 1)); } while (0)
        P8_LD(A, c0); if (c0 + 1 < c1) P8_LD(B, c0 + 1); if (c0 + 2 < c1) P8_LD(C, c0 + 2);
        for (int row = c0; row < c1; row += 4) {
            if (row + 3 < c1) P8_LD(D, row + 3);
            P8_RW(A, row);
            if (row + 1 >= c1) break;
            if (row + 4 < c1) P8_LD(A, row + 4);
            P8_RW(B, row + 1);
            if (row + 2 >= c1) break;
            if (row + 5 < c1) P8_LD(B, row + 5);
            P8_RW(C, row + 2);
            if (row + 3 >= c1) break;
            if (row + 6 < c1) P8_LD(C, row + 6);
            P8_RW(D, row + 3);
        }
#undef P8_LD
#undef P8_RW
#undef P8_POS
#undef P8_W
    }
#undef P8_G2
}

#ifdef PROBE_K
#define PROBE_PH ((PROBE_K == 33 || PROBE_K == 34 || (PROBE_K >= 50 && PROBE_K <= 53)) ? 3 : (PROBE_K >= 60 && PROBE_K <= 63) ? 5 : (PROBE_K == 40) ? 100 : (PROBE_K == 41) ? 101 : PROBE_K)
#define PSTAMP(k) do { if ((k) == PROBE_PH || (k) == PROBE_PH + 1) { const unsigned long long t_ = __builtin_amdgcn_s_memrealtime(); if (F.tid == 0) ((LAS unsigned long long*)(F.lds + TAB_OFF + 768))[(k) - PROBE_PH] = t_; } } while (0)
#else
#define PSTAMP(k) do {} while (0)
#endif
__global__ void __launch_bounds__(NTHR, 2) fwd_kernel(Args args) {
    extern __shared__ __attribute__((aligned(16))) unsigned char lds_raw[];
    Frame F;
    F.lds = (LAS unsigned char*)lds_raw;
    F.w0 = __builtin_amdgcn_readfirstlane((int)threadIdx.x >> 6); F.fresh();
    F.G = gridDim.x; { const int bx = blockIdx.x; F.vcu = (F.G % 8 == 0) ? (bx % 8) * (F.G / 8) + bx / 8 : bx; }
    F.out = args.out; F.ws = args.ws;
    for (int u = F.tid; u < (LDS_BYTES - LDSCTL_OFF) / 4; u += NTHR) ((LAS unsigned*)(F.lds + LDSCTL_OFF))[u] = 0u;
    __syncthreads();
    if (F.tid < 44) ((LAS unsigned*)(F.lds + ARGS_OFF))[F.tid] = ((const __attribute__((address_space(4))) unsigned*)__builtin_amdgcn_kernarg_segment_ptr())[F.tid];
    __syncthreads();
    unsigned* ctl = (unsigned*)(F.ws + WS_CTL);
    XcdBarrier bar = xcd_barrier_post(ctl + CW_BAR, (volatile LAS unsigned*)(F.lds + MISC_OFF) + 8, F.tid == 0);

    PSTAMP(0);
    PSTAMP(100);
    p0_prologue(F);
    __syncthreads();
    PSTAMP(101);
    p1_weights(F);
    PSTAMP(102);
    xcd_barrier(bar, F.w0);
    PSTAMP(1);
    p1_rows(F);
    xcd_barrier(bar, F.w0);
    PSTAMP(2);
    { pg8::DenseSched S; S.init(T, NPROJ, 1024, F.G, (int)blockIdx.x, true);
      pg8::EpiProj E{(f16*)(F.ws + WS_PROJ), (const float*)(F.ws + WS_COS), (const float*)(F.ws + WS_SIN), (float*)(F.ws + WS_CTL + CTL_KMEAN)};
      pg8::gemm_phase<true, false>(F.lds, (const char*)(F.ws + WS_A), (const char*)(F.ws + WS_WIN), 1024, S, E, F.w0); }
    xcd_barrier(bar, F.w0);
    PSTAMP(3);
    p3_mixers(F);
    p3_weights(F);
    xcd_barrier(bar, F.w0);
    PSTAMP(4);
    { pg8::DenseSched S; S.init(T, DM, 1024, F.G, (int)blockIdx.x, false);
      pg8::EpiOut E{F.x(), (const float*)(F.ws + WS_MOD), (f16*)(F.ws + WS_X1), (float*)(F.ws + WS_MLS)};
      pg8::gemm_phase<false, false>(F.lds, (const char*)(F.ws + WS_A), (const char*)(F.ws + WS_WOUT), 1024, S, E, F.w0); }
    xcd_barrier(bar, F.w0);
    PSTAMP(5);
    p5_route(F);
    xcd_barrier(bar, F.w0);
    PSTAMP(6);
    moe_tables(F);
    { pg8::MoeSched S{(const LAS int*)(F.lds + TAB_OFF), F.G, F.vcu, 1024, true, (const int*)(F.ws + WS_LIST), (unsigned*)(F.ws + WS_CTL) + CW_MT};
      pg8::EpiMoe1 E{(unsigned char*)(F.ws + WS_HID)};
      pg8::gemm_phase<false, MOE8>(F.lds, (const char*)(F.ws + WS_H2), (const char*)(F.ws + WS_W1), 1024, S, E, F.w0); }
    PSTAMP(7);
    { pg8::MoeSched S{(const LAS int*)(F.lds + TAB_OFF), F.G, F.G - 1 - F.vcu, 512, false, (const int*)(F.ws + WS_LIST), (unsigned*)(F.ws + WS_CTL) + CW_MT};
      pg8::EpiMoe2 E{(unsigned char*)(F.ws + WS_Y), (const int*)(F.ws + WS_LIST)};
      pg8::gemm_phase<false, MOE8>(F.lds, (const char*)(F.ws + WS_HID), (const char*)(F.ws + WS_W2), 512, S, E, F.w0); }
    xcd_barrier(bar, F.w0);
    PSTAMP(8);
    p8_final(F);
#ifdef PROBE_K
    __syncthreads(); PSTAMP(9); __syncthreads();
    if (blockIdx.x == 0) { unsigned long long tp0 = ((LAS unsigned long long*)(F.lds + TAB_OFF + 768))[0], tp1 = ((LAS unsigned long long*)(F.lds + TAB_OFF + 768))[1];
#if PROBE_K >= 50
        { const LAS unsigned long long* st_ = (const LAS unsigned long long*)(F.lds + TAB_OFF + 768);
          constexpr int PB_ = PROBE_K >= 60 ? 60 : 50;
          const unsigned long long a_ = PROBE_K == PB_ ? st_[0] : st_[PROBE_K - PB_ + 1], b_ = PROBE_K == PB_ + 3 ? st_[1] : st_[PROBE_K - PB_ + 2]; tp0 = a_; tp1 = b_; }
#endif
 const unsigned long long te = __builtin_amdgcn_s_memrealtime(); while (__builtin_amdgcn_s_memrealtime() - te < 8ull * (tp1 - tp0)) __builtin_amdgcn_s_sleep(20); }
#endif
}

extern "C" void kernel_launch(void* const* d_in, const int* in_sizes, int n_in, void* d_out, int out_size, void* d_ws, size_t ws_size, hipStream_t stream) {
    static int grid = 0;
    if (grid == 0) {
        if (n_in != 22 || out_size != T * DM || ws_size < WS_END) { fprintf(stderr, "kernel_launch: unexpected problem (n_in %d, out %d, ws %zu)\n", n_in, out_size, ws_size); grid = -1; return; }
        int dev = 0, cus = 0, per_cu = 0;
        if (hipGetDevice(&dev) != hipSuccess || hipDeviceGetAttribute(&cus, hipDeviceAttributeMultiprocessorCount, dev) != hipSuccess) { grid = -1; return; }
        if (hipFuncSetAttribute((const void*)fwd_kernel, hipFuncAttributeMaxDynamicSharedMemorySize, LDS_BYTES) != hipSuccess) { fprintf(stderr, "kernel_launch: hipFuncSetAttribute failed\n"); grid = -1; return; }
        if (hipOccupancyMaxActiveBlocksPerMultiprocessor(&per_cu, (const void*)fwd_kernel, NTHR, LDS_BYTES) != hipSuccess || per_cu < 1) fprintf(stderr, "kernel_launch: occupancy query says %d\n", per_cu);
        (void)hipGetLastError();
        grid = cus;
    }
    if (grid < 0) return;
    (void)hipMemsetAsync((char*)d_ws + WS_CTL, 0, CTL_ZERO_BYTES, stream);
    Args a{};
    for (int i = 0; i < 22; ++i) a.in[i] = d_in[i];
    a.out = (float*)d_out; a.ws = (unsigned char*)d_ws;
    hipLaunchKernelGGL(fwd_kernel, dim3(grid), dim3(NTHR), LDS_BYTES, stream, a);
}
```
